# Optimizing an MI355X kernel written in HIP

```python
import math
import jax, jax.numpy as jnp
from jax import lax
import numpy as np

D_MODEL = 1024
BATCH = 4
SEQ = 8192
DEPTH = 1

PLE_DIM = 256
CONV_WIDTH = 4
RG_WIDTH = D_MODEL // 2
RG_BLOCKS = 8
RG_BLOCK_DIM = RG_WIDTH // RG_BLOCKS
RG_C = 8.0
GDN_HEADS = 4
GDN_DK = 128
GDN_DV = 128
GDN_QK_WIDTH = GDN_HEADS * GDN_DK
GDN_V_WIDTH = GDN_HEADS * GDN_DV
GDN_CHUNK = 64
MIX_WIDTH = RG_WIDTH + GDN_V_WIDTH
IN_COLS = 2 * RG_WIDTH + 2 * GDN_QK_WIDTH + 2 * GDN_V_WIDTH + 2 * GDN_HEADS
D_FF = -(-8 * D_MODEL // (3 * 256)) * 256
EPS = 1e-6

kernel_name = "hybrid_rglru_gdeltanet_block"


def rmsnorm(x, w):
    xf = x.astype(jnp.float32)
    var = jnp.mean(xf * xf, axis=-1, keepdims=True)
    return (xf * lax.rsqrt(var + EPS) * w.astype(jnp.float32)).astype(x.dtype)


def causal_dwconv(u, w):
    k_taps = w.shape[0]
    s = u.shape[1]
    up = jnp.pad(u, ((0, 0), (k_taps - 1, 0), (0, 0)))
    out = up[:, 0:s] * w[0]
    for j in range(1, k_taps):
        out = out + up[:, j:j + s] * w[j]
    return out


def l2norm(t):
    return t * lax.rsqrt(jnp.sum(t * t, axis=-1, keepdims=True) + EPS)


def rglru_group(xa, ga, conv_w, conv_b, wx, bx, wa, ba, lam):
    b, s, _ = xa.shape
    u = causal_dwconv(xa.astype(jnp.float32), conv_w.astype(jnp.float32)) + conv_b.astype(jnp.float32)
    uh = u.reshape(b, s, RG_BLOCKS, RG_BLOCK_DIM)
    gate_x = jax.nn.sigmoid(jnp.einsum('bshi,hij->bshj', uh, wx.astype(jnp.float32)).reshape(b, s, RG_WIDTH) + bx)
    gate_a = jax.nn.sigmoid(jnp.einsum('bshi,hij->bshj', uh, wa.astype(jnp.float32)).reshape(b, s, RG_WIDTH) + ba)
    log_a = -RG_C * gate_a * jax.nn.softplus(-lam.astype(jnp.float32))
    a = jnp.exp(log_a)
    mult = jnp.sqrt(jnp.maximum(-jnp.expm1(2.0 * log_a), 0.0))
    first = (jnp.arange(s) == 0)[None, :, None]
    mult = jnp.where(first, 1.0, mult)
    bt = u * gate_x * mult

    def combine(l, r):
        return (l[0] * r[0], r[0] * l[1] + r[1])

    _, h = lax.associative_scan(combine, (a, bt), axis=1)
    return h * jax.nn.gelu(ga.astype(jnp.float32))


def gated_delta_rule_chunked(q, k, v, g, beta):
    b, s, h, dk = q.shape
    dv = v.shape[-1]
    n = s // GDN_CHUNK

    def chunks(t):
        t = t.reshape((b, n, GDN_CHUNK, h) + t.shape[3:])
        return jnp.moveaxis(t, 3, 1)

    q = chunks(q * (dk ** -0.5))
    k = chunks(k)
    v = chunks(v)
    beta = chunks(beta)
    gc = jnp.cumsum(chunks(g), axis=-1)
    idx = jnp.arange(GDN_CHUNK)
    causal = idx[:, None] >= idx[None, :]
    strict = idx[:, None] > idx[None, :]
    diff = gc[..., :, None] - gc[..., None, :]
    decay = jnp.where(causal, jnp.exp(jnp.where(causal, diff, 0.0)), 0.0)
    kb = k * beta[..., None]
    kk = jnp.einsum('bhnid,bhnjd->bhnij', kb, k) * decay
    a_mat = jnp.where(strict, kk, 0.0) + jnp.eye(GDN_CHUNK, dtype=kk.dtype)
    u = lax.linalg.triangular_solve(a_mat, v * beta[..., None], left_side=True, lower=True, unit_diagonal=True)
    w = lax.linalg.triangular_solve(a_mat, kb * jnp.exp(gc)[..., None], left_side=True, lower=True, unit_diagonal=True)
    qk = jnp.einsum('bhnid,bhnjd->bhnij', q, k) * decay
    q_dec = q * jnp.exp(gc)[..., None]
    k_dec = k * jnp.exp(gc[..., -1:] - gc)[..., None]
    g_tot = jnp.exp(gc[..., -1])

    def step(state, inp):
        w_n, u_n, qd_n, kd_n, qk_n, gt_n = inp
        v_new = u_n - jnp.einsum('bhcd,bhde->bhce', w_n, state)
        o_n = jnp.einsum('bhcd,bhde->bhce', qd_n, state) + jnp.einsum('bhij,bhje->bhie', qk_n, v_new)
        state = state * gt_n[..., None, None] + jnp.einsum('bhcd,bhce->bhde', kd_n, v_new)
        return state, o_n

    xs = (jnp.moveaxis(w, 2, 0), jnp.moveaxis(u, 2, 0), jnp.moveaxis(q_dec, 2, 0),
          jnp.moveaxis(k_dec, 2, 0), jnp.moveaxis(qk, 2, 0), jnp.moveaxis(g_tot, 2, 0))
    state0 = jnp.zeros((b, h, dk, dv), jnp.float32)
    _, o = lax.scan(step, state0, xs)
    return jnp.transpose(o, (1, 0, 3, 2, 4)).reshape(b, s, h, dv)


def gdn_group(q, k, v, z, b_logit, a_logit, conv_w, a_log, dt_bias, norm_w):
    b, s, _ = q.shape
    qkv = jnp.concatenate([q, k, v], axis=-1).astype(jnp.float32)
    qkv = jax.nn.silu(causal_dwconv(qkv, conv_w.astype(jnp.float32)))
    q, k, v = jnp.split(qkv, [GDN_QK_WIDTH, 2 * GDN_QK_WIDTH], axis=-1)
    q = l2norm(q.reshape(b, s, GDN_HEADS, GDN_DK))
    k = l2norm(k.reshape(b, s, GDN_HEADS, GDN_DK))
    v = v.reshape(b, s, GDN_HEADS, GDN_DV)
    beta = jax.nn.sigmoid(b_logit.astype(jnp.float32))
    g = -jnp.exp(a_log.astype(jnp.float32)) * jax.nn.softplus(a_logit.astype(jnp.float32) + dt_bias)
    o = gated_delta_rule_chunked(q, k, v, g, beta)
    var = jnp.mean(o * o, axis=-1, keepdims=True)
    zh = z.astype(jnp.float32).reshape(b, s, GDN_HEADS, GDN_DV)
    o = o * lax.rsqrt(var + EPS) * norm_w.astype(jnp.float32) * jax.nn.silu(zh)
    return o.reshape(b, s, GDN_V_WIDTH)


def setup_inputs(seed: int = 0) -> dict:
    key = jax.random.key(seed)
    ks = jax.random.split(key, 26)
    f32 = jnp.float32
    nrm = lambda k, shape, scale: jax.random.normal(k, shape, f32) * scale
    gain = lambda k, shape: 1.0 + 0.02 * jax.random.normal(k, shape, f32)
    L = DEPTH
    x = jax.random.normal(ks[0], (BATCH, SEQ, D_MODEL), f32)
    p = jax.random.normal(ks[1], (DEPTH, BATCH, SEQ, PLE_DIM), f32)
    a_c = jax.random.uniform(ks[9], (L, RG_WIDTH), f32, 0.9, 0.999)
    sig = a_c ** (1.0 / RG_C)
    rg_lambda = jnp.log(sig) - jnp.log1p(-sig)
    gdn_a_log = jnp.log(jax.random.uniform(ks[11], (L, GDN_HEADS), f32, 1.0, 16.0))
    dt = jnp.exp(jax.random.uniform(ks[12], (L, GDN_HEADS), f32, math.log(1e-3), math.log(1e-1)))
    gdn_dt_bias = dt + jnp.log(-jnp.expm1(-dt))
    return {
        "x": x,
        "p": p,
        "norm_mix_w": gain(ks[2], (L, D_MODEL)),
        "w_in": nrm(ks[3], (L, D_MODEL, IN_COLS), D_MODEL ** -0.5),
        "conv_a_w": nrm(ks[4], (L, CONV_WIDTH, RG_WIDTH), CONV_WIDTH ** -0.5),
        "conv_a_b": nrm(ks[5], (L, RG_WIDTH), 0.01),
        "rg_wx": nrm(ks[6], (L, RG_BLOCKS, RG_BLOCK_DIM, RG_BLOCK_DIM), RG_BLOCK_DIM ** -0.5),
        "rg_bx": nrm(ks[7], (L, RG_WIDTH), 0.01),
        "rg_wa": nrm(ks[8], (L, RG_BLOCKS, RG_BLOCK_DIM, RG_BLOCK_DIM), RG_BLOCK_DIM ** -0.5),
        "rg_ba": nrm(ks[10], (L, RG_WIDTH), 0.01),
        "rg_lambda": rg_lambda,
        "conv_qkv_w": nrm(ks[13], (L, CONV_WIDTH, 2 * GDN_QK_WIDTH + GDN_V_WIDTH), CONV_WIDTH ** -0.5),
        "gdn_a_log": gdn_a_log,
        "gdn_dt_bias": gdn_dt_bias,
        "gdn_norm_w": gain(ks[14], (L, GDN_DV)),
        "w_out": nrm(ks[15], (L, MIX_WIDTH, D_MODEL), MIX_WIDTH ** -0.5),
        "norm_ffn_w": gain(ks[16], (L, D_MODEL)),
        "w_gate": nrm(ks[17], (L, D_MODEL, D_FF), D_MODEL ** -0.5),
        "w_up": nrm(ks[18], (L, D_MODEL, D_FF), D_MODEL ** -0.5),
        "w_down": nrm(ks[19], (L, D_FF, D_MODEL), D_FF ** -0.5),
        "norm_ple_w": gain(ks[20], (L, D_MODEL)),
        "w_ple_gate": nrm(ks[21], (L, D_MODEL, D_MODEL), D_MODEL ** -0.5),
        "b_ple_gate": nrm(ks[22], (L, D_MODEL), 0.01),
        "w_ple_proj": nrm(ks[23], (L, PLE_DIM, D_MODEL), PLE_DIM ** -0.5),
        "norm_final_w": gain(ks[24], (D_MODEL,)),
    }


def reference(x, p, norm_mix_w, w_in, conv_a_w, conv_a_b, rg_wx, rg_bx, rg_wa, rg_ba, rg_lambda,
              conv_qkv_w, gdn_a_log, gdn_dt_bias, gdn_norm_w, w_out, norm_ffn_w, w_gate, w_up, w_down,
              norm_ple_w, w_ple_gate, b_ple_gate, w_ple_proj, norm_final_w):
    splits = [RG_WIDTH, 2 * RG_WIDTH,
              2 * RG_WIDTH + GDN_QK_WIDTH, 2 * RG_WIDTH + 2 * GDN_QK_WIDTH,
              2 * RG_WIDTH + 2 * GDN_QK_WIDTH + GDN_V_WIDTH,
              2 * RG_WIDTH + 2 * GDN_QK_WIDTH + 2 * GDN_V_WIDTH,
              2 * RG_WIDTH + 2 * GDN_QK_WIDTH + 2 * GDN_V_WIDTH + GDN_HEADS]
    for i in range(DEPTH):
        h = rmsnorm(x, norm_mix_w[i])
        proj = jnp.einsum('bsd,dc->bsc', h, w_in[i])
        xa, ga, q, k, v, z, b_logit, a_logit = jnp.split(proj, splits, axis=-1)
        ya = rglru_group(xa, ga, conv_a_w[i], conv_a_b[i], rg_wx[i], rg_bx[i], rg_wa[i], rg_ba[i], rg_lambda[i])
        yb = gdn_group(q, k, v, z, b_logit, a_logit, conv_qkv_w[i], gdn_a_log[i], gdn_dt_bias[i], gdn_norm_w[i])
        y = jnp.concatenate([ya, yb], axis=-1).astype(x.dtype)
        x = x + jnp.einsum('bsm,md->bsd', y, w_out[i])
        h = rmsnorm(x, norm_ffn_w[i])
        ff = jax.nn.silu(jnp.einsum('bsd,df->bsf', h, w_gate[i])) * jnp.einsum('bsd,df->bsf', h, w_up[i])
        x = x + jnp.einsum('bsf,fd->bsd', ff, w_down[i])
        h = rmsnorm(x, norm_ple_w[i])
        gate = jax.nn.sigmoid(jnp.einsum('bsd,de->bse', h, w_ple_gate[i]) + b_ple_gate[i])
        x = x + gate * jnp.einsum('bsp,pd->bsd', p[i], w_ple_proj[i])
    return rmsnorm(x, norm_final_w)
```

```cpp
#include <hip/hip_runtime.h>
#include <hip/hip_cooperative_groups.h>
#include <cstdio>
#include <cstdint>
namespace cg = cooperative_groups;
namespace pg8 {
#define PG8_LAS __attribute__((address_space(3)))
typedef unsigned short bf16_t;
typedef short bf16x8 __attribute__((ext_vector_type(8)));
typedef float f32x4 __attribute__((ext_vector_type(4)));
typedef unsigned u32x4 __attribute__((ext_vector_type(4)));
constexpr int BM = 256, BK = 64, HALF = 128, HTB = HALF * BK * 2  , STAGE_BYTES = 8 * HTB, NXCD = 8, WGM = 8;

__host__ __device__ __forceinline__ int lds_byte(int r, int c) { const int st = (r >> 4) * 2 + (c >> 5), rr = r & 15, cc = c & 31, ob = rr * 64 + cc * 2; return st * 1024 + (ob ^ (((ob >> 9) & 1) << 5)); }
__host__ __device__ __forceinline__ void stage_rc(int b, int& R, int& C) { const int st = b / 1024, sb = b % 1024, swz = sb ^ (((sb >> 9) & 1) << 5); R = (st >> 1) * 16 + swz / 64; C = (st & 1) * 32 + (swz % 64) / 2; }
__host__ __device__ __forceinline__ int perm32(int rho) { const int n = rho >> 4, i = rho & 15; return 8 * (i >> 2) + 4 * n + (i & 3); }

struct Unit { int pm, pn; };
struct Gemm { const bf16_t* A; const bf16_t* Bt; int M, N, K; };

struct StaticOrder {
    int nM, nN, nwg, G, c;
    __host__ __device__ void init(int M, int N, int G_, int c_) { nM = M / BM; nN = N / BM; nwg = nM * nN; G = G_; c = c_; }
    __host__ __device__ bool next(int i, Unit& u) const {
        const long L = (long)i * G + c; if (L >= nwg) return false;
        int wgid = (int)L; { const int q = nwg / NXCD, r = nwg % NXCD, xcd = wgid % NXCD, off = wgid / NXCD; wgid = (xcd < r ? xcd * (q + 1) : r * (q + 1) + (xcd - r) * q) + off; }
        const int nig = WGM * nN, gid = wgid / nig, fm = gid * WGM, gsz = (nM - fm) < WGM ? (nM - fm) : WGM;
        u.pm = fm + ((wgid % nig) % gsz); u.pn = (wgid % nig) / gsz; return true;
    }
    __device__ __forceinline__ void a_ready(const Unit&) const {}
    __device__ __forceinline__ void done(const Unit&) const {}
};
__device__ __forceinline__ unsigned cvt_pk_bf16(float lo, float hi) { unsigned r; asm volatile("v_cvt_pk_bf16_f32 %0, %1, %2" : "=v"(r) : "v"(lo), "v"(hi)); return r; }
typedef float f32x2 __attribute__((ext_vector_type(2)));
template <class Epi, class Sched, bool STAMP = false>
__device__ __forceinline__ void gemm_phase(PG8_LAS unsigned char* lds, const Gemm g, const Sched& S, const Epi& E, unsigned long long* stamps) {
    const int tid = threadIdx.x, wid = __builtin_amdgcn_readfirstlane(tid >> 6), lane = tid & 63, wr = wid >> 2, wc = wid & 3, fr = lane & 15, fq = lane >> 4;
    const int K = g.K, nt = K / BK;
    int ts_lo = 0, ts_hi = 0, nts = 0; const unsigned long long rt_entry = STAMP ? (unsigned long long)wall_clock64() : 0ull;
#define PG8_STAMP() do { if (STAMP && wid == 0 && nts < 64) { const unsigned long long _c = (unsigned long long)clock64(); \
        ts_lo = (lane == nts) ? (int)(unsigned)_c : ts_lo; ts_hi = (lane == nts) ? (int)(unsigned)(_c >> 32) : ts_hi; ++nts; } } while (0)
    PG8_STAMP();
    unsigned voffA[2], voffB[2];
#pragma unroll
    for (int i = 0; i < 2; ++i) { int R, C; stage_rc(tid * 16 + i * 8192, R, C); const int Rb = Epi::PERM ? ((R & ~31) + perm32(R & 31)) : R;
        voffA[i] = (unsigned)(R * K + C) * 2u; voffB[i] = (unsigned)(Rb * K + C) * 2u; }
    const size_t kstep = (size_t)(BK * 2);
    const size_t hstep = (size_t)HALF * K * 2;
    const size_t tstep = 2 * hstep;
    const unsigned ldsw = (unsigned)wid * 1024u;
    const int aoff = lds_byte(wr * 64 + fr, fq * 8), boff = lds_byte(wc * 32 + fr, fq * 8);
#define PG8_SA(b, h) (((b) * 2 + (h)) * HTB)
#define PG8_SB(b, h) ((4 + (b) * 2 + (h)) * HTB)
#define PG8_STAGE(bufoff, gbase, voff) do { _Pragma("unroll") for (int _i = 0; _i < 2; ++_i) \
        __builtin_amdgcn_global_load_lds((const unsigned*)((const char*)(gbase) + (voff)[_i]), (PG8_LAS unsigned*)(lds + (bufoff) + ldsw + _i * 8192), 16, 0, 0); } while (0)
#define PG8_LDA(dst, b, h) do { _Pragma("unroll") for (int m = 0; m < 4; ++m) _Pragma("unroll") for (int k = 0; k < 2; ++k) dst[m][k] = *(const PG8_LAS bf16x8*)(lds + PG8_SA(b, h) + aoff + m * 2048 + k * 1024); } while (0)
#define PG8_LDB(dst, b, h) do { _Pragma("unroll") for (int n = 0; n < 2; ++n) _Pragma("unroll") for (int k = 0; k < 2; ++k) dst[n][k] = *(const PG8_LAS bf16x8*)(lds + PG8_SB(b, h) + boff + n * 2048 + k * 1024); } while (0)
#define PG8_MMA(ai, bj, At, Bt) do { __builtin_amdgcn_s_setprio(1); _Pragma("unroll") for (int m = 0; m < 4; ++m) _Pragma("unroll") for (int n = 0; n < 2; ++n) _Pragma("unroll") for (int k = 0; k < 2; ++k) \
        acc[ai][bj][m][n] = __builtin_amdgcn_mfma_f32_16x16x32_bf16(Bt[n][k], At[m][k], acc[ai][bj][m][n], 0, 0, 0); __builtin_amdgcn_s_setprio(0); } while (0)
#define PG8_WAIT_V(n) asm volatile("s_waitcnt vmcnt(" #n ")" ::: "memory")
#define PG8_WAIT_L(n) asm volatile("s_waitcnt lgkmcnt(" #n ")" ::: "memory")
#define PG8_BAR __builtin_amdgcn_s_barrier()
#define PG8_SCHED __builtin_amdgcn_sched_barrier(0)
    Unit cur, nxt; int ui = 0;
    if (!S.next(0, cur)) return;
    f32x4 acc[2][2][4][2];
#pragma unroll
    for (int a = 0; a < 2; ++a)
#pragma unroll
        for (int b = 0; b < 2; ++b)
#pragma unroll
            for (int m = 0; m < 4; ++m)
#pragma unroll
                for (int n = 0; n < 2; ++n) acc[a][b][m][n] = (f32x4){0.f, 0.f, 0.f, 0.f};
    bf16x8 At[4][2], B0[2][2], B1[2][2];
    const char* cA = (const char*)g.A + (size_t)cur.pm * tstep; const char* cB = (const char*)g.Bt + (size_t)cur.pn * tstep;
    S.a_ready(cur);
    PG8_STAGE(PG8_SB(0, 0), cB, voffB); PG8_STAGE(PG8_SA(0, 0), cA, voffA); PG8_STAGE(PG8_SB(0, 1), cB + hstep, voffB); PG8_STAGE(PG8_SA(0, 1), cA + hstep, voffA);
    if (wr == 1) PG8_BAR;
    PG8_WAIT_V(4); PG8_BAR;
    PG8_STAGE(PG8_SB(1, 0), cB + kstep, voffB); PG8_STAGE(PG8_SA(1, 0), cA + kstep, voffA); PG8_STAGE(PG8_SB(1, 1), cB + hstep + kstep, voffB);
    PG8_WAIT_V(6); PG8_BAR;
    PG8_STAMP();
    for (;;) {
        const bool has_next = S.next(ui + 1, nxt);
        const char* nA = has_next ? (const char*)g.A + (size_t)nxt.pm * tstep : cA; const char* nB = has_next ? (const char*)g.Bt + (size_t)nxt.pn * tstep : cB;
        for (int t = 0; t < nt; t += 2) {
            const bool last = (t == nt - 2);
            const char* a1 = cA + (size_t)(t + 1) * kstep;
            const char* a2 = last ? nA : cA + (size_t)(t + 2) * kstep; const char* b2 = last ? nB : cB + (size_t)(t + 2) * kstep;
            const char* a3 = a2 + kstep; const char* b3 = b2 + kstep;
            if (last && has_next) S.a_ready(nxt);
            PG8_LDB(B0, 0, 0); PG8_SCHED; PG8_LDA(At, 0, 0); PG8_STAGE(PG8_SA(1, 1), a1 + hstep, voffA);
            PG8_WAIT_L(8); PG8_BAR; PG8_WAIT_L(0); PG8_MMA(0, 0, At, B0); PG8_BAR; PG8_SCHED;
            PG8_LDB(B1, 0, 1); PG8_STAGE(PG8_SB(0, 0), b2, voffB);
            PG8_BAR; PG8_WAIT_L(0); PG8_MMA(0, 1, At, B1); PG8_BAR;
            PG8_LDA(At, 0, 1); PG8_STAGE(PG8_SA(0, 0), a2, voffA);
            PG8_BAR; PG8_WAIT_L(0); PG8_MMA(1, 0, At, B0); PG8_BAR; PG8_SCHED;
            PG8_STAGE(PG8_SB(0, 1), b2 + hstep, voffB);
            PG8_WAIT_V(6); PG8_BAR; PG8_MMA(1, 1, At, B1); PG8_BAR;
            PG8_LDB(B0, 1, 0); PG8_SCHED; PG8_LDA(At, 1, 0); PG8_STAGE(PG8_SA(0, 1), a2 + hstep, voffA);
            PG8_WAIT_L(8); PG8_BAR; PG8_WAIT_L(0); PG8_MMA(0, 0, At, B0); PG8_BAR; PG8_SCHED;
            PG8_LDB(B1, 1, 1); PG8_STAGE(PG8_SB(1, 0), b3, voffB);
            PG8_BAR; PG8_WAIT_L(0); PG8_MMA(0, 1, At, B1); PG8_BAR;
            PG8_LDA(At, 1, 1); PG8_STAGE(PG8_SA(1, 0), a3, voffA);
            PG8_BAR; PG8_WAIT_L(0); PG8_MMA(1, 0, At, B0); PG8_BAR; PG8_SCHED;
            PG8_STAGE(PG8_SB(1, 1), b3 + hstep, voffB);
            PG8_WAIT_V(6); PG8_BAR; PG8_MMA(1, 1, At, B1); PG8_BAR;
        }
        PG8_STAMP();
        if constexpr (!Epi::AFTER_DRAIN) { E(acc, cur, wr, wc, fr, fq); S.done(cur); }
        PG8_STAMP();
        if (!has_next) break;
#pragma unroll
        for (int a = 0; a < 2; ++a)
#pragma unroll
            for (int b = 0; b < 2; ++b)
#pragma unroll
                for (int m = 0; m < 4; ++m)
#pragma unroll
                    for (int n = 0; n < 2; ++n) acc[a][b][m][n] = (f32x4){0.f, 0.f, 0.f, 0.f};
        cur = nxt; cA = nA; cB = nB; ++ui;
    }
    PG8_WAIT_V(0);
    if (wr == 0) PG8_BAR;
    PG8_BAR;
    if constexpr (Epi::AFTER_DRAIN) { E.fused(acc, cur, wr, wc, fr, fq, lds, wid, lane); S.done(cur); }
    PG8_STAMP();
    if (STAMP && wid == 0) { stamps[lane] = lane < nts ? (((unsigned long long)(unsigned)ts_hi << 32) | (unsigned)ts_lo) : 0ull;
        if (lane == 62) stamps[62] = rt_entry; if (lane == 63) stamps[63] = (unsigned long long)wall_clock64(); }
#undef PG8_STAMP
#undef PG8_SA
#undef PG8_SB
#undef PG8_STAGE
#undef PG8_LDA
#undef PG8_LDB
#undef PG8_MMA
#undef PG8_WAIT_V
#undef PG8_WAIT_L
#undef PG8_BAR
#undef PG8_SCHED
}
}
using pg8::bf16_t; using pg8::f32x4; using pg8::u32x4; using pg8::bf16x8; using pg8::cvt_pk_bf16; using pg8::Unit; using pg8::HALF; using pg8::BM;
typedef unsigned u32x2 __attribute__((ext_vector_type(2)));
constexpr int T_ = 32768, D_ = 1024, SEQ_ = 8192, NB_ = 4, INC_ = 3080, PJ_ = 3072, FF_ = 2816, PLE_ = 256, NCH_ = 128;
constexpr float EPS_ = 1e-6f;
constexpr int NTHREADS = 512;
constexpr int LDS_BYTES = 144 * 1024;

constexpr size_t WS_WIN = 4096;
constexpr size_t WS_WOUT = WS_WIN + (size_t)PJ_ * D_ * 2;
constexpr size_t WS_WGU = WS_WOUT + (size_t)D_ * D_ * 2;
constexpr size_t WS_WD = WS_WGU + (size_t)2 * FF_ * D_ * 2;
constexpr size_t WS_WPG = WS_WD + (size_t)D_ * FF_ * 2;
constexpr size_t WS_WPP = WS_WPG + (size_t)D_ * D_ * 2;
constexpr size_t WS_LOGITS = WS_WPP + (size_t)D_ * PLE_ * 2;
constexpr size_t WS_PB = WS_LOGITS + (size_t)T_ * 8 * 4;
constexpr size_t WS_SSA = WS_PB + (size_t)T_ * PLE_ * 2;
constexpr size_t WS_SSB = WS_SSA + (size_t)T_ * 16 * 4;
constexpr size_t WS_PTOT = WS_SSB + (size_t)T_ * 16 * 4;
constexpr size_t WS_HEND = WS_PTOT + (size_t)NB_ * NCH_ * 512 * 4;
constexpr size_t WS_CARRY = WS_HEND + (size_t)NB_ * NCH_ * 512 * 4;
constexpr size_t WS_XB = WS_CARRY + (size_t)NB_ * NCH_ * 512 * 4;
constexpr size_t WS_PROJ = WS_XB + (size_t)T_ * D_ * 2;
constexpr size_t WS_R4 = WS_PROJ + (size_t)T_ * PJ_ * 2;
constexpr size_t WS_Y = WS_R4;
constexpr size_t WS_PP = WS_R4 + (size_t)T_ * D_ * 2;
constexpr size_t WS_END = WS_R4 + (size_t)160 * 1024 * 1024;

struct Params {
    const float* in[25];
    float* out; unsigned char* ws;
    int ph_lo, ph_hi;
};

__device__ __forceinline__ float bf2f(bf16_t b) { return __uint_as_float(((unsigned)b) << 16); }
__device__ __forceinline__ bf16_t f2bf(float f) { return (bf16_t)(cvt_pk_bf16(f, 0.f) & 0xffffu); }
__device__ __forceinline__ float sigmoidf_(float x) { return __builtin_amdgcn_rcpf(1.0f + __expf(-x)); }
__device__ __forceinline__ float siluf_(float x) { return x * __builtin_amdgcn_rcpf(1.0f + __expf(-x)); }
__device__ __forceinline__ float softplusf_(float x) { return fmaxf(x, 0.f) + log1pf(__expf(-fabsf(x))); }
__device__ __forceinline__ float gelu_tanhf_(float x) { const float u = 0.7978845608028654f * (x + 0.044715f * x * x * x); return x * __builtin_amdgcn_rcpf(1.0f + __expf(-2.0f * u)); }
__device__ __forceinline__ float rstd16(const float* ss, int r) {
    const f32x4 a = *(const f32x4*)(ss + (size_t)r * 16), b = *(const f32x4*)(ss + (size_t)r * 16 + 4), c = *(const f32x4*)(ss + (size_t)r * 16 + 8), d = *(const f32x4*)(ss + (size_t)r * 16 + 12);
    const float s = ((a[0] + a[1]) + (a[2] + a[3])) + ((b[0] + b[1]) + (b[2] + b[3])) + ((c[0] + c[1]) + (c[2] + c[3])) + ((d[0] + d[1]) + (d[2] + d[3]));
    return rsqrtf(s * (1.0f / 1024.0f) + EPS_);
}

struct EpiBf16Plain {
    static constexpr bool PERM = true, AFTER_DRAIN = false;
    bf16_t* O; int ldc;
    __device__ __forceinline__ void operator()(const f32x4 (&acc)[2][2][4][2], const Unit& u, int wr, int wc, int fr, int fq) const {
        int row0 = u.pm * BM + wr * 64 + fr; asm volatile("" : "+v"(row0)); const int col0 = u.pn * BM + wc * 32 + 8 * fq;
#pragma unroll
        for (int ai = 0; ai < 2; ++ai)
#pragma unroll
            for (int m = 0; m < 4; ++m) { bf16_t* rowp = O + (size_t)(row0 + ai * HALF + m * 16) * ldc + col0;
#pragma unroll
                for (int bj = 0; bj < 2; ++bj) { const f32x4 v0 = acc[ai][bj][m][0], v1 = acc[ai][bj][m][1]; u32x4 w; w.x = cvt_pk_bf16(v0[0], v0[1]); w.y = cvt_pk_bf16(v0[2], v0[3]); w.z = cvt_pk_bf16(v1[0], v1[1]); w.w = cvt_pk_bf16(v1[2], v1[3]);
                    *(u32x4*)(rowp + bj * HALF) = w; } }
    }
};
struct EpiResid {
    static constexpr bool PERM = false, AFTER_DRAIN = false;
    const float* res; float* out; bf16_t* xb; float* ss;
    __device__ __forceinline__ void operator()(const f32x4 (&acc)[2][2][4][2], const Unit& u, int wr, int wc, int fr, int fq) const {
        int row0 = u.pm * BM + wr * 64 + fr; asm volatile("" : "+v"(row0)); const int col0 = u.pn * BM + wc * 32 + 4 * fq;
#pragma unroll
        for (int ai = 0; ai < 2; ++ai)
#pragma unroll
            for (int m = 0; m < 4; ++m) { const int r = row0 + ai * HALF + m * 16; const size_t off = (size_t)r * D_ + col0; float s = 0.f;
#pragma unroll
                for (int bj = 0; bj < 2; ++bj)
#pragma unroll
                    for (int n = 0; n < 2; ++n) { const size_t c = off + bj * HALF + n * 16; const f32x4 v = *(const f32x4*)(res + c) + acc[ai][bj][m][n]; *(f32x4*)(out + c) = v;
                        s += (v[0] * v[0] + v[1] * v[1]) + (v[2] * v[2] + v[3] * v[3]); u32x2 w; w.x = cvt_pk_bf16(v[0], v[1]); w.y = cvt_pk_bf16(v[2], v[3]); *(u32x2*)(xb + c) = w; }
                s += __shfl_xor(s, 16); s += __shfl_xor(s, 32);
                if (fq == 0) ss[(size_t)r * 16 + u.pn * 4 + wc] = s; asm volatile("" ::: "memory"); }
    }
};
struct EpiGateUp {
    static constexpr bool PERM = true, AFTER_DRAIN = false;
    bf16_t* ff; const float* ss;
    __device__ __forceinline__ void operator()(const f32x4 (&acc)[2][2][4][2], const Unit& u, int wr, int wc, int fr, int fq) const {
        int row0 = u.pm * BM + wr * 64 + fr; asm volatile("" : "+v"(row0)); const int col0 = u.pn * HALF + wc * 32 + 8 * fq;
#pragma unroll
        for (int ai = 0; ai < 2; ++ai)
#pragma unroll
            for (int m = 0; m < 4; ++m) { const int r = row0 + ai * HALF + m * 16; const float rs = rstd16(ss, r);
                float o[8];
#pragma unroll
                for (int n = 0; n < 2; ++n)
#pragma unroll
                    for (int j = 0; j < 4; ++j) { const float g = acc[ai][0][m][n][j] * rs, up = acc[ai][1][m][n][j] * rs; o[n * 4 + j] = siluf_(g) * up; }
                u32x4 w; w.x = cvt_pk_bf16(o[0], o[1]); w.y = cvt_pk_bf16(o[2], o[3]); w.z = cvt_pk_bf16(o[4], o[5]); w.w = cvt_pk_bf16(o[6], o[7]);
                *(u32x4*)(ff + (size_t)r * FF_ + col0) = w; asm volatile("" ::: "memory"); }
    }
};
struct EpiPle {
    static constexpr bool PERM = false, AFTER_DRAIN = false;
    float* out; const bf16_t* pp; const float* bias; const float* ss_in; float* ss_out;
    __device__ __forceinline__ void operator()(const f32x4 (&acc)[2][2][4][2], const Unit& u, int wr, int wc, int fr, int fq) const {
        int row0 = u.pm * BM + wr * 64 + fr; asm volatile("" : "+v"(row0)); const int col0 = u.pn * BM + wc * 32 + 4 * fq;
#pragma unroll
        for (int ai = 0; ai < 2; ++ai)
#pragma unroll
            for (int m = 0; m < 4; ++m) { const int r = row0 + ai * HALF + m * 16; const float rs = rstd16(ss_in, r); float s = 0.f;
#pragma unroll
                for (int bj = 0; bj < 2; ++bj)
#pragma unroll
                    for (int n = 0; n < 2; ++n) { const int cc = col0 + bj * HALF + n * 16; const size_t c = (size_t)r * D_ + cc;
                        const f32x4 bv = *(const f32x4*)(bias + cc); const u32x2 pw = *(const u32x2*)(pp + c); f32x4 v = *(const f32x4*)(out + c);
                        const float p0 = __uint_as_float(pw.x << 16), p1 = __uint_as_float(pw.x & 0xffff0000u), p2 = __uint_as_float(pw.y << 16), p3 = __uint_as_float(pw.y & 0xffff0000u);
                        const f32x4 a = acc[ai][bj][m][n];
                        v[0] += sigmoidf_(a[0] * rs + bv[0]) * p0; v[1] += sigmoidf_(a[1] * rs + bv[1]) * p1; v[2] += sigmoidf_(a[2] * rs + bv[2]) * p2; v[3] += sigmoidf_(a[3] * rs + bv[3]) * p3;
                        *(f32x4*)(out + c) = v; s += (v[0] * v[0] + v[1] * v[1]) + (v[2] * v[2] + v[3] * v[3]); }
                s += __shfl_xor(s, 16); s += __shfl_xor(s, 32);
                if (fq == 0) ss_out[(size_t)r * 16 + u.pn * 4 + wc] = s; asm volatile("" ::: "memory"); }
    }
};

template <class Epi> __device__ __forceinline__ void run_gemm(PG8_LAS unsigned char* lds, const bf16_t* A, const bf16_t* Bt, int M, int N, int K, const Epi& E) {
    pg8::Gemm g; g.A = A; g.Bt = Bt; g.M = M; g.N = N; g.K = K;
    pg8::StaticOrder S; S.init(M, N, (int)gridDim.x, (int)blockIdx.x);
    pg8::gemm_phase<Epi, pg8::StaticOrder, false>(lds, g, S, E, nullptr);
}

__device__ void prep_transpose(const float* __restrict__ W, int K, int ldw, int c0, int ncols, bf16_t* __restrict__ Wt, const float* __restrict__ ks, int mode, float* tile, int rot) {
    const int tid = threadIdx.x, nkt = K / 64, nct = ncols / 64, ntiles = nkt * nct;
    for (int tt = (int)((blockIdx.x + gridDim.x - (rot % gridDim.x)) % gridDim.x); tt < ntiles; tt += gridDim.x) {
        const int kt = tt / nct, ct = tt % nct, k0 = kt * 64, n0 = ct * 64;
        __syncthreads();
#pragma unroll
        for (int i = 0; i < 2; ++i) { const int r = (tid >> 4) + 32 * i, c4 = (tid & 15) * 4; const f32x4 v = *(const f32x4*)(W + (size_t)(k0 + r) * ldw + c0 + n0 + c4);
            const float s = ks ? ks[k0 + r] : 1.0f; tile[r * 65 + c4 + 0] = v[0] * s; tile[r * 65 + c4 + 1] = v[1] * s; tile[r * 65 + c4 + 2] = v[2] * s; tile[r * 65 + c4 + 3] = v[3] * s; }
        __syncthreads();
        const int n = tid >> 3, kseg = (tid & 7) * 8; float v[8];
#pragma unroll
        for (int e = 0; e < 8; ++e) v[e] = tile[(kseg + e) * 65 + n];
        u32x4 w; w.x = cvt_pk_bf16(v[0], v[1]); w.y = cvt_pk_bf16(v[2], v[3]); w.z = cvt_pk_bf16(v[4], v[5]); w.w = cvt_pk_bf16(v[6], v[7]);
        const int f = n0 + n; const int drow = (mode == 0) ? f : (256 * (f >> 7) + 128 * (mode - 1) + (f & 127));
        *(u32x4*)(Wt + (size_t)drow * K + k0 + kseg) = w;
    }
}

__device__ void phase_prep(const Params& p, unsigned char* smem) {
    const int tid = threadIdx.x, wid = __builtin_amdgcn_readfirstlane(tid >> 6), lane = tid & 63;
    unsigned char* ws = p.ws;
    float* tile = (float*)smem;
    float* w8s = (float*)(smem + 20480);
    prep_transpose(p.in[3], D_, INC_, 0, PJ_, (bf16_t*)(ws + WS_WIN), nullptr, 0, tile, 0);
    prep_transpose(p.in[15], D_, D_, 0, D_, (bf16_t*)(ws + WS_WOUT), nullptr, 0, tile, 768);
    prep_transpose(p.in[17], D_, FF_, 0, FF_, (bf16_t*)(ws + WS_WGU), p.in[16], 1, tile, 1024);
    prep_transpose(p.in[18], D_, FF_, 0, FF_, (bf16_t*)(ws + WS_WGU), p.in[16], 2, tile, 1728);
    prep_transpose(p.in[19], FF_, D_, 0, D_, (bf16_t*)(ws + WS_WD), nullptr, 0, tile, 2432);
    prep_transpose(p.in[21], D_, D_, 0, D_, (bf16_t*)(ws + WS_WPG), p.in[20], 0, tile, 3136);
    prep_transpose(p.in[23], PLE_, D_, 0, D_, (bf16_t*)(ws + WS_WPP), nullptr, 0, tile, 3392);
    for (int i = tid; i < 1024 * 8; i += NTHREADS) { const int k = i >> 3, j = i & 7; w8s[i] = p.in[2][k] * p.in[3][(size_t)k * INC_ + PJ_ + j]; }
    __syncthreads();
    {
        const float* x = p.in[0]; const float* nw = p.in[2]; bf16_t* hb = (bf16_t*)(ws + WS_XB); float* logits = (float*)(ws + WS_LOGITS);
        f32x4 nwv[4];
#pragma unroll
        for (int i = 0; i < 4; ++i) nwv[i] = *(const f32x4*)(nw + 4 * (lane + 64 * i));
        for (int row = blockIdx.x * 8 + wid; row < T_; row += gridDim.x * 8) {
            f32x4 v[4]; float s = 0.f;
#pragma unroll
            for (int i = 0; i < 4; ++i) { v[i] = *(const f32x4*)(x + (size_t)row * D_ + 4 * (lane + 64 * i)); s += (v[i][0] * v[i][0] + v[i][1] * v[i][1]) + (v[i][2] * v[i][2] + v[i][3] * v[i][3]); }
#pragma unroll
            for (int o = 1; o < 64; o <<= 1) s += __shfl_xor(s, o);
            const float rs = rsqrtf(s * (1.0f / 1024.0f) + EPS_);
            float lg[8];
#pragma unroll
            for (int j = 0; j < 8; ++j) lg[j] = 0.f;
#pragma unroll
            for (int i = 0; i < 4; ++i) {
                const int k0 = 4 * (lane + 64 * i);
#pragma unroll
                for (int e = 0; e < 4; ++e) { const f32x4 wa = *(const f32x4*)(w8s + (k0 + e) * 8), wb = *(const f32x4*)(w8s + (k0 + e) * 8 + 4); const float xv = v[i][e];
                    lg[0] += xv * wa[0]; lg[1] += xv * wa[1]; lg[2] += xv * wa[2]; lg[3] += xv * wa[3]; lg[4] += xv * wb[0]; lg[5] += xv * wb[1]; lg[6] += xv * wb[2]; lg[7] += xv * wb[3]; }
                const f32x4 h = v[i] * rs * nwv[i]; u32x2 w; w.x = cvt_pk_bf16(h[0], h[1]); w.y = cvt_pk_bf16(h[2], h[3]);
                *(u32x2*)(hb + (size_t)row * D_ + k0) = w;
            }
#pragma unroll
            for (int j = 0; j < 8; ++j) {
#pragma unroll
                for (int o = 1; o < 64; o <<= 1) lg[j] += __shfl_xor(lg[j], o);
            }
            if (lane < 8) { float mine = lg[0];
#pragma unroll
                for (int j = 1; j < 8; ++j) mine = (lane == j) ? lg[j] : mine;
                logits[(size_t)row * 8 + lane] = mine * rs; }
        }
    }
    {
        const f32x4* src = (const f32x4*)p.in[1]; u32x2* dst = (u32x2*)(ws + WS_PB); const size_t n4 = (size_t)T_ * PLE_ / 4;
        for (size_t i = (size_t)blockIdx.x * NTHREADS + tid; i < n4; i += (size_t)gridDim.x * NTHREADS) { const f32x4 v = src[i]; u32x2 w; w.x = cvt_pk_bf16(v[0], v[1]); w.y = cvt_pk_bf16(v[2], v[3]); dst[i] = w; }
    }
}
template <bool FINAL>
__device__ void rg_pass(const Params& p, unsigned char* smem) {
    const int tid = threadIdx.x, wid = __builtin_amdgcn_readfirstlane(tid >> 6), lane = tid & 63, c = wid * 64 + lane;
    unsigned char* ws = p.ws;
    const bf16_t* proj = (const bf16_t*)(ws + WS_PROJ);
    float* U = (float*)smem + wid * 4096;
    float wxr[64], war[64];
#pragma unroll
    for (int k = 0; k < 64; ++k) { const float* wxp = p.in[6] + (size_t)(wid * 64) * 64 + lane; const float* wap = p.in[8] + (size_t)(wid * 64) * 64 + lane;
        wxr[k] = wxp[k * 64]; war[k] = wap[k * 64]; if ((k & 7) == 7) asm volatile("" ::: "memory"); }
    const float cw0 = p.in[4][c], cw1 = p.in[4][512 + c], cw2 = p.in[4][1024 + c], cw3 = p.in[4][1536 + c], cb = p.in[5][c];
    const float bx = p.in[7][c], ba = p.in[9][c], sp = softplusf_(-p.in[10][c]);
    float* ptot = (float*)(ws + WS_PTOT); float* hend = (float*)(ws + WS_HEND); const float* carry = (const float*)(ws + WS_CARRY);
    bf16_t* y = (bf16_t*)(ws + WS_Y);
    for (int unit = blockIdx.x; unit < NB_ * NCH_; unit += gridDim.x) {
        const int n = unit & (NCH_ - 1); const size_t t0 = (size_t)unit * 64;
        float xm3 = 0.f, xm2 = 0.f, xm1 = 0.f;
        if (n != 0) { xm3 = bf2f(proj[(t0 - 3) * PJ_ + c]); xm2 = bf2f(proj[(t0 - 2) * PJ_ + c]); xm1 = bf2f(proj[(t0 - 1) * PJ_ + c]); }
        __syncthreads();
        for (int t = 0; t < 64; ++t) { const float xv = bf2f(proj[(t0 + t) * PJ_ + c]); U[t * 64 + lane] = cw0 * xm3 + cw1 * xm2 + cw2 * xm1 + cw3 * xv + cb; xm3 = xm2; xm2 = xm1; xm1 = xv; }
        __syncthreads();
        float h = FINAL ? carry[(size_t)unit * 512 + c] : 0.f, P = 1.f;
        const bf16_t* gp = proj + t0 * PJ_ + 512 + c; bf16_t* yp = y + t0 * D_ + c;
        for (int tg = 0; tg < 16; ++tg) {
            float px[4], pa[4];
#pragma unroll
            for (int i = 0; i < 4; ++i) { px[i] = bx; pa[i] = ba; }
#pragma unroll
            for (int k4 = 0; k4 < 16; ++k4) {
#pragma unroll
                for (int i = 0; i < 4; ++i) { const f32x4 uv = *(const f32x4*)(U + (tg * 4 + i) * 64 + k4 * 4);
#pragma unroll
                    for (int e = 0; e < 4; ++e) { px[i] += uv[e] * wxr[k4 * 4 + e]; pa[i] += uv[e] * war[k4 * 4 + e]; } }
                if ((k4 & 3) == 3) asm volatile("" ::: "memory");
            }
#pragma unroll
            for (int i = 0; i < 4; ++i) { const int t = tg * 4 + i; const float u = U[t * 64 + lane];
                const float gx = sigmoidf_(px[i]), gg = sigmoidf_(pa[i]); const float la = -8.0f * gg * sp; const float a = __expf(la);
                float mult = sqrtf(fmaxf(-expm1f(2.0f * la), 0.f)); if (n == 0 && t == 0) mult = 1.0f;
                h = a * h + u * gx * mult; P *= a;
                if (FINAL) { const float g = bf2f(gp[(size_t)i * PJ_]); yp[(size_t)i * D_] = f2bf(h * gelu_tanhf_(g)); } }
            if (FINAL) { gp += 4 * PJ_; yp += 4 * D_; }
        }
        if (!FINAL) { ptot[(size_t)unit * 512 + c] = P; hend[(size_t)unit * 512 + c] = h; }
    }
}
__device__ void rg_carry(const Params& p, int idx) {
    unsigned char* ws = p.ws; const float* ptot = (const float*)(ws + WS_PTOT); const float* hend = (const float*)(ws + WS_HEND); float* carry = (float*)(ws + WS_CARRY);
    const int b = idx >> 9, c = idx & 511; float hc = 0.f;
    for (int n0 = 0; n0 < NCH_; n0 += 8) { float P[8], H[8];
#pragma unroll
        for (int i = 0; i < 8; ++i) { const size_t o = (size_t)(b * NCH_ + n0 + i) * 512 + c; P[i] = ptot[o]; H[i] = hend[o]; }
#pragma unroll
        for (int i = 0; i < 8; ++i) { const size_t o = (size_t)(b * NCH_ + n0 + i) * 512 + c; carry[o] = hc; hc = P[i] * hc + H[i]; } }
}

__device__ void gdn_chain_naive(const Params& p, unsigned char* smem, int bh) {
    const int tid = threadIdx.x, b = bh >> 2, h = bh & 3, e = tid & 127, r = tid >> 7;
    unsigned char* ws = p.ws; const bf16_t* proj = (const bf16_t*)(ws + WS_PROJ); const float* logits = (const float*)(ws + WS_LOGITS); bf16_t* y = (bf16_t*)(ws + WS_Y);
    float* qs = (float*)smem; float* ks = qs + 2048; float* vs = ks + 2048; float* os = vs + 2048; float* gs = os + 2048; float* bs = gs + 16;
    float* part = bs + 16;
    float* pqk = part + 2048;
    const float Aexp = __expf(p.in[12][h]), dtb = p.in[13][h];
    const int tok = tid >> 5, sub = tid & 31, ch = sub * 4;
    float cw[3][4][4];
#pragma unroll
    for (int a = 0; a < 3; ++a)
#pragma unroll
        for (int j = 0; j < 4; ++j) { const f32x4 w = *(const f32x4*)(p.in[11] + (size_t)j * 1536 + a * 512 + h * 128 + ch); cw[a][j][0] = w[0]; cw[a][j][1] = w[1]; cw[a][j][2] = w[2]; cw[a][j][3] = w[3]; }
    const f32x4 nwv = *(const f32x4*)(p.in[14] + ch);
    float S[32];
#pragma unroll
    for (int d = 0; d < 32; ++d) S[d] = 0.f;
    int buf = 0;
    for (int blk = 0; blk < SEQ_ / 16; ++blk) {
        const size_t t0 = (size_t)b * SEQ_ + (size_t)blk * 16;
        {
            float o3[3][4];
#pragma unroll
            for (int a = 0; a < 3; ++a) { float acc[4] = {0.f, 0.f, 0.f, 0.f};
#pragma unroll
                for (int j = 0; j < 4; ++j) { const int sp = blk * 16 + tok - 3 + j;
                    if (sp >= 0) { const u32x2 w = *(const u32x2*)(proj + ((size_t)b * SEQ_ + sp) * PJ_ + 1024 + a * 512 + h * 128 + ch);
                        acc[0] += cw[a][j][0] * __uint_as_float(w.x << 16); acc[1] += cw[a][j][1] * __uint_as_float(w.x & 0xffff0000u); acc[2] += cw[a][j][2] * __uint_as_float(w.y << 16); acc[3] += cw[a][j][3] * __uint_as_float(w.y & 0xffff0000u); } }
#pragma unroll
                for (int i = 0; i < 4; ++i) o3[a][i] = siluf_(acc[i]); }
#pragma unroll
            for (int a = 0; a < 2; ++a) { float s = (o3[a][0] * o3[a][0] + o3[a][1] * o3[a][1]) + (o3[a][2] * o3[a][2] + o3[a][3] * o3[a][3]);
#pragma unroll
                for (int o = 1; o < 32; o <<= 1) s += __shfl_xor(s, o);
                const float rs = rsqrtf(s + EPS_) * (a == 0 ? 0.08838834764831845f : 1.0f);
#pragma unroll
                for (int i = 0; i < 4; ++i) o3[a][i] *= rs; }
            *(f32x4*)(qs + tok * 128 + ch) = (f32x4){o3[0][0], o3[0][1], o3[0][2], o3[0][3]};
            *(f32x4*)(ks + tok * 128 + ch) = (f32x4){o3[1][0], o3[1][1], o3[1][2], o3[1][3]};
            *(f32x4*)(vs + tok * 128 + ch) = (f32x4){o3[2][0], o3[2][1], o3[2][2], o3[2][3]};
            if (tid < 16) { const float bl = logits[(t0 + tid) * 8 + h], al = logits[(t0 + tid) * 8 + 4 + h]; bs[tid] = sigmoidf_(bl); gs[tid] = __expf(-Aexp * softplusf_(al + dtb)); }
        }
        __syncthreads();
        for (int i = 0; i < 16; ++i) {
            const float dec = gs[i], beta = bs[i];
            float kq[32], qq[32];
#pragma unroll
            for (int d4 = 0; d4 < 8; ++d4) { const f32x4 kv = *(const f32x4*)(ks + i * 128 + r * 32 + d4 * 4), qv = *(const f32x4*)(qs + i * 128 + r * 32 + d4 * 4);
#pragma unroll
                for (int j = 0; j < 4; ++j) { kq[d4 * 4 + j] = kv[j]; qq[d4 * 4 + j] = qv[j]; } }
            float pk = 0.f, pq = 0.f, pd = 0.f;
#pragma unroll
            for (int d = 0; d < 32; ++d) { S[d] *= dec; pk += kq[d] * S[d]; pq += qq[d] * S[d]; pd += qq[d] * kq[d]; }
            part[((buf * 2 + 0) * 4 + r) * 128 + e] = pk; part[((buf * 2 + 1) * 4 + r) * 128 + e] = pq; if (e == 0) pqk[buf * 4 + r] = pd;
            __syncthreads();
            const float kS = (part[((buf * 2 + 0) * 4 + 0) * 128 + e] + part[((buf * 2 + 0) * 4 + 1) * 128 + e]) + (part[((buf * 2 + 0) * 4 + 2) * 128 + e] + part[((buf * 2 + 0) * 4 + 3) * 128 + e]);
            const float qS = (part[((buf * 2 + 1) * 4 + 0) * 128 + e] + part[((buf * 2 + 1) * 4 + 1) * 128 + e]) + (part[((buf * 2 + 1) * 4 + 2) * 128 + e] + part[((buf * 2 + 1) * 4 + 3) * 128 + e]);
            const float qk = (pqk[buf * 4 + 0] + pqk[buf * 4 + 1]) + (pqk[buf * 4 + 2] + pqk[buf * 4 + 3]);
            const float vn = beta * (vs[i * 128 + e] - kS);
#pragma unroll
            for (int d = 0; d < 32; ++d) S[d] += kq[d] * vn;
            if (r == 0) os[i * 128 + e] = qS + qk * vn;
            buf ^= 1;
        }
        __syncthreads();
        {
            const f32x4 ov = *(const f32x4*)(os + tok * 128 + ch); float s = (ov[0] * ov[0] + ov[1] * ov[1]) + (ov[2] * ov[2] + ov[3] * ov[3]);
#pragma unroll
            for (int o = 1; o < 32; o <<= 1) s += __shfl_xor(s, o);
            const float rs = rsqrtf(s * (1.0f / 128.0f) + EPS_);
            const u32x2 zw = *(const u32x2*)(proj + (t0 + tok) * PJ_ + 2560 + h * 128 + ch);
            const float z0 = __uint_as_float(zw.x << 16), z1 = __uint_as_float(zw.x & 0xffff0000u), z2 = __uint_as_float(zw.y << 16), z3 = __uint_as_float(zw.y & 0xffff0000u);
            u32x2 w; w.x = cvt_pk_bf16(ov[0] * rs * nwv[0] * siluf_(z0), ov[1] * rs * nwv[1] * siluf_(z1)); w.y = cvt_pk_bf16(ov[2] * rs * nwv[2] * siluf_(z2), ov[3] * rs * nwv[3] * siluf_(z3));
            *(u32x2*)(y + (t0 + tok) * D_ + 512 + h * 128 + ch) = w;
        }
        __syncthreads();
    }
}
__device__ void phase_final(const Params& p) {
    const int tid = threadIdx.x, wid = __builtin_amdgcn_readfirstlane(tid >> 6), lane = tid & 63;
    const float* ss = (const float*)(p.ws + WS_SSA); const float* nw = p.in[24]; float* out = p.out;
    f32x4 nwv[4];
#pragma unroll
    for (int i = 0; i < 4; ++i) nwv[i] = *(const f32x4*)(nw + 4 * (lane + 64 * i));
    for (int row = blockIdx.x * 8 + wid; row < T_; row += gridDim.x * 8) {
        const float rs = rstd16(ss, row);
#pragma unroll
        for (int i = 0; i < 4; ++i) { f32x4* q = (f32x4*)(out + (size_t)row * D_ + 4 * (lane + 64 * i)); *q = (*q) * rs * nwv[i]; }
    }
}

constexpr int NPHASES = 11;
__global__ void __launch_bounds__(NTHREADS, 2) mega_fwd(Params p) {
    extern __shared__ __attribute__((aligned(16))) unsigned char smem[];
    PG8_LAS unsigned char* lds = (PG8_LAS unsigned char*)smem;
    cg::grid_group grid = cg::this_grid();
    unsigned char* ws = p.ws;
    bf16_t* xb = (bf16_t*)(ws + WS_XB); bf16_t* proj = (bf16_t*)(ws + WS_PROJ); bf16_t* ff = proj; bf16_t* y = (bf16_t*)(ws + WS_Y); bf16_t* pp = (bf16_t*)(ws + WS_PP);
    float* ssA = (float*)(ws + WS_SSA); float* ssB = (float*)(ws + WS_SSB);
#ifdef ONLY_PHASE
#define PH_ON(n) ((n) == ONLY_PHASE)
#else
#define PH_ON(n) ((n) >= p.ph_lo && (n) < p.ph_hi)
#endif
#define PH_SYNC(n) do { if ((n) > p.ph_lo && (n) < p.ph_hi) grid.sync(); } while (0)
    if (PH_ON(0)) phase_prep(p, smem);
    PH_SYNC(1);
    if (PH_ON(1)) { EpiBf16Plain E; E.O = proj; E.ldc = PJ_; run_gemm(lds, xb, (const bf16_t*)(ws + WS_WIN), T_, PJ_, D_, E); }
    PH_SYNC(2);
    if (PH_ON(2)) rg_pass<false>(p, smem);
    PH_SYNC(3);
    if (PH_ON(3)) { if (blockIdx.x < 16) gdn_chain_naive(p, smem, blockIdx.x); else if (blockIdx.x < 20) rg_carry(p, (blockIdx.x - 16) * NTHREADS + threadIdx.x); }
    PH_SYNC(4);
    if (PH_ON(4)) rg_pass<true>(p, smem);
    PH_SYNC(5);
    if (PH_ON(5)) { EpiResid E; E.res = p.in[0]; E.out = p.out; E.xb = xb; E.ss = ssA; run_gemm(lds, y, (const bf16_t*)(ws + WS_WOUT), T_, D_, D_, E); }
    PH_SYNC(6);
    if (PH_ON(6)) { EpiGateUp E; E.ff = ff; E.ss = ssA; run_gemm(lds, xb, (const bf16_t*)(ws + WS_WGU), T_, 2 * FF_, D_, E); }
    if (PH_ON(10)) { EpiBf16Plain E2; E2.O = pp; E2.ldc = D_; run_gemm(lds, (const bf16_t*)(ws + WS_PB), (const bf16_t*)(ws + WS_WPP), T_, D_, PLE_, E2); }
    PH_SYNC(7);
    if (PH_ON(7)) { EpiResid E; E.res = p.out; E.out = p.out; E.xb = xb; E.ss = ssB; run_gemm(lds, ff, (const bf16_t*)(ws + WS_WD), T_, D_, FF_, E); }
    PH_SYNC(8);
    if (PH_ON(8)) { EpiPle E; E.out = p.out; E.pp = pp; E.bias = p.in[22]; E.ss_in = ssB; E.ss_out = ssA; run_gemm(lds, xb, (const bf16_t*)(ws + WS_WPG), T_, D_, D_, E); }
    PH_SYNC(9);
    if (PH_ON(9)) phase_final(p);
}

extern "C" void kernel_launch(void* const* d_in, const int* in_sizes, int n_in, void* d_out, int out_size, void* d_ws, size_t ws_size, hipStream_t stream) {
    static int grid = 0;
    if (grid == 0) {
        if (n_in != 25 || out_size != T_ * D_ || ws_size < WS_END) { fprintf(stderr, "kernel_launch: unexpected shapes: n_in %d out %d ws %zu (need %zu)\n", n_in, out_size, ws_size, (size_t)WS_END); grid = -1; return; }
        int dev = 0, cus = 0, per_cu = 0;
        hipGetDevice(&dev); hipDeviceGetAttribute(&cus, hipDeviceAttributeMultiprocessorCount, dev);
        if (hipFuncSetAttribute((const void*)mega_fwd, hipFuncAttributeMaxDynamicSharedMemorySize, LDS_BYTES) != hipSuccess) { fprintf(stderr, "kernel_launch: hipFuncSetAttribute failed\n"); grid = -1; return; }
        if (hipOccupancyMaxActiveBlocksPerMultiprocessor(&per_cu, (const void*)mega_fwd, NTHREADS, LDS_BYTES) != hipSuccess || per_cu < 1) { fprintf(stderr, "kernel_launch: occupancy query says %d\n", per_cu); per_cu = 1; }
        (void)hipGetLastError();
        grid = cus * 1;
        if (grid <= 0) grid = 256;
    }
    if (grid < 0) return;
    Params p{};
    for (int i = 0; i < 25; ++i) p.in[i] = (const float*)d_in[i];
    p.out = (float*)d_out; p.ws = (unsigned char*)d_ws; p.ph_lo = 0; p.ph_hi = NPHASES;
    void* args[] = {&p};
    hipError_t e = hipLaunchCooperativeKernel((const void*)mega_fwd, dim3(grid), dim3(NTHREADS), args, LDS_BYTES, stream);
    if (e != hipSuccess) fprintf(stderr, "cooperative launch failed: %s (grid %d)\n", hipGetErrorString(e), grid);
}
```

```cpp
#include <hip/hip_runtime.h>
#include <hip/hip_cooperative_groups.h>
#include <cstdio>
#include <cstdint>
namespace cg = cooperative_groups;
namespace pg8 {
#define PG8_LAS __attribute__((address_space(3)))
typedef unsigned short bf16_t;
typedef short bf16x8 __attribute__((ext_vector_type(8)));
typedef float f32x4 __attribute__((ext_vector_type(4)));
typedef unsigned u32x4 __attribute__((ext_vector_type(4)));
constexpr int BM = 256, BK = 64, HALF = 128, HTB = HALF * BK * 2  , STAGE_BYTES = 8 * HTB, NXCD = 8, WGM = 8;

__host__ __device__ __forceinline__ int lds_byte(int r, int c) { const int st = (r >> 4) * 2 + (c >> 5), rr = r & 15, cc = c & 31, ob = rr * 64 + cc * 2; return st * 1024 + (ob ^ (((ob >> 9) & 1) << 5)); }
__host__ __device__ __forceinline__ void stage_rc(int b, int& R, int& C) { const int st = b / 1024, sb = b % 1024, swz = sb ^ (((sb >> 9) & 1) << 5); R = (st >> 1) * 16 + swz / 64; C = (st & 1) * 32 + (swz % 64) / 2; }
__host__ __device__ __forceinline__ int perm32(int rho) { const int n = rho >> 4, i = rho & 15; return 8 * (i >> 2) + 4 * n + (i & 3); }

struct Unit { int pm, pn; };
struct Gemm { const bf16_t* A; const bf16_t* Bt; int M, N, K; };

struct StaticOrder {
    int nM, nN, nwg, G, c;
    __host__ __device__ void init(int M, int N, int G_, int c_) { nM = M / BM; nN = N / BM; nwg = nM * nN; G = G_; c = c_; }
    __host__ __device__ bool next(int i, Unit& u) const {
        const long L = (long)i * G + c; if (L >= nwg) return false;
        int wgid = (int)L; { const int q = nwg / NXCD, r = nwg % NXCD, xcd = wgid % NXCD, off = wgid / NXCD; wgid = (xcd < r ? xcd * (q + 1) : r * (q + 1) + (xcd - r) * q) + off; }
        const int nig = WGM * nN, gid = wgid / nig, fm = gid * WGM, gsz = (nM - fm) < WGM ? (nM - fm) : WGM;
        u.pm = fm + ((wgid % nig) % gsz); u.pn = (wgid % nig) / gsz; return true;
    }
    __device__ __forceinline__ void a_ready(const Unit&) const {}
    __device__ __forceinline__ void done(const Unit&) const {}
};
typedef __bf16 bf16v2_ __attribute__((ext_vector_type(2)));
typedef float f32v2_ __attribute__((ext_vector_type(2)));
__device__ __forceinline__ unsigned cvt_pk_bf16(float lo, float hi) { f32v2_ v = {lo, hi}; bf16v2_ b = __builtin_convertvector(v, bf16v2_); return __builtin_bit_cast(unsigned, b); }
typedef float f32x2 __attribute__((ext_vector_type(2)));
template <class Epi, class Sched, bool STAMP = false>
__device__ __forceinline__ void gemm_phase(PG8_LAS unsigned char* lds, const Gemm g, const Sched& S, const Epi& E, unsigned long long* stamps) {
    int tid = threadIdx.x; asm volatile("" : "+v"(tid));
    const int wid = __builtin_amdgcn_readfirstlane(tid >> 6), lane = tid & 63, wr = wid >> 2, wc = wid & 3, fr = lane & 15, fq = lane >> 4;
    const int K = g.K, nt = K / BK;
    int ts_lo = 0, ts_hi = 0, nts = 0; const unsigned long long rt_entry = STAMP ? (unsigned long long)wall_clock64() : 0ull;
#define PG8_STAMP() do { if (STAMP && wid == 0 && nts < 64) { const unsigned long long _c = (unsigned long long)clock64(); \
        ts_lo = (lane == nts) ? (int)(unsigned)_c : ts_lo; ts_hi = (lane == nts) ? (int)(unsigned)(_c >> 32) : ts_hi; ++nts; } } while (0)
    PG8_STAMP();
    unsigned voffA[2], voffB[2];
#pragma unroll
    for (int i = 0; i < 2; ++i) { int R, C; stage_rc(tid * 16 + i * 8192, R, C); const int Rb = Epi::PERM ? ((R & ~31) + perm32(R & 31)) : R;
        voffA[i] = (unsigned)(R * K + C) * 2u; voffB[i] = (unsigned)(Rb * K + C) * 2u; }
    const size_t kstep = (size_t)(BK * 2);
    const size_t hstep = (size_t)HALF * K * 2;
    const size_t tstep = 2 * hstep;
    const unsigned ldsw = (unsigned)wid * 1024u;
    const int aoff = lds_byte(wr * 64 + fr, fq * 8), boff = lds_byte(wc * 32 + fr, fq * 8);
#define PG8_SA(b, h) (((b) * 2 + (h)) * HTB)
#define PG8_SB(b, h) ((4 + (b) * 2 + (h)) * HTB)
#define PG8_STAGE(bufoff, gbase, voff) do { _Pragma("unroll") for (int _i = 0; _i < 2; ++_i) \
        __builtin_amdgcn_global_load_lds((const unsigned*)((const char*)(gbase) + (voff)[_i]), (PG8_LAS unsigned*)(lds + (bufoff) + ldsw + _i * 8192), 16, 0, 0); } while (0)
#define PG8_LDA(dst, b, h) do { _Pragma("unroll") for (int m = 0; m < 4; ++m) _Pragma("unroll") for (int k = 0; k < 2; ++k) dst[m][k] = *(const PG8_LAS bf16x8*)(lds + PG8_SA(b, h) + aoff + m * 2048 + k * 1024); } while (0)
#define PG8_LDB(dst, b, h) do { _Pragma("unroll") for (int n = 0; n < 2; ++n) _Pragma("unroll") for (int k = 0; k < 2; ++k) dst[n][k] = *(const PG8_LAS bf16x8*)(lds + PG8_SB(b, h) + boff + n * 2048 + k * 1024); } while (0)
#define PG8_MMA(ai, bj, At, Bt) do { __builtin_amdgcn_s_setprio(1); _Pragma("unroll") for (int m = 0; m < 4; ++m) _Pragma("unroll") for (int n = 0; n < 2; ++n) _Pragma("unroll") for (int k = 0; k < 2; ++k) \
        acc[ai][bj][m][n] = __builtin_amdgcn_mfma_f32_16x16x32_bf16(Bt[n][k], At[m][k], acc[ai][bj][m][n], 0, 0, 0); __builtin_amdgcn_s_setprio(0); } while (0)
#define PG8_WAIT_V(n) asm volatile("s_waitcnt vmcnt(" #n ")" ::: "memory")
#define PG8_WAIT_L(n) asm volatile("s_waitcnt lgkmcnt(" #n ")" ::: "memory")
#define PG8_BAR __builtin_amdgcn_s_barrier()
#define PG8_SCHED __builtin_amdgcn_sched_barrier(0)
    Unit cur, nxt; int ui = 0;
    if (!S.next(0, cur)) return;
    f32x4 acc[2][2][4][2];
#pragma unroll
    for (int a = 0; a < 2; ++a)
#pragma unroll
        for (int b = 0; b < 2; ++b)
#pragma unroll
            for (int m = 0; m < 4; ++m)
#pragma unroll
                for (int n = 0; n < 2; ++n) acc[a][b][m][n] = (f32x4){0.f, 0.f, 0.f, 0.f};
    bf16x8 At[4][2], B0[2][2], B1[2][2];
    const char* cA = (const char*)g.A + (size_t)cur.pm * tstep; const char* cB = (const char*)g.Bt + (size_t)cur.pn * tstep;
    S.a_ready(cur);
    PG8_STAGE(PG8_SB(0, 0), cB, voffB); PG8_STAGE(PG8_SA(0, 0), cA, voffA); PG8_STAGE(PG8_SB(0, 1), cB + hstep, voffB); PG8_STAGE(PG8_SA(0, 1), cA + hstep, voffA);
    if (wr == 1) PG8_BAR;
    PG8_WAIT_V(4); PG8_BAR;
    PG8_STAGE(PG8_SB(1, 0), cB + kstep, voffB); PG8_STAGE(PG8_SA(1, 0), cA + kstep, voffA); PG8_STAGE(PG8_SB(1, 1), cB + hstep + kstep, voffB);
    PG8_WAIT_V(6); PG8_BAR;
    PG8_STAMP();
    for (;;) {
        const bool has_next = S.next(ui + 1, nxt);
        const char* nA = has_next ? (const char*)g.A + (size_t)nxt.pm * tstep : cA; const char* nB = has_next ? (const char*)g.Bt + (size_t)nxt.pn * tstep : cB;
        for (int t = 0; t < nt; t += 2) {
            const bool last = (t == nt - 2);
            const char* a1 = cA + (size_t)(t + 1) * kstep;
            const char* a2 = last ? nA : cA + (size_t)(t + 2) * kstep; const char* b2 = last ? nB : cB + (size_t)(t + 2) * kstep;
            const char* a3 = a2 + kstep; const char* b3 = b2 + kstep;
            if (last && has_next) S.a_ready(nxt);
            PG8_LDB(B0, 0, 0); PG8_SCHED; PG8_LDA(At, 0, 0); PG8_STAGE(PG8_SA(1, 1), a1 + hstep, voffA);
            PG8_WAIT_L(8); PG8_BAR; PG8_WAIT_L(0); PG8_MMA(0, 0, At, B0); PG8_BAR; PG8_SCHED;
            PG8_LDB(B1, 0, 1); PG8_STAGE(PG8_SB(0, 0), b2, voffB);
            PG8_BAR; PG8_WAIT_L(0); PG8_MMA(0, 1, At, B1); PG8_BAR;
            PG8_LDA(At, 0, 1); PG8_STAGE(PG8_SA(0, 0), a2, voffA);
            PG8_BAR; PG8_WAIT_L(0); PG8_MMA(1, 0, At, B0); PG8_BAR; PG8_SCHED;
            PG8_STAGE(PG8_SB(0, 1), b2 + hstep, voffB);
            PG8_WAIT_V(6); PG8_BAR; PG8_MMA(1, 1, At, B1); PG8_BAR;
            PG8_LDB(B0, 1, 0); PG8_SCHED; PG8_LDA(At, 1, 0); PG8_STAGE(PG8_SA(0, 1), a2 + hstep, voffA);
            PG8_WAIT_L(8); PG8_BAR; PG8_WAIT_L(0); PG8_MMA(0, 0, At, B0); PG8_BAR; PG8_SCHED;
            PG8_LDB(B1, 1, 1); PG8_STAGE(PG8_SB(1, 0), b3, voffB);
            PG8_BAR; PG8_WAIT_L(0); PG8_MMA(0, 1, At, B1); PG8_BAR;
            PG8_LDA(At, 1, 1); PG8_STAGE(PG8_SA(1, 0), a3, voffA);
            PG8_BAR; PG8_WAIT_L(0); PG8_MMA(1, 0, At, B0); PG8_BAR; PG8_SCHED;
            PG8_STAGE(PG8_SB(1, 1), b3 + hstep, voffB);
            PG8_WAIT_V(6); PG8_BAR; PG8_MMA(1, 1, At, B1); PG8_BAR;
        }
        PG8_STAMP();
        if constexpr (!Epi::AFTER_DRAIN) { E(acc, cur, wr, wc, fr, fq); S.done(cur); }
        PG8_STAMP();
        if (!has_next) break;
#pragma unroll
        for (int a = 0; a < 2; ++a)
#pragma unroll
            for (int b = 0; b < 2; ++b)
#pragma unroll
                for (int m = 0; m < 4; ++m)
#pragma unroll
                    for (int n = 0; n < 2; ++n) acc[a][b][m][n] = (f32x4){0.f, 0.f, 0.f, 0.f};
        cur = nxt; cA = nA; cB = nB; ++ui;
    }
    PG8_WAIT_V(0);
    if (wr == 0) PG8_BAR;
    PG8_BAR;
    if constexpr (Epi::AFTER_DRAIN) { E.fused(acc, cur, wr, wc, fr, fq, lds, wid, lane); S.done(cur); }
    PG8_STAMP();
    if (STAMP && wid == 0) { stamps[lane] = lane < nts ? (((unsigned long long)(unsigned)ts_hi << 32) | (unsigned)ts_lo) : 0ull;
        if (lane == 62) stamps[62] = rt_entry; if (lane == 63) stamps[63] = (unsigned long long)wall_clock64(); }
#undef PG8_STAMP
#undef PG8_SA
#undef PG8_SB
#undef PG8_STAGE
#undef PG8_LDA
#undef PG8_LDB
#undef PG8_MMA
#undef PG8_WAIT_V
#undef PG8_WAIT_L
#undef PG8_BAR
#undef PG8_SCHED
}
}
#define XB_TMO      128
#define XB_XCNT(j)  (256  + 64 * (j))
#define XB_XSUB(j)  (1280 + 64 * (j))
#define XB_XGEN(j)  (2304 + 64 * (j))
#define XB_TOP      3328
#define XB_TOPGEN   3392
#define XCD_BAR_WORDS 3456
#define XB_SPIN_CAP (1u << 18)
#define LAS __attribute__((address_space(3)))

__device__ __forceinline__ unsigned xb_ld(unsigned* p)              { return __hip_atomic_load(p, __ATOMIC_RELAXED, __HIP_MEMORY_SCOPE_AGENT); }
__device__ __forceinline__ unsigned xb_add(unsigned* p, unsigned v) { return __hip_atomic_fetch_add(p, v, __ATOMIC_RELAXED, __HIP_MEMORY_SCOPE_AGENT); }
__device__ __forceinline__ unsigned xb_xcc_id() { return (unsigned)__builtin_amdgcn_s_getreg((3 << 11) | 20) & 0xFu; }
#define XB_SPIN(cond, bar) do { unsigned _sp = 0; while (cond) { __builtin_amdgcn_s_sleep(1); \
    if ((++_sp & 255u) == 0u) { if (xb_ld(&(bar)[XB_TMO])) break; if (_sp > XB_SPIN_CAP) { atomicAdd(&(bar)[XB_TMO], 1u); break; } } } } while (0)

struct XcdBarrier {
    unsigned* bar; unsigned x;
    volatile LAS unsigned* st;
};

__device__ __forceinline__ XcdBarrier xcd_barrier_post(unsigned* bar, volatile LAS unsigned* st) {
    XcdBarrier b; b.bar = bar; b.x = xb_xcc_id(); b.st = st;
    if (threadIdx.x == 0) (void)xb_add(&bar[XB_XCNT(b.x)], 1u);
    return b;
}
__device__ __forceinline__ void xcd_barrier_complete(unsigned* bar, unsigned x, unsigned& nloc, unsigned& nx) {
    const unsigned G = gridDim.x * gridDim.y * gridDim.z;
    unsigned sum, cnt, mine, sp = 0u;
    for (;;) {
        sum = 0u; cnt = 0u; mine = 0u;
#pragma unroll
        for (unsigned j = 0; j < 16; ++j) { const unsigned c = xb_ld(&bar[XB_XCNT(j)]); sum += c; cnt += (c > 0u) ? 1u : 0u; mine = (j == x) ? c : mine; }
        if (sum == G) break;
        __builtin_amdgcn_s_sleep(1);
        if ((++sp & 255u) == 0u) { if (xb_ld(&bar[XB_TMO])) break; if (sp > XB_SPIN_CAP) { atomicAdd(&bar[XB_TMO], 1u); break; } }
    }
    nloc = mine > 0u ? mine : 1u; nx = cnt > 0u ? cnt : 1u;
}

__device__ __forceinline__ void xcd_barrier(const XcdBarrier& b) {
    asm volatile("s_waitcnt vmcnt(0)" ::: "memory");
    __syncthreads();
    if (threadIdx.x == 0) {
        unsigned* bar = b.bar;
        __builtin_amdgcn_s_waitcnt(0);
        unsigned nloc = b.st[0], nx = b.st[1];
        if (nloc == 0u) { xcd_barrier_complete(bar, b.x, nloc, nx); b.st[0] = nloc; b.st[1] = nx; }
        const unsigned old = xb_add(&bar[XB_XSUB(b.x)], 1u);
        const unsigned gen = old / nloc;
        if (old + 1u == (gen + 1u) * nloc) {
            __builtin_amdgcn_fence(__ATOMIC_RELEASE, "agent");
            asm volatile("s_waitcnt vmcnt(0)" ::: "memory");
            const unsigned og = xb_add(&bar[XB_TOP], 1u);
            const unsigned tg = og / nx;
            if (og + 1u == (tg + 1u) * nx) xb_add(&bar[XB_TOPGEN], 1u);
            else XB_SPIN(xb_ld(&bar[XB_TOPGEN]) == tg, bar);
            __builtin_amdgcn_fence(__ATOMIC_ACQUIRE, "agent");
            xb_add(&bar[XB_XGEN(b.x)], 1u);
            asm volatile("s_waitcnt vmcnt(0)" ::: "memory");
        } else {
            XB_SPIN(xb_ld(&bar[XB_XGEN(b.x)]) == gen, bar);
            __builtin_amdgcn_fence(__ATOMIC_ACQUIRE, "agent");
            asm volatile("s_waitcnt vmcnt(0)" ::: "memory");
        }
    }
    __syncthreads();
}

using pg8::bf16_t; using pg8::f32x4; using pg8::u32x4; using pg8::bf16x8; using pg8::cvt_pk_bf16; using pg8::Unit; using pg8::HALF; using pg8::BM;
typedef unsigned u32x2 __attribute__((ext_vector_type(2)));
constexpr int T_ = 32768, D_ = 1024, SEQ_ = 8192, NB_ = 4, INC_ = 3080, PJ_ = 3072, FF_ = 2816, PLE_ = 256, NCH_ = 128;
constexpr float EPS_ = 1e-6f;
constexpr int NTHREADS = 512;
constexpr int LDS_BYTES = 144 * 1024;

constexpr size_t WS_WIN = 4096;
constexpr size_t WS_WOUT = WS_WIN + (size_t)PJ_ * D_ * 2;
constexpr size_t WS_WGU = WS_WOUT + (size_t)D_ * D_ * 2;
constexpr size_t WS_WD = WS_WGU + (size_t)2 * FF_ * D_ * 2;
constexpr size_t WS_WPG = WS_WD + (size_t)D_ * FF_ * 2;
constexpr size_t WS_WPP = WS_WPG + (size_t)D_ * D_ * 2;
constexpr size_t WS_LOGITS = WS_WPP + (size_t)D_ * PLE_ * 2;
constexpr size_t WS_PB = WS_LOGITS + (size_t)T_ * 8 * 4;
constexpr size_t WS_SSA = WS_PB + (size_t)T_ * PLE_ * 2;
constexpr size_t WS_SSB = WS_SSA + (size_t)T_ * 16 * 4;
constexpr size_t WS_PTOT = WS_SSB + (size_t)T_ * 16 * 4;
constexpr size_t WS_HEND = WS_PTOT + (size_t)NB_ * NCH_ * 512 * 4;
constexpr size_t WS_CARRY = WS_HEND + (size_t)NB_ * NCH_ * 512 * 4;
constexpr size_t WS_GTOT = WS_CARRY + (size_t)NB_ * NCH_ * 512 * 4;
constexpr size_t WS_XB = WS_GTOT + 8192;
constexpr size_t WS_PROJ = WS_XB + (size_t)T_ * D_ * 2;
constexpr size_t WS_R4 = WS_PROJ + (size_t)T_ * PJ_ * 2;
constexpr size_t WS_Y = WS_XB;
constexpr size_t WS_XB2 = WS_R4;
constexpr size_t WS_PP = WS_R4 + (size_t)T_ * D_ * 2;
constexpr size_t WS_ORAW = WS_R4 + (size_t)2048 * 73728;
constexpr size_t WS_BAR = WS_R4 + (size_t)2048 * 73728 + (size_t)T_ * 512 * 2;
constexpr size_t WS_END = WS_BAR + 16384;

struct Params {
    const float* in[25];
    float* out; unsigned char* ws;
    int ph_lo, ph_hi;
};

__device__ __forceinline__ float bf2f(bf16_t b) { return __uint_as_float(((unsigned)b) << 16); }
__device__ __forceinline__ bf16_t f2bf(float f) { return (bf16_t)(cvt_pk_bf16(f, 0.f) & 0xffffu); }
__device__ __forceinline__ float sigmoidf_(float x) { return __builtin_amdgcn_rcpf(1.0f + __expf(-x)); }
__device__ __forceinline__ float siluf_(float x) { return x * __builtin_amdgcn_rcpf(1.0f + __expf(-x)); }
__device__ __forceinline__ float softplusf_(float x) { return fmaxf(x, 0.f) + log1pf(__expf(-fabsf(x))); }
__device__ __forceinline__ float gelu_tanhf_(float x) { const float u = 0.7978845608028654f * (x + 0.044715f * x * x * x); return x * __builtin_amdgcn_rcpf(1.0f + __expf(-2.0f * u)); }
__device__ __forceinline__ float rstd16(const float* ss, int r) {
    const f32x4 a = *(const f32x4*)(ss + (size_t)r * 16), b = *(const f32x4*)(ss + (size_t)r * 16 + 4), c = *(const f32x4*)(ss + (size_t)r * 16 + 8), d = *(const f32x4*)(ss + (size_t)r * 16 + 12);
    const float s = ((a[0] + a[1]) + (a[2] + a[3])) + ((b[0] + b[1]) + (b[2] + b[3])) + ((c[0] + c[1]) + (c[2] + c[3])) + ((d[0] + d[1]) + (d[2] + d[3]));
    return rsqrtf(s * (1.0f / 1024.0f) + EPS_);
}

template <int CTRL> __device__ __forceinline__ float dpp_f(float x) { return __int_as_float(__builtin_amdgcn_update_dpp(0, __float_as_int(x), CTRL, 0xf, 0xf, false)); }
__device__ __forceinline__ float red8(float x) { x += dpp_f<0xB1>(x); x += dpp_f<0x4E>(x); x += dpp_f<0x141>(x); return x; }
struct EpiBf16Plain {
    static constexpr bool PERM = true, AFTER_DRAIN = false;
    bf16_t* O; int ldc;
    __device__ __forceinline__ void operator()(const f32x4 (&acc)[2][2][4][2], const Unit& u, int wr, int wc, int fr, int fq) const {
        int row0 = u.pm * BM + wr * 64 + fr; asm volatile("" : "+v"(row0)); const int col0 = u.pn * BM + wc * 32 + 8 * fq;
#pragma unroll
        for (int ai = 0; ai < 2; ++ai)
#pragma unroll
            for (int m = 0; m < 4; ++m) { bf16_t* rowp = O + (size_t)(row0 + ai * HALF + m * 16) * ldc + col0;
#pragma unroll
                for (int bj = 0; bj < 2; ++bj) { const f32x4 v0 = acc[ai][bj][m][0], v1 = acc[ai][bj][m][1]; u32x4 w; w.x = cvt_pk_bf16(v0[0], v0[1]); w.y = cvt_pk_bf16(v0[2], v0[3]); w.z = cvt_pk_bf16(v1[0], v1[1]); w.w = cvt_pk_bf16(v1[2], v1[3]);
                    *(u32x4*)(rowp + bj * HALF) = w; } }
    }
};
__device__ __forceinline__ void rstd8(const float* ss, int row0, float (&rs)[8]) {
#pragma unroll
    for (int ai = 0; ai < 2; ++ai) { f32x4 t[4][4];
#pragma unroll
        for (int m = 0; m < 4; ++m)
#pragma unroll
            for (int q = 0; q < 4; ++q) t[m][q] = *(const f32x4*)(ss + (size_t)(row0 + ai * HALF + m * 16) * 16 + 4 * q);
#pragma unroll
        for (int m = 0; m < 4; ++m) { const float sm = (((t[m][0][0] + t[m][0][1]) + (t[m][0][2] + t[m][0][3])) + ((t[m][1][0] + t[m][1][1]) + (t[m][1][2] + t[m][1][3]))) + (((t[m][2][0] + t[m][2][1]) + (t[m][2][2] + t[m][2][3])) + ((t[m][3][0] + t[m][3][1]) + (t[m][3][2] + t[m][3][3])));
            rs[ai * 4 + m] = rsqrtf(sm * (1.0f / 1024.0f) + EPS_); }
        asm volatile("" ::: "memory"); }
}
template <bool RES_BF16>
struct EpiResid {
    static constexpr bool PERM = false, AFTER_DRAIN = false;
    const float* res; bf16_t* xb; float* ss;
    __device__ __forceinline__ void operator()(const f32x4 (&acc)[2][2][4][2], const Unit& u, int wr, int wc, int fr, int fq) const {
        int row0 = u.pm * BM + wr * 64 + fr; asm volatile("" : "+v"(row0)); const int col0 = u.pn * BM + wc * 32 + 4 * fq;
        const unsigned e0 = (unsigned)row0 * D_ + col0;
#pragma unroll
        for (int ai = 0; ai < 2; ++ai) {
            constexpr int NB = RES_BF16 ? 4 : 2;
#pragma unroll
            for (int mh = 0; mh < 4 / NB; ++mh) {
                f32x4 rv[NB][2][2];
#pragma unroll
                for (int mm = 0; mm < NB; ++mm)
#pragma unroll
                    for (int bj = 0; bj < 2; ++bj)
#pragma unroll
                        for (int n = 0; n < 2; ++n) { const unsigned e = e0 + (unsigned)((ai * HALF + (mh * NB + mm) * 16) * D_ + bj * HALF + n * 16);
                            if (RES_BF16) { const u32x2 w = *(const u32x2*)((const char*)xb + (size_t)(e * 2u)); rv[mm][bj][n] = (f32x4){__uint_as_float(w.x << 16), __uint_as_float(w.x & 0xffff0000u), __uint_as_float(w.y << 16), __uint_as_float(w.y & 0xffff0000u)}; }
                            else rv[mm][bj][n] = *(const f32x4*)((const char*)res + (size_t)(e * 4u)); }
#pragma unroll
                for (int mm = 0; mm < NB; ++mm) { const int m = mh * NB + mm, r = row0 + ai * HALF + m * 16; float s = 0.f;
#pragma unroll
                    for (int bj = 0; bj < 2; ++bj)
#pragma unroll
                        for (int n = 0; n < 2; ++n) { const unsigned e = e0 + (unsigned)((ai * HALF + m * 16) * D_ + bj * HALF + n * 16); const f32x4 v = rv[mm][bj][n] + acc[ai][bj][m][n];
                            s += (v[0] * v[0] + v[1] * v[1]) + (v[2] * v[2] + v[3] * v[3]); u32x2 w; w.x = cvt_pk_bf16(v[0], v[1]); w.y = cvt_pk_bf16(v[2], v[3]); *(u32x2*)((char*)xb + (size_t)(e * 2u)) = w; }
                    s += __shfl_xor(s, 16); s += __shfl_xor(s, 32);
                    if (fq == 0) ss[(size_t)r * 16 + u.pn * 4 + wc] = s; }
                asm volatile("" ::: "memory"); } }
    }
};
struct EpiGateUp {
    static constexpr bool PERM = true, AFTER_DRAIN = false;
    bf16_t* ff; const float* ss;
    __device__ __forceinline__ void operator()(const f32x4 (&acc)[2][2][4][2], const Unit& u, int wr, int wc, int fr, int fq) const {
        int row0 = u.pm * BM + wr * 64 + fr; asm volatile("" : "+v"(row0)); const int col0 = u.pn * HALF + wc * 32 + 8 * fq;
        float rsv[8]; rstd8(ss, row0, rsv);
#pragma unroll
        for (int ai = 0; ai < 2; ++ai)
#pragma unroll
            for (int m = 0; m < 4; ++m) { const int r = row0 + ai * HALF + m * 16; const float rs = rsv[ai * 4 + m], rs2 = rs * rs, nrl = -1.4426950408889634f * rs;
                float o[8];
#pragma unroll
                for (int n = 0; n < 2; ++n)
#pragma unroll
                    for (int j = 0; j < 4; ++j) { const float ag = acc[ai][0][m][n][j], au = acc[ai][1][m][n][j];
                        o[n * 4 + j] = (ag * au) * rs2 * __builtin_amdgcn_rcpf(1.0f + __builtin_amdgcn_exp2f(ag * nrl)); }
                u32x4 w; w.x = cvt_pk_bf16(o[0], o[1]); w.y = cvt_pk_bf16(o[2], o[3]); w.z = cvt_pk_bf16(o[4], o[5]); w.w = cvt_pk_bf16(o[6], o[7]);
                *(u32x4*)(ff + (size_t)r * FF_ + col0) = w; }
    }
};
struct EpiPle {
    static constexpr bool PERM = false, AFTER_DRAIN = false;
    const bf16_t* x2b; bf16_t* x3b; const bf16_t* pp; const float* bias; const float* ss_in; float* ss_out;
    __device__ __forceinline__ void operator()(const f32x4 (&acc)[2][2][4][2], const Unit& u, int wr, int wc, int fr, int fq) const {
        int row0 = u.pm * BM + wr * 64 + fr; asm volatile("" : "+v"(row0)); const int col0 = u.pn * BM + wc * 32 + 4 * fq;
        const unsigned b0 = ((unsigned)row0 * D_ + col0) * 2u;
        const unsigned s0 = (unsigned)row0 * 64u;
        u32x2 X[2][2][2], P[2][2][2]; f32x4 S[2][4];
#define EP_LOAD(set, g) do { const unsigned ro_ = (unsigned)(((g) >> 2) * HALF + ((g) & 3) * 16); \
        _Pragma("unroll") for (int bj = 0; bj < 2; ++bj) _Pragma("unroll") for (int n = 0; n < 2; ++n) { const unsigned bo_ = b0 + (ro_ * D_ + bj * HALF + n * 16) * 2u; \
            X[set][bj][n] = *(const u32x2*)((const char*)x2b + (size_t)bo_); P[set][bj][n] = *(const u32x2*)((const char*)pp + (size_t)bo_); } \
        _Pragma("unroll") for (int q = 0; q < 4; ++q) S[set][q] = *(const f32x4*)((const char*)ss_in + (size_t)(s0 + ro_ * 64u + q * 16u)); } while (0)
        EP_LOAD(0, 0);
#pragma unroll
        for (int g = 0; g < 8; ++g) { const int ai = g >> 2, m = g & 3, st = g & 1, r = row0 + ai * HALF + m * 16;
            if (g < 7) EP_LOAD((g + 1) & 1, g + 1);
            const float sm = (((S[st][0][0] + S[st][0][1]) + (S[st][0][2] + S[st][0][3])) + ((S[st][1][0] + S[st][1][1]) + (S[st][1][2] + S[st][1][3]))) + (((S[st][2][0] + S[st][2][1]) + (S[st][2][2] + S[st][2][3])) + ((S[st][3][0] + S[st][3][1]) + (S[st][3][2] + S[st][3][3])));
            const float rs = rsqrtf(sm * (1.0f / 1024.0f) + EPS_); float s = 0.f;
#pragma unroll
            for (int bj = 0; bj < 2; ++bj)
#pragma unroll
                for (int n = 0; n < 2; ++n) { const unsigned bo = b0 + (unsigned)(((ai * HALF + m * 16) * D_ + bj * HALF + n * 16) * 2); const u32x2 w2 = P[st][bj][n], x2 = X[st][bj][n]; const f32x4 a = acc[ai][bj][m][n]; const f32x4 bb = *(const f32x4*)(bias + col0 + bj * HALF + n * 16);
                    f32x4 v = {__uint_as_float(x2.x << 16), __uint_as_float(x2.x & 0xffff0000u), __uint_as_float(x2.y << 16), __uint_as_float(x2.y & 0xffff0000u)};
                    const float p0 = __uint_as_float(w2.x << 16), p1 = __uint_as_float(w2.x & 0xffff0000u), p2 = __uint_as_float(w2.y << 16), p3 = __uint_as_float(w2.y & 0xffff0000u);
                    v[0] += sigmoidf_(a[0] * rs + bb[0]) * p0; v[1] += sigmoidf_(a[1] * rs + bb[1]) * p1; v[2] += sigmoidf_(a[2] * rs + bb[2]) * p2; v[3] += sigmoidf_(a[3] * rs + bb[3]) * p3;
                    u32x2 xw; xw.x = cvt_pk_bf16(v[0], v[1]); xw.y = cvt_pk_bf16(v[2], v[3]); *(u32x2*)((char*)x3b + (size_t)bo) = xw; s += (v[0] * v[0] + v[1] * v[1]) + (v[2] * v[2] + v[3] * v[3]); }
            s += __shfl_xor(s, 16); s += __shfl_xor(s, 32);
            if (fq == 0) ss_out[(size_t)r * 16 + u.pn * 4 + wc] = s;
            asm volatile("" ::: "memory"); }
#undef EP_LOAD
    }
};

template <class Epi> __device__ __forceinline__ void run_gemm(PG8_LAS unsigned char* lds, const bf16_t* A, const bf16_t* Bt, int M, int N, int K, const Epi& E) {
    pg8::Gemm g; g.A = A; g.Bt = Bt; g.M = M; g.N = N; g.K = K;
    pg8::StaticOrder S; S.init(M, N, (int)gridDim.x, (int)blockIdx.x);
    pg8::gemm_phase<Epi, pg8::StaticOrder, false>(lds, g, S, E, nullptr);
}

__device__ void prep_transpose(const float* __restrict__ W, int K, int ldw, int c0, int ncols, bf16_t* __restrict__ Wt, const float* __restrict__ ks, int mode, float* tile, int rot, int widx, int nw) {
    const int tid = threadIdx.x, nkt = K / 64, nct = ncols / 64, ntiles = nkt * nct;
    for (int tt = (widx + nw - (rot % nw)) % nw; tt < ntiles; tt += nw) {
        const int kt = tt / nct, ct = tt % nct, k0 = kt * 64, n0 = ct * 64;
        __syncthreads();
#pragma unroll
        for (int i = 0; i < 2; ++i) { const int r = (tid >> 4) + 32 * i, c4 = (tid & 15) * 4; const f32x4 v = *(const f32x4*)(W + (size_t)(k0 + r) * ldw + c0 + n0 + c4);
            const float s = ks ? ks[k0 + r] : 1.0f; tile[r * 65 + c4 + 0] = v[0] * s; tile[r * 65 + c4 + 1] = v[1] * s; tile[r * 65 + c4 + 2] = v[2] * s; tile[r * 65 + c4 + 3] = v[3] * s; }
        __syncthreads();
        const int n = tid >> 3, kseg = (tid & 7) * 8; float v[8];
#pragma unroll
        for (int e = 0; e < 8; ++e) v[e] = tile[(kseg + e) * 65 + n];
        u32x4 w; w.x = cvt_pk_bf16(v[0], v[1]); w.y = cvt_pk_bf16(v[2], v[3]); w.z = cvt_pk_bf16(v[4], v[5]); w.w = cvt_pk_bf16(v[6], v[7]);
        const int f = n0 + n; const int drow = (mode == 0) ? f : (256 * (f >> 7) + 128 * (mode - 1) + (f & 127));
        *(u32x4*)(Wt + (size_t)drow * K + k0 + kseg) = w;
    }
}


__device__ __forceinline__ void prep_weights_late(const Params& p, unsigned char* smem, int widx, int nw) {
    unsigned char* ws = p.ws; float* tile = (float*)smem;
    __syncthreads();
    prep_transpose(p.in[15], D_, D_, 0, D_, (bf16_t*)(ws + WS_WOUT), nullptr, 0, tile, 0, widx, nw);
    prep_transpose(p.in[17], D_, FF_, 0, FF_, (bf16_t*)(ws + WS_WGU), p.in[16], 1, tile, 256, widx, nw);
    prep_transpose(p.in[18], D_, FF_, 0, FF_, (bf16_t*)(ws + WS_WGU), p.in[16], 2, tile, 960, widx, nw);
    prep_transpose(p.in[19], FF_, D_, 0, D_, (bf16_t*)(ws + WS_WD), nullptr, 0, tile, 1664, widx, nw);
    prep_transpose(p.in[21], D_, D_, 0, D_, (bf16_t*)(ws + WS_WPG), p.in[20], 0, tile, 2368, widx, nw);
    prep_transpose(p.in[23], PLE_, D_, 0, D_, (bf16_t*)(ws + WS_WPP), nullptr, 0, tile, 2624, widx, nw);
}

__device__ __forceinline__ void phase_prep(const Params& p, unsigned char* smem) {
    const int tid = threadIdx.x, wid = __builtin_amdgcn_readfirstlane(tid >> 6), lane = tid & 63;
    unsigned char* ws = p.ws;
    float* tile = (float*)smem;
    float* w8s = (float*)(smem + 20480);
    if (blockIdx.x == 0 && tid < 32) ((unsigned*)ws)[tid] = 0u;
    prep_transpose(p.in[3], D_, INC_, 0, PJ_, (bf16_t*)(ws + WS_WIN), nullptr, 0, tile, 0, (int)blockIdx.x, (int)gridDim.x);
    for (int i = tid; i < 1024 * 8; i += NTHREADS) { const int k = i >> 3, j = i & 7; w8s[i] = p.in[2][k] * p.in[3][(size_t)k * INC_ + PJ_ + j]; }
    __syncthreads();
    {
        const float* x = p.in[0]; const float* nw = p.in[2]; bf16_t* hb = (bf16_t*)(ws + WS_XB); float* logits = (float*)(ws + WS_LOGITS);
        f32x4 nwv[4];
#pragma unroll
        for (int i = 0; i < 4; ++i) nwv[i] = *(const f32x4*)(nw + 4 * (lane + 64 * i));
        f32x4 vn[4]; int row = blockIdx.x * 8 + wid;
        if (row < T_) {
#pragma unroll
            for (int i = 0; i < 4; ++i) vn[i] = *(const f32x4*)(x + (size_t)row * D_ + 4 * (lane + 64 * i)); }
        for (; row < T_; row += gridDim.x * 8) {
            f32x4 v[4]; float s = 0.f;
#pragma unroll
            for (int i = 0; i < 4; ++i) { v[i] = vn[i]; s += (v[i][0] * v[i][0] + v[i][1] * v[i][1]) + (v[i][2] * v[i][2] + v[i][3] * v[i][3]); }
            { const int nrow = row + gridDim.x * 8;
              if (nrow < T_) {
#pragma unroll
                for (int i = 0; i < 4; ++i) vn[i] = *(const f32x4*)(x + (size_t)nrow * D_ + 4 * (lane + 64 * i)); } }
            s = red8(s); s += dpp_f<0x140>(s); s += __shfl_xor(s, 16); s += __shfl_xor(s, 32);
            const float rs = rsqrtf(s * (1.0f / 1024.0f) + EPS_);
            float lg[8];
#pragma unroll
            for (int j = 0; j < 8; ++j) lg[j] = 0.f;
#pragma unroll
            for (int i = 0; i < 4; ++i) {
                const int k0 = 4 * (lane + 64 * i);
#pragma unroll
                for (int e = 0; e < 4; ++e) { const f32x4 wa = *(const f32x4*)(w8s + (k0 + e) * 8), wb = *(const f32x4*)(w8s + (k0 + e) * 8 + 4); const float xv = v[i][e];
                    lg[0] += xv * wa[0]; lg[1] += xv * wa[1]; lg[2] += xv * wa[2]; lg[3] += xv * wa[3]; lg[4] += xv * wb[0]; lg[5] += xv * wb[1]; lg[6] += xv * wb[2]; lg[7] += xv * wb[3]; }
                const f32x4 h = v[i] * rs * nwv[i]; u32x2 w; w.x = cvt_pk_bf16(h[0], h[1]); w.y = cvt_pk_bf16(h[2], h[3]);
                *(u32x2*)(hb + (size_t)row * D_ + k0) = w;
            }
            const bool b5 = (lane & 32) != 0, b4 = (lane & 16) != 0, b3 = (lane & 8) != 0;
            float k4[4], k2[2];
#pragma unroll
            for (int j = 0; j < 4; ++j) { const float send = b5 ? lg[j] : lg[j + 4]; const float keep = b5 ? lg[j + 4] : lg[j]; k4[j] = keep + __shfl_xor(send, 32); }
#pragma unroll
            for (int j = 0; j < 2; ++j) { const float send = b4 ? k4[j] : k4[j + 2]; const float keep = b4 ? k4[j + 2] : k4[j]; k2[j] = keep + __shfl_xor(send, 16); }
            float k1; { const float send = b3 ? k2[0] : k2[1]; const float keep = b3 ? k2[1] : k2[0]; k1 = keep + __shfl_xor(send, 8); }
            k1 = red8(k1);
            if ((lane & 7) == 0) logits[(size_t)row * 8 + ((lane >> 5) & 1) * 4 + ((lane >> 4) & 1) * 2 + ((lane >> 3) & 1)] = k1 * rs;
        }
    }
    {
        const f32x4* src = (const f32x4*)p.in[1]; u32x2* dst = (u32x2*)(ws + WS_PB); const size_t n4 = (size_t)T_ * PLE_ / 4;
        for (size_t i = (size_t)blockIdx.x * NTHREADS + tid; i < n4; i += (size_t)gridDim.x * NTHREADS) { const f32x4 v = src[i]; u32x2 w; w.x = cvt_pk_bf16(v[0], v[1]); w.y = cvt_pk_bf16(v[2], v[3]); dst[i] = w; }
    }
}
__device__ __forceinline__ bf16x8 pack8(const f32x4 a, const f32x4 b) { u32x4 w; w.x = cvt_pk_bf16(a[0], a[1]); w.y = cvt_pk_bf16(a[2], a[3]); w.z = cvt_pk_bf16(b[0], b[1]); w.w = cvt_pk_bf16(b[2], b[3]); return __builtin_bit_cast(bf16x8, w); }
#define MFMA16(a, b, c) __builtin_amdgcn_mfma_f32_16x16x32_bf16((a), (b), (c), 0, 0, 0)
__device__ __forceinline__ float neg_expm1_small(float x) {
    const float ps = -x * (1.0f + x * (0.5f + x * (0.16666667f + x * (0.041666668f + x * (0.008333334f + x * 0.0013888889f)))));
    return (x > -0.25f) ? ps : (1.0f - __expf(x));
}
template <bool FINAL>
__device__ __forceinline__ void rg_pass_mfma(const Params& p, unsigned char* smem, int widx, int nworkers) {
    const int tid = threadIdx.x, wid = __builtin_amdgcn_readfirstlane(tid >> 6), lane = tid & 63, n16o = lane & 15, fqo = lane >> 4, c = wid * 64 + lane;
    unsigned char* ws = p.ws;
    const bf16_t* proj = (const bf16_t*)(ws + WS_PROJ);
    float* U = (float*)smem + wid * 4096;
    float* ptot = (float*)(ws + WS_PTOT); float* hend = (float*)(ws + WS_HEND); const float* carry = (const float*)(ws + WS_CARRY);
    bf16_t* y = (bf16_t*)(ws + WS_Y);
    bf16x8 Bx[4][2], Ba[4][2];
#pragma unroll
    for (int nt = 0; nt < 4; ++nt)
#pragma unroll
        for (int ks = 0; ks < 2; ++ks) { const float* wx = p.in[6] + (size_t)(wid * 64 + 32 * ks) * 64 + (size_t)(8 * fqo) * 64 + 16 * nt + n16o; const float* wa = p.in[8] + (size_t)(wid * 64 + 32 * ks) * 64 + (size_t)(8 * fqo) * 64 + 16 * nt + n16o;
            f32x4 x0 = {wx[0], wx[64], wx[128], wx[192]}, x1 = {wx[256], wx[320], wx[384], wx[448]}, a0 = {wa[0], wa[64], wa[128], wa[192]}, a1 = {wa[256], wa[320], wa[384], wa[448]};
            Bx[nt][ks] = pack8(x0, x1); Ba[nt][ks] = pack8(a0, a1); asm volatile("" ::: "memory"); }
    const float cw0 = p.in[4][c], cw1 = p.in[4][512 + c], cw2 = p.in[4][1024 + c], cw3 = p.in[4][1536 + c], cb = p.in[5][c];
    float bxv[4], bav[4], spv[4];
#pragma unroll
    for (int nt = 0; nt < 4; ++nt) { const int cgl = wid * 64 + 16 * nt + n16o; bxv[nt] = p.in[7][cgl]; bav[nt] = p.in[9][cgl]; spv[nt] = softplusf_(-p.in[10][cgl]); }
    for (int unit = widx; unit < NB_ * NCH_; unit += nworkers) {
        const int n = unit & (NCH_ - 1); const size_t t0 = (size_t)unit * 64;
        float xm3 = 0.f, xm2 = 0.f, xm1 = 0.f;
        if (n != 0) { xm3 = bf2f(proj[(t0 - 3) * PJ_ + c]); xm2 = bf2f(proj[(t0 - 2) * PJ_ + c]); xm1 = bf2f(proj[(t0 - 1) * PJ_ + c]); }
        __syncthreads();
        { bf16_t xr[16]; const bf16_t* xp0 = proj + t0 * PJ_ + c;
#pragma unroll
          for (int i = 0; i < 16; ++i) xr[i] = xp0[(size_t)i * PJ_];
#pragma unroll
          for (int tb = 0; tb < 4; ++tb) { bf16_t xn[16]; const bf16_t* xp = proj + (t0 + (tb + 1) * 16) * PJ_ + c;
            if (tb < 3) {
#pragma unroll
                for (int i = 0; i < 16; ++i) xn[i] = xp[(size_t)i * PJ_]; }
#pragma unroll
            for (int i = 0; i < 16; ++i) { const float xv = bf2f(xr[i]); U[(tb * 16 + i) * 64 + lane] = cw0 * xm3 + cw1 * xm2 + cw2 * xm1 + cw3 * xv + cb; xm3 = xm2; xm2 = xm1; xm1 = xv; }
            if (tb < 3) {
#pragma unroll
                for (int i = 0; i < 16; ++i) xr[i] = xn[i]; } } }
        __syncthreads();
        const bf16_t* gub = proj + t0 * PJ_ + 512; bf16_t* yub = y + t0 * D_;
#pragma unroll
        for (int nt = 0; nt < 4; ++nt) {
            asm volatile("" ::: "memory");
            int lane_o = lane; asm volatile("" : "+v"(lane_o));
            const int n16 = lane_o & 15, fq = lane_o >> 4;
            const int chl = 16 * nt + n16, cgl = wid * 64 + chl;
            bf16x8 Af[4][2];
#pragma unroll
            for (int mt = 0; mt < 4; ++mt)
#pragma unroll
                for (int ks = 0; ks < 2; ++ks) { const float* up = U + (16 * (n16 >> 2) + 4 * mt + (n16 & 3)) * 64 + 32 * ks + 8 * fq; Af[mt][ks] = pack8(*(const f32x4*)up, *(const f32x4*)(up + 4)); }

            bf16_t gr[16];
            if (FINAL) {
#pragma unroll
                for (int i = 0; i < 16; ++i) gr[i] = gub[(16 * fq + i) * PJ_ + cgl]; }
            f32x4 ax[4], aa[4];
#pragma unroll
            for (int mt = 0; mt < 4; ++mt) { ax[mt] = (f32x4){bxv[nt], bxv[nt], bxv[nt], bxv[nt]}; aa[mt] = (f32x4){bav[nt], bav[nt], bav[nt], bav[nt]}; }
#pragma unroll
            for (int mt = 0; mt < 4; ++mt)
#pragma unroll
                for (int ks = 0; ks < 2; ++ks) { ax[mt] = MFMA16(Af[mt][ks], Bx[nt][ks], ax[mt]); aa[mt] = MFMA16(Af[mt][ks], Ba[nt][ks], aa[mt]); }
            float av[16], bv[16]; float hl = 0.f, Pl = 1.f;
#pragma unroll
            for (int i = 0; i < 16; ++i) { const int mt = i >> 2, j = i & 3, tok = 16 * fq + i; const float u = U[tok * 64 + chl];
                const float gx = sigmoidf_(ax[mt][j]), gg = sigmoidf_(aa[mt][j]); const float la = -8.0f * gg * spv[nt]; const float a = __expf(la);
                float mult = sqrtf(fmaxf(neg_expm1_small(2.0f * la), 0.f)); if (n == 0 && tok == 0) mult = 1.0f;
                av[i] = a; bv[i] = u * gx * mult; hl = a * hl + bv[i]; Pl *= a; }
            float Pg[4], Hg[4];
#pragma unroll
            for (int g = 0; g < 4; ++g) { Pg[g] = __shfl(Pl, n16 + 16 * g); Hg[g] = __shfl(hl, n16 + 16 * g); }
            if (FINAL) {
                float h = carry[(size_t)unit * 512 + cgl];
#pragma unroll
                for (int g = 0; g < 3; ++g) if (g < fq) h = Pg[g] * h + Hg[g];
#pragma unroll
                for (int i = 0; i < 16; ++i) { h = av[i] * h + bv[i]; yub[(16 * fq + i) * D_ + cgl] = f2bf(h * gelu_tanhf_(bf2f(gr[i]))); }
            } else {
                float cc = 0.f, Pp = 1.f;
#pragma unroll
                for (int g = 0; g < 4; ++g) { cc = Pg[g] * cc + Hg[g]; Pp *= Pg[g]; }
                if (fq == 0) { ptot[(size_t)unit * 512 + cgl] = Pp; hend[(size_t)unit * 512 + cgl] = cc; }
            }
        }
    }
}

__device__ __forceinline__ void rg_carry(const Params& p, int idx) {
    unsigned char* ws = p.ws; const float* ptot = (const float*)(ws + WS_PTOT); const float* hend = (const float*)(ws + WS_HEND); float* carry = (float*)(ws + WS_CARRY);
    const int b = idx >> 9, c = idx & 511; float hc = 0.f;
    for (int n0 = 0; n0 < NCH_; n0 += 8) { float P[8], H[8];
#pragma unroll
        for (int i = 0; i < 8; ++i) { const size_t o = (size_t)(b * NCH_ + n0 + i) * 512 + c; P[i] = ptot[o]; H[i] = hend[o]; }
#pragma unroll
        for (int i = 0; i < 8; ++i) { const size_t o = (size_t)(b * NCH_ + n0 + i) * 512 + c; carry[o] = hc; hc = P[i] * hc + H[i]; } }
}

constexpr int GU_BYTES = 73728, GU_KDT = 32768, GU_QK = 49152, GU_U = 57344;
typedef float f32x2_ __attribute__((ext_vector_type(2)));
__device__ __forceinline__ int tok_of_pos(int p) { return 16 * (2 * (p >> 5) + ((p >> 2) & 1)) + 4 * ((p >> 3) & 3) + (p & 3); }
__device__ __forceinline__ void unpack8(const u32x4 w, float* f) { f[0] = __uint_as_float(w.x << 16); f[1] = __uint_as_float(w.x & 0xffff0000u); f[2] = __uint_as_float(w.y << 16); f[3] = __uint_as_float(w.y & 0xffff0000u);
    f[4] = __uint_as_float(w.z << 16); f[5] = __uint_as_float(w.z & 0xffff0000u); f[6] = __uint_as_float(w.w << 16); f[7] = __uint_as_float(w.w & 0xffff0000u); }

__device__ __forceinline__ void gdn_pass_a(const Params& p, unsigned char* smem) {
    const int tid = threadIdx.x, wid = __builtin_amdgcn_readfirstlane(tid >> 6);
    unsigned char* ws = p.ws; const bf16_t* proj = (const bf16_t*)(ws + WS_PROJ); const float* logits = (const float*)(ws + WS_LOGITS); float* gtot = (float*)(ws + WS_GTOT);
    bf16_t* Kb = (bf16_t*)smem; bf16_t* Qb = (bf16_t*)(smem + 17408); bf16_t* VBt = (bf16_t*)(smem + 34816); bf16_t* KBGt = (bf16_t*)(smem + 53248);
    float* Lsw = (float*)(smem + 71680); bf16_t* Tb = (bf16_t*)(smem + 89088); float* gcs = (float*)(smem + 98304); float* betas = gcs + 64; float* kdec = gcs + 128;
    const int lane0 = tid & 63, tg0 = tid >> 5, ch0 = (tid & 31) * 4;
    for (int ub = blockIdx.x * 8; ub < 2048; ub += gridDim.x * 8) {
        const int bh = ub >> 7, b = bh >> 2, h = bh & 3;
        const float Aexp = __expf(p.in[12][h]), dtb = p.in[13][h];
        float cw[3][4][4];
#pragma unroll
        for (int a = 0; a < 3; ++a)
#pragma unroll
            for (int j = 0; j < 4; ++j) { const f32x4 w = *(const f32x4*)(p.in[11] + (size_t)j * 1536 + a * 512 + h * 128 + ch0); cw[a][j][0] = w[0]; cw[a][j][1] = w[1]; cw[a][j][2] = w[2]; cw[a][j][3] = w[3]; }
        u32x2 pre[3][7]; float lgb, lga;
#define GA_PREFETCH(unit_) do { const int n_ = (unit_) & 127; const size_t t0_ = (size_t)b * SEQ_ + (size_t)n_ * 64; \
        lgb = logits[(t0_ + lane0) * 8 + h]; lga = logits[(t0_ + lane0) * 8 + 4 + h]; \
        _Pragma("unroll") for (int r = 0; r < 7; ++r) { const int sp_ = n_ * 64 + 4 * tg0 - 3 + r; \
            _Pragma("unroll") for (int a = 0; a < 3; ++a) pre[a][r] = (sp_ >= 0) ? *(const u32x2*)(proj + ((size_t)b * SEQ_ + sp_) * PJ_ + 1024 + a * 512 + h * 128 + ch0) : (u32x2){0u, 0u}; } } while (0)
        GA_PREFETCH(ub);
        for (int k = 0; k < 8; ++k) {
            const int unit = ub + k, n = unit & 127;
            int tid_o = tid; asm volatile("" : "+v"(tid_o));
            const int lane = tid_o & 63, r16 = lane & 15, kq = lane >> 4, cg4 = tid_o & 31, tg = tid_o >> 5, ch = cg4 * 4;
            unsigned char* gbase = ws + WS_R4 + (size_t)unit * GU_BYTES;
            const float betav = sigmoidf_(lgb);
            float gc = -Aexp * softplusf_(lga + dtb);
#pragma unroll
            for (int o = 1; o < 64; o <<= 1) { const float tmp = __shfl_up(gc, o); if (lane >= o) gc += tmp; }
            const float gclast = __shfl(gc, 63);
            if (wid == 0) { gcs[lane] = gc; betas[lane] = betav; kdec[lane] = __expf(gclast - gc); }
            {
                float x[7][4], o[4][4], bt[4], egt[4];
#pragma unroll
                for (int t = 0; t < 4; ++t) { bt[t] = __shfl(betav, 4 * tg + t); egt[t] = __expf(__shfl(gc, 4 * tg + t)); }
#pragma unroll
                for (int a = 0; a < 3; ++a) {
#pragma unroll
                    for (int r = 0; r < 7; ++r) { x[r][0] = __uint_as_float(pre[a][r].x << 16); x[r][1] = __uint_as_float(pre[a][r].x & 0xffff0000u); x[r][2] = __uint_as_float(pre[a][r].y << 16); x[r][3] = __uint_as_float(pre[a][r].y & 0xffff0000u); }
#pragma unroll
                    for (int t = 0; t < 4; ++t)
#pragma unroll
                        for (int e = 0; e < 4; ++e) { float acc = cw[a][0][e] * x[t][e]; acc += cw[a][1][e] * x[t + 1][e]; acc += cw[a][2][e] * x[t + 2][e]; acc += cw[a][3][e] * x[t + 3][e]; o[t][e] = siluf_(acc); }
                    if (a < 2) {
#pragma unroll
                        for (int t = 0; t < 4; ++t) { float ssq = (o[t][0] * o[t][0] + o[t][1] * o[t][1]) + (o[t][2] * o[t][2] + o[t][3] * o[t][3]);
                            ssq += dpp_f<0xB1>(ssq); ssq += dpp_f<0x4E>(ssq); ssq += dpp_f<0x141>(ssq); ssq += dpp_f<0x140>(ssq); ssq += __shfl_xor(ssq, 16);
                            const float rs = rsqrtf(ssq + EPS_) * (a == 0 ? 0.08838834764831845f : 1.0f);
#pragma unroll
                            for (int e = 0; e < 4; ++e) o[t][e] *= rs; }
                    }
                    if (a == 0) {
#pragma unroll
                        for (int t = 0; t < 4; ++t) { const int tok = 4 * tg + t; u32x2 w; w.x = cvt_pk_bf16(o[t][0], o[t][1]); w.y = cvt_pk_bf16(o[t][2], o[t][3]); *(u32x2*)(Qb + tok * 136 + ch) = w;
                            u32x2 wd; wd.x = cvt_pk_bf16(o[t][0] * egt[t], o[t][1] * egt[t]); wd.y = cvt_pk_bf16(o[t][2] * egt[t], o[t][3] * egt[t]);
                            *(u32x2*)((bf16_t*)gbase + (size_t)(64 + tok) * 128 + 32 * (cg4 >> 3) + 8 * (cg4 & 3) + 4 * ((cg4 >> 2) & 1)) = wd; }
                    } else if (a == 1) {
#pragma unroll
                        for (int t = 0; t < 4; ++t) { const int tok = 4 * tg + t; u32x2 w; w.x = cvt_pk_bf16(o[t][0], o[t][1]); w.y = cvt_pk_bf16(o[t][2], o[t][3]); *(u32x2*)(Kb + tok * 136 + ch) = w; }
#pragma unroll
                        for (int e = 0; e < 4; ++e) { u32x2 w; w.x = cvt_pk_bf16(o[0][e] * bt[0] * egt[0], o[1][e] * bt[1] * egt[1]); w.y = cvt_pk_bf16(o[2][e] * bt[2] * egt[2], o[3][e] * bt[3] * egt[3]); *(u32x2*)(KBGt + (ch + e) * 72 + (((tg >> 1) ^ (cg4 & 7)) << 3) + 4 * (tg & 1)) = w; }
                    } else {
#pragma unroll
                        for (int e = 0; e < 4; ++e) { u32x2 w; w.x = cvt_pk_bf16(o[0][e] * bt[0], o[1][e] * bt[1]); w.y = cvt_pk_bf16(o[2][e] * bt[2], o[3][e] * bt[3]); *(u32x2*)(VBt + (ch + e) * 72 + (((tg >> 1) ^ (cg4 & 7)) << 3) + 4 * (tg & 1)) = w; }
                    }
                }
            }
            if (k + 1 < 8) GA_PREFETCH(unit + 1);
            __syncthreads();
#pragma unroll
            for (int rep = 0; rep < 2; ++rep) {
                const int tl = wid + 8 * rep, jt = tl >> 2, it = tl & 3;
                f32x4 accQ = {0.f, 0.f, 0.f, 0.f}, accK = {0.f, 0.f, 0.f, 0.f};
#pragma unroll
                for (int ks = 0; ks < 4; ++ks) { const bf16x8 a = *(const bf16x8*)(Kb + (16 * jt + r16) * 136 + 32 * ks + 8 * kq);
                    const bf16x8 bq = *(const bf16x8*)(Qb + (16 * it + r16) * 136 + 32 * ks + 8 * kq), bk = *(const bf16x8*)(Kb + (16 * it + r16) * 136 + 32 * ks + 8 * kq);
                    accQ = MFMA16(a, bq, accQ); accK = MFMA16(a, bk, accK); }
                const int i = 16 * it + r16; const float gi = gcs[i], bi = betas[i]; float qv[4];
#pragma unroll
                for (int jj = 0; jj < 4; ++jj) { const int j = 16 * jt + 4 * kq + jj; const float d = __expf(fminf(gi - gcs[j], 0.f));
                    qv[jj] = (i >= j) ? accQ[jj] * d : 0.f; Lsw[i * 68 + (j & 7) * 8 + (j >> 3)] = (i > j) ? bi * accK[jj] * d : 0.f; }
                u32x2 w; w.x = cvt_pk_bf16(qv[0], qv[1]); w.y = cvt_pk_bf16(qv[2], qv[3]);
                *(u32x2*)((bf16_t*)(gbase + GU_QK) + i * 64 + 32 * (jt >> 1) + 8 * kq + 4 * (jt & 1)) = w;
            }
            __syncthreads();
            {
                const int s = lane & 7, c = 8 * wid + (lane >> 3); float t[8];
#pragma unroll
                for (int m = 0; m < 8; ++m) t[m] = 0.f;
                f32x4 la[2][2]; la[0][0] = *(const f32x4*)(Lsw + s * 8); la[0][1] = *(const f32x4*)(Lsw + s * 8 + 4);
#pragma unroll
                for (int i = 0; i < 64; ++i) {
                    if (i + 1 < 64) { la[(i + 1) & 1][0] = *(const f32x4*)(Lsw + (i + 1) * 68 + s * 8); la[(i + 1) & 1][1] = *(const f32x4*)(Lsw + (i + 1) * 68 + s * 8 + 4); }
                    asm volatile("" ::: "memory");
                    const f32x4 l0 = la[i & 1][0], l1 = la[i & 1][1];
                    float part = 0.f;
#pragma unroll
                    for (int m = 0; m < 8; ++m) if (8 * m <= i) part += ((m < 4) ? l0[m & 3] : l1[m & 3]) * t[m];
                    part = red8(part);
                    const float val = ((i == c) ? 1.0f : 0.0f) - part;
                    if (s == (i & 7)) t[i >> 3] = val;
                }
#pragma unroll
                for (int m = 0; m < 8; ++m) Tb[(8 * m + s) * 72 + c] = f2bf(t[m]);
            }
            __syncthreads();
            {
#pragma unroll
                for (int mt = 0; mt < 4; ++mt) { f32x4 acc = {0.f, 0.f, 0.f, 0.f};
#pragma unroll
                    for (int ks = 0; ks < 2; ++ks) { const bf16x8 a = *(const bf16x8*)(Tb + (16 * mt + r16) * 72 + 32 * ks + 8 * kq), bb = *(const bf16x8*)(VBt + (16 * wid + r16) * 72 + (((4 * ks + kq) ^ ((4 * wid + (r16 >> 2)) & 7)) << 3)); acc = MFMA16(a, bb, acc); }
                    u32x2 w; w.x = cvt_pk_bf16(acc[0], acc[1]); w.y = cvt_pk_bf16(acc[2], acc[3]);
                    *(u32x2*)((bf16_t*)(gbase + GU_U) + ((wid * 4 + mt) * 64 + lane) * 4) = w; }
#pragma unroll
                for (int it = 0; it < 4; ++it) { f32x4 acc = {0.f, 0.f, 0.f, 0.f};
#pragma unroll
                    for (int ks = 0; ks < 2; ++ks) { const bf16x8 a = *(const bf16x8*)(KBGt + (16 * wid + r16) * 72 + (((4 * ks + kq) ^ ((4 * wid + (r16 >> 2)) & 7)) << 3)), bb = *(const bf16x8*)(Tb + (16 * it + r16) * 72 + 32 * ks + 8 * kq); acc = MFMA16(a, bb, acc); }
                    u32x2 w; w.x = cvt_pk_bf16(acc[0], acc[1]); w.y = cvt_pk_bf16(acc[2], acc[3]);
                    *(u32x2*)((bf16_t*)gbase + (16 * it + r16) * 128 + 32 * (wid >> 1) + 8 * kq + 4 * (wid & 1)) = w; }
                const int dk = tid_o >> 2, pg = tid_o & 3; float v[16];
#pragma unroll
                for (int e = 0; e < 16; ++e) { const int tk = tok_of_pos(16 * pg + e); v[e] = bf2f(Kb[tk * 136 + dk]) * kdec[tk]; }
                u32x4 w0, w1; w0.x = cvt_pk_bf16(v[0], v[1]); w0.y = cvt_pk_bf16(v[2], v[3]); w0.z = cvt_pk_bf16(v[4], v[5]); w0.w = cvt_pk_bf16(v[6], v[7]);
                w1.x = cvt_pk_bf16(v[8], v[9]); w1.y = cvt_pk_bf16(v[10], v[11]); w1.z = cvt_pk_bf16(v[12], v[13]); w1.w = cvt_pk_bf16(v[14], v[15]);
                *(u32x4*)((bf16_t*)(gbase + GU_KDT) + dk * 64 + 16 * pg) = w0; *(u32x4*)((bf16_t*)(gbase + GU_KDT) + dk * 64 + 16 * pg + 8) = w1;
                if (tid == 0) gtot[unit] = __expf(gclast);
            }
            __syncthreads();
        }
    }
#undef GA_PREFETCH
}

constexpr int GB_BUF = 62464, GB_KDT = 34816, GB_QK = 53248, GB_BUF2 = GB_BUF + 4096 + 16;
__device__ __forceinline__ void gdn_pass_b(const Params& p, unsigned char* smem, int wg) {
    const int tid = threadIdx.x, wid = __builtin_amdgcn_readfirstlane(tid >> 6), lane = tid & 63, r16 = lane & 15, kq = lane >> 4;
    const int bh = wg >> 2, cgp = wg & 3, b = bh >> 2, h = bh & 3, nt = cgp * 2 + wid;
    unsigned char* ws = p.ws; const unsigned char* ubase = ws + WS_R4 + (size_t)(bh * 128) * GU_BYTES; const float* gtot = (const float*)(ws + WS_GTOT) + bh * 128;
    bf16_t* oraw = (bf16_t*)(ws + WS_ORAW);
#define GB_BAR() do { asm volatile("s_waitcnt lgkmcnt(0)" ::: "memory"); __builtin_amdgcn_s_barrier(); asm volatile("" ::: "memory"); } while (0)
    if (wid >= 2) {
        const int lt = tid - 128;
        int dsto[10]; size_t srco[10];
#pragma unroll
        for (int it = 0; it < 10; ++it) { const int q = lt + 384 * it;
            dsto[it] = (q < 2048) ? (q >> 4) * 272 + (q & 15) * 16 : (q < 3072) ? GB_KDT + ((q - 2048) >> 3) * 144 + ((q - 2048) & 7) * 16 : (q < 3584) ? GB_QK + ((q - 3072) >> 3) * 144 + ((q - 3072) & 7) * 16 : GB_BUF + (q - 3584) * 16;
            srco[it] = (q < 3584) ? (size_t)q * 16 : (size_t)(GU_U + cgp * 4096 + (q - 3584) * 16); }
        u32x4 sa[10], sb[10], sc[10]; float ga = 0.f, gb = 0.f, gc = 0.f;
#define GB_LD(st, g, n_) do { const unsigned char* rp_ = ubase + (size_t)(n_) * GU_BYTES; _Pragma("unroll") for (int it = 0; it < 10; ++it) st[it] = *(const u32x4*)(rp_ + srco[it]); if (lt == 0) g = gtot[n_]; } while (0)
#define GB_WR(st, g, bufi) do { unsigned char* bp_ = smem + (bufi) * GB_BUF2; _Pragma("unroll") for (int it = 0; it < 10; ++it) *(u32x4*)(bp_ + dsto[it]) = st[it]; if (lt == 0) *(float*)(bp_ + GB_BUF + 4096) = g; } while (0)
        GB_LD(sa, ga, 0); GB_WR(sa, ga, 0); GB_BAR();
        GB_LD(sa, ga, 1); GB_LD(sb, gb, 2); GB_LD(sc, gc, 3);
        for (int n0 = 0; n0 < NCH_; n0 += 3) {
            { const int n = n0;     if (n < NCH_) { if (n + 1 < NCH_) GB_WR(sa, ga, (n + 1) & 1); if (n + 4 < NCH_) GB_LD(sa, ga, n + 4); GB_BAR(); } }
            { const int n = n0 + 1; if (n < NCH_) { if (n + 1 < NCH_) GB_WR(sb, gb, (n + 1) & 1); if (n + 4 < NCH_) GB_LD(sb, gb, n + 4); GB_BAR(); } }
            { const int n = n0 + 2; if (n < NCH_) { if (n + 1 < NCH_) GB_WR(sc, gc, (n + 1) & 1); if (n + 4 < NCH_) GB_LD(sc, gc, n + 4); GB_BAR(); } }
        }
#undef GB_LD
#undef GB_WR
    } else {
        f32x4 S[8]; bf16x8 Sb[4];
#pragma unroll
        for (int d = 0; d < 8; ++d) S[d] = (f32x4){0.f, 0.f, 0.f, 0.f};
#pragma unroll
        for (int k = 0; k < 4; ++k) Sb[k] = (bf16x8){0, 0, 0, 0, 0, 0, 0, 0};
        GB_BAR();
        for (int n = 0; n < NCH_; ++n) {
            const unsigned char* L = smem + (n & 1) * GB_BUF2; const float gt = *(const float*)(L + GB_BUF + 4096); const size_t t0 = (size_t)b * SEQ_ + (size_t)n * 64;
            u32x2 uw[4];
#pragma unroll
            for (int tt = 0; tt < 4; ++tt) uw[tt] = *(const u32x2*)(L + GB_BUF + ((wid * 4 + tt) * 64 + lane) * 8);
            f32x4 P[8];
#pragma unroll
            for (int m = 0; m < 8; ++m) P[m] = (f32x4){0.f, 0.f, 0.f, 0.f};
#pragma unroll
            for (int ks = 0; ks < 4; ++ks)
#pragma unroll
                for (int mt = 0; mt < 8; ++mt) { const bf16x8 a = *(const bf16x8*)(L + (16 * mt + r16) * 272 + (32 * ks + 8 * kq) * 2); P[mt] = MFMA16(a, Sb[ks], P[mt]); }
            f32x4 vn[4];
#pragma unroll
            for (int tt = 0; tt < 4; ++tt) { const f32x4 u = {__uint_as_float(uw[tt].x << 16), __uint_as_float(uw[tt].x & 0xffff0000u), __uint_as_float(uw[tt].y << 16), __uint_as_float(uw[tt].y & 0xffff0000u)}; vn[tt] = u - P[tt]; }
            bf16x8 Vb[2]; Vb[0] = pack8(vn[0], vn[1]); Vb[1] = pack8(vn[2], vn[3]);
#pragma unroll
            for (int tt = 0; tt < 4; ++tt) { f32x4 O = P[4 + tt];
#pragma unroll
                for (int ks = 0; ks < 2; ++ks) { const bf16x8 a = *(const bf16x8*)(L + GB_QK + (16 * tt + r16) * 144 + (32 * ks + 8 * kq) * 2); O = MFMA16(a, Vb[ks], O); }
                bf16_t* op = oraw + (t0 + 16 * tt + 4 * kq) * 512 + h * 128 + 16 * nt + r16;
#pragma unroll
                for (int j = 0; j < 4; ++j) op[(size_t)j * 512] = f2bf(O[j]); }
#pragma unroll
            for (int dt = 0; dt < 8; ++dt) { f32x4 acc = S[dt] * gt;
#pragma unroll
                for (int ks = 0; ks < 2; ++ks) { const bf16x8 a = *(const bf16x8*)(L + GB_KDT + (16 * dt + r16) * 144 + (32 * ks + 8 * kq) * 2); acc = MFMA16(a, Vb[ks], acc); }
                S[dt] = acc; }
#pragma unroll
            for (int ks = 0; ks < 4; ++ks) Sb[ks] = pack8(S[2 * ks], S[2 * ks + 1]);
            GB_BAR();
        }
    }
#undef GB_BAR
}

__device__ __forceinline__ void gdn_norm(const Params& p) {
    unsigned char* ws = p.ws; const bf16_t* oraw = (const bf16_t*)(ws + WS_ORAW); const bf16_t* proj = (const bf16_t*)(ws + WS_PROJ); bf16_t* y = (bf16_t*)(ws + WS_Y);
    int tid_o = threadIdx.x; asm volatile("" : "+v"(tid_o));
    const int gtid = blockIdx.x * NTHREADS + tid_o, sub = gtid & 31; const f32x4 nwv = *(const f32x4*)(p.in[14] + sub * 4);
    const int stride = (gridDim.x * NTHREADS) >> 5;
    for (int item0 = gtid >> 5; item0 < T_ * 4; item0 += 4 * stride) {
        u32x2 ow[4], zw[4];
#pragma unroll
        for (int q = 0; q < 4; ++q) { const int item = item0 + q * stride; const int t = item >> 2, h = item & 3;
            if (item < T_ * 4) { ow[q] = *(const u32x2*)(oraw + (size_t)t * 512 + h * 128 + sub * 4); zw[q] = *(const u32x2*)(proj + (size_t)t * PJ_ + 2560 + h * 128 + sub * 4); } else { ow[q] = (u32x2){0u, 0u}; zw[q] = (u32x2){0u, 0u}; } }
#pragma unroll
        for (int q = 0; q < 4; ++q) { const int item = item0 + q * stride; const int t = item >> 2, h = item & 3;
            const f32x4 ov = {__uint_as_float(ow[q].x << 16), __uint_as_float(ow[q].x & 0xffff0000u), __uint_as_float(ow[q].y << 16), __uint_as_float(ow[q].y & 0xffff0000u)};
            float s = (ov[0] * ov[0] + ov[1] * ov[1]) + (ov[2] * ov[2] + ov[3] * ov[3]);
#pragma unroll
            for (int o = 1; o < 32; o <<= 1) s += __shfl_xor(s, o);
            const float rs = rsqrtf(s * (1.0f / 128.0f) + EPS_);
            const float z0 = __uint_as_float(zw[q].x << 16), z1 = __uint_as_float(zw[q].x & 0xffff0000u), z2 = __uint_as_float(zw[q].y << 16), z3 = __uint_as_float(zw[q].y & 0xffff0000u);
            u32x2 w; w.x = cvt_pk_bf16(ov[0] * rs * nwv[0] * siluf_(z0), ov[1] * rs * nwv[1] * siluf_(z1)); w.y = cvt_pk_bf16(ov[2] * rs * nwv[2] * siluf_(z2), ov[3] * rs * nwv[3] * siluf_(z3));
            if (item < T_ * 4) *(u32x2*)(y + (size_t)t * D_ + 512 + h * 128 + sub * 4) = w; }
    }
}

__device__ __forceinline__ void phase_final(const Params& p) {
    const int tid = threadIdx.x, wid = __builtin_amdgcn_readfirstlane(tid >> 6), lane = tid & 63;
    const float* ss = (const float*)(p.ws + WS_SSA); const float* nw = p.in[24]; float* out = p.out; const bf16_t* x3b = (const bf16_t*)(p.ws + WS_XB);
    f32x4 nwv[4];
#pragma unroll
    for (int i = 0; i < 4; ++i) nwv[i] = *(const f32x4*)(nw + 4 * (lane + 64 * i));
    u32x2 wn[4]; int row = blockIdx.x * 8 + wid;
    if (row < T_) {
#pragma unroll
        for (int i = 0; i < 4; ++i) wn[i] = *(const u32x2*)(x3b + (size_t)row * D_ + 4 * (lane + 64 * i)); }
    for (; row < T_; row += gridDim.x * 8) {
        const float rs = rstd16(ss, row);
        u32x2 wc[4];
#pragma unroll
        for (int i = 0; i < 4; ++i) wc[i] = wn[i];
        { const int nrow = row + gridDim.x * 8;
          if (nrow < T_) {
#pragma unroll
            for (int i = 0; i < 4; ++i) wn[i] = *(const u32x2*)(x3b + (size_t)nrow * D_ + 4 * (lane + 64 * i)); } }
#pragma unroll
        for (int i = 0; i < 4; ++i) { const u32x2 w = wc[i]; const f32x4 v = {__uint_as_float(w.x << 16), __uint_as_float(w.x & 0xffff0000u), __uint_as_float(w.y << 16), __uint_as_float(w.y & 0xffff0000u)};
            *(f32x4*)(out + (size_t)row * D_ + 4 * (lane + 64 * i)) = v * rs * nwv[i]; }
    }
}

constexpr int NPHASES = 11;
__global__ void __launch_bounds__(NTHREADS, 2) mega_fwd(Params p) {
    extern __shared__ __attribute__((aligned(16))) unsigned char smem[];
    PG8_LAS unsigned char* lds = (PG8_LAS unsigned char*)smem;
    cg::grid_group grid = cg::this_grid();
    unsigned char* ws = p.ws;
    bf16_t* hb = (bf16_t*)(ws + WS_XB); bf16_t* xb = (bf16_t*)(ws + WS_XB2); bf16_t* proj = (bf16_t*)(ws + WS_PROJ); bf16_t* ff = proj; bf16_t* y = (bf16_t*)(ws + WS_Y); bf16_t* pp = (bf16_t*)(ws + WS_PP);
    float* ssA = (float*)(ws + WS_SSA); float* ssB = (float*)(ws + WS_SSB);
#ifdef ONLY_PHASE
#define PH_ON(n) ((n) == ONLY_PHASE)
#else
#define PH_ON(n) ((n) >= p.ph_lo && (n) < p.ph_hi)
#endif
    volatile LAS unsigned* xst = (volatile LAS unsigned*)(lds + LDS_BYTES - 16);
    if (threadIdx.x == 0) { xst[0] = 0u; xst[1] = 0u; xst[2] = 0u; xst[3] = 0u; }
    __syncthreads();
    const XcdBarrier xbar = xcd_barrier_post((unsigned*)(ws + WS_BAR), xst);
    if (p.ph_lo == 0x7fffffff) grid.sync();
#define PH_SYNC(n) do { if ((n) > p.ph_lo && (n) < p.ph_hi) { xcd_barrier(xbar); } } while (0)
    if (PH_ON(0)) phase_prep(p, smem);
    PH_SYNC(1);
    if (PH_ON(1)) { EpiBf16Plain E; E.O = proj; E.ldc = PJ_; run_gemm(lds, hb, (const bf16_t*)(ws + WS_WIN), T_, PJ_, D_, E); }
    PH_SYNC(2);
    if (PH_ON(2)) { rg_pass_mfma<false>(p, smem, (int)blockIdx.x, (int)gridDim.x); __syncthreads(); gdn_pass_a(p, smem); }
    PH_SYNC(3);
    if (PH_ON(3)) {
        unsigned* flag = (unsigned*)ws + 16;
        if (blockIdx.x < 64) { const int xq = blockIdx.x & 7, kq8 = blockIdx.x >> 3;
            gdn_pass_b(p, smem, ((xq + 8 * (kq8 >> 2)) << 2) | (kq8 & 3)); }
        else {
            if (blockIdx.x < 68) { rg_carry(p, (blockIdx.x - 64) * NTHREADS + threadIdx.x); __threadfence(); __syncthreads();
                if (threadIdx.x == 0) __hip_atomic_fetch_add(flag, 1u, __ATOMIC_RELEASE, __HIP_MEMORY_SCOPE_AGENT); }
            prep_weights_late(p, smem, (int)blockIdx.x - 64, (int)gridDim.x - 64);
            if (threadIdx.x == 0) { while (__hip_atomic_load(flag, __ATOMIC_ACQUIRE, __HIP_MEMORY_SCOPE_AGENT) < 4u) __builtin_amdgcn_s_sleep(8); }
            __syncthreads(); __threadfence();
            rg_pass_mfma<true>(p, smem, (int)blockIdx.x - 64, (int)gridDim.x - 64);
        }
    }
    PH_SYNC(4);
    if (PH_ON(4)) gdn_norm(p);
    PH_SYNC(5);
    if (PH_ON(5)) { EpiResid<false> E; E.res = p.in[0]; E.xb = xb; E.ss = ssA; run_gemm(lds, y, (const bf16_t*)(ws + WS_WOUT), T_, D_, D_, E); }
    PH_SYNC(6);
    if (PH_ON(6)) { EpiGateUp E; E.ff = ff; E.ss = ssA; run_gemm(lds, xb, (const bf16_t*)(ws + WS_WGU), T_, 2 * FF_, D_, E); }
    if (PH_ON(10)) { EpiBf16Plain E2; E2.O = pp; E2.ldc = D_; run_gemm(lds, (const bf16_t*)(ws + WS_PB), (const bf16_t*)(ws + WS_WPP), T_, D_, PLE_, E2); }
    PH_SYNC(7);
    if (PH_ON(7)) { EpiResid<true> E; E.res = nullptr; E.xb = xb; E.ss = ssB; run_gemm(lds, ff, (const bf16_t*)(ws + WS_WD), T_, D_, FF_, E); }
    PH_SYNC(8);
    if (PH_ON(8)) { EpiPle E; E.x2b = xb; E.x3b = hb; E.pp = pp; E.bias = p.in[22]; E.ss_in = ssB; E.ss_out = ssA; run_gemm(lds, xb, (const bf16_t*)(ws + WS_WPG), T_, D_, D_, E); }
    PH_SYNC(9);
    if (PH_ON(9)) phase_final(p);
}

extern "C" void kernel_launch(void* const* d_in, const int* in_sizes, int n_in, void* d_out, int out_size, void* d_ws, size_t ws_size, hipStream_t stream) {
    static int grid = 0;
    if (grid == 0) {
        if (n_in != 25 || out_size != T_ * D_ || ws_size < WS_END) { fprintf(stderr, "kernel_launch: unexpected shapes: n_in %d out %d ws %zu (need %zu)\n", n_in, out_size, ws_size, (size_t)WS_END); grid = -1; return; }
        int dev = 0, cus = 0, per_cu = 0;
        hipGetDevice(&dev); hipDeviceGetAttribute(&cus, hipDeviceAttributeMultiprocessorCount, dev);
        if (hipFuncSetAttribute((const void*)mega_fwd, hipFuncAttributeMaxDynamicSharedMemorySize, LDS_BYTES) != hipSuccess) { fprintf(stderr, "kernel_launch: hipFuncSetAttribute failed\n"); grid = -1; return; }
        if (hipOccupancyMaxActiveBlocksPerMultiprocessor(&per_cu, (const void*)mega_fwd, NTHREADS, LDS_BYTES) != hipSuccess || per_cu < 1) { fprintf(stderr, "kernel_launch: occupancy query says %d\n", per_cu); per_cu = 1; }
        (void)hipGetLastError();
        grid = cus * 1;
        if (grid <= 0) grid = 256;
    }
    if (grid < 0) return;
    Params p{};
    for (int i = 0; i < 25; ++i) p.in[i] = (const float*)d_in[i];
    p.out = (float*)d_out; p.ws = (unsigned char*)d_ws; p.ph_lo = 0; p.ph_hi = NPHASES;
    if (hipMemsetAsync((char*)d_ws + WS_BAR, 0, XCD_BAR_WORDS * 4, stream) != hipSuccess) { fprintf(stderr, "kernel_launch: memset of the barrier words failed\n"); return; }
    void* args[] = {&p};
    hipError_t e = hipLaunchCooperativeKernel((const void*)mega_fwd, dim3(grid), dim3(NTHREADS), args, LDS_BYTES, stream);
    if (e != hipSuccess) fprintf(stderr, "cooperative launch failed: %s (grid %d)\n", hipGetErrorString(e), grid);
}
```

```cpp
#include <hip/hip_runtime.h>
#include <hip/hip_cooperative_groups.h>
#include <cstdio>
#include <cstdint>
namespace cg = cooperative_groups;
namespace pg8 {
#define PG8_LAS __attribute__((address_space(3)))
typedef unsigned short bf16_t;
typedef short bf16x8 __attribute__((ext_vector_type(8)));
typedef float f32x4 __attribute__((ext_vector_type(4)));
typedef unsigned u32x4 __attribute__((ext_vector_type(4)));
constexpr int BM = 256, BK = 64, HALF = 128, HTB = HALF * BK * 2  , STAGE_BYTES = 8 * HTB, NXCD = 8, WGM = 8;

__host__ __device__ __forceinline__ int lds_byte(int r, int c) { const int st = (r >> 4) * 2 + (c >> 5), rr = r & 15, cc = c & 31, ob = rr * 64 + cc * 2; return st * 1024 + (ob ^ (((ob >> 9) & 1) << 5)); }
__host__ __device__ __forceinline__ void stage_rc(int b, int& R, int& C) { const int st = b / 1024, sb = b % 1024, swz = sb ^ (((sb >> 9) & 1) << 5); R = (st >> 1) * 16 + swz / 64; C = (st & 1) * 32 + (swz % 64) / 2; }
__host__ __device__ __forceinline__ int perm32(int rho) { const int n = rho >> 4, i = rho & 15; return 8 * (i >> 2) + 4 * n + (i & 3); }

struct Unit { int pm, pn; };
struct Gemm { const bf16_t* A; const bf16_t* Bt; int M, N, K; };

struct StaticOrder {
    int nM, nN, nwg, G, c;
    __host__ __device__ void init(int M, int N, int G_, int c_) { nM = M / BM; nN = N / BM; nwg = nM * nN; G = G_; c = c_; }
    __host__ __device__ bool next(int i, Unit& u) const {
        const long L = (long)i * G + c; if (L >= nwg) return false;
        int wgid = (int)L; { const int q = nwg / NXCD, r = nwg % NXCD, xcd = wgid % NXCD, off = wgid / NXCD; wgid = (xcd < r ? xcd * (q + 1) : r * (q + 1) + (xcd - r) * q) + off; }
        const int nig = WGM * nN, gid = wgid / nig, fm = gid * WGM, gsz = (nM - fm) < WGM ? (nM - fm) : WGM;
        u.pm = fm + ((wgid % nig) % gsz); u.pn = (wgid % nig) / gsz; return true;
    }
    __device__ __forceinline__ void a_ready(const Unit&) const {}
    __device__ __forceinline__ void done(const Unit&) const {}
};
typedef __bf16 bf16v2_ __attribute__((ext_vector_type(2)));
typedef float f32v2_ __attribute__((ext_vector_type(2)));
__device__ __forceinline__ unsigned cvt_pk_bf16(float lo, float hi) { f32v2_ v = {lo, hi}; bf16v2_ b = __builtin_convertvector(v, bf16v2_); return __builtin_bit_cast(unsigned, b); }
typedef float f32x2 __attribute__((ext_vector_type(2)));
template <class Epi, class Sched, bool STAMP = false>
__device__ __forceinline__ void gemm_phase(PG8_LAS unsigned char* lds, const Gemm g, const Sched& S, const Epi& E, unsigned long long* stamps) {
    int tid = threadIdx.x; asm volatile("" : "+v"(tid));
    const int wid = __builtin_amdgcn_readfirstlane(tid >> 6), lane = tid & 63, wr = wid >> 2, wc = wid & 3, fr = lane & 15, fq = lane >> 4;
    const int K = g.K, nt = K / BK;
    int ts_lo = 0, ts_hi = 0, nts = 0; const unsigned long long rt_entry = STAMP ? (unsigned long long)wall_clock64() : 0ull;
#define PG8_STAMP() do { if (STAMP && wid == 0 && nts < 64) { const unsigned long long _c = (unsigned long long)clock64(); \
        ts_lo = (lane == nts) ? (int)(unsigned)_c : ts_lo; ts_hi = (lane == nts) ? (int)(unsigned)(_c >> 32) : ts_hi; ++nts; } } while (0)
    PG8_STAMP();
    unsigned voffA[2], voffB[2];
#pragma unroll
    for (int i = 0; i < 2; ++i) { int R, C; stage_rc(tid * 16 + i * 8192, R, C); const int Rb = Epi::PERM ? ((R & ~31) + perm32(R & 31)) : R;
        voffA[i] = (unsigned)(R * K + C) * 2u; voffB[i] = (unsigned)(Rb * K + C) * 2u; }
    const size_t kstep = (size_t)(BK * 2);
    const size_t hstep = (size_t)HALF * K * 2;
    const size_t tstep = 2 * hstep;
    const unsigned ldsw = (unsigned)wid * 1024u;
    const int aoff = lds_byte(wr * 64 + fr, fq * 8), boff = lds_byte(wc * 32 + fr, fq * 8);
#define PG8_SA(b, h) (((b) * 2 + (h)) * HTB)
#define PG8_SB(b, h) ((4 + (b) * 2 + (h)) * HTB)
#define PG8_STAGE(bufoff, gbase, voff) do { _Pragma("unroll") for (int _i = 0; _i < 2; ++_i) \
        __builtin_amdgcn_global_load_lds((const unsigned*)((const char*)(gbase) + (voff)[_i]), (PG8_LAS unsigned*)(lds + (bufoff) + ldsw + _i * 8192), 16, 0, 0); } while (0)
#define PG8_LDA(dst, b, h) do { _Pragma("unroll") for (int m = 0; m < 4; ++m) _Pragma("unroll") for (int k = 0; k < 2; ++k) dst[m][k] = *(const PG8_LAS bf16x8*)(lds + PG8_SA(b, h) + aoff + m * 2048 + k * 1024); } while (0)
#define PG8_LDB(dst, b, h) do { _Pragma("unroll") for (int n = 0; n < 2; ++n) _Pragma("unroll") for (int k = 0; k < 2; ++k) dst[n][k] = *(const PG8_LAS bf16x8*)(lds + PG8_SB(b, h) + boff + n * 2048 + k * 1024); } while (0)
#define PG8_MMA(ai, bj, At, Bt) do { __builtin_amdgcn_s_setprio(1); _Pragma("unroll") for (int m = 0; m < 4; ++m) _Pragma("unroll") for (int n = 0; n < 2; ++n) _Pragma("unroll") for (int k = 0; k < 2; ++k) \
        acc[ai][bj][m][n] = __builtin_amdgcn_mfma_f32_16x16x32_bf16(Bt[n][k], At[m][k], acc[ai][bj][m][n], 0, 0, 0); __builtin_amdgcn_s_setprio(0); } while (0)
#define PG8_WAIT_V(n) asm volatile("s_waitcnt vmcnt(" #n ")" ::: "memory")
#define PG8_WAIT_L(n) asm volatile("s_waitcnt lgkmcnt(" #n ")" ::: "memory")
#define PG8_BAR __builtin_amdgcn_s_barrier()
#define PG8_SCHED __builtin_amdgcn_sched_barrier(0)
    Unit cur, nxt; int ui = 0;
    if (!S.next(0, cur)) return;
    f32x4 acc[2][2][4][2];
#pragma unroll
    for (int a = 0; a < 2; ++a)
#pragma unroll
        for (int b = 0; b < 2; ++b)
#pragma unroll
            for (int m = 0; m < 4; ++m)
#pragma unroll
                for (int n = 0; n < 2; ++n) acc[a][b][m][n] = (f32x4){0.f, 0.f, 0.f, 0.f};
    bf16x8 At[4][2], B0[2][2], B1[2][2];
    const char* cA = (const char*)g.A + (size_t)cur.pm * tstep; const char* cB = (const char*)g.Bt + (size_t)cur.pn * tstep;
    S.a_ready(cur);
    PG8_STAGE(PG8_SB(0, 0), cB, voffB); PG8_STAGE(PG8_SA(0, 0), cA, voffA); PG8_STAGE(PG8_SB(0, 1), cB + hstep, voffB); PG8_STAGE(PG8_SA(0, 1), cA + hstep, voffA);
    if (wr == 1) PG8_BAR;
    PG8_WAIT_V(4); PG8_BAR;
    PG8_STAGE(PG8_SB(1, 0), cB + kstep, voffB); PG8_STAGE(PG8_SA(1, 0), cA + kstep, voffA); PG8_STAGE(PG8_SB(1, 1), cB + hstep + kstep, voffB);
    PG8_WAIT_V(6); PG8_BAR;
    PG8_STAMP();
    for (;;) {
        const bool has_next = S.next(ui + 1, nxt);
        const char* nA = has_next ? (const char*)g.A + (size_t)nxt.pm * tstep : cA; const char* nB = has_next ? (const char*)g.Bt + (size_t)nxt.pn * tstep : cB;
        for (int t = 0; t < nt; t += 2) {
            const bool last = (t == nt - 2);
            const char* a1 = cA + (size_t)(t + 1) * kstep;
            const char* a2 = last ? nA : cA + (size_t)(t + 2) * kstep; const char* b2 = last ? nB : cB + (size_t)(t + 2) * kstep;
            const char* a3 = a2 + kstep; const char* b3 = b2 + kstep;
            if (last && has_next) S.a_ready(nxt);
            PG8_LDB(B0, 0, 0); PG8_SCHED; PG8_LDA(At, 0, 0); PG8_STAGE(PG8_SA(1, 1), a1 + hstep, voffA);
            PG8_WAIT_L(8); PG8_BAR; PG8_WAIT_L(0); PG8_MMA(0, 0, At, B0); PG8_BAR; PG8_SCHED;
            PG8_LDB(B1, 0, 1); PG8_STAGE(PG8_SB(0, 0), b2, voffB);
            PG8_BAR; PG8_WAIT_L(0); PG8_MMA(0, 1, At, B1); PG8_BAR;
            PG8_LDA(At, 0, 1); PG8_STAGE(PG8_SA(0, 0), a2, voffA);
            PG8_BAR; PG8_WAIT_L(0); PG8_MMA(1, 0, At, B0); PG8_BAR; PG8_SCHED;
            PG8_STAGE(PG8_SB(0, 1), b2 + hstep, voffB);
            PG8_WAIT_V(6); PG8_BAR; PG8_MMA(1, 1, At, B1); PG8_BAR;
            PG8_LDB(B0, 1, 0); PG8_SCHED; PG8_LDA(At, 1, 0); PG8_STAGE(PG8_SA(0, 1), a2 + hstep, voffA);
            PG8_WAIT_L(8); PG8_BAR; PG8_WAIT_L(0); PG8_MMA(0, 0, At, B0); PG8_BAR; PG8_SCHED;
            PG8_LDB(B1, 1, 1); PG8_STAGE(PG8_SB(1, 0), b3, voffB);
            PG8_BAR; PG8_WAIT_L(0); PG8_MMA(0, 1, At, B1); PG8_BAR;
            PG8_LDA(At, 1, 1); PG8_STAGE(PG8_SA(1, 0), a3, voffA);
            PG8_BAR; PG8_WAIT_L(0); PG8_MMA(1, 0, At, B0); PG8_BAR; PG8_SCHED;
            PG8_STAGE(PG8_SB(1, 1), b3 + hstep, voffB);
            PG8_WAIT_V(6); PG8_BAR; PG8_MMA(1, 1, At, B1); PG8_BAR;
        }
        PG8_STAMP();
        if constexpr (!Epi::AFTER_DRAIN) { E(acc, cur, wr, wc, fr, fq); S.done(cur); }
        PG8_STAMP();
        if (!has_next) break;
#pragma unroll
        for (int a = 0; a < 2; ++a)
#pragma unroll
            for (int b = 0; b < 2; ++b)
#pragma unroll
                for (int m = 0; m < 4; ++m)
#pragma unroll
                    for (int n = 0; n < 2; ++n) acc[a][b][m][n] = (f32x4){0.f, 0.f, 0.f, 0.f};
        cur = nxt; cA = nA; cB = nB; ++ui;
    }
    PG8_WAIT_V(0);
    if (wr == 0) PG8_BAR;
    PG8_BAR;
    if constexpr (Epi::AFTER_DRAIN) { E.fused(acc, cur, wr, wc, fr, fq, lds, wid, lane); S.done(cur); }
    PG8_STAMP();
    if (STAMP && wid == 0) { stamps[lane] = lane < nts ? (((unsigned long long)(unsigned)ts_hi << 32) | (unsigned)ts_lo) : 0ull;
        if (lane == 62) stamps[62] = rt_entry; if (lane == 63) stamps[63] = (unsigned long long)wall_clock64(); }
#undef PG8_STAMP
#undef PG8_SA
#undef PG8_SB
#undef PG8_STAGE
#undef PG8_LDA
#undef PG8_LDB
#undef PG8_MMA
#undef PG8_WAIT_V
#undef PG8_WAIT_L
#undef PG8_BAR
#undef PG8_SCHED
}
}
#define XB_TMO      128
#define XB_XCNT(j)  (256  + 64 * (j))
#define XB_XSUB(j)  (1280 + 64 * (j))
#define XB_XGEN(j)  (2304 + 64 * (j))
#define XB_TOP      3328
#define XB_TOPGEN   3392
#define XCD_BAR_WORDS 3456
#define XB_SPIN_CAP (1u << 18)
#define LAS __attribute__((address_space(3)))

__device__ __forceinline__ unsigned xb_ld(unsigned* p)              { return __hip_atomic_load(p, __ATOMIC_RELAXED, __HIP_MEMORY_SCOPE_AGENT); }
__device__ __forceinline__ unsigned xb_add(unsigned* p, unsigned v) { return __hip_atomic_fetch_add(p, v, __ATOMIC_RELAXED, __HIP_MEMORY_SCOPE_AGENT); }
__device__ __forceinline__ unsigned xb_xcc_id() { return (unsigned)__builtin_amdgcn_s_getreg((3 << 11) | 20) & 0xFu; }
#define XB_SPIN(cond, bar) do { unsigned _sp = 0; while (cond) { __builtin_amdgcn_s_sleep(1); \
    if ((++_sp & 255u) == 0u) { if (xb_ld(&(bar)[XB_TMO])) break; if (_sp > XB_SPIN_CAP) { atomicAdd(&(bar)[XB_TMO], 1u); break; } } } } while (0)

struct XcdBarrier {
    unsigned* bar; unsigned x;
    volatile LAS unsigned* st;
};

__device__ __forceinline__ XcdBarrier xcd_barrier_post(unsigned* bar, volatile LAS unsigned* st) {
    XcdBarrier b; b.bar = bar; b.x = xb_xcc_id(); b.st = st;
    if (threadIdx.x == 0) (void)xb_add(&bar[XB_XCNT(b.x)], 1u);
    return b;
}
__device__ __forceinline__ void xcd_barrier_complete(unsigned* bar, unsigned x, unsigned& nloc, unsigned& nx) {
    const unsigned G = gridDim.x * gridDim.y * gridDim.z;
    unsigned sum, cnt, mine, sp = 0u;
    for (;;) {
        sum = 0u; cnt = 0u; mine = 0u;
#pragma unroll
        for (unsigned j = 0; j < 16; ++j) { const unsigned c = xb_ld(&bar[XB_XCNT(j)]); sum += c; cnt += (c > 0u) ? 1u : 0u; mine = (j == x) ? c : mine; }
        if (sum == G) break;
        __builtin_amdgcn_s_sleep(1);
        if ((++sp & 255u) == 0u) { if (xb_ld(&bar[XB_TMO])) break; if (sp > XB_SPIN_CAP) { atomicAdd(&bar[XB_TMO], 1u); break; } }
    }
    nloc = mine > 0u ? mine : 1u; nx = cnt > 0u ? cnt : 1u;
}

__device__ __forceinline__ void xcd_barrier(const XcdBarrier& b) {
    asm volatile("s_waitcnt vmcnt(0)" ::: "memory");
    __syncthreads();
    if (threadIdx.x == 0) {
        unsigned* bar = b.bar;
        __builtin_amdgcn_s_waitcnt(0);
        unsigned nloc = b.st[0], nx = b.st[1];
        if (nloc == 0u) { xcd_barrier_complete(bar, b.x, nloc, nx); b.st[0] = nloc; b.st[1] = nx; }
        const unsigned old = xb_add(&bar[XB_XSUB(b.x)], 1u);
        const unsigned gen = old / nloc;
        if (old + 1u == (gen + 1u) * nloc) {
            __builtin_amdgcn_fence(__ATOMIC_RELEASE, "agent");
            asm volatile("s_waitcnt vmcnt(0)" ::: "memory");
            const unsigned og = xb_add(&bar[XB_TOP], 1u);
            const unsigned tg = og / nx;
            if (og + 1u == (tg + 1u) * nx) xb_add(&bar[XB_TOPGEN], 1u);
            else XB_SPIN(xb_ld(&bar[XB_TOPGEN]) == tg, bar);
            __builtin_amdgcn_fence(__ATOMIC_ACQUIRE, "agent");
            xb_add(&bar[XB_XGEN(b.x)], 1u);
            asm volatile("s_waitcnt vmcnt(0)" ::: "memory");
        } else {
            XB_SPIN(xb_ld(&bar[XB_XGEN(b.x)]) == gen, bar);
            __builtin_amdgcn_fence(__ATOMIC_ACQUIRE, "agent");
            asm volatile("s_waitcnt vmcnt(0)" ::: "memory");
        }
    }
    __syncthreads();
}

using pg8::bf16_t; using pg8::f32x4; using pg8::u32x4; using pg8::bf16x8; using pg8::cvt_pk_bf16; using pg8::Unit; using pg8::HALF; using pg8::BM;
typedef unsigned u32x2 __attribute__((ext_vector_type(2)));
constexpr int T_ = 32768, D_ = 1024, SEQ_ = 8192, NB_ = 4, INC_ = 3080, PJ_ = 3072, FF_ = 2816, PLE_ = 256, NCH_ = 128;
constexpr float EPS_ = 1e-6f;
constexpr int NTHREADS = 512;
constexpr int LDS_BYTES = 144 * 1024;

constexpr size_t WS_WIN = 4096;
constexpr size_t WS_WOUT = WS_WIN + (size_t)PJ_ * D_ * 2;
constexpr size_t WS_WGU = WS_WOUT + (size_t)D_ * D_ * 2;
constexpr size_t WS_WD = WS_WGU + (size_t)2 * FF_ * D_ * 2;
constexpr size_t WS_WPG = WS_WD + (size_t)D_ * FF_ * 2;
constexpr size_t WS_WPP = WS_WPG + (size_t)D_ * D_ * 2;
constexpr size_t WS_LOGITS = WS_WPP + (size_t)D_ * PLE_ * 2;
constexpr size_t WS_PB = WS_LOGITS + (size_t)T_ * 8 * 4;
constexpr size_t WS_SSA = WS_PB + (size_t)T_ * PLE_ * 2;
constexpr size_t WS_SSB = WS_SSA + (size_t)T_ * 16 * 4;
constexpr size_t WS_PTOT = WS_SSB + (size_t)T_ * 16 * 4;
constexpr size_t WS_HEND = WS_PTOT + (size_t)NB_ * NCH_ * 512 * 4;
constexpr size_t WS_CARRY = WS_HEND + (size_t)NB_ * NCH_ * 512 * 4;
constexpr size_t WS_GTOT = WS_CARRY + (size_t)NB_ * NCH_ * 512 * 4;
constexpr size_t WS_XB = WS_GTOT + 8192;
constexpr size_t WS_PROJ = WS_XB + (size_t)T_ * D_ * 2;
constexpr size_t WS_R4 = WS_PROJ + (size_t)T_ * PJ_ * 2;
constexpr size_t WS_Y = WS_XB;
constexpr size_t WS_XB2 = WS_R4;
constexpr size_t WS_PP = WS_R4 + (size_t)T_ * D_ * 2;
constexpr size_t WS_ORAW = WS_R4 + (size_t)2048 * 73728;
constexpr size_t WS_BAR = WS_R4 + (size_t)2048 * 73728 + (size_t)T_ * 512 * 2;
constexpr size_t WS_END = WS_BAR + 16384;

struct Params {
    const float* in[25];
    float* out; unsigned char* ws;
    int ph_lo, ph_hi;
};

__device__ __forceinline__ float bf2f(bf16_t b) { return __uint_as_float(((unsigned)b) << 16); }
__device__ __forceinline__ bf16_t f2bf(float f) { return (bf16_t)(cvt_pk_bf16(f, 0.f) & 0xffffu); }
__device__ __forceinline__ float sigmoidf_(float x) { return __builtin_amdgcn_rcpf(1.0f + __expf(-x)); }
__device__ __forceinline__ float siluf_(float x) { return x * __builtin_amdgcn_rcpf(1.0f + __expf(-x)); }
__device__ __forceinline__ float softplusf_(float x) { return fmaxf(x, 0.f) + log1pf(__expf(-fabsf(x))); }
__device__ __forceinline__ float gelu_tanhf_(float x) { const float u = 0.7978845608028654f * (x + 0.044715f * x * x * x); return x * __builtin_amdgcn_rcpf(1.0f + __expf(-2.0f * u)); }
__device__ __forceinline__ float rstd16(const float* ss, int r) {
    const f32x4 a = *(const f32x4*)(ss + (size_t)r * 16), b = *(const f32x4*)(ss + (size_t)r * 16 + 4), c = *(const f32x4*)(ss + (size_t)r * 16 + 8), d = *(const f32x4*)(ss + (size_t)r * 16 + 12);
    const float s = ((a[0] + a[1]) + (a[2] + a[3])) + ((b[0] + b[1]) + (b[2] + b[3])) + ((c[0] + c[1]) + (c[2] + c[3])) + ((d[0] + d[1]) + (d[2] + d[3]));
    return rsqrtf(s * (1.0f / 1024.0f) + EPS_);
}

template <int CTRL> __device__ __forceinline__ float dpp_f(float x) { return __int_as_float(__builtin_amdgcn_update_dpp(0, __float_as_int(x), CTRL, 0xf, 0xf, false)); }
__device__ __forceinline__ float red8(float x) { x += dpp_f<0xB1>(x); x += dpp_f<0x4E>(x); x += dpp_f<0x141>(x); return x; }
struct EpiBf16Plain {
    static constexpr bool PERM = true, AFTER_DRAIN = false;
    bf16_t* O; int ldc;
    __device__ __forceinline__ void operator()(const f32x4 (&acc)[2][2][4][2], const Unit& u, int wr, int wc, int fr, int fq) const {
        int row0 = u.pm * BM + wr * 64 + fr; asm volatile("" : "+v"(row0)); const int col0 = u.pn * BM + wc * 32 + 8 * fq;
#pragma unroll
        for (int ai = 0; ai < 2; ++ai)
#pragma unroll
            for (int m = 0; m < 4; ++m) { bf16_t* rowp = O + (size_t)(row0 + ai * HALF + m * 16) * ldc + col0;
#pragma unroll
                for (int bj = 0; bj < 2; ++bj) { const f32x4 v0 = acc[ai][bj][m][0], v1 = acc[ai][bj][m][1]; u32x4 w; w.x = cvt_pk_bf16(v0[0], v0[1]); w.y = cvt_pk_bf16(v0[2], v0[3]); w.z = cvt_pk_bf16(v1[0], v1[1]); w.w = cvt_pk_bf16(v1[2], v1[3]);
                    *(u32x4*)(rowp + bj * HALF) = w; } }
    }
};
__device__ __forceinline__ void rstd8(const float* ss, int row0, float (&rs)[8]) {
#pragma unroll
    for (int ai = 0; ai < 2; ++ai) { f32x4 t[4][4];
#pragma unroll
        for (int m = 0; m < 4; ++m)
#pragma unroll
            for (int q = 0; q < 4; ++q) t[m][q] = *(const f32x4*)(ss + (size_t)(row0 + ai * HALF + m * 16) * 16 + 4 * q);
#pragma unroll
        for (int m = 0; m < 4; ++m) { const float sm = (((t[m][0][0] + t[m][0][1]) + (t[m][0][2] + t[m][0][3])) + ((t[m][1][0] + t[m][1][1]) + (t[m][1][2] + t[m][1][3]))) + (((t[m][2][0] + t[m][2][1]) + (t[m][2][2] + t[m][2][3])) + ((t[m][3][0] + t[m][3][1]) + (t[m][3][2] + t[m][3][3])));
            rs[ai * 4 + m] = rsqrtf(sm * (1.0f / 1024.0f) + EPS_); }
        asm volatile("" ::: "memory"); }
}
template <bool RES_BF16>
struct EpiResid {
    static constexpr bool PERM = false, AFTER_DRAIN = false;
    const float* res; bf16_t* xb; float* ss;
    __device__ __forceinline__ void operator()(const f32x4 (&acc)[2][2][4][2], const Unit& u, int wr, int wc, int fr, int fq) const {
        int row0 = u.pm * BM + wr * 64 + fr; asm volatile("" : "+v"(row0)); const int col0 = u.pn * BM + wc * 32 + 4 * fq;
        const unsigned e0 = (unsigned)row0 * D_ + col0;
#pragma unroll
        for (int ai = 0; ai < 2; ++ai) {
            constexpr int NB = RES_BF16 ? 4 : 2;
#pragma unroll
            for (int mh = 0; mh < 4 / NB; ++mh) {
                f32x4 rv[NB][2][2];
#pragma unroll
                for (int mm = 0; mm < NB; ++mm)
#pragma unroll
                    for (int bj = 0; bj < 2; ++bj)
#pragma unroll
                        for (int n = 0; n < 2; ++n) { const unsigned e = e0 + (unsigned)((ai * HALF + (mh * NB + mm) * 16) * D_ + bj * HALF + n * 16);
                            if (RES_BF16) { const u32x2 w = *(const u32x2*)((const char*)xb + (size_t)(e * 2u)); rv[mm][bj][n] = (f32x4){__uint_as_float(w.x << 16), __uint_as_float(w.x & 0xffff0000u), __uint_as_float(w.y << 16), __uint_as_float(w.y & 0xffff0000u)}; }
                            else rv[mm][bj][n] = *(const f32x4*)((const char*)res + (size_t)(e * 4u)); }
#pragma unroll
                for (int mm = 0; mm < NB; ++mm) { const int m = mh * NB + mm, r = row0 + ai * HALF + m * 16; float s = 0.f;
#pragma unroll
                    for (int bj = 0; bj < 2; ++bj)
#pragma unroll
                        for (int n = 0; n < 2; ++n) { const unsigned e = e0 + (unsigned)((ai * HALF + m * 16) * D_ + bj * HALF + n * 16); const f32x4 v = rv[mm][bj][n] + acc[ai][bj][m][n];
                            s += (v[0] * v[0] + v[1] * v[1]) + (v[2] * v[2] + v[3] * v[3]); u32x2 w; w.x = cvt_pk_bf16(v[0], v[1]); w.y = cvt_pk_bf16(v[2], v[3]); *(u32x2*)((char*)xb + (size_t)(e * 2u)) = w; }
                    s += __shfl_xor(s, 16); s += __shfl_xor(s, 32);
                    if (fq == 0) ss[(size_t)r * 16 + u.pn * 4 + wc] = s; }
                asm volatile("" ::: "memory"); } }
    }
};
struct EpiGateUp {
    static constexpr bool PERM = true, AFTER_DRAIN = false;
    bf16_t* ff; const float* ss;
    __device__ __forceinline__ void operator()(const f32x4 (&acc)[2][2][4][2], const Unit& u, int wr, int wc, int fr, int fq) const {
        int row0 = u.pm * BM + wr * 64 + fr; asm volatile("" : "+v"(row0)); const int col0 = u.pn * HALF + wc * 32 + 8 * fq;
        float rsv[8]; rstd8(ss, row0, rsv);
#pragma unroll
        for (int ai = 0; ai < 2; ++ai)
#pragma unroll
            for (int m = 0; m < 4; ++m) { const int r = row0 + ai * HALF + m * 16; const float rs = rsv[ai * 4 + m];
                float o[8];
#pragma unroll
                for (int n = 0; n < 2; ++n)
#pragma unroll
                    for (int j = 0; j < 4; ++j) { const float g = acc[ai][0][m][n][j] * rs, up = acc[ai][1][m][n][j] * rs; o[n * 4 + j] = siluf_(g) * up; }
                u32x4 w; w.x = cvt_pk_bf16(o[0], o[1]); w.y = cvt_pk_bf16(o[2], o[3]); w.z = cvt_pk_bf16(o[4], o[5]); w.w = cvt_pk_bf16(o[6], o[7]);
                *(u32x4*)(ff + (size_t)r * FF_ + col0) = w; }
    }
};
struct EpiPle {
    static constexpr bool PERM = false, AFTER_DRAIN = false;
    const bf16_t* x2b; bf16_t* x3b; const bf16_t* pp; const float* bias; const float* ss_in; float* ss_out;
    __device__ __forceinline__ void operator()(const f32x4 (&acc)[2][2][4][2], const Unit& u, int wr, int wc, int fr, int fq) const {
        int row0 = u.pm * BM + wr * 64 + fr; asm volatile("" : "+v"(row0)); const int col0 = u.pn * BM + wc * 32 + 4 * fq;
        const unsigned b0 = ((unsigned)row0 * D_ + col0) * 2u;
        const unsigned s0 = (unsigned)row0 * 64u;
        u32x2 X[2][2][2], P[2][2][2]; f32x4 S[2][4];
#define EP_LOAD(set, g) do { const unsigned ro_ = (unsigned)(((g) >> 2) * HALF + ((g) & 3) * 16); \
        _Pragma("unroll") for (int bj = 0; bj < 2; ++bj) _Pragma("unroll") for (int n = 0; n < 2; ++n) { const unsigned bo_ = b0 + (ro_ * D_ + bj * HALF + n * 16) * 2u; \
            X[set][bj][n] = *(const u32x2*)((const char*)x2b + (size_t)bo_); P[set][bj][n] = *(const u32x2*)((const char*)pp + (size_t)bo_); } \
        _Pragma("unroll") for (int q = 0; q < 4; ++q) S[set][q] = *(const f32x4*)((const char*)ss_in + (size_t)(s0 + ro_ * 64u + q * 16u)); } while (0)
        EP_LOAD(0, 0);
#pragma unroll
        for (int g = 0; g < 8; ++g) { const int ai = g >> 2, m = g & 3, st = g & 1, r = row0 + ai * HALF + m * 16;
            if (g < 7) EP_LOAD((g + 1) & 1, g + 1);
            const float sm = (((S[st][0][0] + S[st][0][1]) + (S[st][0][2] + S[st][0][3])) + ((S[st][1][0] + S[st][1][1]) + (S[st][1][2] + S[st][1][3]))) + (((S[st][2][0] + S[st][2][1]) + (S[st][2][2] + S[st][2][3])) + ((S[st][3][0] + S[st][3][1]) + (S[st][3][2] + S[st][3][3])));
            const float rs = rsqrtf(sm * (1.0f / 1024.0f) + EPS_); float s = 0.f;
#pragma unroll
            for (int bj = 0; bj < 2; ++bj)
#pragma unroll
                for (int n = 0; n < 2; ++n) { const unsigned bo = b0 + (unsigned)(((ai * HALF + m * 16) * D_ + bj * HALF + n * 16) * 2); const u32x2 w2 = P[st][bj][n], x2 = X[st][bj][n]; const f32x4 a = acc[ai][bj][m][n]; const f32x4 bb = *(const f32x4*)(bias + col0 + bj * HALF + n * 16);
                    f32x4 v = {__uint_as_float(x2.x << 16), __uint_as_float(x2.x & 0xffff0000u), __uint_as_float(x2.y << 16), __uint_as_float(x2.y & 0xffff0000u)};
                    const float p0 = __uint_as_float(w2.x << 16), p1 = __uint_as_float(w2.x & 0xffff0000u), p2 = __uint_as_float(w2.y << 16), p3 = __uint_as_float(w2.y & 0xffff0000u);
                    v[0] += sigmoidf_(a[0] * rs + bb[0]) * p0; v[1] += sigmoidf_(a[1] * rs + bb[1]) * p1; v[2] += sigmoidf_(a[2] * rs + bb[2]) * p2; v[3] += sigmoidf_(a[3] * rs + bb[3]) * p3;
                    u32x2 xw; xw.x = cvt_pk_bf16(v[0], v[1]); xw.y = cvt_pk_bf16(v[2], v[3]); *(u32x2*)((char*)x3b + (size_t)bo) = xw; s += (v[0] * v[0] + v[1] * v[1]) + (v[2] * v[2] + v[3] * v[3]); }
            s += __shfl_xor(s, 16); s += __shfl_xor(s, 32);
            if (fq == 0) ss_out[(size_t)r * 16 + u.pn * 4 + wc] = s;
            asm volatile("" ::: "memory"); }
#undef EP_LOAD
    }
};

template <class Epi> __device__ __forceinline__ void run_gemm(PG8_LAS unsigned char* lds, const bf16_t* A, const bf16_t* Bt, int M, int N, int K, const Epi& E) {
    pg8::Gemm g; g.A = A; g.Bt = Bt; g.M = M; g.N = N; g.K = K;
    pg8::StaticOrder S; S.init(M, N, (int)gridDim.x, (int)blockIdx.x);
    pg8::gemm_phase<Epi, pg8::StaticOrder, false>(lds, g, S, E, nullptr);
}

__device__ void prep_transpose(const float* __restrict__ W, int K, int ldw, int c0, int ncols, bf16_t* __restrict__ Wt, const float* __restrict__ ks, int mode, float* tile, int rot, int widx, int nw) {
    const int tid = threadIdx.x, nkt = K / 64, nct = ncols / 64, ntiles = nkt * nct;
    for (int tt = (widx + nw - (rot % nw)) % nw; tt < ntiles; tt += nw) {
        const int kt = tt / nct, ct = tt % nct, k0 = kt * 64, n0 = ct * 64;
        __syncthreads();
#pragma unroll
        for (int i = 0; i < 2; ++i) { const int r = (tid >> 4) + 32 * i, c4 = (tid & 15) * 4; const f32x4 v = *(const f32x4*)(W + (size_t)(k0 + r) * ldw + c0 + n0 + c4);
            const float s = ks ? ks[k0 + r] : 1.0f; tile[r * 65 + c4 + 0] = v[0] * s; tile[r * 65 + c4 + 1] = v[1] * s; tile[r * 65 + c4 + 2] = v[2] * s; tile[r * 65 + c4 + 3] = v[3] * s; }
        __syncthreads();
        const int n = tid >> 3, kseg = (tid & 7) * 8; float v[8];
#pragma unroll
        for (int e = 0; e < 8; ++e) v[e] = tile[(kseg + e) * 65 + n];
        u32x4 w; w.x = cvt_pk_bf16(v[0], v[1]); w.y = cvt_pk_bf16(v[2], v[3]); w.z = cvt_pk_bf16(v[4], v[5]); w.w = cvt_pk_bf16(v[6], v[7]);
        const int f = n0 + n; const int drow = (mode == 0) ? f : (256 * (f >> 7) + 128 * (mode - 1) + (f & 127));
        *(u32x4*)(Wt + (size_t)drow * K + k0 + kseg) = w;
    }
}


__device__ __forceinline__ void prep_weights_late(const Params& p, unsigned char* smem, int widx, int nw) {
    unsigned char* ws = p.ws; float* tile = (float*)smem;
    __syncthreads();
    prep_transpose(p.in[15], D_, D_, 0, D_, (bf16_t*)(ws + WS_WOUT), nullptr, 0, tile, 0, widx, nw);
    prep_transpose(p.in[17], D_, FF_, 0, FF_, (bf16_t*)(ws + WS_WGU), p.in[16], 1, tile, 256, widx, nw);
    prep_transpose(p.in[18], D_, FF_, 0, FF_, (bf16_t*)(ws + WS_WGU), p.in[16], 2, tile, 960, widx, nw);
    prep_transpose(p.in[19], FF_, D_, 0, D_, (bf16_t*)(ws + WS_WD), nullptr, 0, tile, 1664, widx, nw);
    prep_transpose(p.in[21], D_, D_, 0, D_, (bf16_t*)(ws + WS_WPG), p.in[20], 0, tile, 2368, widx, nw);
}

__device__ __forceinline__ void phase_prep(const Params& p, unsigned char* smem) {
    const int tid = threadIdx.x, wid = __builtin_amdgcn_readfirstlane(tid >> 6), lane = tid & 63;
    unsigned char* ws = p.ws;
    float* tile = (float*)smem;
    float* w8s = (float*)(smem + 20480);
    if (blockIdx.x == 0 && tid < 32) ((unsigned*)ws)[tid] = 0u;
    prep_transpose(p.in[3], D_, INC_, 0, PJ_, (bf16_t*)(ws + WS_WIN), nullptr, 0, tile, 0, (int)blockIdx.x, (int)gridDim.x);
    prep_transpose(p.in[23], PLE_, D_, 0, D_, (bf16_t*)(ws + WS_WPP), nullptr, 0, tile, 768, (int)blockIdx.x, (int)gridDim.x);
    for (int i = tid; i < 1024 * 8; i += NTHREADS) { const int k = i >> 3, j = i & 7; w8s[i] = p.in[2][k] * p.in[3][(size_t)k * INC_ + PJ_ + j]; }
    __syncthreads();
    {
        const float* x = p.in[0]; const float* nw = p.in[2]; bf16_t* hb = (bf16_t*)(ws + WS_XB); float* logits = (float*)(ws + WS_LOGITS);
        f32x4 nwv[4];
#pragma unroll
        for (int i = 0; i < 4; ++i) nwv[i] = *(const f32x4*)(nw + 4 * (lane + 64 * i));
        f32x4 vn[4]; int row = blockIdx.x * 8 + wid;
        if (row < T_) {
#pragma unroll
            for (int i = 0; i < 4; ++i) vn[i] = *(const f32x4*)(x + (size_t)row * D_ + 4 * (lane + 64 * i)); }
        for (; row < T_; row += gridDim.x * 8) {
            f32x4 v[4]; float s = 0.f;
#pragma unroll
            for (int i = 0; i < 4; ++i) { v[i] = vn[i]; s += (v[i][0] * v[i][0] + v[i][1] * v[i][1]) + (v[i][2] * v[i][2] + v[i][3] * v[i][3]); }
            { const int nrow = row + gridDim.x * 8;
              if (nrow < T_) {
#pragma unroll
                for (int i = 0; i < 4; ++i) vn[i] = *(const f32x4*)(x + (size_t)nrow * D_ + 4 * (lane + 64 * i)); } }
            s = red8(s); s += dpp_f<0x140>(s); s += __shfl_xor(s, 16); s += __shfl_xor(s, 32);
            const float rs = rsqrtf(s * (1.0f / 1024.0f) + EPS_);
            float lg[8];
#pragma unroll
            for (int j = 0; j < 8; ++j) lg[j] = 0.f;
#pragma unroll
            for (int i = 0; i < 4; ++i) {
                const int k0 = 4 * (lane + 64 * i);
#pragma unroll
                for (int e = 0; e < 4; ++e) { const f32x4 wa = *(const f32x4*)(w8s + (k0 + e) * 8), wb = *(const f32x4*)(w8s + (k0 + e) * 8 + 4); const float xv = v[i][e];
                    lg[0] += xv * wa[0]; lg[1] += xv * wa[1]; lg[2] += xv * wa[2]; lg[3] += xv * wa[3]; lg[4] += xv * wb[0]; lg[5] += xv * wb[1]; lg[6] += xv * wb[2]; lg[7] += xv * wb[3]; }
                const f32x4 h = v[i] * rs * nwv[i]; u32x2 w; w.x = cvt_pk_bf16(h[0], h[1]); w.y = cvt_pk_bf16(h[2], h[3]);
                *(u32x2*)(hb + (size_t)row * D_ + k0) = w;
            }
            const bool b5 = (lane & 32) != 0, b4 = (lane & 16) != 0, b3 = (lane & 8) != 0;
            float k4[4], k2[2];
#pragma unroll
            for (int j = 0; j < 4; ++j) { const float send = b5 ? lg[j] : lg[j + 4]; const float keep = b5 ? lg[j + 4] : lg[j]; k4[j] = keep + __shfl_xor(send, 32); }
#pragma unroll
            for (int j = 0; j < 2; ++j) { const float send = b4 ? k4[j] : k4[j + 2]; const float keep = b4 ? k4[j + 2] : k4[j]; k2[j] = keep + __shfl_xor(send, 16); }
            float k1; { const float send = b3 ? k2[0] : k2[1]; const float keep = b3 ? k2[1] : k2[0]; k1 = keep + __shfl_xor(send, 8); }
            k1 = red8(k1);
            if ((lane & 7) == 0) logits[(size_t)row * 8 + ((lane >> 5) & 1) * 4 + ((lane >> 4) & 1) * 2 + ((lane >> 3) & 1)] = k1 * rs;
        }
    }
    {
        const f32x4* src = (const f32x4*)p.in[1]; u32x2* dst = (u32x2*)(ws + WS_PB); const size_t n4 = (size_t)T_ * PLE_ / 4;
        for (size_t i = (size_t)blockIdx.x * NTHREADS + tid; i < n4; i += (size_t)gridDim.x * NTHREADS) { const f32x4 v = src[i]; u32x2 w; w.x = cvt_pk_bf16(v[0], v[1]); w.y = cvt_pk_bf16(v[2], v[3]); dst[i] = w; }
    }
}
__device__ __forceinline__ bf16x8 pack8(const f32x4 a, const f32x4 b) { u32x4 w; w.x = cvt_pk_bf16(a[0], a[1]); w.y = cvt_pk_bf16(a[2], a[3]); w.z = cvt_pk_bf16(b[0], b[1]); w.w = cvt_pk_bf16(b[2], b[3]); return __builtin_bit_cast(bf16x8, w); }
#define MFMA16(a, b, c) __builtin_amdgcn_mfma_f32_16x16x32_bf16((a), (b), (c), 0, 0, 0)
__device__ __forceinline__ float neg_expm1_small(float x) {
    const float ps = -x * (1.0f + x * (0.5f + x * (0.16666667f + x * (0.041666668f + x * (0.008333334f + x * 0.0013888889f)))));
    return (x > -0.25f) ? ps : (1.0f - __expf(x));
}
template <bool FINAL>
__device__ __forceinline__ void rg_pass_mfma(const Params& p, unsigned char* smem, int widx, int nworkers) {
    const int tid = threadIdx.x, wid = __builtin_amdgcn_readfirstlane(tid >> 6), lane = tid & 63, n16o = lane & 15, fqo = lane >> 4, c = wid * 64 + lane;
    unsigned char* ws = p.ws;
    const bf16_t* proj = (const bf16_t*)(ws + WS_PROJ);
    float* U = (float*)smem + wid * 4096;
    float* ptot = (float*)(ws + WS_PTOT); float* hend = (float*)(ws + WS_HEND); const float* carry = (const float*)(ws + WS_CARRY);
    bf16_t* y = (bf16_t*)(ws + WS_Y);
    bf16x8 Bx[4][2], Ba[4][2];
#pragma unroll
    for (int nt = 0; nt < 4; ++nt)
#pragma unroll
        for (int ks = 0; ks < 2; ++ks) { const float* wx = p.in[6] + (size_t)(wid * 64 + 32 * ks) * 64 + (size_t)(8 * fqo) * 64 + 16 * nt + n16o; const float* wa = p.in[8] + (size_t)(wid * 64 + 32 * ks) * 64 + (size_t)(8 * fqo) * 64 + 16 * nt + n16o;
            f32x4 x0 = {wx[0], wx[64], wx[128], wx[192]}, x1 = {wx[256], wx[320], wx[384], wx[448]}, a0 = {wa[0], wa[64], wa[128], wa[192]}, a1 = {wa[256], wa[320], wa[384], wa[448]};
            Bx[nt][ks] = pack8(x0, x1); Ba[nt][ks] = pack8(a0, a1); asm volatile("" ::: "memory"); }
    const float cw0 = p.in[4][c], cw1 = p.in[4][512 + c], cw2 = p.in[4][1024 + c], cw3 = p.in[4][1536 + c], cb = p.in[5][c];
    float bxv[4], bav[4], spv[4];
#pragma unroll
    for (int nt = 0; nt < 4; ++nt) { const int cgl = wid * 64 + 16 * nt + n16o; bxv[nt] = p.in[7][cgl]; bav[nt] = p.in[9][cgl]; spv[nt] = softplusf_(-p.in[10][cgl]); }
    for (int unit = widx; unit < NB_ * NCH_; unit += nworkers) {
        const int n = unit & (NCH_ - 1); const size_t t0 = (size_t)unit * 64;
        float xm3 = 0.f, xm2 = 0.f, xm1 = 0.f;
        if (n != 0) { xm3 = bf2f(proj[(t0 - 3) * PJ_ + c]); xm2 = bf2f(proj[(t0 - 2) * PJ_ + c]); xm1 = bf2f(proj[(t0 - 1) * PJ_ + c]); }
        __syncthreads();
        { bf16_t xr[16]; const bf16_t* xp0 = proj + t0 * PJ_ + c;
#pragma unroll
          for (int i = 0; i < 16; ++i) xr[i] = xp0[(size_t)i * PJ_];
#pragma unroll
          for (int tb = 0; tb < 4; ++tb) { bf16_t xn[16]; const bf16_t* xp = proj + (t0 + (tb + 1) * 16) * PJ_ + c;
            if (tb < 3) {
#pragma unroll
                for (int i = 0; i < 16; ++i) xn[i] = xp[(size_t)i * PJ_]; }
#pragma unroll
            for (int i = 0; i < 16; ++i) { const float xv = bf2f(xr[i]); U[(tb * 16 + i) * 64 + lane] = cw0 * xm3 + cw1 * xm2 + cw2 * xm1 + cw3 * xv + cb; xm3 = xm2; xm2 = xm1; xm1 = xv; }
            if (tb < 3) {
#pragma unroll
                for (int i = 0; i < 16; ++i) xr[i] = xn[i]; } } }
        __syncthreads();
        const bf16_t* gub = proj + t0 * PJ_ + 512; bf16_t* yub = y + t0 * D_;
#pragma unroll
        for (int nt = 0; nt < 4; ++nt) {
            asm volatile("" ::: "memory");
            int lane_o = lane; asm volatile("" : "+v"(lane_o));
            const int n16 = lane_o & 15, fq = lane_o >> 4;
            const int chl = 16 * nt + n16, cgl = wid * 64 + chl;
            bf16x8 Af[4][2];
#pragma unroll
            for (int mt = 0; mt < 4; ++mt)
#pragma unroll
                for (int ks = 0; ks < 2; ++ks) { const float* up = U + (16 * (n16 >> 2) + 4 * mt + (n16 & 3)) * 64 + 32 * ks + 8 * fq; Af[mt][ks] = pack8(*(const f32x4*)up, *(const f32x4*)(up + 4)); }

            bf16_t gr[16];
            if (FINAL) {
#pragma unroll
                for (int i = 0; i < 16; ++i) gr[i] = gub[(16 * fq + i) * PJ_ + cgl]; }
            f32x4 ax[4], aa[4];
#pragma unroll
            for (int mt = 0; mt < 4; ++mt) { ax[mt] = (f32x4){bxv[nt], bxv[nt], bxv[nt], bxv[nt]}; aa[mt] = (f32x4){bav[nt], bav[nt], bav[nt], bav[nt]}; }
#pragma unroll
            for (int mt = 0; mt < 4; ++mt)
#pragma unroll
                for (int ks = 0; ks < 2; ++ks) { ax[mt] = MFMA16(Af[mt][ks], Bx[nt][ks], ax[mt]); aa[mt] = MFMA16(Af[mt][ks], Ba[nt][ks], aa[mt]); }
            float av[16], bv[16]; float hl = 0.f, Pl = 1.f;
#pragma unroll
            for (int i = 0; i < 16; ++i) { const int mt = i >> 2, j = i & 3, tok = 16 * fq + i; const float u = U[tok * 64 + chl];
                const float gx = sigmoidf_(ax[mt][j]), gg = sigmoidf_(aa[mt][j]); const float la = -8.0f * gg * spv[nt]; const float a = __expf(la);
                float mult = sqrtf(fmaxf(neg_expm1_small(2.0f * la), 0.f)); if (n == 0 && tok == 0) mult = 1.0f;
                av[i] = a; bv[i] = u * gx * mult; hl = a * hl + bv[i]; Pl *= a; }
            float Pg[4], Hg[4];
#pragma unroll
            for (int g = 0; g < 4; ++g) { Pg[g] = __shfl(Pl, n16 + 16 * g); Hg[g] = __shfl(hl, n16 + 16 * g); }
            if (FINAL) {
                float h = carry[(size_t)unit * 512 + cgl];
#pragma unroll
                for (int g = 0; g < 3; ++g) if (g < fq) h = Pg[g] * h + Hg[g];
#pragma unroll
                for (int i = 0; i < 16; ++i) { h = av[i] * h + bv[i]; yub[(16 * fq + i) * D_ + cgl] = f2bf(h * gelu_tanhf_(bf2f(gr[i]))); }
            } else {
                float cc = 0.f, Pp = 1.f;
#pragma unroll
                for (int g = 0; g < 4; ++g) { cc = Pg[g] * cc + Hg[g]; Pp *= Pg[g]; }
                if (fq == 0) { ptot[(size_t)unit * 512 + cgl] = Pp; hend[(size_t)unit * 512 + cgl] = cc; }
            }
        }
    }
}

__device__ __forceinline__ void rg_carry(const Params& p, int idx) {
    unsigned char* ws = p.ws; const float* ptot = (const float*)(ws + WS_PTOT); const float* hend = (const float*)(ws + WS_HEND); float* carry = (float*)(ws + WS_CARRY);
    const int b = idx >> 9, c = idx & 511; float hc = 0.f;
    for (int n0 = 0; n0 < NCH_; n0 += 8) { float P[8], H[8];
#pragma unroll
        for (int i = 0; i < 8; ++i) { const size_t o = (size_t)(b * NCH_ + n0 + i) * 512 + c; P[i] = ptot[o]; H[i] = hend[o]; }
#pragma unroll
        for (int i = 0; i < 8; ++i) { const size_t o = (size_t)(b * NCH_ + n0 + i) * 512 + c; carry[o] = hc; hc = P[i] * hc + H[i]; } }
}

constexpr int GU_BYTES = 73728, GU_KDT = 32768, GU_QK = 49152, GU_U = 57344;
typedef float f32x2_ __attribute__((ext_vector_type(2)));
__device__ __forceinline__ int tok_of_pos(int p) { return 16 * (2 * (p >> 5) + ((p >> 2) & 1)) + 4 * ((p >> 3) & 3) + (p & 3); }
__device__ __forceinline__ void unpack8(const u32x4 w, float* f) { f[0] = __uint_as_float(w.x << 16); f[1] = __uint_as_float(w.x & 0xffff0000u); f[2] = __uint_as_float(w.y << 16); f[3] = __uint_as_float(w.y & 0xffff0000u);
    f[4] = __uint_as_float(w.z << 16); f[5] = __uint_as_float(w.z & 0xffff0000u); f[6] = __uint_as_float(w.w << 16); f[7] = __uint_as_float(w.w & 0xffff0000u); }

__device__ __forceinline__ void gdn_pass_a(const Params& p, unsigned char* smem) {
    const int tid = threadIdx.x, wid = __builtin_amdgcn_readfirstlane(tid >> 6);
    unsigned char* ws = p.ws; const bf16_t* proj = (const bf16_t*)(ws + WS_PROJ); const float* logits = (const float*)(ws + WS_LOGITS); float* gtot = (float*)(ws + WS_GTOT);
    bf16_t* Kb = (bf16_t*)smem; bf16_t* Qb = (bf16_t*)(smem + 17408); bf16_t* VBt = (bf16_t*)(smem + 34816); bf16_t* KBGt = (bf16_t*)(smem + 53248);
    float* Lsw = (float*)(smem + 71680); bf16_t* Tb = (bf16_t*)(smem + 89088); float* gcs = (float*)(smem + 98304); float* betas = gcs + 64; float* kdec = gcs + 128;
    const int lane0 = tid & 63, tg0 = tid >> 5, ch0 = (tid & 31) * 4;
    for (int ub = blockIdx.x * 8; ub < 2048; ub += gridDim.x * 8) {
        const int bh = ub >> 7, b = bh >> 2, h = bh & 3;
        const float Aexp = __expf(p.in[12][h]), dtb = p.in[13][h];
        float cw[3][4][4];
#pragma unroll
        for (int a = 0; a < 3; ++a)
#pragma unroll
            for (int j = 0; j < 4; ++j) { const f32x4 w = *(const f32x4*)(p.in[11] + (size_t)j * 1536 + a * 512 + h * 128 + ch0); cw[a][j][0] = w[0]; cw[a][j][1] = w[1]; cw[a][j][2] = w[2]; cw[a][j][3] = w[3]; }
        u32x2 pre[3][7]; float lgb, lga;
#define GA_PREFETCH(unit_) do { const int n_ = (unit_) & 127; const size_t t0_ = (size_t)b * SEQ_ + (size_t)n_ * 64; \
        lgb = logits[(t0_ + lane0) * 8 + h]; lga = logits[(t0_ + lane0) * 8 + 4 + h]; \
        _Pragma("unroll") for (int r = 0; r < 7; ++r) { const int sp_ = n_ * 64 + 4 * tg0 - 3 + r; \
            _Pragma("unroll") for (int a = 0; a < 3; ++a) pre[a][r] = (sp_ >= 0) ? *(const u32x2*)(proj + ((size_t)b * SEQ_ + sp_) * PJ_ + 1024 + a * 512 + h * 128 + ch0) : (u32x2){0u, 0u}; } } while (0)
        GA_PREFETCH(ub);
        for (int k = 0; k < 8; ++k) {
            const int unit = ub + k, n = unit & 127;
            int tid_o = tid; asm volatile("" : "+v"(tid_o));
            const int lane = tid_o & 63, r16 = lane & 15, kq = lane >> 4, cg4 = tid_o & 31, tg = tid_o >> 5, ch = cg4 * 4;
            unsigned char* gbase = ws + WS_R4 + (size_t)unit * GU_BYTES;
            const float betav = sigmoidf_(lgb);
            float gc = -Aexp * softplusf_(lga + dtb);
#pragma unroll
            for (int o = 1; o < 64; o <<= 1) { const float tmp = __shfl_up(gc, o); if (lane >= o) gc += tmp; }
            const float gclast = __shfl(gc, 63);
            if (wid == 0) { gcs[lane] = gc; betas[lane] = betav; kdec[lane] = __expf(gclast - gc); }
            {
                float x[7][4], o[4][4], bt[4], egt[4];
#pragma unroll
                for (int t = 0; t < 4; ++t) { bt[t] = __shfl(betav, 4 * tg + t); egt[t] = __expf(__shfl(gc, 4 * tg + t)); }
#pragma unroll
                for (int a = 0; a < 3; ++a) {
#pragma unroll
                    for (int r = 0; r < 7; ++r) { x[r][0] = __uint_as_float(pre[a][r].x << 16); x[r][1] = __uint_as_float(pre[a][r].x & 0xffff0000u); x[r][2] = __uint_as_float(pre[a][r].y << 16); x[r][3] = __uint_as_float(pre[a][r].y & 0xffff0000u); }
#pragma unroll
                    for (int t = 0; t < 4; ++t)
#pragma unroll
                        for (int e = 0; e < 4; ++e) { float acc = cw[a][0][e] * x[t][e]; acc += cw[a][1][e] * x[t + 1][e]; acc += cw[a][2][e] * x[t + 2][e]; acc += cw[a][3][e] * x[t + 3][e]; o[t][e] = siluf_(acc); }
                    if (a < 2) {
#pragma unroll
                        for (int t = 0; t < 4; ++t) { float ssq = (o[t][0] * o[t][0] + o[t][1] * o[t][1]) + (o[t][2] * o[t][2] + o[t][3] * o[t][3]);
                            ssq += dpp_f<0xB1>(ssq); ssq += dpp_f<0x4E>(ssq); ssq += dpp_f<0x141>(ssq); ssq += dpp_f<0x140>(ssq); ssq += __shfl_xor(ssq, 16);
                            const float rs = rsqrtf(ssq + EPS_) * (a == 0 ? 0.08838834764831845f : 1.0f);
#pragma unroll
                            for (int e = 0; e < 4; ++e) o[t][e] *= rs; }
                    }
                    if (a == 0) {
#pragma unroll
                        for (int t = 0; t < 4; ++t) { const int tok = 4 * tg + t; u32x2 w; w.x = cvt_pk_bf16(o[t][0], o[t][1]); w.y = cvt_pk_bf16(o[t][2], o[t][3]); *(u32x2*)(Qb + tok * 136 + ch) = w;
                            u32x2 wd; wd.x = cvt_pk_bf16(o[t][0] * egt[t], o[t][1] * egt[t]); wd.y = cvt_pk_bf16(o[t][2] * egt[t], o[t][3] * egt[t]);
                            *(u32x2*)((bf16_t*)gbase + (size_t)(64 + tok) * 128 + 32 * (cg4 >> 3) + 8 * (cg4 & 3) + 4 * ((cg4 >> 2) & 1)) = wd; }
                    } else if (a == 1) {
#pragma unroll
                        for (int t = 0; t < 4; ++t) { const int tok = 4 * tg + t; u32x2 w; w.x = cvt_pk_bf16(o[t][0], o[t][1]); w.y = cvt_pk_bf16(o[t][2], o[t][3]); *(u32x2*)(Kb + tok * 136 + ch) = w; }
#pragma unroll
                        for (int e = 0; e < 4; ++e) { u32x2 w; w.x = cvt_pk_bf16(o[0][e] * bt[0] * egt[0], o[1][e] * bt[1] * egt[1]); w.y = cvt_pk_bf16(o[2][e] * bt[2] * egt[2], o[3][e] * bt[3] * egt[3]); *(u32x2*)(KBGt + (ch + e) * 72 + (((tg >> 1) ^ (cg4 & 7)) << 3) + 4 * (tg & 1)) = w; }
                    } else {
#pragma unroll
                        for (int e = 0; e < 4; ++e) { u32x2 w; w.x = cvt_pk_bf16(o[0][e] * bt[0], o[1][e] * bt[1]); w.y = cvt_pk_bf16(o[2][e] * bt[2], o[3][e] * bt[3]); *(u32x2*)(VBt + (ch + e) * 72 + (((tg >> 1) ^ (cg4 & 7)) << 3) + 4 * (tg & 1)) = w; }
                    }
                }
            }
            if (k + 1 < 8) GA_PREFETCH(unit + 1);
            __syncthreads();
#pragma unroll
            for (int rep = 0; rep < 2; ++rep) {
                const int tl = wid + 8 * rep, jt = tl >> 2, it = tl & 3;
                f32x4 accQ = {0.f, 0.f, 0.f, 0.f}, accK = {0.f, 0.f, 0.f, 0.f};
#pragma unroll
                for (int ks = 0; ks < 4; ++ks) { const bf16x8 a = *(const bf16x8*)(Kb + (16 * jt + r16) * 136 + 32 * ks + 8 * kq);
                    const bf16x8 bq = *(const bf16x8*)(Qb + (16 * it + r16) * 136 + 32 * ks + 8 * kq), bk = *(const bf16x8*)(Kb + (16 * it + r16) * 136 + 32 * ks + 8 * kq);
                    accQ = MFMA16(a, bq, accQ); accK = MFMA16(a, bk, accK); }
                const int i = 16 * it + r16; const float gi = gcs[i], bi = betas[i]; float qv[4];
#pragma unroll
                for (int jj = 0; jj < 4; ++jj) { const int j = 16 * jt + 4 * kq + jj; const float d = __expf(fminf(gi - gcs[j], 0.f));
                    qv[jj] = (i >= j) ? accQ[jj] * d : 0.f; Lsw[i * 68 + (j & 7) * 8 + (j >> 3)] = (i > j) ? bi * accK[jj] * d : 0.f; }
                u32x2 w; w.x = cvt_pk_bf16(qv[0], qv[1]); w.y = cvt_pk_bf16(qv[2], qv[3]);
                *(u32x2*)((bf16_t*)(gbase + GU_QK) + i * 64 + 32 * (jt >> 1) + 8 * kq + 4 * (jt & 1)) = w;
            }
            __syncthreads();
            {
                const int s = lane & 7, c = 8 * wid + (lane >> 3); float t[8];
#pragma unroll
                for (int m = 0; m < 8; ++m) t[m] = 0.f;
                f32x4 la[2][2]; la[0][0] = *(const f32x4*)(Lsw + s * 8); la[0][1] = *(const f32x4*)(Lsw + s * 8 + 4);
#pragma unroll
                for (int i = 0; i < 64; ++i) {
                    if (i + 1 < 64) { la[(i + 1) & 1][0] = *(const f32x4*)(Lsw + (i + 1) * 68 + s * 8); la[(i + 1) & 1][1] = *(const f32x4*)(Lsw + (i + 1) * 68 + s * 8 + 4); }
                    asm volatile("" ::: "memory");
                    const f32x4 l0 = la[i & 1][0], l1 = la[i & 1][1];
                    float part = 0.f;
#pragma unroll
                    for (int m = 0; m < 8; ++m) if (8 * m <= i) part += ((m < 4) ? l0[m & 3] : l1[m & 3]) * t[m];
                    part = red8(part);
                    const float val = ((i == c) ? 1.0f : 0.0f) - part;
                    if (s == (i & 7)) t[i >> 3] = val;
                }
#pragma unroll
                for (int m = 0; m < 8; ++m) Tb[(8 * m + s) * 72 + c] = f2bf(t[m]);
            }
            __syncthreads();
            {
#pragma unroll
                for (int mt = 0; mt < 4; ++mt) { f32x4 acc = {0.f, 0.f, 0.f, 0.f};
#pragma unroll
                    for (int ks = 0; ks < 2; ++ks) { const bf16x8 a = *(const bf16x8*)(Tb + (16 * mt + r16) * 72 + 32 * ks + 8 * kq), bb = *(const bf16x8*)(VBt + (16 * wid + r16) * 72 + (((4 * ks + kq) ^ ((4 * wid + (r16 >> 2)) & 7)) << 3)); acc = MFMA16(a, bb, acc); }
                    u32x2 w; w.x = cvt_pk_bf16(acc[0], acc[1]); w.y = cvt_pk_bf16(acc[2], acc[3]);
                    *(u32x2*)((bf16_t*)(gbase + GU_U) + ((wid * 4 + mt) * 64 + lane) * 4) = w; }
#pragma unroll
                for (int it = 0; it < 4; ++it) { f32x4 acc = {0.f, 0.f, 0.f, 0.f};
#pragma unroll
                    for (int ks = 0; ks < 2; ++ks) { const bf16x8 a = *(const bf16x8*)(KBGt + (16 * wid + r16) * 72 + (((4 * ks + kq) ^ ((4 * wid + (r16 >> 2)) & 7)) << 3)), bb = *(const bf16x8*)(Tb + (16 * it + r16) * 72 + 32 * ks + 8 * kq); acc = MFMA16(a, bb, acc); }
                    u32x2 w; w.x = cvt_pk_bf16(acc[0], acc[1]); w.y = cvt_pk_bf16(acc[2], acc[3]);
                    *(u32x2*)((bf16_t*)gbase + (16 * it + r16) * 128 + 32 * (wid >> 1) + 8 * kq + 4 * (wid & 1)) = w; }
                const int dk = tid_o >> 2, pg = tid_o & 3; float v[16];
#pragma unroll
                for (int e = 0; e < 16; ++e) { const int tk = tok_of_pos(16 * pg + e); v[e] = bf2f(Kb[tk * 136 + dk]) * kdec[tk]; }
                u32x4 w0, w1; w0.x = cvt_pk_bf16(v[0], v[1]); w0.y = cvt_pk_bf16(v[2], v[3]); w0.z = cvt_pk_bf16(v[4], v[5]); w0.w = cvt_pk_bf16(v[6], v[7]);
                w1.x = cvt_pk_bf16(v[8], v[9]); w1.y = cvt_pk_bf16(v[10], v[11]); w1.z = cvt_pk_bf16(v[12], v[13]); w1.w = cvt_pk_bf16(v[14], v[15]);
                *(u32x4*)((bf16_t*)(gbase + GU_KDT) + dk * 64 + 16 * pg) = w0; *(u32x4*)((bf16_t*)(gbase + GU_KDT) + dk * 64 + 16 * pg + 8) = w1;
                if (tid == 0) gtot[unit] = __expf(gclast);
            }
            __syncthreads();
        }
    }
#undef GA_PREFETCH
}

constexpr int GB_BUF = 62464, GB_KDT = 34816, GB_QK = 53248, GB_BUF2 = GB_BUF + 4096 + 16;
__device__ __forceinline__ void gdn_pass_b(const Params& p, unsigned char* smem, int wg) {
    const int tid = threadIdx.x, wid = __builtin_amdgcn_readfirstlane(tid >> 6), lane = tid & 63, r16 = lane & 15, kq = lane >> 4;
    const int bh = wg >> 2, cgp = wg & 3, b = bh >> 2, h = bh & 3, nt = cgp * 2 + wid;
    unsigned char* ws = p.ws; const unsigned char* ubase = ws + WS_R4 + (size_t)(bh * 128) * GU_BYTES; const float* gtot = (const float*)(ws + WS_GTOT) + bh * 128;
    bf16_t* oraw = (bf16_t*)(ws + WS_ORAW);
#define GB_BAR() do { asm volatile("s_waitcnt lgkmcnt(0)" ::: "memory"); __builtin_amdgcn_s_barrier(); asm volatile("" ::: "memory"); } while (0)
    if (wid >= 2) {
        const int lt = tid - 128;
        int dsto[10]; size_t srco[10];
#pragma unroll
        for (int it = 0; it < 10; ++it) { const int q = lt + 384 * it;
            dsto[it] = (q < 2048) ? (q >> 4) * 272 + (q & 15) * 16 : (q < 3072) ? GB_KDT + ((q - 2048) >> 3) * 144 + ((q - 2048) & 7) * 16 : (q < 3584) ? GB_QK + ((q - 3072) >> 3) * 144 + ((q - 3072) & 7) * 16 : GB_BUF + (q - 3584) * 16;
            srco[it] = (q < 3584) ? (size_t)q * 16 : (size_t)(GU_U + cgp * 4096 + (q - 3584) * 16); }
        u32x4 sa[10], sb[10], sc[10]; float ga = 0.f, gb = 0.f, gc = 0.f;
#define GB_LD(st, g, n_) do { const unsigned char* rp_ = ubase + (size_t)(n_) * GU_BYTES; _Pragma("unroll") for (int it = 0; it < 10; ++it) st[it] = *(const u32x4*)(rp_ + srco[it]); if (lt == 0) g = gtot[n_]; } while (0)
#define GB_WR(st, g, bufi) do { unsigned char* bp_ = smem + (bufi) * GB_BUF2; _Pragma("unroll") for (int it = 0; it < 10; ++it) *(u32x4*)(bp_ + dsto[it]) = st[it]; if (lt == 0) *(float*)(bp_ + GB_BUF + 4096) = g; } while (0)
        GB_LD(sa, ga, 0); GB_WR(sa, ga, 0); GB_BAR();
        GB_LD(sa, ga, 1); GB_LD(sb, gb, 2); GB_LD(sc, gc, 3);
        for (int n0 = 0; n0 < NCH_; n0 += 3) {
            { const int n = n0;     if (n < NCH_) { if (n + 1 < NCH_) GB_WR(sa, ga, (n + 1) & 1); if (n + 4 < NCH_) GB_LD(sa, ga, n + 4); GB_BAR(); } }
            { const int n = n0 + 1; if (n < NCH_) { if (n + 1 < NCH_) GB_WR(sb, gb, (n + 1) & 1); if (n + 4 < NCH_) GB_LD(sb, gb, n + 4); GB_BAR(); } }
            { const int n = n0 + 2; if (n < NCH_) { if (n + 1 < NCH_) GB_WR(sc, gc, (n + 1) & 1); if (n + 4 < NCH_) GB_LD(sc, gc, n + 4); GB_BAR(); } }
        }
#undef GB_LD
#undef GB_WR
    } else {
        f32x4 S[8]; bf16x8 Sb[4];
#pragma unroll
        for (int d = 0; d < 8; ++d) S[d] = (f32x4){0.f, 0.f, 0.f, 0.f};
#pragma unroll
        for (int k = 0; k < 4; ++k) Sb[k] = (bf16x8){0, 0, 0, 0, 0, 0, 0, 0};
        GB_BAR();
        for (int n = 0; n < NCH_; ++n) {
            const unsigned char* L = smem + (n & 1) * GB_BUF2; const float gt = *(const float*)(L + GB_BUF + 4096); const size_t t0 = (size_t)b * SEQ_ + (size_t)n * 64;
            u32x2 uw[4];
#pragma unroll
            for (int tt = 0; tt < 4; ++tt) uw[tt] = *(const u32x2*)(L + GB_BUF + ((wid * 4 + tt) * 64 + lane) * 8);
            f32x4 P[8];
#pragma unroll
            for (int m = 0; m < 8; ++m) P[m] = (f32x4){0.f, 0.f, 0.f, 0.f};
#pragma unroll
            for (int ks = 0; ks < 4; ++ks)
#pragma unroll
                for (int mt = 0; mt < 8; ++mt) { const bf16x8 a = *(const bf16x8*)(L + (16 * mt + r16) * 272 + (32 * ks + 8 * kq) * 2); P[mt] = MFMA16(a, Sb[ks], P[mt]); }
            f32x4 vn[4];
#pragma unroll
            for (int tt = 0; tt < 4; ++tt) { const f32x4 u = {__uint_as_float(uw[tt].x << 16), __uint_as_float(uw[tt].x & 0xffff0000u), __uint_as_float(uw[tt].y << 16), __uint_as_float(uw[tt].y & 0xffff0000u)}; vn[tt] = u - P[tt]; }
            bf16x8 Vb[2]; Vb[0] = pack8(vn[0], vn[1]); Vb[1] = pack8(vn[2], vn[3]);
#pragma unroll
            for (int tt = 0; tt < 4; ++tt) { f32x4 O = P[4 + tt];
#pragma unroll
                for (int ks = 0; ks < 2; ++ks) { const bf16x8 a = *(const bf16x8*)(L + GB_QK + (16 * tt + r16) * 144 + (32 * ks + 8 * kq) * 2); O = MFMA16(a, Vb[ks], O); }
                bf16_t* op = oraw + (t0 + 16 * tt + 4 * kq) * 512 + h * 128 + 16 * nt + r16;
#pragma unroll
                for (int j = 0; j < 4; ++j) op[(size_t)j * 512] = f2bf(O[j]); }
#pragma unroll
            for (int dt = 0; dt < 8; ++dt) { f32x4 acc = S[dt] * gt;
#pragma unroll
                for (int ks = 0; ks < 2; ++ks) { const bf16x8 a = *(const bf16x8*)(L + GB_KDT + (16 * dt + r16) * 144 + (32 * ks + 8 * kq) * 2); acc = MFMA16(a, Vb[ks], acc); }
                S[dt] = acc; }
#pragma unroll
            for (int ks = 0; ks < 4; ++ks) Sb[ks] = pack8(S[2 * ks], S[2 * ks + 1]);
            GB_BAR();
        }
    }
#undef GB_BAR
}

__device__ __forceinline__ void gdn_norm(const Params& p) {
    unsigned char* ws = p.ws; const bf16_t* oraw = (const bf16_t*)(ws + WS_ORAW); const bf16_t* proj = (const bf16_t*)(ws + WS_PROJ); bf16_t* y = (bf16_t*)(ws + WS_Y);
    int tid_o = threadIdx.x; asm volatile("" : "+v"(tid_o));
    const int gtid = blockIdx.x * NTHREADS + tid_o, sub = gtid & 31; const f32x4 nwv = *(const f32x4*)(p.in[14] + sub * 4);
    const int stride = (gridDim.x * NTHREADS) >> 5;
    for (int item0 = gtid >> 5; item0 < T_ * 4; item0 += 4 * stride) {
        u32x2 ow[4], zw[4];
#pragma unroll
        for (int q = 0; q < 4; ++q) { const int item = item0 + q * stride; const int t = item >> 2, h = item & 3;
            if (item < T_ * 4) { ow[q] = *(const u32x2*)(oraw + (size_t)t * 512 + h * 128 + sub * 4); zw[q] = *(const u32x2*)(proj + (size_t)t * PJ_ + 2560 + h * 128 + sub * 4); } else { ow[q] = (u32x2){0u, 0u}; zw[q] = (u32x2){0u, 0u}; } }
#pragma unroll
        for (int q = 0; q < 4; ++q) { const int item = item0 + q * stride; const int t = item >> 2, h = item & 3;
            const f32x4 ov = {__uint_as_float(ow[q].x << 16), __uint_as_float(ow[q].x & 0xffff0000u), __uint_as_float(ow[q].y << 16), __uint_as_float(ow[q].y & 0xffff0000u)};
            float s = (ov[0] * ov[0] + ov[1] * ov[1]) + (ov[2] * ov[2] + ov[3] * ov[3]);
#pragma unroll
            for (int o = 1; o < 32; o <<= 1) s += __shfl_xor(s, o);
            const float rs = rsqrtf(s * (1.0f / 128.0f) + EPS_);
            const float z0 = __uint_as_float(zw[q].x << 16), z1 = __uint_as_float(zw[q].x & 0xffff0000u), z2 = __uint_as_float(zw[q].y << 16), z3 = __uint_as_float(zw[q].y & 0xffff0000u);
            u32x2 w; w.x = cvt_pk_bf16(ov[0] * rs * nwv[0] * siluf_(z0), ov[1] * rs * nwv[1] * siluf_(z1)); w.y = cvt_pk_bf16(ov[2] * rs * nwv[2] * siluf_(z2), ov[3] * rs * nwv[3] * siluf_(z3));
            if (item < T_ * 4) *(u32x2*)(y + (size_t)t * D_ + 512 + h * 128 + sub * 4) = w; }
    }
}

__device__ __forceinline__ void phase_final(const Params& p) {
    const int tid = threadIdx.x, wid = __builtin_amdgcn_readfirstlane(tid >> 6), lane = tid & 63;
    const float* ss = (const float*)(p.ws + WS_SSA); const float* nw = p.in[24]; float* out = p.out; const bf16_t* x3b = (const bf16_t*)(p.ws + WS_XB);
    f32x4 nwv[4];
#pragma unroll
    for (int i = 0; i < 4; ++i) nwv[i] = *(const f32x4*)(nw + 4 * (lane + 64 * i));
    u32x2 wn[4]; int row = blockIdx.x * 8 + wid;
    if (row < T_) {
#pragma unroll
        for (int i = 0; i < 4; ++i) wn[i] = *(const u32x2*)(x3b + (size_t)row * D_ + 4 * (lane + 64 * i)); }
    for (; row < T_; row += gridDim.x * 8) {
        const float rs = rstd16(ss, row);
        u32x2 wc[4];
#pragma unroll
        for (int i = 0; i < 4; ++i) wc[i] = wn[i];
        { const int nrow = row + gridDim.x * 8;
          if (nrow < T_) {
#pragma unroll
            for (int i = 0; i < 4; ++i) wn[i] = *(const u32x2*)(x3b + (size_t)nrow * D_ + 4 * (lane + 64 * i)); } }
#pragma unroll
        for (int i = 0; i < 4; ++i) { const u32x2 w = wc[i]; const f32x4 v = {__uint_as_float(w.x << 16), __uint_as_float(w.x & 0xffff0000u), __uint_as_float(w.y << 16), __uint_as_float(w.y & 0xffff0000u)};
            *(f32x4*)(out + (size_t)row * D_ + 4 * (lane + 64 * i)) = v * rs * nwv[i]; }
    }
}

constexpr int NPHASES = 11;
__global__ void __launch_bounds__(NTHREADS, 2) mega_fwd(Params p) {
    extern __shared__ __attribute__((aligned(16))) unsigned char smem[];
    PG8_LAS unsigned char* lds = (PG8_LAS unsigned char*)smem;
    cg::grid_group grid = cg::this_grid();
    unsigned char* ws = p.ws;
    bf16_t* hb = (bf16_t*)(ws + WS_XB); bf16_t* xb = (bf16_t*)(ws + WS_XB2); bf16_t* proj = (bf16_t*)(ws + WS_PROJ); bf16_t* ff = proj; bf16_t* y = (bf16_t*)(ws + WS_Y); bf16_t* pp = (bf16_t*)p.out;
    float* ssA = (float*)(ws + WS_SSA); float* ssB = (float*)(ws + WS_SSB);
#ifdef ONLY_PHASE
#define PH_ON(n) ((n) == ONLY_PHASE)
#else
#define PH_ON(n) ((n) >= p.ph_lo && (n) < p.ph_hi)
#endif
    volatile LAS unsigned* xst = (volatile LAS unsigned*)(lds + LDS_BYTES - 16);
    if (threadIdx.x == 0) { xst[0] = 0u; xst[1] = 0u; xst[2] = 0u; xst[3] = 0u; }
    __syncthreads();
    const XcdBarrier xbar = xcd_barrier_post((unsigned*)(ws + WS_BAR), xst);
    if (p.ph_lo == 0x7fffffff) grid.sync();
#define PH_SYNC(n) do { if ((n) > p.ph_lo && (n) < p.ph_hi) { xcd_barrier(xbar); } } while (0)
    if (PH_ON(0)) phase_prep(p, smem);
    PH_SYNC(1);
    if (PH_ON(1)) { EpiBf16Plain E; E.O = proj; E.ldc = PJ_; run_gemm(lds, hb, (const bf16_t*)(ws + WS_WIN), T_, PJ_, D_, E); }
    PH_SYNC(2);
    if (PH_ON(2)) { rg_pass_mfma<false>(p, smem, (int)blockIdx.x, (int)gridDim.x); __syncthreads(); gdn_pass_a(p, smem); }
    PH_SYNC(3);
    if (PH_ON(3)) {
        unsigned* flag = (unsigned*)ws + 16;
        if (blockIdx.x < 64) { const int xq = blockIdx.x & 7, kq8 = blockIdx.x >> 3;
            gdn_pass_b(p, smem, ((xq + 8 * (kq8 >> 2)) << 2) | (kq8 & 3)); }
        else {
            if (blockIdx.x < 68) { rg_carry(p, (blockIdx.x - 64) * NTHREADS + threadIdx.x); __threadfence(); __syncthreads();
                if (threadIdx.x == 0) __hip_atomic_fetch_add(flag, 1u, __ATOMIC_RELEASE, __HIP_MEMORY_SCOPE_AGENT); }
            prep_weights_late(p, smem, (int)blockIdx.x - 64, (int)gridDim.x - 64);
            if (threadIdx.x == 0) { while (__hip_atomic_load(flag, __ATOMIC_ACQUIRE, __HIP_MEMORY_SCOPE_AGENT) < 4u) __builtin_amdgcn_s_sleep(8); }
            __syncthreads(); __threadfence();
            rg_pass_mfma<true>(p, smem, (int)blockIdx.x - 64, (int)gridDim.x - 64);
            __syncthreads();
            { EpiBf16Plain E2; E2.O = pp; E2.ldc = D_; pg8::Gemm g2; g2.A = (const bf16_t*)(ws + WS_PB); g2.Bt = (const bf16_t*)(ws + WS_WPP); g2.M = T_; g2.N = D_; g2.K = PLE_;
              pg8::StaticOrder S2; S2.init(T_, D_, (int)gridDim.x - 64, (int)blockIdx.x - 64); pg8::gemm_phase<EpiBf16Plain, pg8::StaticOrder, false>(lds, g2, S2, E2, nullptr); }
        }
    }
    PH_SYNC(4);
    if (PH_ON(4)) gdn_norm(p);
    PH_SYNC(5);
    if (PH_ON(5)) { EpiResid<false> E; E.res = p.in[0]; E.xb = xb; E.ss = ssA; run_gemm(lds, y, (const bf16_t*)(ws + WS_WOUT), T_, D_, D_, E); }
    PH_SYNC(6);
    if (PH_ON(6)) { EpiGateUp E; E.ff = ff; E.ss = ssA; run_gemm(lds, xb, (const bf16_t*)(ws + WS_WGU), T_, 2 * FF_, D_, E); }
    PH_SYNC(7);
    if (PH_ON(7)) { EpiResid<true> E; E.res = nullptr; E.xb = xb; E.ss = ssB; run_gemm(lds, ff, (const bf16_t*)(ws + WS_WD), T_, D_, FF_, E); }
    PH_SYNC(8);
    if (PH_ON(8)) { EpiPle E; E.x2b = xb; E.x3b = hb; E.pp = pp; E.bias = p.in[22]; E.ss_in = ssB; E.ss_out = ssA; run_gemm(lds, xb, (const bf16_t*)(ws + WS_WPG), T_, D_, D_, E); }
    PH_SYNC(9);
    if (PH_ON(9)) phase_final(p);
}

extern "C" void kernel_launch(void* const* d_in, const int* in_sizes, int n_in, void* d_out, int out_size, void* d_ws, size_t ws_size, hipStream_t stream) {
    static int grid = 0;
    if (grid == 0) {
        if (n_in != 25 || out_size != T_ * D_ || ws_size < WS_END) { fprintf(stderr, "kernel_launch: unexpected shapes: n_in %d out %d ws %zu (need %zu)\n", n_in, out_size, ws_size, (size_t)WS_END); grid = -1; return; }
        int dev = 0, cus = 0, per_cu = 0;
        hipGetDevice(&dev); hipDeviceGetAttribute(&cus, hipDeviceAttributeMultiprocessorCount, dev);
        if (hipFuncSetAttribute((const void*)mega_fwd, hipFuncAttributeMaxDynamicSharedMemorySize, LDS_BYTES) != hipSuccess) { fprintf(stderr, "kernel_launch: hipFuncSetAttribute failed\n"); grid = -1; return; }
        if (hipOccupancyMaxActiveBlocksPerMultiprocessor(&per_cu, (const void*)mega_fwd, NTHREADS, LDS_BYTES) != hipSuccess || per_cu < 1) { fprintf(stderr, "kernel_launch: occupancy query says %d\n", per_cu); per_cu = 1; }
        (void)hipGetLastError();
        grid = cus * 1;
        if (grid <= 0) grid = 256;
    }
    if (grid < 0) return;
    Params p{};
    for (int i = 0; i < 25; ++i) p.in[i] = (const float*)d_in[i];
    p.out = (float*)d_out; p.ws = (unsigned char*)d_ws; p.ph_lo = 0; p.ph_hi = NPHASES;
    if (hipMemsetAsync((char*)d_ws + WS_BAR, 0, XCD_BAR_WORDS * 4, stream) != hipSuccess) { fprintf(stderr, "kernel_launch: memset of the barrier words failed\n"); return; }
    void* args[] = {&p};
    hipError_t e = hipLaunchCooperativeKernel((const void*)mega_fwd, dim3(grid), dim3(NTHREADS), args, LDS_BYTES, stream);
    if (e != hipSuccess) fprintf(stderr, "cooperative launch failed: %s (grid %d)\n", hipGetErrorString(e), grid);
}
```

```cpp
#include <hip/hip_runtime.h>
#include <hip/hip_cooperative_groups.h>
#include <cstdio>
#include <cstdint>
namespace cg = cooperative_groups;
namespace pg8 {
#define PG8_LAS __attribute__((address_space(3)))
typedef unsigned short bf16_t;
typedef short bf16x8 __attribute__((ext_vector_type(8)));
typedef float f32x4 __attribute__((ext_vector_type(4)));
typedef unsigned u32x4 __attribute__((ext_vector_type(4)));
constexpr int BM = 256, BK = 64, HALF = 128, HTB = HALF * BK * 2  , STAGE_BYTES = 8 * HTB, NXCD = 8, WGM = 8;

__host__ __device__ __forceinline__ int lds_byte(int r, int c) { const int st = (r >> 4) * 2 + (c >> 5), rr = r & 15, cc = c & 31, ob = rr * 64 + cc * 2; return st * 1024 + (ob ^ (((ob >> 9) & 1) << 5)); }
__host__ __device__ __forceinline__ void stage_rc(int b, int& R, int& C) { const int st = b / 1024, sb = b % 1024, swz = sb ^ (((sb >> 9) & 1) << 5); R = (st >> 1) * 16 + swz / 64; C = (st & 1) * 32 + (swz % 64) / 2; }
__host__ __device__ __forceinline__ int perm32(int rho) { const int n = rho >> 4, i = rho & 15; return 8 * (i >> 2) + 4 * n + (i & 3); }

struct Unit { int pm, pn; };
struct Gemm { const bf16_t* A; const bf16_t* Bt; int M, N, K; };

struct StaticOrder {
    int nM, nN, nwg, G, c;
    __host__ __device__ void init(int M, int N, int G_, int c_) { nM = M / BM; nN = N / BM; nwg = nM * nN; G = G_; c = c_; }
    __host__ __device__ bool next(int i, Unit& u) const {
        const long L = (long)i * G + c; if (L >= nwg) return false;
        int wgid = (int)L; { const int q = nwg / NXCD, r = nwg % NXCD, xcd = wgid % NXCD, off = wgid / NXCD; wgid = (xcd < r ? xcd * (q + 1) : r * (q + 1) + (xcd - r) * q) + off; }
        const int nig = WGM * nN, gid = wgid / nig, fm = gid * WGM, gsz = (nM - fm) < WGM ? (nM - fm) : WGM;
        u.pm = fm + ((wgid % nig) % gsz); u.pn = (wgid % nig) / gsz; return true;
    }
    __device__ __forceinline__ void a_ready(const Unit&) const {}
    __device__ __forceinline__ void done(const Unit&) const {}
};
typedef __bf16 bf16v2_ __attribute__((ext_vector_type(2)));
typedef float f32v2_ __attribute__((ext_vector_type(2)));
__device__ __forceinline__ unsigned cvt_pk_bf16(float lo, float hi) { f32v2_ v = {lo, hi}; bf16v2_ b = __builtin_convertvector(v, bf16v2_); return __builtin_bit_cast(unsigned, b); }
typedef float f32x2 __attribute__((ext_vector_type(2)));
template <class Epi, class Sched, bool STAMP = false>
__device__ __forceinline__ void gemm_phase(PG8_LAS unsigned char* lds, const Gemm g, const Sched& S, const Epi& E, unsigned long long* stamps) {
    int tid = threadIdx.x; asm volatile("" : "+v"(tid));
    const int wid = __builtin_amdgcn_readfirstlane(tid >> 6), lane = tid & 63, wr = wid >> 2, wc = wid & 3, fr = lane & 15, fq = lane >> 4;
    const int K = g.K, nt = K / BK;
    int ts_lo = 0, ts_hi = 0, nts = 0; const unsigned long long rt_entry = STAMP ? (unsigned long long)wall_clock64() : 0ull;
#define PG8_STAMP() do { if (STAMP && wid == 0 && nts < 64) { const unsigned long long _c = (unsigned long long)clock64(); \
        ts_lo = (lane == nts) ? (int)(unsigned)_c : ts_lo; ts_hi = (lane == nts) ? (int)(unsigned)(_c >> 32) : ts_hi; ++nts; } } while (0)
    PG8_STAMP();
    unsigned voffA[2], voffB[2];
#pragma unroll
    for (int i = 0; i < 2; ++i) { int R, C; stage_rc(tid * 16 + i * 8192, R, C); const int Rb = Epi::PERM ? ((R & ~31) + perm32(R & 31)) : R;
        voffA[i] = (unsigned)(R * K + C) * 2u; voffB[i] = (unsigned)(Rb * K + C) * 2u; }
    const size_t kstep = (size_t)(BK * 2);
    const size_t hstep = (size_t)HALF * K * 2;
    const size_t tstep = 2 * hstep;
    const unsigned ldsw = (unsigned)wid * 1024u;
    const int aoff = lds_byte(wr * 64 + fr, fq * 8), boff = lds_byte(wc * 32 + fr, fq * 8);
#define PG8_SA(b, h) (((b) * 2 + (h)) * HTB)
#define PG8_SB(b, h) ((4 + (b) * 2 + (h)) * HTB)
#define PG8_STAGE(bufoff, gbase, voff) do { _Pragma("unroll") for (int _i = 0; _i < 2; ++_i) \
        __builtin_amdgcn_global_load_lds((const unsigned*)((const char*)(gbase) + (voff)[_i]), (PG8_LAS unsigned*)(lds + (bufoff) + ldsw + _i * 8192), 16, 0, 0); } while (0)
#define PG8_LDA(dst, b, h) do { _Pragma("unroll") for (int m = 0; m < 4; ++m) _Pragma("unroll") for (int k = 0; k < 2; ++k) dst[m][k] = *(const PG8_LAS bf16x8*)(lds + PG8_SA(b, h) + aoff + m * 2048 + k * 1024); } while (0)
#define PG8_LDB(dst, b, h) do { _Pragma("unroll") for (int n = 0; n < 2; ++n) _Pragma("unroll") for (int k = 0; k < 2; ++k) dst[n][k] = *(const PG8_LAS bf16x8*)(lds + PG8_SB(b, h) + boff + n * 2048 + k * 1024); } while (0)
#define PG8_MMA(ai, bj, At, Bt) do { __builtin_amdgcn_s_setprio(1); _Pragma("unroll") for (int m = 0; m < 4; ++m) _Pragma("unroll") for (int n = 0; n < 2; ++n) _Pragma("unroll") for (int k = 0; k < 2; ++k) \
        acc[ai][bj][m][n] = __builtin_amdgcn_mfma_f32_16x16x32_bf16(Bt[n][k], At[m][k], acc[ai][bj][m][n], 0, 0, 0); __builtin_amdgcn_s_setprio(0); } while (0)
#define PG8_WAIT_V(n) asm volatile("s_waitcnt vmcnt(" #n ")" ::: "memory")
#define PG8_WAIT_L(n) asm volatile("s_waitcnt lgkmcnt(" #n ")" ::: "memory")
#define PG8_BAR __builtin_amdgcn_s_barrier()
#define PG8_SCHED __builtin_amdgcn_sched_barrier(0)
    Unit cur, nxt; int ui = 0;
    if (!S.next(0, cur)) return;
    f32x4 acc[2][2][4][2];
#pragma unroll
    for (int a = 0; a < 2; ++a)
#pragma unroll
        for (int b = 0; b < 2; ++b)
#pragma unroll
            for (int m = 0; m < 4; ++m)
#pragma unroll
                for (int n = 0; n < 2; ++n) acc[a][b][m][n] = (f32x4){0.f, 0.f, 0.f, 0.f};
    bf16x8 At[4][2], B0[2][2], B1[2][2];
    const char* cA = (const char*)g.A + (size_t)cur.pm * tstep; const char* cB = (const char*)g.Bt + (size_t)cur.pn * tstep;
    S.a_ready(cur);
    PG8_STAGE(PG8_SB(0, 0), cB, voffB); PG8_STAGE(PG8_SA(0, 0), cA, voffA); PG8_STAGE(PG8_SB(0, 1), cB + hstep, voffB); PG8_STAGE(PG8_SA(0, 1), cA + hstep, voffA);
    if (wr == 1) PG8_BAR;
    PG8_WAIT_V(4); PG8_BAR;
    PG8_STAGE(PG8_SB(1, 0), cB + kstep, voffB); PG8_STAGE(PG8_SA(1, 0), cA + kstep, voffA); PG8_STAGE(PG8_SB(1, 1), cB + hstep + kstep, voffB);
    PG8_WAIT_V(6); PG8_BAR;
    PG8_STAMP();
    for (;;) {
        const bool has_next = S.next(ui + 1, nxt);
        const char* nA = has_next ? (const char*)g.A + (size_t)nxt.pm * tstep : cA; const char* nB = has_next ? (const char*)g.Bt + (size_t)nxt.pn * tstep : cB;
        for (int t = 0; t < nt; t += 2) {
            const bool last = (t == nt - 2);
            const char* a1 = cA + (size_t)(t + 1) * kstep;
            const char* a2 = last ? nA : cA + (size_t)(t + 2) * kstep; const char* b2 = last ? nB : cB + (size_t)(t + 2) * kstep;
            const char* a3 = a2 + kstep; const char* b3 = b2 + kstep;
            if (last && has_next) S.a_ready(nxt);
            PG8_LDB(B0, 0, 0); PG8_SCHED; PG8_LDA(At, 0, 0); PG8_STAGE(PG8_SA(1, 1), a1 + hstep, voffA);
            PG8_WAIT_L(8); PG8_BAR; PG8_WAIT_L(0); PG8_MMA(0, 0, At, B0); PG8_BAR; PG8_SCHED;
            PG8_LDB(B1, 0, 1); PG8_STAGE(PG8_SB(0, 0), b2, voffB);
            PG8_BAR; PG8_WAIT_L(0); PG8_MMA(0, 1, At, B1); PG8_BAR;
            PG8_LDA(At, 0, 1); PG8_STAGE(PG8_SA(0, 0), a2, voffA);
            PG8_BAR; PG8_WAIT_L(0); PG8_MMA(1, 0, At, B0); PG8_BAR; PG8_SCHED;
            PG8_STAGE(PG8_SB(0, 1), b2 + hstep, voffB);
            PG8_WAIT_V(6); PG8_BAR; PG8_MMA(1, 1, At, B1); PG8_BAR;
            PG8_LDB(B0, 1, 0); PG8_SCHED; PG8_LDA(At, 1, 0); PG8_STAGE(PG8_SA(0, 1), a2 + hstep, voffA);
            PG8_WAIT_L(8); PG8_BAR; PG8_WAIT_L(0); PG8_MMA(0, 0, At, B0); PG8_BAR; PG8_SCHED;
            PG8_LDB(B1, 1, 1); PG8_STAGE(PG8_SB(1, 0), b3, voffB);
            PG8_BAR; PG8_WAIT_L(0); PG8_MMA(0, 1, At, B1); PG8_BAR;
            PG8_LDA(At, 1, 1); PG8_STAGE(PG8_SA(1, 0), a3, voffA);
            PG8_BAR; PG8_WAIT_L(0); PG8_MMA(1, 0, At, B0); PG8_BAR; PG8_SCHED;
            PG8_STAGE(PG8_SB(1, 1), b3 + hstep, voffB);
            PG8_WAIT_V(6); PG8_BAR; PG8_MMA(1, 1, At, B1); PG8_BAR;
        }
        PG8_STAMP();
        if constexpr (!Epi::AFTER_DRAIN) { E(acc, cur, wr, wc, fr, fq); S.done(cur); }
        PG8_STAMP();
        if (!has_next) break;
#pragma unroll
        for (int a = 0; a < 2; ++a)
#pragma unroll
            for (int b = 0; b < 2; ++b)
#pragma unroll
                for (int m = 0; m < 4; ++m)
#pragma unroll
                    for (int n = 0; n < 2; ++n) acc[a][b][m][n] = (f32x4){0.f, 0.f, 0.f, 0.f};
        cur = nxt; cA = nA; cB = nB; ++ui;
    }
    PG8_WAIT_V(0);
    if (wr == 0) PG8_BAR;
    PG8_BAR;
    if constexpr (Epi::AFTER_DRAIN) { E.fused(acc, cur, wr, wc, fr, fq, lds, wid, lane); S.done(cur); }
    PG8_STAMP();
    if (STAMP && wid == 0) { stamps[lane] = lane < nts ? (((unsigned long long)(unsigned)ts_hi << 32) | (unsigned)ts_lo) : 0ull;
        if (lane == 62) stamps[62] = rt_entry; if (lane == 63) stamps[63] = (unsigned long long)wall_clock64(); }
#undef PG8_STAMP
#undef PG8_SA
#undef PG8_SB
#undef PG8_STAGE
#undef PG8_LDA
#undef PG8_LDB
#undef PG8_MMA
#undef PG8_WAIT_V
#undef PG8_WAIT_L
#undef PG8_BAR
#undef PG8_SCHED
}
}
#define XB_TMO      128
#define XB_XCNT(j)  (256  + 64 * (j))
#define XB_XSUB(j)  (1280 + 64 * (j))
#define XB_XGEN(j)  (2304 + 64 * (j))
#define XB_TOP      3328
#define XB_TOPGEN   3392
#define XCD_BAR_WORDS 3456
#define XB_SPIN_CAP (1u << 18)
#define LAS __attribute__((address_space(3)))

__device__ __forceinline__ unsigned xb_ld(unsigned* p)              { return __hip_atomic_load(p, __ATOMIC_RELAXED, __HIP_MEMORY_SCOPE_AGENT); }
__device__ __forceinline__ unsigned xb_add(unsigned* p, unsigned v) { return __hip_atomic_fetch_add(p, v, __ATOMIC_RELAXED, __HIP_MEMORY_SCOPE_AGENT); }
__device__ __forceinline__ unsigned xb_xcc_id() { return (unsigned)__builtin_amdgcn_s_getreg((3 << 11) | 20) & 0xFu; }
#define XB_SPIN(cond, bar) do { unsigned _sp = 0; while (cond) { __builtin_amdgcn_s_sleep(1); \
    if ((++_sp & 255u) == 0u) { if (xb_ld(&(bar)[XB_TMO])) break; if (_sp > XB_SPIN_CAP) { atomicAdd(&(bar)[XB_TMO], 1u); break; } } } } while (0)

struct XcdBarrier {
    unsigned* bar; unsigned x;
    volatile LAS unsigned* st;
};

__device__ __forceinline__ XcdBarrier xcd_barrier_post(unsigned* bar, volatile LAS unsigned* st) {
    XcdBarrier b; b.bar = bar; b.x = xb_xcc_id(); b.st = st;
    if (threadIdx.x == 0) (void)xb_add(&bar[XB_XCNT(b.x)], 1u);
    return b;
}
__device__ __forceinline__ void xcd_barrier_complete(unsigned* bar, unsigned x, unsigned& nloc, unsigned& nx) {
    const unsigned G = gridDim.x * gridDim.y * gridDim.z;
    unsigned sum, cnt, mine, sp = 0u;
    for (;;) {
        sum = 0u; cnt = 0u; mine = 0u;
#pragma unroll
        for (unsigned j = 0; j < 16; ++j) { const unsigned c = xb_ld(&bar[XB_XCNT(j)]); sum += c; cnt += (c > 0u) ? 1u : 0u; mine = (j == x) ? c : mine; }
        if (sum == G) break;
        __builtin_amdgcn_s_sleep(1);
        if ((++sp & 255u) == 0u) { if (xb_ld(&bar[XB_TMO])) break; if (sp > XB_SPIN_CAP) { atomicAdd(&bar[XB_TMO], 1u); break; } }
    }
    nloc = mine > 0u ? mine : 1u; nx = cnt > 0u ? cnt : 1u;
}

__device__ __forceinline__ void xcd_barrier(const XcdBarrier& b) {
    asm volatile("s_waitcnt vmcnt(0)" ::: "memory");
    __syncthreads();
    if (threadIdx.x == 0) {
        unsigned* bar = b.bar;
        __builtin_amdgcn_s_waitcnt(0);
        unsigned nloc = b.st[0], nx = b.st[1];
        if (nloc == 0u) { xcd_barrier_complete(bar, b.x, nloc, nx); b.st[0] = nloc; b.st[1] = nx; }
        const unsigned old = xb_add(&bar[XB_XSUB(b.x)], 1u);
        const unsigned gen = old / nloc;
        if (old + 1u == (gen + 1u) * nloc) {
            __builtin_amdgcn_fence(__ATOMIC_RELEASE, "agent");
            asm volatile("s_waitcnt vmcnt(0)" ::: "memory");
            const unsigned og = xb_add(&bar[XB_TOP], 1u);
            const unsigned tg = og / nx;
            if (og + 1u == (tg + 1u) * nx) xb_add(&bar[XB_TOPGEN], 1u);
            else XB_SPIN(xb_ld(&bar[XB_TOPGEN]) == tg, bar);
            __builtin_amdgcn_fence(__ATOMIC_ACQUIRE, "agent");
            xb_add(&bar[XB_XGEN(b.x)], 1u);
            asm volatile("s_waitcnt vmcnt(0)" ::: "memory");
        } else {
            XB_SPIN(xb_ld(&bar[XB_XGEN(b.x)]) == gen, bar);
            __builtin_amdgcn_fence(__ATOMIC_ACQUIRE, "agent");
            asm volatile("s_waitcnt vmcnt(0)" ::: "memory");
        }
    }
    __syncthreads();
}

using pg8::bf16_t; using pg8::f32x4; using pg8::u32x4; using pg8::bf16x8; using pg8::cvt_pk_bf16; using pg8::Unit; using pg8::HALF; using pg8::BM;
typedef unsigned u32x2 __attribute__((ext_vector_type(2)));
constexpr int T_ = 32768, D_ = 1024, SEQ_ = 8192, NB_ = 4, INC_ = 3080, PJ_ = 3072, FF_ = 2816, PLE_ = 256, NCH_ = 128;
constexpr float EPS_ = 1e-6f;
constexpr int NTHREADS = 512;
constexpr int LDS_BYTES = 144 * 1024;

constexpr size_t WS_WIN = 4096;
constexpr size_t WS_WOUT = WS_WIN + (size_t)PJ_ * D_ * 2;
constexpr size_t WS_WGU = WS_WOUT + (size_t)D_ * D_ * 2;
constexpr size_t WS_WD = WS_WGU + (size_t)2 * FF_ * D_ * 2;
constexpr size_t WS_WPG = WS_WD + (size_t)D_ * FF_ * 2;
constexpr size_t WS_WPP = WS_WPG + (size_t)D_ * D_ * 2;
constexpr size_t WS_LOGITS = WS_WPP + (size_t)D_ * PLE_ * 2;
constexpr size_t WS_PB = WS_LOGITS + (size_t)T_ * 8 * 4;
constexpr size_t WS_SSA = WS_PB + (size_t)T_ * PLE_ * 2;
constexpr size_t WS_SSB = WS_SSA + (size_t)T_ * 16 * 4;
constexpr size_t WS_PTOT = WS_SSB + (size_t)T_ * 16 * 4;
constexpr size_t WS_HEND = WS_PTOT + (size_t)NB_ * NCH_ * 512 * 4;
constexpr size_t WS_CARRY = WS_HEND + (size_t)NB_ * NCH_ * 512 * 4;
constexpr size_t WS_GTOT = WS_CARRY + (size_t)NB_ * NCH_ * 512 * 4;
constexpr size_t WS_XB = WS_GTOT + 8192;
constexpr size_t WS_PROJ = WS_XB + (size_t)T_ * D_ * 2;
constexpr size_t WS_R4 = WS_PROJ + (size_t)T_ * PJ_ * 2;
constexpr size_t WS_Y = WS_XB;
constexpr size_t WS_XB2 = WS_R4;
constexpr size_t WS_PP = WS_R4 + (size_t)T_ * D_ * 2;
constexpr size_t WS_ORAW = WS_R4 + (size_t)2048 * 73728;
constexpr size_t WS_BAR = WS_R4 + (size_t)2048 * 73728 + (size_t)T_ * 512 * 2;
constexpr size_t WS_RGW = WS_BAR + 16384;
constexpr size_t WS_END = WS_RGW + 131072;

struct Params {
    const float* in[25];
    float* out; unsigned char* ws;
    int ph_lo, ph_hi;
};

__device__ __forceinline__ float bf2f(bf16_t b) { return __uint_as_float(((unsigned)b) << 16); }
__device__ __forceinline__ bf16_t f2bf(float f) { return (bf16_t)(cvt_pk_bf16(f, 0.f) & 0xffffu); }
__device__ __forceinline__ float sigmoidf_(float x) { return __builtin_amdgcn_rcpf(1.0f + __expf(-x)); }
__device__ __forceinline__ float siluf_(float x) { return x * __builtin_amdgcn_rcpf(1.0f + __expf(-x)); }
__device__ __forceinline__ float softplusf_(float x) { return fmaxf(x, 0.f) + log1pf(__expf(-fabsf(x))); }
__device__ __forceinline__ float gelu_tanhf_(float x) { const float u = 0.7978845608028654f * (x + 0.044715f * x * x * x); return x * __builtin_amdgcn_rcpf(1.0f + __expf(-2.0f * u)); }
__device__ __forceinline__ float rstd16(const float* ss, int r) {
    const f32x4 a = *(const f32x4*)(ss + (size_t)r * 16), b = *(const f32x4*)(ss + (size_t)r * 16 + 4), c = *(const f32x4*)(ss + (size_t)r * 16 + 8), d = *(const f32x4*)(ss + (size_t)r * 16 + 12);
    const float s = ((a[0] + a[1]) + (a[2] + a[3])) + ((b[0] + b[1]) + (b[2] + b[3])) + ((c[0] + c[1]) + (c[2] + c[3])) + ((d[0] + d[1]) + (d[2] + d[3]));
    return rsqrtf(s * (1.0f / 1024.0f) + EPS_);
}

template <int CTRL> __device__ __forceinline__ float dpp_f(float x) { return __int_as_float(__builtin_amdgcn_update_dpp(0, __float_as_int(x), CTRL, 0xf, 0xf, false)); }
__device__ __forceinline__ float red8(float x) { x += dpp_f<0xB1>(x); x += dpp_f<0x4E>(x); x += dpp_f<0x141>(x); return x; }
struct EpiBf16Plain {
    static constexpr bool PERM = true, AFTER_DRAIN = false;
    bf16_t* O; int ldc;
    __device__ __forceinline__ void operator()(const f32x4 (&acc)[2][2][4][2], const Unit& u, int wr, int wc, int fr, int fq) const {
        int row0 = u.pm * BM + wr * 64 + fr; asm volatile("" : "+v"(row0)); const int col0 = u.pn * BM + wc * 32 + 8 * fq;
#pragma unroll
        for (int ai = 0; ai < 2; ++ai)
#pragma unroll
            for (int m = 0; m < 4; ++m) { bf16_t* rowp = O + (size_t)(row0 + ai * HALF + m * 16) * ldc + col0;
#pragma unroll
                for (int bj = 0; bj < 2; ++bj) { const f32x4 v0 = acc[ai][bj][m][0], v1 = acc[ai][bj][m][1]; u32x4 w; w.x = cvt_pk_bf16(v0[0], v0[1]); w.y = cvt_pk_bf16(v0[2], v0[3]); w.z = cvt_pk_bf16(v1[0], v1[1]); w.w = cvt_pk_bf16(v1[2], v1[3]);
                    *(u32x4*)(rowp + bj * HALF) = w; } }
    }
};
__device__ __forceinline__ void rstd8(const float* ss, int row0, float (&rs)[8]) {
#pragma unroll
    for (int ai = 0; ai < 2; ++ai) { f32x4 t[4][4];
#pragma unroll
        for (int m = 0; m < 4; ++m)
#pragma unroll
            for (int q = 0; q < 4; ++q) t[m][q] = *(const f32x4*)(ss + (size_t)(row0 + ai * HALF + m * 16) * 16 + 4 * q);
#pragma unroll
        for (int m = 0; m < 4; ++m) { const float sm = (((t[m][0][0] + t[m][0][1]) + (t[m][0][2] + t[m][0][3])) + ((t[m][1][0] + t[m][1][1]) + (t[m][1][2] + t[m][1][3]))) + (((t[m][2][0] + t[m][2][1]) + (t[m][2][2] + t[m][2][3])) + ((t[m][3][0] + t[m][3][1]) + (t[m][3][2] + t[m][3][3])));
            rs[ai * 4 + m] = rsqrtf(sm * (1.0f / 1024.0f) + EPS_); }
        asm volatile("" ::: "memory"); }
}
template <bool RES_BF16>
struct EpiResid {
    static constexpr bool PERM = false, AFTER_DRAIN = false;
    const float* res; bf16_t* xb; float* ss;
    __device__ __forceinline__ void operator()(const f32x4 (&acc)[2][2][4][2], const Unit& u, int wr, int wc, int fr, int fq) const {
        int row0 = u.pm * BM + wr * 64 + fr; asm volatile("" : "+v"(row0)); const int col0 = u.pn * BM + wc * 32 + 4 * fq;
        const unsigned e0 = (unsigned)row0 * D_ + col0;
#pragma unroll
        for (int ai = 0; ai < 2; ++ai) {
            constexpr int NB = RES_BF16 ? 4 : 2;
#pragma unroll
            for (int mh = 0; mh < 4 / NB; ++mh) {
                f32x4 rv[NB][2][2];
#pragma unroll
                for (int mm = 0; mm < NB; ++mm)
#pragma unroll
                    for (int bj = 0; bj < 2; ++bj)
#pragma unroll
                        for (int n = 0; n < 2; ++n) { const unsigned e = e0 + (unsigned)((ai * HALF + (mh * NB + mm) * 16) * D_ + bj * HALF + n * 16);
                            if (RES_BF16) { const u32x2 w = *(const u32x2*)((const char*)xb + (size_t)(e * 2u)); rv[mm][bj][n] = (f32x4){__uint_as_float(w.x << 16), __uint_as_float(w.x & 0xffff0000u), __uint_as_float(w.y << 16), __uint_as_float(w.y & 0xffff0000u)}; }
                            else rv[mm][bj][n] = *(const f32x4*)((const char*)res + (size_t)(e * 4u)); }
#pragma unroll
                for (int mm = 0; mm < NB; ++mm) { const int m = mh * NB + mm, r = row0 + ai * HALF + m * 16; float s = 0.f;
#pragma unroll
                    for (int bj = 0; bj < 2; ++bj)
#pragma unroll
                        for (int n = 0; n < 2; ++n) { const unsigned e = e0 + (unsigned)((ai * HALF + m * 16) * D_ + bj * HALF + n * 16); const f32x4 v = rv[mm][bj][n] + acc[ai][bj][m][n];
                            s += (v[0] * v[0] + v[1] * v[1]) + (v[2] * v[2] + v[3] * v[3]); u32x2 w; w.x = cvt_pk_bf16(v[0], v[1]); w.y = cvt_pk_bf16(v[2], v[3]); *(u32x2*)((char*)xb + (size_t)(e * 2u)) = w; }
                    s += __shfl_xor(s, 16); s += __shfl_xor(s, 32);
                    if (fq == 0) ss[(size_t)r * 16 + u.pn * 4 + wc] = s; }
                asm volatile("" ::: "memory"); } }
    }
};
struct EpiGateUp {
    static constexpr bool PERM = true, AFTER_DRAIN = false;
    bf16_t* ff; const float* ss;
    __device__ __forceinline__ void operator()(const f32x4 (&acc)[2][2][4][2], const Unit& u, int wr, int wc, int fr, int fq) const {
        int row0 = u.pm * BM + wr * 64 + fr; asm volatile("" : "+v"(row0)); const int col0 = u.pn * HALF + wc * 32 + 8 * fq;
        float rsv[8]; rstd8(ss, row0, rsv);
#pragma unroll
        for (int ai = 0; ai < 2; ++ai)
#pragma unroll
            for (int m = 0; m < 4; ++m) { const int r = row0 + ai * HALF + m * 16; const float rs = rsv[ai * 4 + m];
                float o[8];
#pragma unroll
                for (int n = 0; n < 2; ++n)
#pragma unroll
                    for (int j = 0; j < 4; ++j) { const float g = acc[ai][0][m][n][j] * rs, up = acc[ai][1][m][n][j] * rs; o[n * 4 + j] = siluf_(g) * up; }
                u32x4 w; w.x = cvt_pk_bf16(o[0], o[1]); w.y = cvt_pk_bf16(o[2], o[3]); w.z = cvt_pk_bf16(o[4], o[5]); w.w = cvt_pk_bf16(o[6], o[7]);
                *(u32x4*)(ff + (size_t)r * FF_ + col0) = w; }
    }
};
struct EpiPle {
    static constexpr bool PERM = false, AFTER_DRAIN = false;
    const bf16_t* x2b; bf16_t* x3b; const bf16_t* pp; const float* bias; const float* ss_in; float* ss_out;
    __device__ __forceinline__ void operator()(const f32x4 (&acc)[2][2][4][2], const Unit& u, int wr, int wc, int fr, int fq) const {
        int row0 = u.pm * BM + wr * 64 + fr; asm volatile("" : "+v"(row0)); const int col0 = u.pn * BM + wc * 32 + 4 * fq;
        const unsigned b0 = ((unsigned)row0 * D_ + col0) * 2u;
        const unsigned s0 = (unsigned)row0 * 64u;
        u32x2 X[2][2][2], P[2][2][2]; f32x4 S[2][4];
#define EP_LOAD(set, g) do { const unsigned ro_ = (unsigned)(((g) >> 2) * HALF + ((g) & 3) * 16); \
        _Pragma("unroll") for (int bj = 0; bj < 2; ++bj) _Pragma("unroll") for (int n = 0; n < 2; ++n) { const unsigned bo_ = b0 + (ro_ * D_ + bj * HALF + n * 16) * 2u; \
            X[set][bj][n] = *(const u32x2*)((const char*)x2b + (size_t)bo_); P[set][bj][n] = *(const u32x2*)((const char*)pp + (size_t)bo_); } \
        _Pragma("unroll") for (int q = 0; q < 4; ++q) S[set][q] = *(const f32x4*)((const char*)ss_in + (size_t)(s0 + ro_ * 64u + q * 16u)); } while (0)
        EP_LOAD(0, 0);
#pragma unroll
        for (int g = 0; g < 8; ++g) { const int ai = g >> 2, m = g & 3, st = g & 1, r = row0 + ai * HALF + m * 16;
            if (g < 7) EP_LOAD((g + 1) & 1, g + 1);
            const float sm = (((S[st][0][0] + S[st][0][1]) + (S[st][0][2] + S[st][0][3])) + ((S[st][1][0] + S[st][1][1]) + (S[st][1][2] + S[st][1][3]))) + (((S[st][2][0] + S[st][2][1]) + (S[st][2][2] + S[st][2][3])) + ((S[st][3][0] + S[st][3][1]) + (S[st][3][2] + S[st][3][3])));
            const float rs = rsqrtf(sm * (1.0f / 1024.0f) + EPS_); float s = 0.f;
#pragma unroll
            for (int bj = 0; bj < 2; ++bj)
#pragma unroll
                for (int n = 0; n < 2; ++n) { const unsigned bo = b0 + (unsigned)(((ai * HALF + m * 16) * D_ + bj * HALF + n * 16) * 2); const u32x2 w2 = P[st][bj][n], x2 = X[st][bj][n]; const f32x4 a = acc[ai][bj][m][n]; const f32x4 bb = *(const f32x4*)(bias + col0 + bj * HALF + n * 16);
                    f32x4 v = {__uint_as_float(x2.x << 16), __uint_as_float(x2.x & 0xffff0000u), __uint_as_float(x2.y << 16), __uint_as_float(x2.y & 0xffff0000u)};
                    const float p0 = __uint_as_float(w2.x << 16), p1 = __uint_as_float(w2.x & 0xffff0000u), p2 = __uint_as_float(w2.y << 16), p3 = __uint_as_float(w2.y & 0xffff0000u);
                    v[0] += sigmoidf_(a[0] * rs + bb[0]) * p0; v[1] += sigmoidf_(a[1] * rs + bb[1]) * p1; v[2] += sigmoidf_(a[2] * rs + bb[2]) * p2; v[3] += sigmoidf_(a[3] * rs + bb[3]) * p3;
                    u32x2 xw; xw.x = cvt_pk_bf16(v[0], v[1]); xw.y = cvt_pk_bf16(v[2], v[3]); *(u32x2*)((char*)x3b + (size_t)bo) = xw; s += (v[0] * v[0] + v[1] * v[1]) + (v[2] * v[2] + v[3] * v[3]); }
            s += __shfl_xor(s, 16); s += __shfl_xor(s, 32);
            if (fq == 0) ss_out[(size_t)r * 16 + u.pn * 4 + wc] = s;
            asm volatile("" ::: "memory"); }
#undef EP_LOAD
    }
};

template <class Epi> __device__ __forceinline__ void run_gemm(PG8_LAS unsigned char* lds, const bf16_t* A, const bf16_t* Bt, int M, int N, int K, const Epi& E) {
    pg8::Gemm g; g.A = A; g.Bt = Bt; g.M = M; g.N = N; g.K = K;
    pg8::StaticOrder S; S.init(M, N, (int)gridDim.x, (int)blockIdx.x);
    pg8::gemm_phase<Epi, pg8::StaticOrder, false>(lds, g, S, E, nullptr);
}

__device__ void prep_transpose(const float* __restrict__ W, int K, int ldw, int c0, int ncols, bf16_t* __restrict__ Wt, const float* __restrict__ ks, int mode, float* tile, int rot, int widx, int nw) {
    const int tid = threadIdx.x, nkt = K / 64, nct = ncols / 64, ntiles = nkt * nct;
    for (int tt = (widx + nw - (rot % nw)) % nw; tt < ntiles; tt += nw) {
        const int kt = tt / nct, ct = tt % nct, k0 = kt * 64, n0 = ct * 64;
        __syncthreads();
#pragma unroll
        for (int i = 0; i < 2; ++i) { const int r = (tid >> 4) + 32 * i, c4 = (tid & 15) * 4; const f32x4 v = *(const f32x4*)(W + (size_t)(k0 + r) * ldw + c0 + n0 + c4);
            const float s = ks ? ks[k0 + r] : 1.0f; tile[r * 65 + c4 + 0] = v[0] * s; tile[r * 65 + c4 + 1] = v[1] * s; tile[r * 65 + c4 + 2] = v[2] * s; tile[r * 65 + c4 + 3] = v[3] * s; }
        __syncthreads();
        const int n = tid >> 3, kseg = (tid & 7) * 8; float v[8];
#pragma unroll
        for (int e = 0; e < 8; ++e) v[e] = tile[(kseg + e) * 65 + n];
        u32x4 w; w.x = cvt_pk_bf16(v[0], v[1]); w.y = cvt_pk_bf16(v[2], v[3]); w.z = cvt_pk_bf16(v[4], v[5]); w.w = cvt_pk_bf16(v[6], v[7]);
        const int f = n0 + n; const int drow = (mode == 0) ? f : (256 * (f >> 7) + 128 * (mode - 1) + (f & 127));
        *(u32x4*)(Wt + (size_t)drow * K + k0 + kseg) = w;
    }
}


__device__ __forceinline__ void prep_weights_late(const Params& p, unsigned char* smem, int widx, int nw) {
    unsigned char* ws = p.ws; float* tile = (float*)smem;
    __syncthreads();
    prep_transpose(p.in[15], D_, D_, 0, D_, (bf16_t*)(ws + WS_WOUT), nullptr, 0, tile, 0, widx, nw);
    prep_transpose(p.in[17], D_, FF_, 0, FF_, (bf16_t*)(ws + WS_WGU), p.in[16], 1, tile, 256, widx, nw);
    prep_transpose(p.in[18], D_, FF_, 0, FF_, (bf16_t*)(ws + WS_WGU), p.in[16], 2, tile, 960, widx, nw);
    prep_transpose(p.in[19], FF_, D_, 0, D_, (bf16_t*)(ws + WS_WD), nullptr, 0, tile, 1664, widx, nw);
    prep_transpose(p.in[21], D_, D_, 0, D_, (bf16_t*)(ws + WS_WPG), p.in[20], 0, tile, 2368, widx, nw);
}

__device__ __forceinline__ void phase_prep(const Params& p, unsigned char* smem) {
    const int tid = threadIdx.x, wid = __builtin_amdgcn_readfirstlane(tid >> 6), lane = tid & 63;
    unsigned char* ws = p.ws;
    float* tile = (float*)smem;
    float* w8s = (float*)(smem + 20480);
    if (blockIdx.x == 0 && tid < 32) ((unsigned*)ws)[tid] = 0u;
    prep_transpose(p.in[3], D_, INC_, 0, PJ_, (bf16_t*)(ws + WS_WIN), nullptr, 0, tile, 0, (int)blockIdx.x, (int)gridDim.x);
    prep_transpose(p.in[23], PLE_, D_, 0, D_, (bf16_t*)(ws + WS_WPP), nullptr, 0, tile, 768, (int)blockIdx.x, (int)gridDim.x);
    if (blockIdx.x < 8) {
        const int hh = blockIdx.x;
        for (int item = tid; item < 1024; item += NTHREADS) { const int gate = item >> 9, fragi = (item >> 6) & 7, ln = item & 63, ntf = fragi >> 1, ksf = fragi & 1, n16f = ln & 15, fqf = ln >> 4;
            const float* wsrc = p.in[gate ? 8 : 6] + (size_t)(hh * 64 + 32 * ksf + 8 * fqf) * 64 + 16 * ntf + n16f;
            const f32x4 lo = {wsrc[0], wsrc[64], wsrc[128], wsrc[192]}, hi = {wsrc[256], wsrc[320], wsrc[384], wsrc[448]};
            u32x4 w; w.x = cvt_pk_bf16(lo[0], lo[1]); w.y = cvt_pk_bf16(lo[2], lo[3]); w.z = cvt_pk_bf16(hi[0], hi[1]); w.w = cvt_pk_bf16(hi[2], hi[3]);
            *(u32x4*)(ws + WS_RGW + ((size_t)((hh * 2 + gate) * 8 + fragi) * 64 + ln) * 16) = w; }
    }
    for (int i = tid; i < 1024 * 8; i += NTHREADS) { const int k = i >> 3, j = i & 7; w8s[i] = p.in[2][k] * p.in[3][(size_t)k * INC_ + PJ_ + j]; }
    __syncthreads();
    {
        const float* x = p.in[0]; const float* nw = p.in[2]; bf16_t* hb = (bf16_t*)(ws + WS_XB); float* logits = (float*)(ws + WS_LOGITS);
        f32x4 nwv[4];
#pragma unroll
        for (int i = 0; i < 4; ++i) nwv[i] = *(const f32x4*)(nw + 4 * (lane + 64 * i));
        f32x4 vn[4]; int row = blockIdx.x * 8 + wid;
        if (row < T_) {
#pragma unroll
            for (int i = 0; i < 4; ++i) vn[i] = *(const f32x4*)(x + (size_t)row * D_ + 4 * (lane + 64 * i)); }
        for (; row < T_; row += gridDim.x * 8) {
            f32x4 v[4]; float s = 0.f;
#pragma unroll
            for (int i = 0; i < 4; ++i) { v[i] = vn[i]; s += (v[i][0] * v[i][0] + v[i][1] * v[i][1]) + (v[i][2] * v[i][2] + v[i][3] * v[i][3]); }
            { const int nrow = row + gridDim.x * 8;
              if (nrow < T_) {
#pragma unroll
                for (int i = 0; i < 4; ++i) vn[i] = *(const f32x4*)(x + (size_t)nrow * D_ + 4 * (lane + 64 * i)); } }
            s = red8(s); s += dpp_f<0x140>(s); s += __shfl_xor(s, 16); s += __shfl_xor(s, 32);
            const float rs = rsqrtf(s * (1.0f / 1024.0f) + EPS_);
            float lg[8];
#pragma unroll
            for (int j = 0; j < 8; ++j) lg[j] = 0.f;
#pragma unroll
            for (int i = 0; i < 4; ++i) {
                const int k0 = 4 * (lane + 64 * i);
#pragma unroll
                for (int e = 0; e < 4; ++e) { const f32x4 wa = *(const f32x4*)(w8s + (k0 + e) * 8), wb = *(const f32x4*)(w8s + (k0 + e) * 8 + 4); const float xv = v[i][e];
                    lg[0] += xv * wa[0]; lg[1] += xv * wa[1]; lg[2] += xv * wa[2]; lg[3] += xv * wa[3]; lg[4] += xv * wb[0]; lg[5] += xv * wb[1]; lg[6] += xv * wb[2]; lg[7] += xv * wb[3]; }
                const f32x4 h = v[i] * rs * nwv[i]; u32x2 w; w.x = cvt_pk_bf16(h[0], h[1]); w.y = cvt_pk_bf16(h[2], h[3]);
                *(u32x2*)(hb + (size_t)row * D_ + k0) = w;
            }
            const bool b5 = (lane & 32) != 0, b4 = (lane & 16) != 0, b3 = (lane & 8) != 0;
            float k4[4], k2[2];
#pragma unroll
            for (int j = 0; j < 4; ++j) { const float send = b5 ? lg[j] : lg[j + 4]; const float keep = b5 ? lg[j + 4] : lg[j]; k4[j] = keep + __shfl_xor(send, 32); }
#pragma unroll
            for (int j = 0; j < 2; ++j) { const float send = b4 ? k4[j] : k4[j + 2]; const float keep = b4 ? k4[j + 2] : k4[j]; k2[j] = keep + __shfl_xor(send, 16); }
            float k1; { const float send = b3 ? k2[0] : k2[1]; const float keep = b3 ? k2[1] : k2[0]; k1 = keep + __shfl_xor(send, 8); }
            k1 = red8(k1);
            if ((lane & 7) == 0) logits[(size_t)row * 8 + ((lane >> 5) & 1) * 4 + ((lane >> 4) & 1) * 2 + ((lane >> 3) & 1)] = k1 * rs;
        }
    }
    {
        const f32x4* src = (const f32x4*)p.in[1]; u32x2* dst = (u32x2*)(ws + WS_PB); const size_t n4 = (size_t)T_ * PLE_ / 4;
        for (size_t i = (size_t)blockIdx.x * NTHREADS + tid; i < n4; i += (size_t)gridDim.x * NTHREADS) { const f32x4 v = src[i]; u32x2 w; w.x = cvt_pk_bf16(v[0], v[1]); w.y = cvt_pk_bf16(v[2], v[3]); dst[i] = w; }
    }
}
__device__ __forceinline__ bf16x8 pack8(const f32x4 a, const f32x4 b) { u32x4 w; w.x = cvt_pk_bf16(a[0], a[1]); w.y = cvt_pk_bf16(a[2], a[3]); w.z = cvt_pk_bf16(b[0], b[1]); w.w = cvt_pk_bf16(b[2], b[3]); return __builtin_bit_cast(bf16x8, w); }
#define MFMA16(a, b, c) __builtin_amdgcn_mfma_f32_16x16x32_bf16((a), (b), (c), 0, 0, 0)
__device__ __forceinline__ float neg_expm1_small(float x, float ehalf) {
    const float ps = -x * (1.0f + x * (0.5f + x * (0.16666667f + x * (0.041666668f + x * (0.008333334f + x * 0.0013888889f)))));
    return (x > -0.25f) ? ps : (1.0f - ehalf * ehalf);
}
template <bool FINAL>
__device__ __forceinline__ void rg_pass_mfma(const Params& p, unsigned char* smem, int widx, int nworkers) {
    const int tid = threadIdx.x, wid = __builtin_amdgcn_readfirstlane(tid >> 6), lane = tid & 63, n16o = lane & 15, fqo = lane >> 4, c = wid * 64 + lane;
    unsigned char* ws = p.ws;
    const bf16_t* proj = (const bf16_t*)(ws + WS_PROJ);
    float* U = (float*)smem + wid * 4352;
    float* ptot = (float*)(ws + WS_PTOT); float* hend = (float*)(ws + WS_HEND); const float* carry = (const float*)(ws + WS_CARRY);
    bf16_t* y = (bf16_t*)(ws + WS_Y);
    bf16x8 Bx[4][2], Ba[4][2];
#pragma unroll
    for (int nt = 0; nt < 4; ++nt)
#pragma unroll
        for (int ks = 0; ks < 2; ++ks) { const unsigned char* fb = ws + WS_RGW + ((size_t)(wid * 16 + nt * 2 + ks) * 64 + lane) * 16;
            Bx[nt][ks] = *(const bf16x8*)fb; Ba[nt][ks] = *(const bf16x8*)(fb + 8 * 64 * 16); }
    const float cw0 = p.in[4][c], cw1 = p.in[4][512 + c], cw2 = p.in[4][1024 + c], cw3 = p.in[4][1536 + c], cb = p.in[5][c];
    float bxv[4], bav[4], spv[4];
#pragma unroll
    for (int nt = 0; nt < 4; ++nt) { const int cgl = wid * 64 + 16 * nt + n16o; bxv[nt] = p.in[7][cgl]; bav[nt] = p.in[9][cgl]; spv[nt] = softplusf_(-p.in[10][cgl]); }
    for (int unit = widx; unit < NB_ * NCH_; unit += nworkers) {
        const int n = unit & (NCH_ - 1); const size_t t0 = (size_t)unit * 64;
        float xm3 = 0.f, xm2 = 0.f, xm1 = 0.f;
        if (n != 0) { xm3 = bf2f(proj[(t0 - 3) * PJ_ + c]); xm2 = bf2f(proj[(t0 - 2) * PJ_ + c]); xm1 = bf2f(proj[(t0 - 1) * PJ_ + c]); }
        __syncthreads();
        { bf16_t xr[16]; const bf16_t* xp0 = proj + t0 * PJ_ + c;
#pragma unroll
          for (int i = 0; i < 16; ++i) xr[i] = xp0[(size_t)i * PJ_];
#pragma unroll
          for (int tb = 0; tb < 4; ++tb) { bf16_t xn[16]; const bf16_t* xp = proj + (t0 + (tb + 1) * 16) * PJ_ + c;
            if (tb < 3) {
#pragma unroll
                for (int i = 0; i < 16; ++i) xn[i] = xp[(size_t)i * PJ_]; }
#pragma unroll
            for (int i = 0; i < 16; ++i) { const float xv = bf2f(xr[i]); U[(16 * ((i >> 2) & 3) + 4 * tb + (i & 3)) * 68 + lane] = cw0 * xm3 + cw1 * xm2 + cw2 * xm1 + cw3 * xv + cb; xm3 = xm2; xm2 = xm1; xm1 = xv; }
            if (tb < 3) {
#pragma unroll
                for (int i = 0; i < 16; ++i) xr[i] = xn[i]; } } }
        __syncthreads();
        const bf16_t* gub = proj + t0 * PJ_ + 512; bf16_t* yub = y + t0 * D_;
#pragma unroll
        for (int nt = 0; nt < 4; ++nt) {
            asm volatile("" ::: "memory");
            int lane_o = lane; asm volatile("" : "+v"(lane_o));
            const int n16 = lane_o & 15, fq = lane_o >> 4;
            const int chl = 16 * nt + n16, cgl = wid * 64 + chl;
            bf16x8 Af[4][2];
#pragma unroll
            for (int mt = 0; mt < 4; ++mt)
#pragma unroll
                for (int ks = 0; ks < 2; ++ks) { const float* up = U + (16 * mt + n16) * 68 + 32 * ks + 8 * fq; Af[mt][ks] = pack8(*(const f32x4*)up, *(const f32x4*)(up + 4)); }

            bf16_t gr[16];
            if (FINAL) {
#pragma unroll
                for (int i = 0; i < 16; ++i) gr[i] = gub[(16 * fq + i) * PJ_ + cgl]; }
            f32x4 ax[4], aa[4];
#pragma unroll
            for (int mt = 0; mt < 4; ++mt) { ax[mt] = (f32x4){bxv[nt], bxv[nt], bxv[nt], bxv[nt]}; aa[mt] = (f32x4){bav[nt], bav[nt], bav[nt], bav[nt]}; }
#pragma unroll
            for (int mt = 0; mt < 4; ++mt)
#pragma unroll
                for (int ks = 0; ks < 2; ++ks) { ax[mt] = MFMA16(Af[mt][ks], Bx[nt][ks], ax[mt]); aa[mt] = MFMA16(Af[mt][ks], Ba[nt][ks], aa[mt]); }
            float av[16], bv[16]; float hl = 0.f, Pl = 1.f;
#pragma unroll
            for (int i = 0; i < 16; ++i) { const int mt = i >> 2, j = i & 3, tok = 16 * fq + i; const float u = U[(16 * mt + 4 * fq + j) * 68 + chl];
                const float gx = sigmoidf_(ax[mt][j]), gg = sigmoidf_(aa[mt][j]); const float la = -8.0f * gg * spv[nt]; const float a = __expf(la);
                float mult = sqrtf(fmaxf(neg_expm1_small(2.0f * la, a), 0.f)); if (n == 0 && tok == 0) mult = 1.0f;
                av[i] = a; bv[i] = u * gx * mult; hl = a * hl + bv[i]; Pl *= a; }
            float Pg[4], Hg[4];
#pragma unroll
            for (int g = 0; g < 4; ++g) { Pg[g] = __shfl(Pl, n16 + 16 * g); Hg[g] = __shfl(hl, n16 + 16 * g); }
            if (FINAL) {
                float h = carry[(size_t)unit * 512 + cgl];
#pragma unroll
                for (int g = 0; g < 3; ++g) if (g < fq) h = Pg[g] * h + Hg[g];
#pragma unroll
                for (int i = 0; i < 16; ++i) { h = av[i] * h + bv[i]; yub[(16 * fq + i) * D_ + cgl] = f2bf(h * gelu_tanhf_(bf2f(gr[i]))); }
            } else {
                float cc = 0.f, Pp = 1.f;
#pragma unroll
                for (int g = 0; g < 4; ++g) { cc = Pg[g] * cc + Hg[g]; Pp *= Pg[g]; }
                if (fq == 0) { ptot[(size_t)unit * 512 + cgl] = Pp; hend[(size_t)unit * 512 + cgl] = cc; }
            }
        }
    }
}

__device__ __forceinline__ void rg_carry(const Params& p, int idx) {
    unsigned char* ws = p.ws; const float* ptot = (const float*)(ws + WS_PTOT); const float* hend = (const float*)(ws + WS_HEND); float* carry = (float*)(ws + WS_CARRY);
    const int b = idx >> 9, c = idx & 511; float hc = 0.f;
    for (int n0 = 0; n0 < NCH_; n0 += 8) { float P[8], H[8];
#pragma unroll
        for (int i = 0; i < 8; ++i) { const size_t o = (size_t)(b * NCH_ + n0 + i) * 512 + c; P[i] = ptot[o]; H[i] = hend[o]; }
#pragma unroll
        for (int i = 0; i < 8; ++i) { const size_t o = (size_t)(b * NCH_ + n0 + i) * 512 + c; carry[o] = hc; hc = P[i] * hc + H[i]; } }
}

constexpr int GU_BYTES = 73728, GU_KDT = 32768, GU_QK = 49152, GU_U = 57344;
typedef float f32x2_ __attribute__((ext_vector_type(2)));
__device__ __forceinline__ int tok_of_pos(int p) { return 16 * (2 * (p >> 5) + ((p >> 2) & 1)) + 4 * ((p >> 3) & 3) + (p & 3); }
__device__ __forceinline__ void unpack8(const u32x4 w, float* f) { f[0] = __uint_as_float(w.x << 16); f[1] = __uint_as_float(w.x & 0xffff0000u); f[2] = __uint_as_float(w.y << 16); f[3] = __uint_as_float(w.y & 0xffff0000u);
    f[4] = __uint_as_float(w.z << 16); f[5] = __uint_as_float(w.z & 0xffff0000u); f[6] = __uint_as_float(w.w << 16); f[7] = __uint_as_float(w.w & 0xffff0000u); }

__device__ __forceinline__ void gdn_pass_a(const Params& p, unsigned char* smem) {
    const int tid = threadIdx.x, wid = __builtin_amdgcn_readfirstlane(tid >> 6);
    unsigned char* ws = p.ws; const bf16_t* proj = (const bf16_t*)(ws + WS_PROJ); const float* logits = (const float*)(ws + WS_LOGITS); float* gtot = (float*)(ws + WS_GTOT);
    bf16_t* Kb = (bf16_t*)smem; bf16_t* Qb = (bf16_t*)(smem + 17408); bf16_t* VBt = (bf16_t*)(smem + 34816); bf16_t* KBGt = (bf16_t*)(smem + 53248);
    float* Lsw = (float*)(smem + 71680); bf16_t* Tb = (bf16_t*)(smem + 89088); float* gcs = (float*)(smem + 98304); float* betas = gcs + 64; float* kdec = gcs + 128;
    const int lane0 = tid & 63, tg0 = tid >> 5, ch0 = (tid & 31) * 4;
    for (int ub = blockIdx.x * 8; ub < 2048; ub += gridDim.x * 8) {
        const int bh = ub >> 7, b = bh >> 2, h = bh & 3;
        const float Aexp = __expf(p.in[12][h]), dtb = p.in[13][h];
        float cw[3][4][4];
#pragma unroll
        for (int a = 0; a < 3; ++a)
#pragma unroll
            for (int j = 0; j < 4; ++j) { const f32x4 w = *(const f32x4*)(p.in[11] + (size_t)j * 1536 + a * 512 + h * 128 + ch0); cw[a][j][0] = w[0]; cw[a][j][1] = w[1]; cw[a][j][2] = w[2]; cw[a][j][3] = w[3]; }
        u32x2 pre[3][7]; float lgb, lga;
#define GA_PREFETCH(unit_) do { const int n_ = (unit_) & 127; const size_t t0_ = (size_t)b * SEQ_ + (size_t)n_ * 64; \
        lgb = logits[(t0_ + lane0) * 8 + h]; lga = logits[(t0_ + lane0) * 8 + 4 + h]; \
        _Pragma("unroll") for (int r = 0; r < 7; ++r) { const int sp_ = n_ * 64 + 4 * tg0 - 3 + r; \
            _Pragma("unroll") for (int a = 0; a < 3; ++a) pre[a][r] = (sp_ >= 0) ? *(const u32x2*)(proj + ((size_t)b * SEQ_ + sp_) * PJ_ + 1024 + a * 512 + h * 128 + ch0) : (u32x2){0u, 0u}; } } while (0)
        GA_PREFETCH(ub);
        for (int k = 0; k < 8; ++k) {
            const int unit = ub + k, n = unit & 127;
            int tid_o = tid; asm volatile("" : "+v"(tid_o));
            const int lane = tid_o & 63, r16 = lane & 15, kq = lane >> 4, cg4 = tid_o & 31, tg = tid_o >> 5, ch = cg4 * 4;
            unsigned char* gbase = ws + WS_R4 + (size_t)unit * GU_BYTES;
            const float betav = sigmoidf_(lgb);
            float gc = -Aexp * softplusf_(lga + dtb);
#pragma unroll
            for (int o = 1; o < 64; o <<= 1) { const float tmp = __shfl_up(gc, o); if (lane >= o) gc += tmp; }
            const float gclast = __shfl(gc, 63);
            if (wid == 0) { gcs[lane] = gc; betas[lane] = betav; kdec[lane] = __expf(gclast - gc); }
            {
                float x[7][4], o[4][4], bt[4], egt[4];
#pragma unroll
                for (int t = 0; t < 4; ++t) { bt[t] = __shfl(betav, 4 * tg + t); egt[t] = __expf(__shfl(gc, 4 * tg + t)); }
#pragma unroll
                for (int a = 0; a < 3; ++a) {
#pragma unroll
                    for (int r = 0; r < 7; ++r) { x[r][0] = __uint_as_float(pre[a][r].x << 16); x[r][1] = __uint_as_float(pre[a][r].x & 0xffff0000u); x[r][2] = __uint_as_float(pre[a][r].y << 16); x[r][3] = __uint_as_float(pre[a][r].y & 0xffff0000u); }
#pragma unroll
                    for (int t = 0; t < 4; ++t)
#pragma unroll
                        for (int e = 0; e < 4; ++e) { float acc = cw[a][0][e] * x[t][e]; acc += cw[a][1][e] * x[t + 1][e]; acc += cw[a][2][e] * x[t + 2][e]; acc += cw[a][3][e] * x[t + 3][e]; o[t][e] = siluf_(acc); }
                    if (a < 2) {
#pragma unroll
                        for (int t = 0; t < 4; ++t) { float ssq = (o[t][0] * o[t][0] + o[t][1] * o[t][1]) + (o[t][2] * o[t][2] + o[t][3] * o[t][3]);
                            ssq += dpp_f<0xB1>(ssq); ssq += dpp_f<0x4E>(ssq); ssq += dpp_f<0x141>(ssq); ssq += dpp_f<0x140>(ssq); ssq += __shfl_xor(ssq, 16);
                            const float rs = rsqrtf(ssq + EPS_) * (a == 0 ? 0.08838834764831845f : 1.0f);
#pragma unroll
                            for (int e = 0; e < 4; ++e) o[t][e] *= rs; }
                    }
                    if (a == 0) {
#pragma unroll
                        for (int t = 0; t < 4; ++t) { const int tok = 4 * tg + t; u32x2 w; w.x = cvt_pk_bf16(o[t][0], o[t][1]); w.y = cvt_pk_bf16(o[t][2], o[t][3]); *(u32x2*)(Qb + tok * 136 + ch) = w;
                            u32x2 wd; wd.x = cvt_pk_bf16(o[t][0] * egt[t], o[t][1] * egt[t]); wd.y = cvt_pk_bf16(o[t][2] * egt[t], o[t][3] * egt[t]);
                            *(u32x2*)((bf16_t*)gbase + (size_t)(64 + tok) * 128 + 32 * (cg4 >> 3) + 8 * (cg4 & 3) + 4 * ((cg4 >> 2) & 1)) = wd; }
                    } else if (a == 1) {
#pragma unroll
                        for (int t = 0; t < 4; ++t) { const int tok = 4 * tg + t; u32x2 w; w.x = cvt_pk_bf16(o[t][0], o[t][1]); w.y = cvt_pk_bf16(o[t][2], o[t][3]); *(u32x2*)(Kb + tok * 136 + ch) = w; }
#pragma unroll
                        for (int e = 0; e < 4; ++e) { u32x2 w; w.x = cvt_pk_bf16(o[0][e] * bt[0] * egt[0], o[1][e] * bt[1] * egt[1]); w.y = cvt_pk_bf16(o[2][e] * bt[2] * egt[2], o[3][e] * bt[3] * egt[3]); *(u32x2*)(KBGt + (ch + e) * 72 + (((tg >> 1) ^ (cg4 & 7)) << 3) + 4 * (tg & 1)) = w; }
                    } else {
#pragma unroll
                        for (int e = 0; e < 4; ++e) { u32x2 w; w.x = cvt_pk_bf16(o[0][e] * bt[0], o[1][e] * bt[1]); w.y = cvt_pk_bf16(o[2][e] * bt[2], o[3][e] * bt[3]); *(u32x2*)(VBt + (ch + e) * 72 + (((tg >> 1) ^ (cg4 & 7)) << 3) + 4 * (tg & 1)) = w; }
                    }
                }
            }
            if (k + 1 < 8) GA_PREFETCH(unit + 1);
            __syncthreads();
#pragma unroll
            for (int rep = 0; rep < 2; ++rep) {
                const int tl = wid + 8 * rep, jt = tl >> 2, it = tl & 3;
                f32x4 accQ = {0.f, 0.f, 0.f, 0.f}, accK = {0.f, 0.f, 0.f, 0.f};
#pragma unroll
                for (int ks = 0; ks < 4; ++ks) { const bf16x8 a = *(const bf16x8*)(Kb + (16 * jt + r16) * 136 + 32 * ks + 8 * kq);
                    const bf16x8 bq = *(const bf16x8*)(Qb + (16 * it + r16) * 136 + 32 * ks + 8 * kq), bk = *(const bf16x8*)(Kb + (16 * it + r16) * 136 + 32 * ks + 8 * kq);
                    accQ = MFMA16(a, bq, accQ); accK = MFMA16(a, bk, accK); }
                const int i = 16 * it + r16; const float gi = gcs[i], bi = betas[i]; float qv[4];
#pragma unroll
                for (int jj = 0; jj < 4; ++jj) { const int j = 16 * jt + 4 * kq + jj; const float d = __expf(fminf(gi - gcs[j], 0.f));
                    qv[jj] = (i >= j) ? accQ[jj] * d : 0.f; Lsw[i * 68 + (j & 7) * 8 + (j >> 3)] = (i > j) ? bi * accK[jj] * d : 0.f; }
                u32x2 w; w.x = cvt_pk_bf16(qv[0], qv[1]); w.y = cvt_pk_bf16(qv[2], qv[3]);
                *(u32x2*)((bf16_t*)(gbase + GU_QK) + i * 64 + 32 * (jt >> 1) + 8 * kq + 4 * (jt & 1)) = w;
            }
            __syncthreads();
            {
                const int s = lane & 7, c = 8 * wid + (lane >> 3); float t[8];
#pragma unroll
                for (int m = 0; m < 8; ++m) t[m] = 0.f;
                f32x4 la[2][2]; la[0][0] = *(const f32x4*)(Lsw + s * 8); la[0][1] = *(const f32x4*)(Lsw + s * 8 + 4);
#pragma unroll
                for (int i = 0; i < 64; ++i) {
                    if (i + 1 < 64) { la[(i + 1) & 1][0] = *(const f32x4*)(Lsw + (i + 1) * 68 + s * 8); la[(i + 1) & 1][1] = *(const f32x4*)(Lsw + (i + 1) * 68 + s * 8 + 4); }
                    asm volatile("" ::: "memory");
                    const f32x4 l0 = la[i & 1][0], l1 = la[i & 1][1];
                    float part = 0.f;
#pragma unroll
                    for (int m = 0; m < 8; ++m) if (8 * m <= i) part += ((m < 4) ? l0[m & 3] : l1[m & 3]) * t[m];
                    part = red8(part);
                    const float val = ((i == c) ? 1.0f : 0.0f) - part;
                    if (s == (i & 7)) t[i >> 3] = val;
                }
#pragma unroll
                for (int m = 0; m < 8; ++m) Tb[(8 * m + s) * 72 + c] = f2bf(t[m]);
            }
            __syncthreads();
            {
#pragma unroll
                for (int mt = 0; mt < 4; ++mt) { f32x4 acc = {0.f, 0.f, 0.f, 0.f};
#pragma unroll
                    for (int ks = 0; ks < 2; ++ks) { const bf16x8 a = *(const bf16x8*)(Tb + (16 * mt + r16) * 72 + 32 * ks + 8 * kq), bb = *(const bf16x8*)(VBt + (16 * wid + r16) * 72 + (((4 * ks + kq) ^ ((4 * wid + (r16 >> 2)) & 7)) << 3)); acc = MFMA16(a, bb, acc); }
                    u32x2 w; w.x = cvt_pk_bf16(acc[0], acc[1]); w.y = cvt_pk_bf16(acc[2], acc[3]);
                    *(u32x2*)((bf16_t*)(gbase + GU_U) + ((wid * 4 + mt) * 64 + lane) * 4) = w; }
#pragma unroll
                for (int it = 0; it < 4; ++it) { f32x4 acc = {0.f, 0.f, 0.f, 0.f};
#pragma unroll
                    for (int ks = 0; ks < 2; ++ks) { const bf16x8 a = *(const bf16x8*)(KBGt + (16 * wid + r16) * 72 + (((4 * ks + kq) ^ ((4 * wid + (r16 >> 2)) & 7)) << 3)), bb = *(const bf16x8*)(Tb + (16 * it + r16) * 72 + 32 * ks + 8 * kq); acc = MFMA16(a, bb, acc); }
                    u32x2 w; w.x = cvt_pk_bf16(acc[0], acc[1]); w.y = cvt_pk_bf16(acc[2], acc[3]);
                    *(u32x2*)((bf16_t*)gbase + (16 * it + r16) * 128 + 32 * (wid >> 1) + 8 * kq + 4 * (wid & 1)) = w; }
                const int dk = tid_o >> 2, pg = tid_o & 3; float v[16];
#pragma unroll
                for (int e = 0; e < 16; ++e) { const int tk = tok_of_pos(16 * pg + e); v[e] = bf2f(Kb[tk * 136 + dk]) * kdec[tk]; }
                u32x4 w0, w1; w0.x = cvt_pk_bf16(v[0], v[1]); w0.y = cvt_pk_bf16(v[2], v[3]); w0.z = cvt_pk_bf16(v[4], v[5]); w0.w = cvt_pk_bf16(v[6], v[7]);
                w1.x = cvt_pk_bf16(v[8], v[9]); w1.y = cvt_pk_bf16(v[10], v[11]); w1.z = cvt_pk_bf16(v[12], v[13]); w1.w = cvt_pk_bf16(v[14], v[15]);
                *(u32x4*)((bf16_t*)(gbase + GU_KDT) + dk * 64 + 16 * pg) = w0; *(u32x4*)((bf16_t*)(gbase + GU_KDT) + dk * 64 + 16 * pg + 8) = w1;
                if (tid == 0) gtot[unit] = __expf(gclast);
            }
            __syncthreads();
        }
    }
#undef GA_PREFETCH
}

constexpr int GB_BUF = 62464, GB_KDT = 34816, GB_QK = 53248, GB_BUF2 = GB_BUF + 4096 + 16;
__device__ __forceinline__ void gdn_pass_b(const Params& p, unsigned char* smem, int wg) {
    const int tid = threadIdx.x, wid = __builtin_amdgcn_readfirstlane(tid >> 6), lane = tid & 63, r16 = lane & 15, kq = lane >> 4;
    const int bh = wg >> 2, cgp = wg & 3, b = bh >> 2, h = bh & 3, nt = cgp * 2 + wid;
    unsigned char* ws = p.ws; const unsigned char* ubase = ws + WS_R4 + (size_t)(bh * 128) * GU_BYTES; const float* gtot = (const float*)(ws + WS_GTOT) + bh * 128;
    bf16_t* oraw = (bf16_t*)(ws + WS_ORAW);
#define GB_BAR() do { asm volatile("s_waitcnt lgkmcnt(0)" ::: "memory"); __builtin_amdgcn_s_barrier(); asm volatile("" ::: "memory"); } while (0)
    if (wid >= 2) {
        const int lt = tid - 128;
        int dsto[10]; size_t srco[10];
#pragma unroll
        for (int it = 0; it < 10; ++it) { const int q = lt + 384 * it;
            dsto[it] = (q < 2048) ? (q >> 4) * 272 + (q & 15) * 16 : (q < 3072) ? GB_KDT + ((q - 2048) >> 3) * 144 + ((q - 2048) & 7) * 16 : (q < 3584) ? GB_QK + ((q - 3072) >> 3) * 144 + ((q - 3072) & 7) * 16 : GB_BUF + (q - 3584) * 16;
            srco[it] = (q < 3584) ? (size_t)q * 16 : (size_t)(GU_U + cgp * 4096 + (q - 3584) * 16); }
        u32x4 sa[10], sb[10], sc[10]; float ga = 0.f, gb = 0.f, gc = 0.f;
#define GB_LD(st, g, n_) do { const unsigned char* rp_ = ubase + (size_t)(n_) * GU_BYTES; _Pragma("unroll") for (int it = 0; it < 10; ++it) st[it] = *(const u32x4*)(rp_ + srco[it]); if (lt == 0) g = gtot[n_]; } while (0)
#define GB_WR(st, g, bufi) do { unsigned char* bp_ = smem + (bufi) * GB_BUF2; _Pragma("unroll") for (int it = 0; it < 10; ++it) *(u32x4*)(bp_ + dsto[it]) = st[it]; if (lt == 0) *(float*)(bp_ + GB_BUF + 4096) = g; } while (0)
        GB_LD(sa, ga, 0); GB_WR(sa, ga, 0); GB_BAR();
        GB_LD(sa, ga, 1); GB_LD(sb, gb, 2); GB_LD(sc, gc, 3);
        for (int n0 = 0; n0 < NCH_; n0 += 3) {
            { const int n = n0;     if (n < NCH_) { if (n + 1 < NCH_) GB_WR(sa, ga, (n + 1) & 1); if (n + 4 < NCH_) GB_LD(sa, ga, n + 4); GB_BAR(); } }
            { const int n = n0 + 1; if (n < NCH_) { if (n + 1 < NCH_) GB_WR(sb, gb, (n + 1) & 1); if (n + 4 < NCH_) GB_LD(sb, gb, n + 4); GB_BAR(); } }
            { const int n = n0 + 2; if (n < NCH_) { if (n + 1 < NCH_) GB_WR(sc, gc, (n + 1) & 1); if (n + 4 < NCH_) GB_LD(sc, gc, n + 4); GB_BAR(); } }
        }
#undef GB_LD
#undef GB_WR
    } else {
        f32x4 S[8]; bf16x8 Sb[4];
#pragma unroll
        for (int d = 0; d < 8; ++d) S[d] = (f32x4){0.f, 0.f, 0.f, 0.f};
#pragma unroll
        for (int k = 0; k < 4; ++k) Sb[k] = (bf16x8){0, 0, 0, 0, 0, 0, 0, 0};
        GB_BAR();
        for (int n = 0; n < NCH_; ++n) {
            const unsigned char* L = smem + (n & 1) * GB_BUF2; const float gt = *(const float*)(L + GB_BUF + 4096); const size_t t0 = (size_t)b * SEQ_ + (size_t)n * 64;
            u32x2 uw[4];
#pragma unroll
            for (int tt = 0; tt < 4; ++tt) uw[tt] = *(const u32x2*)(L + GB_BUF + ((wid * 4 + tt) * 64 + lane) * 8);
            f32x4 P[8];
#pragma unroll
            for (int m = 0; m < 8; ++m) P[m] = (f32x4){0.f, 0.f, 0.f, 0.f};
#pragma unroll
            for (int ks = 0; ks < 4; ++ks)
#pragma unroll
                for (int mt = 0; mt < 8; ++mt) { const bf16x8 a = *(const bf16x8*)(L + (16 * mt + r16) * 272 + (32 * ks + 8 * kq) * 2); P[mt] = MFMA16(a, Sb[ks], P[mt]); }
            f32x4 vn[4];
#pragma unroll
            for (int tt = 0; tt < 4; ++tt) { const f32x4 u = {__uint_as_float(uw[tt].x << 16), __uint_as_float(uw[tt].x & 0xffff0000u), __uint_as_float(uw[tt].y << 16), __uint_as_float(uw[tt].y & 0xffff0000u)}; vn[tt] = u - P[tt]; }
            bf16x8 Vb[2]; Vb[0] = pack8(vn[0], vn[1]); Vb[1] = pack8(vn[2], vn[3]);
#pragma unroll
            for (int tt = 0; tt < 4; ++tt) { f32x4 O = P[4 + tt];
#pragma unroll
                for (int ks = 0; ks < 2; ++ks) { const bf16x8 a = *(const bf16x8*)(L + GB_QK + (16 * tt + r16) * 144 + (32 * ks + 8 * kq) * 2); O = MFMA16(a, Vb[ks], O); }
                bf16_t* op = oraw + (t0 + 16 * tt + 4 * kq) * 512 + h * 128 + 16 * nt + r16;
#pragma unroll
                for (int j = 0; j < 4; ++j) op[(size_t)j * 512] = f2bf(O[j]); }
#pragma unroll
            for (int dt = 0; dt < 8; ++dt) { f32x4 acc = S[dt] * gt;
#pragma unroll
                for (int ks = 0; ks < 2; ++ks) { const bf16x8 a = *(const bf16x8*)(L + GB_KDT + (16 * dt + r16) * 144 + (32 * ks + 8 * kq) * 2); acc = MFMA16(a, Vb[ks], acc); }
                S[dt] = acc; }
#pragma unroll
            for (int ks = 0; ks < 4; ++ks) Sb[ks] = pack8(S[2 * ks], S[2 * ks + 1]);
            GB_BAR();
        }
    }
#undef GB_BAR
}

__device__ __forceinline__ void gdn_norm(const Params& p) {
    unsigned char* ws = p.ws; const bf16_t* oraw = (const bf16_t*)(ws + WS_ORAW); const bf16_t* proj = (const bf16_t*)(ws + WS_PROJ); bf16_t* y = (bf16_t*)(ws + WS_Y);
    int tid_o = threadIdx.x; asm volatile("" : "+v"(tid_o));
    const int gtid = blockIdx.x * NTHREADS + tid_o, sub = gtid & 31; const f32x4 nwv = *(const f32x4*)(p.in[14] + sub * 4);
    const int stride = (gridDim.x * NTHREADS) >> 5;
    for (int item0 = gtid >> 5; item0 < T_ * 4; item0 += 4 * stride) {
        u32x2 ow[4], zw[4];
#pragma unroll
        for (int q = 0; q < 4; ++q) { const int item = item0 + q * stride; const int t = item >> 2, h = item & 3;
            if (item < T_ * 4) { ow[q] = *(const u32x2*)(oraw + (size_t)t * 512 + h * 128 + sub * 4); zw[q] = *(const u32x2*)(proj + (size_t)t * PJ_ + 2560 + h * 128 + sub * 4); } else { ow[q] = (u32x2){0u, 0u}; zw[q] = (u32x2){0u, 0u}; } }
#pragma unroll
        for (int q = 0; q < 4; ++q) { const int item = item0 + q * stride; const int t = item >> 2, h = item & 3;
            const f32x4 ov = {__uint_as_float(ow[q].x << 16), __uint_as_float(ow[q].x & 0xffff0000u), __uint_as_float(ow[q].y << 16), __uint_as_float(ow[q].y & 0xffff0000u)};
            float s = (ov[0] * ov[0] + ov[1] * ov[1]) + (ov[2] * ov[2] + ov[3] * ov[3]);
#pragma unroll
            for (int o = 1; o < 32; o <<= 1) s += __shfl_xor(s, o);
            const float rs = rsqrtf(s * (1.0f / 128.0f) + EPS_);
            const float z0 = __uint_as_float(zw[q].x << 16), z1 = __uint_as_float(zw[q].x & 0xffff0000u), z2 = __uint_as_float(zw[q].y << 16), z3 = __uint_as_float(zw[q].y & 0xffff0000u);
            u32x2 w; w.x = cvt_pk_bf16(ov[0] * rs * nwv[0] * siluf_(z0), ov[1] * rs * nwv[1] * siluf_(z1)); w.y = cvt_pk_bf16(ov[2] * rs * nwv[2] * siluf_(z2), ov[3] * rs * nwv[3] * siluf_(z3));
            if (item < T_ * 4) *(u32x2*)(y + (size_t)t * D_ + 512 + h * 128 + sub * 4) = w; }
    }
}

__device__ __forceinline__ void phase_final(const Params& p) {
    const int tid = threadIdx.x, wid = __builtin_amdgcn_readfirstlane(tid >> 6), lane = tid & 63;
    const float* ss = (const float*)(p.ws + WS_SSA); const float* nw = p.in[24]; float* out = p.out; const bf16_t* x3b = (const bf16_t*)(p.ws + WS_XB);
    f32x4 nwv[4];
#pragma unroll
    for (int i = 0; i < 4; ++i) nwv[i] = *(const f32x4*)(nw + 4 * (lane + 64 * i));
    u32x2 wn[4]; int row = blockIdx.x * 8 + wid;
    if (row < T_) {
#pragma unroll
        for (int i = 0; i < 4; ++i) wn[i] = *(const u32x2*)(x3b + (size_t)row * D_ + 4 * (lane + 64 * i)); }
    for (; row < T_; row += gridDim.x * 8) {
        const float rs = rstd16(ss, row);
        u32x2 wc[4];
#pragma unroll
        for (int i = 0; i < 4; ++i) wc[i] = wn[i];
        { const int nrow = row + gridDim.x * 8;
          if (nrow < T_) {
#pragma unroll
            for (int i = 0; i < 4; ++i) wn[i] = *(const u32x2*)(x3b + (size_t)nrow * D_ + 4 * (lane + 64 * i)); } }
#pragma unroll
        for (int i = 0; i < 4; ++i) { const u32x2 w = wc[i]; const f32x4 v = {__uint_as_float(w.x << 16), __uint_as_float(w.x & 0xffff0000u), __uint_as_float(w.y << 16), __uint_as_float(w.y & 0xffff0000u)};
            *(f32x4*)(out + (size_t)row * D_ + 4 * (lane + 64 * i)) = v * rs * nwv[i]; }
    }
}

constexpr int NPHASES = 11;
__global__ void __launch_bounds__(NTHREADS, 2) mega_fwd(Params p) {
    extern __shared__ __attribute__((aligned(16))) unsigned char smem[];
    PG8_LAS unsigned char* lds = (PG8_LAS unsigned char*)smem;
    cg::grid_group grid = cg::this_grid();
    unsigned char* ws = p.ws;
    bf16_t* hb = (bf16_t*)(ws + WS_XB); bf16_t* xb = (bf16_t*)(ws + WS_XB2); bf16_t* proj = (bf16_t*)(ws + WS_PROJ); bf16_t* ff = proj; bf16_t* y = (bf16_t*)(ws + WS_Y); bf16_t* pp = (bf16_t*)p.out;
    float* ssA = (float*)(ws + WS_SSA); float* ssB = (float*)(ws + WS_SSB);
#ifdef ONLY_PHASE
#define PH_ON(n) ((n) == ONLY_PHASE)
#else
#define PH_ON(n) ((n) >= p.ph_lo && (n) < p.ph_hi)
#endif
    volatile LAS unsigned* xst = (volatile LAS unsigned*)(lds + LDS_BYTES - 16);
    if (threadIdx.x == 0) { xst[0] = 0u; xst[1] = 0u; xst[2] = 0u; xst[3] = 0u; }
    __syncthreads();
    const XcdBarrier xbar = xcd_barrier_post((unsigned*)(ws + WS_BAR), xst);
    if (p.ph_lo == 0x7fffffff) grid.sync();
#define PH_SYNC(n) do { if ((n) > p.ph_lo && (n) < p.ph_hi) { xcd_barrier(xbar); } } while (0)
    if (PH_ON(0)) phase_prep(p, smem);
    PH_SYNC(1);
    if (PH_ON(1)) { EpiBf16Plain E; E.O = proj; E.ldc = PJ_; run_gemm(lds, hb, (const bf16_t*)(ws + WS_WIN), T_, PJ_, D_, E); }
    PH_SYNC(2);
    if (PH_ON(2)) { rg_pass_mfma<false>(p, smem, (int)blockIdx.x, (int)gridDim.x); __syncthreads(); gdn_pass_a(p, smem); }
    PH_SYNC(3);
    if (PH_ON(3)) {
        unsigned* flag = (unsigned*)ws + 16;
        if (blockIdx.x < 64) { const int xq = blockIdx.x & 7, kq8 = blockIdx.x >> 3;
            gdn_pass_b(p, smem, ((xq + 8 * (kq8 >> 2)) << 2) | (kq8 & 3)); }
        else {
            if (blockIdx.x < 68) { rg_carry(p, (blockIdx.x - 64) * NTHREADS + threadIdx.x); __threadfence(); __syncthreads();
                if (threadIdx.x == 0) __hip_atomic_fetch_add(flag, 1u, __ATOMIC_RELEASE, __HIP_MEMORY_SCOPE_AGENT); }
            prep_weights_late(p, smem, (int)blockIdx.x - 64, (int)gridDim.x - 64);
            if (threadIdx.x == 0) { while (__hip_atomic_load(flag, __ATOMIC_ACQUIRE, __HIP_MEMORY_SCOPE_AGENT) < 4u) __builtin_amdgcn_s_sleep(8); }
            __syncthreads(); __threadfence();
            rg_pass_mfma<true>(p, smem, (int)blockIdx.x - 64, (int)gridDim.x - 64);
            __syncthreads();
            { EpiBf16Plain E2; E2.O = pp; E2.ldc = D_; pg8::Gemm g2; g2.A = (const bf16_t*)(ws + WS_PB); g2.Bt = (const bf16_t*)(ws + WS_WPP); g2.M = T_; g2.N = D_; g2.K = PLE_;
              pg8::StaticOrder S2; S2.init(T_, D_, (int)gridDim.x - 64, (int)blockIdx.x - 64); pg8::gemm_phase<EpiBf16Plain, pg8::StaticOrder, false>(lds, g2, S2, E2, nullptr); }
        }
    }
    PH_SYNC(4);
    if (PH_ON(4)) gdn_norm(p);
    PH_SYNC(5);
    if (PH_ON(5)) { EpiResid<false> E; E.res = p.in[0]; E.xb = xb; E.ss = ssA; run_gemm(lds, y, (const bf16_t*)(ws + WS_WOUT), T_, D_, D_, E); }
    PH_SYNC(6);
    if (PH_ON(6)) { EpiGateUp E; E.ff = ff; E.ss = ssA; run_gemm(lds, xb, (const bf16_t*)(ws + WS_WGU), T_, 2 * FF_, D_, E); }
    PH_SYNC(7);
    if (PH_ON(7)) { EpiResid<true> E; E.res = nullptr; E.xb = xb; E.ss = ssB; run_gemm(lds, ff, (const bf16_t*)(ws + WS_WD), T_, D_, FF_, E); }
    PH_SYNC(8);
    if (PH_ON(8)) { EpiPle E; E.x2b = xb; E.x3b = hb; E.pp = pp; E.bias = p.in[22]; E.ss_in = ssB; E.ss_out = ssA; run_gemm(lds, xb, (const bf16_t*)(ws + WS_WPG), T_, D_, D_, E); }
    PH_SYNC(9);
    if (PH_ON(9)) phase_final(p);
}

extern "C" void kernel_launch(void* const* d_in, const int* in_sizes, int n_in, void* d_out, int out_size, void* d_ws, size_t ws_size, hipStream_t stream) {
    static int grid = 0;
    if (grid == 0) {
        if (n_in != 25 || out_size != T_ * D_ || ws_size < WS_END) { fprintf(stderr, "kernel_launch: unexpected shapes: n_in %d out %d ws %zu (need %zu)\n", n_in, out_size, ws_size, (size_t)WS_END); grid = -1; return; }
        int dev = 0, cus = 0, per_cu = 0;
        hipGetDevice(&dev); hipDeviceGetAttribute(&cus, hipDeviceAttributeMultiprocessorCount, dev);
        if (hipFuncSetAttribute((const void*)mega_fwd, hipFuncAttributeMaxDynamicSharedMemorySize, LDS_BYTES) != hipSuccess) { fprintf(stderr, "kernel_launch: hipFuncSetAttribute failed\n"); grid = -1; return; }
        if (hipOccupancyMaxActiveBlocksPerMultiprocessor(&per_cu, (const void*)mega_fwd, NTHREADS, LDS_BYTES) != hipSuccess || per_cu < 1) { fprintf(stderr, "kernel_launch: occupancy query says %d\n", per_cu); per_cu = 1; }
        (void)hipGetLastError();
        grid = cus * 1;
        if (grid <= 0) grid = 256;
    }
    if (grid < 0) return;
    Params p{};
    for (int i = 0; i < 25; ++i) p.in[i] = (const float*)d_in[i];
    p.out = (float*)d_out; p.ws = (unsigned char*)d_ws; p.ph_lo = 0; p.ph_hi = NPHASES;
    if (hipMemsetAsync((char*)d_ws + WS_BAR, 0, XCD_BAR_WORDS * 4, stream) != hipSuccess) { fprintf(stderr, "kernel_launch: memset of the barrier words failed\n"); return; }
    void* args[] = {&p};
    hipError_t e = hipLaunchCooperativeKernel((const void*)mega_fwd, dim3(grid), dim3(NTHREADS), args, LDS_BYTES, stream);
    if (e != hipSuccess) fprintf(stderr, "cooperative launch failed: %s (grid %d)\n", hipGetErrorString(e), grid);
}
```

```cpp
#include <hip/hip_runtime.h>
#include <hip/hip_cooperative_groups.h>
#include <cstdio>
#include <cstdint>
namespace cg = cooperative_groups;
namespace pg8 {
#define PG8_LAS __attribute__((address_space(3)))
typedef unsigned short bf16_t;
typedef short bf16x8 __attribute__((ext_vector_type(8)));
typedef float f32x4 __attribute__((ext_vector_type(4)));
typedef unsigned u32x4 __attribute__((ext_vector_type(4)));
constexpr int BM = 256, BK = 64, HALF = 128, HTB = HALF * BK * 2  , STAGE_BYTES = 8 * HTB, NXCD = 8, WGM = 8;

__host__ __device__ __forceinline__ int lds_byte(int r, int c) { const int st = (r >> 4) * 2 + (c >> 5), rr = r & 15, cc = c & 31, ob = rr * 64 + cc * 2; return st * 1024 + (ob ^ (((ob >> 9) & 1) << 5)); }
__host__ __device__ __forceinline__ void stage_rc(int b, int& R, int& C) { const int st = b / 1024, sb = b % 1024, swz = sb ^ (((sb >> 9) & 1) << 5); R = (st >> 1) * 16 + swz / 64; C = (st & 1) * 32 + (swz % 64) / 2; }
__host__ __device__ __forceinline__ int perm32(int rho) { const int n = rho >> 4, i = rho & 15; return 8 * (i >> 2) + 4 * n + (i & 3); }

struct Unit { int pm, pn; };
struct Gemm { const bf16_t* A; const bf16_t* Bt; int M, N, K; };

struct StaticOrder {
    int nM, nN, nwg, G, c;
    __host__ __device__ void init(int M, int N, int G_, int c_) { nM = M / BM; nN = N / BM; nwg = nM * nN; G = G_; c = c_; }
    __host__ __device__ bool next(int i, Unit& u) const {
        const long L = (long)i * G + c; if (L >= nwg) return false;
        int wgid = (int)L; { const int q = nwg / NXCD, r = nwg % NXCD, xcd = wgid % NXCD, off = wgid / NXCD; wgid = (xcd < r ? xcd * (q + 1) : r * (q + 1) + (xcd - r) * q) + off; }
        const int nig = WGM * nN, gid = wgid / nig, fm = gid * WGM, gsz = (nM - fm) < WGM ? (nM - fm) : WGM;
        u.pm = fm + ((wgid % nig) % gsz); u.pn = (wgid % nig) / gsz; return true;
    }
    __device__ __forceinline__ void a_ready(const Unit&) const {}
    __device__ __forceinline__ void done(const Unit&) const {}
};
typedef __bf16 bf16v2_ __attribute__((ext_vector_type(2)));
typedef float f32v2_ __attribute__((ext_vector_type(2)));
__device__ __forceinline__ unsigned cvt_pk_bf16(float lo, float hi) { f32v2_ v = {lo, hi}; bf16v2_ b = __builtin_convertvector(v, bf16v2_); return __builtin_bit_cast(unsigned, b); }
typedef float f32x2 __attribute__((ext_vector_type(2)));
template <class Epi, class Sched, bool ALIGN_EPI = false, bool SP2 = false>
__device__ __forceinline__ void gemm_phase(PG8_LAS unsigned char* lds, const Gemm g, const Sched& S, const Epi& E) {
    int tid = threadIdx.x; asm volatile("" : "+v"(tid));
    const int wid = __builtin_amdgcn_readfirstlane(tid >> 6), lane = tid & 63, wr = wid >> 2, wc = wid & 3, fr = lane & 15, fq = lane >> 4;
    const int K = g.K, nt = K / BK;
    unsigned voffA[2], voffB[2];
#pragma unroll
    for (int i = 0; i < 2; ++i) { int R, C; stage_rc(tid * 16 + i * 8192, R, C); const int Rb = Epi::PERM ? ((R & ~31) + perm32(R & 31)) : R;
        voffA[i] = (unsigned)(R * K + C) * 2u; voffB[i] = (unsigned)(Rb * K + C) * 2u; }
    const size_t kstep = (size_t)(BK * 2);
    const size_t hstep = (size_t)HALF * K * 2;
    const size_t tstep = 2 * hstep;
    const unsigned ldsw = (unsigned)wid * 1024u;
    const int aoff = lds_byte(wr * 64 + fr, fq * 8), boff = lds_byte(wc * 32 + fr, fq * 8);
#define PG8_SA(b, h) (((b) * 2 + (h)) * HTB)
#define PG8_SB(b, h) ((4 + (b) * 2 + (h)) * HTB)
#define PG8_STAGE(bufoff, gbase, voff) do { _Pragma("unroll") for (int _i = 0; _i < 2; ++_i) \
        __builtin_amdgcn_global_load_lds((const unsigned*)((const char*)(gbase) + (voff)[_i]), (PG8_LAS unsigned*)(lds + (bufoff) + ldsw + _i * 8192), 16, 0, 0); } while (0)
#define PG8_LDA(dst, b, h) do { _Pragma("unroll") for (int m = 0; m < 4; ++m) _Pragma("unroll") for (int k = 0; k < 2; ++k) dst[m][k] = *(const PG8_LAS bf16x8*)(lds + PG8_SA(b, h) + aoff + m * 2048 + k * 1024); } while (0)
#define PG8_LDB(dst, b, h) do { _Pragma("unroll") for (int n = 0; n < 2; ++n) _Pragma("unroll") for (int k = 0; k < 2; ++k) dst[n][k] = *(const PG8_LAS bf16x8*)(lds + PG8_SB(b, h) + boff + n * 2048 + k * 1024); } while (0)
#define PG8_MMA(ai, bj, At, Bt) do { __builtin_amdgcn_s_setprio(1); _Pragma("unroll") for (int m = 0; m < 4; ++m) _Pragma("unroll") for (int n = 0; n < 2; ++n) _Pragma("unroll") for (int k = 0; k < 2; ++k) \
        acc[ai][bj][m][n] = __builtin_amdgcn_mfma_f32_16x16x32_bf16(Bt[n][k], At[m][k], acc[ai][bj][m][n], 0, 0, 0); __builtin_amdgcn_s_setprio(0); } while (0)
#define PG8_WAIT_V(n) asm volatile("s_waitcnt vmcnt(" #n ")" ::: "memory")
#define PG8_WAIT_L(n) asm volatile("s_waitcnt lgkmcnt(" #n ")" ::: "memory")
#define PG8_BAR __builtin_amdgcn_s_barrier()
#define PG8_SCHED __builtin_amdgcn_sched_barrier(0)
    Unit cur, nxt; int ui = 0;
    if (!S.next(0, cur)) return;
    f32x4 acc[2][2][4][2];
#pragma unroll
    for (int a = 0; a < 2; ++a)
#pragma unroll
        for (int b = 0; b < 2; ++b)
#pragma unroll
            for (int m = 0; m < 4; ++m)
#pragma unroll
                for (int n = 0; n < 2; ++n) acc[a][b][m][n] = (f32x4){0.f, 0.f, 0.f, 0.f};
    bf16x8 At[4][2], B0[2][2], B1[2][2];
    const char* cA = (const char*)g.A + (size_t)cur.pm * tstep; const char* cB = (const char*)g.Bt + (size_t)cur.pn * tstep;
    S.a_ready(cur);
    if constexpr (SP2) {
        PG8_STAGE(PG8_SB(0, 0), cB, voffB); PG8_STAGE(PG8_SB(0, 1), cB + hstep, voffB); PG8_STAGE(PG8_SA(0, 0), cA, voffA); PG8_STAGE(PG8_SA(0, 1), cA + hstep, voffA);
        if (wr == 1) PG8_BAR;
        PG8_WAIT_V(2); PG8_BAR;
        PG8_STAGE(PG8_SB(1, 0), cB + kstep, voffB); PG8_STAGE(PG8_SA(1, 0), cA + kstep, voffA); PG8_STAGE(PG8_SB(1, 1), cB + hstep + kstep, voffB);
        PG8_WAIT_V(6); PG8_BAR;
    } else {
        PG8_STAGE(PG8_SB(0, 0), cB, voffB); PG8_STAGE(PG8_SA(0, 0), cA, voffA); PG8_STAGE(PG8_SB(0, 1), cB + hstep, voffB); PG8_STAGE(PG8_SA(0, 1), cA + hstep, voffA);
        if (wr == 1) PG8_BAR;
        PG8_WAIT_V(4); PG8_BAR;
        PG8_STAGE(PG8_SB(1, 0), cB + kstep, voffB); PG8_STAGE(PG8_SA(1, 0), cA + kstep, voffA); PG8_STAGE(PG8_SB(1, 1), cB + hstep + kstep, voffB);
        PG8_WAIT_V(6); PG8_BAR;
    }
    for (;;) {
        const bool has_next = S.next(ui + 1, nxt);
        const char* nA = has_next ? (const char*)g.A + (size_t)nxt.pm * tstep : cA; const char* nB = has_next ? (const char*)g.Bt + (size_t)nxt.pn * tstep : cB;
        for (int t = 0; t < nt; t += 2) {
            const bool last = (t == nt - 2);
            const char* a1 = cA + (size_t)(t + 1) * kstep;
            const char* a2 = last ? nA : cA + (size_t)(t + 2) * kstep; const char* b2 = last ? nB : cB + (size_t)(t + 2) * kstep;
            const char* a3 = a2 + kstep; const char* b3 = b2 + kstep;
            if (last && has_next) S.a_ready(nxt);
            if constexpr (SP2) {
            PG8_LDB(B0, 0, 0); PG8_LDB(B1, 0, 1); PG8_SCHED; PG8_LDA(At, 0, 0); PG8_STAGE(PG8_SA(1, 1), a1 + hstep, voffA);
            PG8_WAIT_V(8); PG8_WAIT_L(0); PG8_BAR; PG8_MMA(0, 0, At, B0); PG8_MMA(0, 1, At, B1); PG8_BAR; PG8_SCHED;
            PG8_LDA(At, 0, 1); PG8_STAGE(PG8_SB(0, 0), b2, voffB); PG8_STAGE(PG8_SB(0, 1), b2 + hstep, voffB); PG8_STAGE(PG8_SA(0, 0), a2, voffA);
            PG8_WAIT_V(8); PG8_WAIT_L(0); PG8_BAR; PG8_MMA(1, 0, At, B0); PG8_MMA(1, 1, At, B1); PG8_BAR; PG8_SCHED;
            PG8_LDB(B0, 1, 0); PG8_LDB(B1, 1, 1); PG8_SCHED; PG8_LDA(At, 1, 0); PG8_STAGE(PG8_SA(0, 1), a2 + hstep, voffA);
            PG8_WAIT_V(8); PG8_WAIT_L(0); PG8_BAR; PG8_MMA(0, 0, At, B0); PG8_MMA(0, 1, At, B1); PG8_BAR; PG8_SCHED;
            PG8_LDA(At, 1, 1); PG8_STAGE(PG8_SB(1, 0), b3, voffB); PG8_STAGE(PG8_SB(1, 1), b3 + hstep, voffB); PG8_STAGE(PG8_SA(1, 0), a3, voffA);
            PG8_WAIT_V(8); PG8_WAIT_L(0); PG8_BAR; PG8_MMA(1, 0, At, B0); PG8_MMA(1, 1, At, B1); PG8_BAR; PG8_SCHED;
            } else {
            PG8_LDB(B0, 0, 0); PG8_SCHED; PG8_LDA(At, 0, 0); PG8_STAGE(PG8_SA(1, 1), a1 + hstep, voffA);
            PG8_WAIT_L(8); PG8_BAR; PG8_WAIT_L(0); PG8_MMA(0, 0, At, B0); PG8_BAR; PG8_SCHED;
            PG8_LDB(B1, 0, 1); PG8_STAGE(PG8_SB(0, 0), b2, voffB);
            PG8_BAR; PG8_WAIT_L(0); PG8_MMA(0, 1, At, B1); PG8_BAR;
            PG8_LDA(At, 0, 1); PG8_STAGE(PG8_SA(0, 0), a2, voffA);
            PG8_BAR; PG8_WAIT_L(0); PG8_MMA(1, 0, At, B0); PG8_BAR; PG8_SCHED;
            PG8_STAGE(PG8_SB(0, 1), b2 + hstep, voffB);
            PG8_WAIT_V(6); PG8_BAR; PG8_MMA(1, 1, At, B1); PG8_BAR;
            PG8_LDB(B0, 1, 0); PG8_SCHED; PG8_LDA(At, 1, 0); PG8_STAGE(PG8_SA(0, 1), a2 + hstep, voffA);
            PG8_WAIT_L(8); PG8_BAR; PG8_WAIT_L(0); PG8_MMA(0, 0, At, B0); PG8_BAR; PG8_SCHED;
            PG8_LDB(B1, 1, 1); PG8_STAGE(PG8_SB(1, 0), b3, voffB);
            PG8_BAR; PG8_WAIT_L(0); PG8_MMA(0, 1, At, B1); PG8_BAR;
            PG8_LDA(At, 1, 1); PG8_STAGE(PG8_SA(1, 0), a3, voffA);
            PG8_BAR; PG8_WAIT_L(0); PG8_MMA(1, 0, At, B0); PG8_BAR; PG8_SCHED;
            PG8_STAGE(PG8_SB(1, 1), b3 + hstep, voffB);
            PG8_WAIT_V(6); PG8_BAR; PG8_MMA(1, 1, At, B1); PG8_BAR;
            }
        }
        if constexpr (ALIGN_EPI) { if (wr == 0) PG8_BAR; }
        if constexpr (!Epi::AFTER_DRAIN) { E(acc, cur, wr, wc, fr, fq); S.done(cur); }
        if (!has_next) break;
#pragma unroll
        for (int a = 0; a < 2; ++a)
#pragma unroll
            for (int b = 0; b < 2; ++b)
#pragma unroll
                for (int m = 0; m < 4; ++m)
#pragma unroll
                    for (int n = 0; n < 2; ++n) acc[a][b][m][n] = (f32x4){0.f, 0.f, 0.f, 0.f};
        cur = nxt; cA = nA; cB = nB; ++ui;
        if constexpr (ALIGN_EPI) { if (wr == 1) PG8_BAR; }
    }
    PG8_WAIT_V(0);
    if constexpr (!ALIGN_EPI) { if (wr == 0) PG8_BAR; }
    PG8_BAR;
    if constexpr (Epi::AFTER_DRAIN) { E.fused(acc, cur, wr, wc, fr, fq, lds, wid, lane); S.done(cur); }
#undef PG8_SA
#undef PG8_SB
#undef PG8_STAGE
#undef PG8_LDA
#undef PG8_LDB
#undef PG8_MMA
#undef PG8_WAIT_V
#undef PG8_WAIT_L
#undef PG8_BAR
#undef PG8_SCHED
}
}
#define XB_TMO      128
#define XB_XCNT(j)  (256  + 64 * (j))
#define XB_XSUB(j)  (1280 + 64 * (j))
#define XB_XGEN(j)  (2304 + 64 * (j))
#define XB_TOP      3328
#define XB_TOPGEN   3392
#define XCD_BAR_WORDS 3456
#define XB_SPIN_CAP (1u << 18)
#define LAS __attribute__((address_space(3)))

__device__ __forceinline__ unsigned xb_ld(unsigned* p)              { return __hip_atomic_load(p, __ATOMIC_RELAXED, __HIP_MEMORY_SCOPE_AGENT); }
__device__ __forceinline__ unsigned xb_add(unsigned* p, unsigned v) { return __hip_atomic_fetch_add(p, v, __ATOMIC_RELAXED, __HIP_MEMORY_SCOPE_AGENT); }
__device__ __forceinline__ unsigned xb_xcc_id() { return (unsigned)__builtin_amdgcn_s_getreg((3 << 11) | 20) & 0xFu; }
#define XB_SPIN(cond, bar) do { unsigned _sp = 0; while (cond) { __builtin_amdgcn_s_sleep(1); \
    if ((++_sp & 255u) == 0u) { if (xb_ld(&(bar)[XB_TMO])) break; if (_sp > XB_SPIN_CAP) { atomicAdd(&(bar)[XB_TMO], 1u); break; } } } } while (0)

struct XcdBarrier {
    unsigned* bar; unsigned x;
    volatile LAS unsigned* st;
};

__device__ __forceinline__ XcdBarrier xcd_barrier_post(unsigned* bar, volatile LAS unsigned* st) {
    XcdBarrier b; b.bar = bar; b.x = xb_xcc_id(); b.st = st;
    if (threadIdx.x == 0) (void)xb_add(&bar[XB_XCNT(b.x)], 1u);
    return b;
}
__device__ __forceinline__ void xcd_barrier_complete(unsigned* bar, unsigned x, unsigned& nloc, unsigned& nx) {
    const unsigned G = gridDim.x * gridDim.y * gridDim.z;
    unsigned sum, cnt, mine, sp = 0u;
    for (;;) {
        sum = 0u; cnt = 0u; mine = 0u;
#pragma unroll
        for (unsigned j = 0; j < 16; ++j) { const unsigned c = xb_ld(&bar[XB_XCNT(j)]); sum += c; cnt += (c > 0u) ? 1u : 0u; mine = (j == x) ? c : mine; }
        if (sum == G) break;
        __builtin_amdgcn_s_sleep(1);
        if ((++sp & 255u) == 0u) { if (xb_ld(&bar[XB_TMO])) break; if (sp > XB_SPIN_CAP) { atomicAdd(&bar[XB_TMO], 1u); break; } }
    }
    nloc = mine > 0u ? mine : 1u; nx = cnt > 0u ? cnt : 1u;
}

__device__ __forceinline__ void xcd_barrier(const XcdBarrier& b) {
    asm volatile("s_waitcnt vmcnt(0)" ::: "memory");
    __syncthreads();
    if (threadIdx.x == 0) {
        unsigned* bar = b.bar;
        __builtin_amdgcn_s_waitcnt(0);
        unsigned nloc = b.st[0], nx = b.st[1];
        if (nloc == 0u) { xcd_barrier_complete(bar, b.x, nloc, nx); b.st[0] = nloc; b.st[1] = nx; }
        const unsigned old = xb_add(&bar[XB_XSUB(b.x)], 1u);
        const unsigned gen = old / nloc;
        if (old + 1u == (gen + 1u) * nloc) {
            __builtin_amdgcn_fence(__ATOMIC_RELEASE, "agent");
            asm volatile("s_waitcnt vmcnt(0)" ::: "memory");
            const unsigned og = xb_add(&bar[XB_TOP], 1u);
            const unsigned tg = og / nx;
            if (og + 1u == (tg + 1u) * nx) xb_add(&bar[XB_TOPGEN], 1u);
            else XB_SPIN(xb_ld(&bar[XB_TOPGEN]) == tg, bar);
            __builtin_amdgcn_fence(__ATOMIC_ACQUIRE, "agent");
            xb_add(&bar[XB_XGEN(b.x)], 1u);
            asm volatile("s_waitcnt vmcnt(0)" ::: "memory");
        } else {
            XB_SPIN(xb_ld(&bar[XB_XGEN(b.x)]) == gen, bar);
            __builtin_amdgcn_fence(__ATOMIC_ACQUIRE, "agent");
            asm volatile("s_waitcnt vmcnt(0)" ::: "memory");
        }
    }
    __syncthreads();
}

constexpr bool GEMM_SP2 = true, GEMM_ALIGN = true;
using pg8::bf16_t; using pg8::f32x4; using pg8::u32x4; using pg8::bf16x8; using pg8::cvt_pk_bf16; using pg8::Unit; using pg8::HALF; using pg8::BM;
typedef unsigned u32x2 __attribute__((ext_vector_type(2)));
constexpr int T_ = 32768, D_ = 1024, SEQ_ = 8192, NB_ = 4, INC_ = 3080, PJ_ = 3072, FF_ = 2816, PLE_ = 256, NCH_ = 128;
constexpr float EPS_ = 1e-6f;
constexpr int NTHREADS = 512;
constexpr int LDS_BYTES = 144 * 1024;

constexpr size_t WS_WIN = 4096;
constexpr size_t WS_WOUT = WS_WIN + (size_t)PJ_ * D_ * 2;
constexpr size_t WS_WGU = WS_WOUT + (size_t)D_ * D_ * 2;
constexpr size_t WS_WD = WS_WGU + (size_t)2 * FF_ * D_ * 2;
constexpr size_t WS_WPG = WS_WD + (size_t)D_ * FF_ * 2;
constexpr size_t WS_WPP = WS_WPG + (size_t)D_ * D_ * 2;
constexpr size_t WS_LOGITS = WS_WPP + (size_t)D_ * PLE_ * 2;
constexpr size_t WS_PB = WS_LOGITS + (size_t)T_ * 8 * 4;
constexpr size_t WS_SSA = WS_PB + (size_t)T_ * PLE_ * 2;
constexpr size_t WS_SSB = WS_SSA + (size_t)T_ * 16 * 4;
constexpr size_t WS_PTOT = WS_SSB + (size_t)T_ * 16 * 4;
constexpr size_t WS_HEND = WS_PTOT + (size_t)NB_ * NCH_ * 512 * 4;
constexpr size_t WS_CARRY = WS_HEND + (size_t)NB_ * NCH_ * 512 * 4;
constexpr size_t WS_GTOT = WS_CARRY + (size_t)NB_ * NCH_ * 512 * 4;
constexpr size_t WS_XB = WS_GTOT + 8192;
constexpr size_t WS_PROJ = WS_XB + (size_t)T_ * D_ * 2;
constexpr size_t WS_R4 = WS_PROJ + (size_t)T_ * PJ_ * 2;
constexpr size_t WS_Y = WS_XB;
constexpr size_t WS_XB2 = WS_R4;
constexpr size_t WS_PP = WS_R4 + (size_t)T_ * D_ * 2;
constexpr size_t WS_ORAW = WS_R4 + (size_t)2048 * 73728;
constexpr size_t WS_BAR = WS_R4 + (size_t)2048 * 73728 + (size_t)T_ * 512 * 2;
constexpr size_t WS_RGW = WS_BAR + 16384;
constexpr size_t WS_END = WS_RGW + 131072;

struct Params {
    const float* in[25];
    float* out; unsigned char* ws;
    int ph_lo, ph_hi;
};

__device__ __forceinline__ float bf2f(bf16_t b) { return __uint_as_float(((unsigned)b) << 16); }
__device__ __forceinline__ bf16_t f2bf(float f) { return (bf16_t)(cvt_pk_bf16(f, 0.f) & 0xffffu); }
__device__ __forceinline__ float sigmoidf_(float x) { return __builtin_amdgcn_rcpf(1.0f + __expf(-x)); }
__device__ __forceinline__ float siluf_(float x) { return x * __builtin_amdgcn_rcpf(1.0f + __expf(-x)); }
__device__ __forceinline__ float softplusf_(float x) { return fmaxf(x, 0.f) + log1pf(__expf(-fabsf(x))); }
__device__ __forceinline__ float gelu_tanhf_(float x) { const float u = 0.7978845608028654f * (x + 0.044715f * x * x * x); return x * __builtin_amdgcn_rcpf(1.0f + __expf(-2.0f * u)); }
__device__ __forceinline__ float rstd16(const float* ss, int r) {
    const f32x4 a = *(const f32x4*)(ss + (size_t)r * 16), b = *(const f32x4*)(ss + (size_t)r * 16 + 4), c = *(const f32x4*)(ss + (size_t)r * 16 + 8), d = *(const f32x4*)(ss + (size_t)r * 16 + 12);
    const float s = ((a[0] + a[1]) + (a[2] + a[3])) + ((b[0] + b[1]) + (b[2] + b[3])) + ((c[0] + c[1]) + (c[2] + c[3])) + ((d[0] + d[1]) + (d[2] + d[3]));
    return rsqrtf(s * (1.0f / 1024.0f) + EPS_);
}

template <int CTRL> __device__ __forceinline__ float dpp_f(float x) { return __int_as_float(__builtin_amdgcn_update_dpp(0, __float_as_int(x), CTRL, 0xf, 0xf, false)); }
__device__ __forceinline__ float red8(float x) { x += dpp_f<0xB1>(x); x += dpp_f<0x4E>(x); x += dpp_f<0x141>(x); return x; }
struct EpiBf16Plain {
    static constexpr bool PERM = true, AFTER_DRAIN = false;
    bf16_t* O; int ldc;
    __device__ __forceinline__ void operator()(const f32x4 (&acc)[2][2][4][2], const Unit& u, int wr, int wc, int fr, int fq) const {
        int row0 = u.pm * BM + wr * 64 + fr; asm volatile("" : "+v"(row0)); const int col0 = u.pn * BM + wc * 32 + 8 * fq;
#pragma unroll
        for (int ai = 0; ai < 2; ++ai)
#pragma unroll
            for (int m = 0; m < 4; ++m) { bf16_t* rowp = O + (size_t)(row0 + ai * HALF + m * 16) * ldc + col0;
#pragma unroll
                for (int bj = 0; bj < 2; ++bj) { const f32x4 v0 = acc[ai][bj][m][0], v1 = acc[ai][bj][m][1]; u32x4 w; w.x = cvt_pk_bf16(v0[0], v0[1]); w.y = cvt_pk_bf16(v0[2], v0[3]); w.z = cvt_pk_bf16(v1[0], v1[1]); w.w = cvt_pk_bf16(v1[2], v1[3]);
                    *(u32x4*)(rowp + bj * HALF) = w; } }
    }
};
__device__ __forceinline__ void rstd8(const float* ss, int row0, float (&rs)[8]) {
#pragma unroll
    for (int ai = 0; ai < 2; ++ai) { f32x4 t[4][4];
#pragma unroll
        for (int m = 0; m < 4; ++m)
#pragma unroll
            for (int q = 0; q < 4; ++q) t[m][q] = *(const f32x4*)(ss + (size_t)(row0 + ai * HALF + m * 16) * 16 + 4 * q);
#pragma unroll
        for (int m = 0; m < 4; ++m) { const float sm = (((t[m][0][0] + t[m][0][1]) + (t[m][0][2] + t[m][0][3])) + ((t[m][1][0] + t[m][1][1]) + (t[m][1][2] + t[m][1][3]))) + (((t[m][2][0] + t[m][2][1]) + (t[m][2][2] + t[m][2][3])) + ((t[m][3][0] + t[m][3][1]) + (t[m][3][2] + t[m][3][3])));
            rs[ai * 4 + m] = rsqrtf(sm * (1.0f / 1024.0f) + EPS_); }
        asm volatile("" ::: "memory"); }
}
template <bool RES_BF16>
struct EpiResid {
    static constexpr bool PERM = false, AFTER_DRAIN = false;
    const float* res; bf16_t* xb; float* ss;
    __device__ __forceinline__ void operator()(const f32x4 (&acc)[2][2][4][2], const Unit& u, int wr, int wc, int fr, int fq) const {
        int row0 = u.pm * BM + wr * 64 + fr; asm volatile("" : "+v"(row0)); const int col0 = u.pn * BM + wc * 32 + 4 * fq;
        const unsigned e0 = (unsigned)row0 * D_ + col0;
#pragma unroll
        for (int ai = 0; ai < 2; ++ai) {
            constexpr int NB = RES_BF16 ? 4 : 2;
#pragma unroll
            for (int mh = 0; mh < 4 / NB; ++mh) {
                f32x4 rv[NB][2][2];
#pragma unroll
                for (int mm = 0; mm < NB; ++mm)
#pragma unroll
                    for (int bj = 0; bj < 2; ++bj)
#pragma unroll
                        for (int n = 0; n < 2; ++n) { const unsigned e = e0 + (unsigned)((ai * HALF + (mh * NB + mm) * 16) * D_ + bj * HALF + n * 16);
                            if (RES_BF16) { const u32x2 w = *(const u32x2*)((const char*)xb + (size_t)(e * 2u)); rv[mm][bj][n] = (f32x4){__uint_as_float(w.x << 16), __uint_as_float(w.x & 0xffff0000u), __uint_as_float(w.y << 16), __uint_as_float(w.y & 0xffff0000u)}; }
                            else rv[mm][bj][n] = *(const f32x4*)((const char*)res + (size_t)(e * 4u)); }
#pragma unroll
                for (int mm = 0; mm < NB; ++mm) { const int m = mh * NB + mm, r = row0 + ai * HALF + m * 16; float s = 0.f;
#pragma unroll
                    for (int bj = 0; bj < 2; ++bj)
#pragma unroll
                        for (int n = 0; n < 2; ++n) { const unsigned e = e0 + (unsigned)((ai * HALF + m * 16) * D_ + bj * HALF + n * 16); const f32x4 v = rv[mm][bj][n] + acc[ai][bj][m][n];
                            s += (v[0] * v[0] + v[1] * v[1]) + (v[2] * v[2] + v[3] * v[3]); u32x2 w; w.x = cvt_pk_bf16(v[0], v[1]); w.y = cvt_pk_bf16(v[2], v[3]); *(u32x2*)((char*)xb + (size_t)(e * 2u)) = w; }
                    s += __shfl_xor(s, 16); s += __shfl_xor(s, 32);
                    if (fq == 0) ss[(size_t)r * 16 + u.pn * 4 + wc] = s; }
                asm volatile("" ::: "memory"); } }
    }
};
struct EpiGateUp {
    static constexpr bool PERM = true, AFTER_DRAIN = false;
    bf16_t* ff; const float* ss;
    __device__ __forceinline__ void operator()(const f32x4 (&acc)[2][2][4][2], const Unit& u, int wr, int wc, int fr, int fq) const {
        int row0 = u.pm * BM + wr * 64 + fr; asm volatile("" : "+v"(row0)); const int col0 = u.pn * HALF + wc * 32 + 8 * fq;
        float rsv[8]; rstd8(ss, row0, rsv);
#pragma unroll
        for (int ai = 0; ai < 2; ++ai)
#pragma unroll
            for (int m = 0; m < 4; ++m) { const int r = row0 + ai * HALF + m * 16; const float rs = rsv[ai * 4 + m];
                float o[8];
#pragma unroll
                for (int n = 0; n < 2; ++n)
#pragma unroll
                    for (int j = 0; j < 4; ++j) { const float g = acc[ai][0][m][n][j] * rs, up = acc[ai][1][m][n][j] * rs; o[n * 4 + j] = siluf_(g) * up; }
                u32x4 w; w.x = cvt_pk_bf16(o[0], o[1]); w.y = cvt_pk_bf16(o[2], o[3]); w.z = cvt_pk_bf16(o[4], o[5]); w.w = cvt_pk_bf16(o[6], o[7]);
                *(u32x4*)(ff + (size_t)r * FF_ + col0) = w; }
    }
};
struct EpiPle {
    static constexpr bool PERM = false, AFTER_DRAIN = false;
    const bf16_t* x2b; bf16_t* x3b; const bf16_t* pp; const float* bias; const float* ss_in; float* ss_out;
    __device__ __forceinline__ void operator()(const f32x4 (&acc)[2][2][4][2], const Unit& u, int wr, int wc, int fr, int fq) const {
        int row0 = u.pm * BM + wr * 64 + fr; asm volatile("" : "+v"(row0)); const int col0 = u.pn * BM + wc * 32 + 4 * fq;
        const unsigned b0 = ((unsigned)row0 * D_ + col0) * 2u;
        const unsigned s0 = (unsigned)row0 * 64u;
        u32x2 X[2][2][2], P[2][2][2]; f32x4 S[2][4];
#define EP_LOAD(set, g) do { const unsigned ro_ = (unsigned)(((g) >> 2) * HALF + ((g) & 3) * 16); \
        _Pragma("unroll") for (int bj = 0; bj < 2; ++bj) _Pragma("unroll") for (int n = 0; n < 2; ++n) { const unsigned bo_ = b0 + (ro_ * D_ + bj * HALF + n * 16) * 2u; \
            X[set][bj][n] = *(const u32x2*)((const char*)x2b + (size_t)bo_); P[set][bj][n] = *(const u32x2*)((const char*)pp + (size_t)bo_); } \
        _Pragma("unroll") for (int q = 0; q < 4; ++q) S[set][q] = *(const f32x4*)((const char*)ss_in + (size_t)(s0 + ro_ * 64u + q * 16u)); } while (0)
        EP_LOAD(0, 0);
#pragma unroll
        for (int g = 0; g < 8; ++g) { const int ai = g >> 2, m = g & 3, st = g & 1, r = row0 + ai * HALF + m * 16;
            if (g < 7) EP_LOAD((g + 1) & 1, g + 1);
            const float sm = (((S[st][0][0] + S[st][0][1]) + (S[st][0][2] + S[st][0][3])) + ((S[st][1][0] + S[st][1][1]) + (S[st][1][2] + S[st][1][3]))) + (((S[st][2][0] + S[st][2][1]) + (S[st][2][2] + S[st][2][3])) + ((S[st][3][0] + S[st][3][1]) + (S[st][3][2] + S[st][3][3])));
            const float rs = rsqrtf(sm * (1.0f / 1024.0f) + EPS_); float s = 0.f;
#pragma unroll
            for (int bj = 0; bj < 2; ++bj)
#pragma unroll
                for (int n = 0; n < 2; ++n) { const unsigned bo = b0 + (unsigned)(((ai * HALF + m * 16) * D_ + bj * HALF + n * 16) * 2); const u32x2 w2 = P[st][bj][n], x2 = X[st][bj][n]; const f32x4 a = acc[ai][bj][m][n]; const f32x4 bb = *(const f32x4*)(bias + col0 + bj * HALF + n * 16);
                    f32x4 v = {__uint_as_float(x2.x << 16), __uint_as_float(x2.x & 0xffff0000u), __uint_as_float(x2.y << 16), __uint_as_float(x2.y & 0xffff0000u)};
                    const float p0 = __uint_as_float(w2.x << 16), p1 = __uint_as_float(w2.x & 0xffff0000u), p2 = __uint_as_float(w2.y << 16), p3 = __uint_as_float(w2.y & 0xffff0000u);
                    v[0] += sigmoidf_(a[0] * rs + bb[0]) * p0; v[1] += sigmoidf_(a[1] * rs + bb[1]) * p1; v[2] += sigmoidf_(a[2] * rs + bb[2]) * p2; v[3] += sigmoidf_(a[3] * rs + bb[3]) * p3;
                    u32x2 xw; xw.x = cvt_pk_bf16(v[0], v[1]); xw.y = cvt_pk_bf16(v[2], v[3]); *(u32x2*)((char*)x3b + (size_t)bo) = xw; s += (v[0] * v[0] + v[1] * v[1]) + (v[2] * v[2] + v[3] * v[3]); }
            s += __shfl_xor(s, 16); s += __shfl_xor(s, 32);
            if (fq == 0) ss_out[(size_t)r * 16 + u.pn * 4 + wc] = s;
            asm volatile("" ::: "memory"); }
#undef EP_LOAD
    }
};

template <class Epi> __device__ __forceinline__ void run_gemm(PG8_LAS unsigned char* lds, const bf16_t* A, const bf16_t* Bt, int M, int N, int K, const Epi& E) {
    pg8::Gemm g; g.A = A; g.Bt = Bt; g.M = M; g.N = N; g.K = K;
    pg8::StaticOrder S; S.init(M, N, (int)gridDim.x, (int)blockIdx.x);
    pg8::gemm_phase<Epi, pg8::StaticOrder, GEMM_ALIGN, GEMM_SP2>(lds, g, S, E);
}

__device__ void prep_transpose(const float* __restrict__ W, int K, int ldw, int c0, int ncols, bf16_t* __restrict__ Wt, const float* __restrict__ ks, int mode, float* tile, int rot, int widx, int nw) {
    const int tid = threadIdx.x, nkt = K / 64, nct = ncols / 64, ntiles = nkt * nct;
    for (int tt = (widx + nw - (rot % nw)) % nw; tt < ntiles; tt += nw) {
        const int kt = tt / nct, ct = tt % nct, k0 = kt * 64, n0 = ct * 64;
        __syncthreads();
#pragma unroll
        for (int i = 0; i < 2; ++i) { const int r = (tid >> 4) + 32 * i, c4 = (tid & 15) * 4; const f32x4 v = *(const f32x4*)(W + (size_t)(k0 + r) * ldw + c0 + n0 + c4);
            const float s = ks ? ks[k0 + r] : 1.0f; tile[r * 65 + c4 + 0] = v[0] * s; tile[r * 65 + c4 + 1] = v[1] * s; tile[r * 65 + c4 + 2] = v[2] * s; tile[r * 65 + c4 + 3] = v[3] * s; }
        __syncthreads();
        const int n = tid >> 3, kseg = (tid & 7) * 8; float v[8];
#pragma unroll
        for (int e = 0; e < 8; ++e) v[e] = tile[(kseg + e) * 65 + n];
        u32x4 w; w.x = cvt_pk_bf16(v[0], v[1]); w.y = cvt_pk_bf16(v[2], v[3]); w.z = cvt_pk_bf16(v[4], v[5]); w.w = cvt_pk_bf16(v[6], v[7]);
        const int f = n0 + n; const int drow = (mode == 0) ? f : (256 * (f >> 7) + 128 * (mode - 1) + (f & 127));
        *(u32x4*)(Wt + (size_t)drow * K + k0 + kseg) = w;
    }
}


__device__ __forceinline__ void prep_weights_late(const Params& p, unsigned char* smem, int widx, int nw) {
    unsigned char* ws = p.ws; float* tile = (float*)smem;
    __syncthreads();
    prep_transpose(p.in[15], D_, D_, 0, D_, (bf16_t*)(ws + WS_WOUT), nullptr, 0, tile, 0, widx, nw);
    prep_transpose(p.in[17], D_, FF_, 0, FF_, (bf16_t*)(ws + WS_WGU), p.in[16], 1, tile, 256, widx, nw);
    prep_transpose(p.in[18], D_, FF_, 0, FF_, (bf16_t*)(ws + WS_WGU), p.in[16], 2, tile, 960, widx, nw);
    prep_transpose(p.in[19], FF_, D_, 0, D_, (bf16_t*)(ws + WS_WD), nullptr, 0, tile, 1664, widx, nw);
    prep_transpose(p.in[21], D_, D_, 0, D_, (bf16_t*)(ws + WS_WPG), p.in[20], 0, tile, 2368, widx, nw);
}

__device__ __forceinline__ void phase_prep(const Params& p, unsigned char* smem) {
    const int tid = threadIdx.x, wid = __builtin_amdgcn_readfirstlane(tid >> 6), lane = tid & 63;
    unsigned char* ws = p.ws;
    float* tile = (float*)smem;
    float* w8s = (float*)(smem + 20480);
    if (blockIdx.x == 0 && tid < 32) ((unsigned*)ws)[tid] = 0u;
    prep_transpose(p.in[3], D_, INC_, 0, PJ_, (bf16_t*)(ws + WS_WIN), nullptr, 0, tile, 0, (int)blockIdx.x, (int)gridDim.x);
    prep_transpose(p.in[23], PLE_, D_, 0, D_, (bf16_t*)(ws + WS_WPP), nullptr, 0, tile, 768, (int)blockIdx.x, (int)gridDim.x);
    if (blockIdx.x < 8) {
        const int hh = blockIdx.x;
        for (int item = tid; item < 1024; item += NTHREADS) { const int gate = item >> 9, fragi = (item >> 6) & 7, ln = item & 63, ntf = fragi >> 1, ksf = fragi & 1, n16f = ln & 15, fqf = ln >> 4;
            const float* wsrc = p.in[gate ? 8 : 6] + (size_t)(hh * 64 + 32 * ksf + 8 * fqf) * 64 + 16 * ntf + n16f;
            const f32x4 lo = {wsrc[0], wsrc[64], wsrc[128], wsrc[192]}, hi = {wsrc[256], wsrc[320], wsrc[384], wsrc[448]};
            u32x4 w; w.x = cvt_pk_bf16(lo[0], lo[1]); w.y = cvt_pk_bf16(lo[2], lo[3]); w.z = cvt_pk_bf16(hi[0], hi[1]); w.w = cvt_pk_bf16(hi[2], hi[3]);
            *(u32x4*)(ws + WS_RGW + ((size_t)((hh * 2 + gate) * 8 + fragi) * 64 + ln) * 16) = w; }
    }
    for (int i = tid; i < 1024 * 8; i += NTHREADS) { const int k = i >> 3, j = i & 7; w8s[i] = p.in[2][k] * p.in[3][(size_t)k * INC_ + PJ_ + j]; }
    __syncthreads();
    {
        const float* x = p.in[0]; const float* nw = p.in[2]; bf16_t* hb = (bf16_t*)(ws + WS_XB); float* logits = (float*)(ws + WS_LOGITS);
        f32x4 nwv[4];
#pragma unroll
        for (int i = 0; i < 4; ++i) nwv[i] = *(const f32x4*)(nw + 4 * (lane + 64 * i));
        f32x4 vn[4]; int row = blockIdx.x * 8 + wid;
        if (row < T_) {
#pragma unroll
            for (int i = 0; i < 4; ++i) vn[i] = *(const f32x4*)(x + (size_t)row * D_ + 4 * (lane + 64 * i)); }
        for (; row < T_; row += gridDim.x * 8) {
            f32x4 v[4]; float s = 0.f;
#pragma unroll
            for (int i = 0; i < 4; ++i) { v[i] = vn[i]; s += (v[i][0] * v[i][0] + v[i][1] * v[i][1]) + (v[i][2] * v[i][2] + v[i][3] * v[i][3]); }
            { const int nrow = row + gridDim.x * 8;
              if (nrow < T_) {
#pragma unroll
                for (int i = 0; i < 4; ++i) vn[i] = *(const f32x4*)(x + (size_t)nrow * D_ + 4 * (lane + 64 * i)); } }
            s = red8(s); s += dpp_f<0x140>(s); s += __shfl_xor(s, 16); s += __shfl_xor(s, 32);
            const float rs = rsqrtf(s * (1.0f / 1024.0f) + EPS_);
            float lg[8];
#pragma unroll
            for (int j = 0; j < 8; ++j) lg[j] = 0.f;
#pragma unroll
            for (int i = 0; i < 4; ++i) {
                const int k0 = 4 * (lane + 64 * i);
#pragma unroll
                for (int e = 0; e < 4; ++e) { const f32x4 wa = *(const f32x4*)(w8s + (k0 + e) * 8), wb = *(const f32x4*)(w8s + (k0 + e) * 8 + 4); const float xv = v[i][e];
                    lg[0] += xv * wa[0]; lg[1] += xv * wa[1]; lg[2] += xv * wa[2]; lg[3] += xv * wa[3]; lg[4] += xv * wb[0]; lg[5] += xv * wb[1]; lg[6] += xv * wb[2]; lg[7] += xv * wb[3]; }
                const f32x4 h = v[i] * rs * nwv[i]; u32x2 w; w.x = cvt_pk_bf16(h[0], h[1]); w.y = cvt_pk_bf16(h[2], h[3]);
                *(u32x2*)(hb + (size_t)row * D_ + k0) = w;
            }
            const bool b5 = (lane & 32) != 0, b4 = (lane & 16) != 0, b3 = (lane & 8) != 0;
            float k4[4], k2[2];
#pragma unroll
            for (int j = 0; j < 4; ++j) { const float send = b5 ? lg[j] : lg[j + 4]; const float keep = b5 ? lg[j + 4] : lg[j]; k4[j] = keep + __shfl_xor(send, 32); }
#pragma unroll
            for (int j = 0; j < 2; ++j) { const float send = b4 ? k4[j] : k4[j + 2]; const float keep = b4 ? k4[j + 2] : k4[j]; k2[j] = keep + __shfl_xor(send, 16); }
            float k1; { const float send = b3 ? k2[0] : k2[1]; const float keep = b3 ? k2[1] : k2[0]; k1 = keep + __shfl_xor(send, 8); }
            k1 = red8(k1);
            if ((lane & 7) == 0) logits[(size_t)row * 8 + ((lane >> 5) & 1) * 4 + ((lane >> 4) & 1) * 2 + ((lane >> 3) & 1)] = k1 * rs;
        }
    }
    {
        const f32x4* src = (const f32x4*)p.in[1]; u32x2* dst = (u32x2*)(ws + WS_PB); const size_t n4 = (size_t)T_ * PLE_ / 4;
        for (size_t i = (size_t)blockIdx.x * NTHREADS + tid; i < n4; i += (size_t)gridDim.x * NTHREADS) { const f32x4 v = src[i]; u32x2 w; w.x = cvt_pk_bf16(v[0], v[1]); w.y = cvt_pk_bf16(v[2], v[3]); dst[i] = w; }
    }
}
__device__ __forceinline__ bf16x8 pack8(const f32x4 a, const f32x4 b) { u32x4 w; w.x = cvt_pk_bf16(a[0], a[1]); w.y = cvt_pk_bf16(a[2], a[3]); w.z = cvt_pk_bf16(b[0], b[1]); w.w = cvt_pk_bf16(b[2], b[3]); return __builtin_bit_cast(bf16x8, w); }
#define MFMA16(a, b, c) __builtin_amdgcn_mfma_f32_16x16x32_bf16((a), (b), (c), 0, 0, 0)
__device__ __forceinline__ float neg_expm1_small(float x, float ehalf) {
    const float ps = -x * (1.0f + x * (0.5f + x * (0.16666667f + x * (0.041666668f + x * (0.008333334f + x * 0.0013888889f)))));
    return (x > -0.25f) ? ps : (1.0f - ehalf * ehalf);
}
template <bool FINAL>
__device__ __forceinline__ void rg_pass_mfma(const Params& p, unsigned char* smem, int widx, int nworkers) {
    const int tid = threadIdx.x, wid = __builtin_amdgcn_readfirstlane(tid >> 6), lane = tid & 63, n16o = lane & 15, fqo = lane >> 4, c = wid * 64 + lane;
    unsigned char* ws = p.ws;
    const bf16_t* proj = (const bf16_t*)(ws + WS_PROJ);
    float* U = (float*)smem + wid * 4352;
    float* ptot = (float*)(ws + WS_PTOT); float* hend = (float*)(ws + WS_HEND); const float* carry = (const float*)(ws + WS_CARRY);
    bf16_t* y = (bf16_t*)(ws + WS_Y);
    bf16x8 Bx[4][2], Ba[4][2];
#pragma unroll
    for (int nt = 0; nt < 4; ++nt)
#pragma unroll
        for (int ks = 0; ks < 2; ++ks) { const unsigned char* fb = ws + WS_RGW + ((size_t)(wid * 16 + nt * 2 + ks) * 64 + lane) * 16;
            Bx[nt][ks] = *(const bf16x8*)fb; Ba[nt][ks] = *(const bf16x8*)(fb + 8 * 64 * 16); }
    const float cw0 = p.in[4][c], cw1 = p.in[4][512 + c], cw2 = p.in[4][1024 + c], cw3 = p.in[4][1536 + c], cb = p.in[5][c];
    float bxv[4], bav[4], spv[4];
#pragma unroll
    for (int nt = 0; nt < 4; ++nt) { const int cgl = wid * 64 + 16 * nt + n16o; bxv[nt] = p.in[7][cgl]; bav[nt] = p.in[9][cgl]; spv[nt] = softplusf_(-p.in[10][cgl]); }
    for (int unit = widx; unit < NB_ * NCH_; unit += nworkers) {
        const int n = unit & (NCH_ - 1); const size_t t0 = (size_t)unit * 64;
        float xm3 = 0.f, xm2 = 0.f, xm1 = 0.f;
        if (n != 0) { xm3 = bf2f(proj[(t0 - 3) * PJ_ + c]); xm2 = bf2f(proj[(t0 - 2) * PJ_ + c]); xm1 = bf2f(proj[(t0 - 1) * PJ_ + c]); }
        __syncthreads();
        { bf16_t xr[16]; const bf16_t* xp0 = proj + t0 * PJ_ + c;
#pragma unroll
          for (int i = 0; i < 16; ++i) xr[i] = xp0[(size_t)i * PJ_];
#pragma unroll
          for (int tb = 0; tb < 4; ++tb) { bf16_t xn[16]; const bf16_t* xp = proj + (t0 + (tb + 1) * 16) * PJ_ + c;
            if (tb < 3) {
#pragma unroll
                for (int i = 0; i < 16; ++i) xn[i] = xp[(size_t)i * PJ_]; }
#pragma unroll
            for (int i = 0; i < 16; ++i) { const float xv = bf2f(xr[i]); U[(16 * ((i >> 2) & 3) + 4 * tb + (i & 3)) * 68 + lane] = cw0 * xm3 + cw1 * xm2 + cw2 * xm1 + cw3 * xv + cb; xm3 = xm2; xm2 = xm1; xm1 = xv; }
            if (tb < 3) {
#pragma unroll
                for (int i = 0; i < 16; ++i) xr[i] = xn[i]; } } }
        __syncthreads();
        const bf16_t* gub = proj + t0 * PJ_ + 512; bf16_t* yub = y + t0 * D_;
#pragma unroll
        for (int nt = 0; nt < 4; ++nt) {
            asm volatile("" ::: "memory");
            int lane_o = lane; asm volatile("" : "+v"(lane_o));
            const int n16 = lane_o & 15, fq = lane_o >> 4;
            const int chl = 16 * nt + n16, cgl = wid * 64 + chl;
            bf16x8 Af[4][2];
#pragma unroll
            for (int mt = 0; mt < 4; ++mt)
#pragma unroll
                for (int ks = 0; ks < 2; ++ks) { const float* up = U + (16 * mt + n16) * 68 + 32 * ks + 8 * fq; Af[mt][ks] = pack8(*(const f32x4*)up, *(const f32x4*)(up + 4)); }

            bf16_t gr[16];
            if (FINAL) {
#pragma unroll
                for (int i = 0; i < 16; ++i) gr[i] = gub[(16 * fq + i) * PJ_ + cgl]; }
            f32x4 ax[4], aa[4];
#pragma unroll
            for (int mt = 0; mt < 4; ++mt) { ax[mt] = (f32x4){bxv[nt], bxv[nt], bxv[nt], bxv[nt]}; aa[mt] = (f32x4){bav[nt], bav[nt], bav[nt], bav[nt]}; }
#pragma unroll
            for (int mt = 0; mt < 4; ++mt)
#pragma unroll
                for (int ks = 0; ks < 2; ++ks) { ax[mt] = MFMA16(Af[mt][ks], Bx[nt][ks], ax[mt]); aa[mt] = MFMA16(Af[mt][ks], Ba[nt][ks], aa[mt]); }
            float av[16], bv[16]; float hl = 0.f, Pl = 1.f;
#pragma unroll
            for (int i = 0; i < 16; ++i) { const int mt = i >> 2, j = i & 3, tok = 16 * fq + i; const float u = U[(16 * mt + 4 * fq + j) * 68 + chl];
                const float gx = sigmoidf_(ax[mt][j]), gg = sigmoidf_(aa[mt][j]); const float la = -8.0f * gg * spv[nt]; const float a = __expf(la);
                float mult = sqrtf(fmaxf(neg_expm1_small(2.0f * la, a), 0.f)); if (n == 0 && tok == 0) mult = 1.0f;
                av[i] = a; bv[i] = u * gx * mult; hl = a * hl + bv[i]; Pl *= a; }
            float Pg[4], Hg[4];
#pragma unroll
            for (int g = 0; g < 4; ++g) { Pg[g] = __shfl(Pl, n16 + 16 * g); Hg[g] = __shfl(hl, n16 + 16 * g); }
            if (FINAL) {
                float h = carry[(size_t)unit * 512 + cgl];
#pragma unroll
                for (int g = 0; g < 3; ++g) if (g < fq) h = Pg[g] * h + Hg[g];
#pragma unroll
                for (int i = 0; i < 16; ++i) { h = av[i] * h + bv[i]; yub[(16 * fq + i) * D_ + cgl] = f2bf(h * gelu_tanhf_(bf2f(gr[i]))); }
            } else {
                float cc = 0.f, Pp = 1.f;
#pragma unroll
                for (int g = 0; g < 4; ++g) { cc = Pg[g] * cc + Hg[g]; Pp *= Pg[g]; }
                if (fq == 0) { ptot[(size_t)unit * 512 + cgl] = Pp; hend[(size_t)unit * 512 + cgl] = cc; }
            }
        }
    }
}

__device__ __forceinline__ void rg_carry(const Params& p, int idx) {
    unsigned char* ws = p.ws; const float* ptot = (const float*)(ws + WS_PTOT); const float* hend = (const float*)(ws + WS_HEND); float* carry = (float*)(ws + WS_CARRY);
    const int b = idx >> 9, c = idx & 511; float hc = 0.f;
    for (int n0 = 0; n0 < NCH_; n0 += 8) { float P[8], H[8];
#pragma unroll
        for (int i = 0; i < 8; ++i) { const size_t o = (size_t)(b * NCH_ + n0 + i) * 512 + c; P[i] = ptot[o]; H[i] = hend[o]; }
#pragma unroll
        for (int i = 0; i < 8; ++i) { const size_t o = (size_t)(b * NCH_ + n0 + i) * 512 + c; carry[o] = hc; hc = P[i] * hc + H[i]; } }
}

constexpr int GU_BYTES = 73728, GU_KDT = 32768, GU_QK = 49152, GU_U = 57344;
typedef float f32x2_ __attribute__((ext_vector_type(2)));
__device__ __forceinline__ int tok_of_pos(int p) { return 16 * (2 * (p >> 5) + ((p >> 2) & 1)) + 4 * ((p >> 3) & 3) + (p & 3); }
__device__ __forceinline__ void unpack8(const u32x4 w, float* f) { f[0] = __uint_as_float(w.x << 16); f[1] = __uint_as_float(w.x & 0xffff0000u); f[2] = __uint_as_float(w.y << 16); f[3] = __uint_as_float(w.y & 0xffff0000u);
    f[4] = __uint_as_float(w.z << 16); f[5] = __uint_as_float(w.z & 0xffff0000u); f[6] = __uint_as_float(w.w << 16); f[7] = __uint_as_float(w.w & 0xffff0000u); }

__device__ __forceinline__ void gdn_pass_a(const Params& p, unsigned char* smem) {
    const int tid = threadIdx.x, wid = __builtin_amdgcn_readfirstlane(tid >> 6);
    unsigned char* ws = p.ws; const bf16_t* proj = (const bf16_t*)(ws + WS_PROJ); const float* logits = (const float*)(ws + WS_LOGITS); float* gtot = (float*)(ws + WS_GTOT);
    bf16_t* Kb = (bf16_t*)smem; bf16_t* Qb = (bf16_t*)(smem + 17408); bf16_t* VBt = (bf16_t*)(smem + 34816); bf16_t* KBGt = (bf16_t*)(smem + 53248);
    float* Lsw = (float*)(smem + 71680); bf16_t* Tb = (bf16_t*)(smem + 89088); float* gcs = (float*)(smem + 98304); float* betas = gcs + 64; float* kdec = gcs + 128;
    const int lane0 = tid & 63, tg0 = tid >> 5, ch0 = (tid & 31) * 4;
    for (int ub = blockIdx.x * 8; ub < 2048; ub += gridDim.x * 8) {
        const int bh = ub >> 7, b = bh >> 2, h = bh & 3;
        const float Aexp = __expf(p.in[12][h]), dtb = p.in[13][h];
        float cw[3][4][4];
#pragma unroll
        for (int a = 0; a < 3; ++a)
#pragma unroll
            for (int j = 0; j < 4; ++j) { const f32x4 w = *(const f32x4*)(p.in[11] + (size_t)j * 1536 + a * 512 + h * 128 + ch0); cw[a][j][0] = w[0]; cw[a][j][1] = w[1]; cw[a][j][2] = w[2]; cw[a][j][3] = w[3]; }
        u32x2 pre[3][7]; float lgb, lga;
#define GA_PREFETCH(unit_) do { const int n_ = (unit_) & 127; const size_t t0_ = (size_t)b * SEQ_ + (size_t)n_ * 64; \
        lgb = logits[(t0_ + lane0) * 8 + h]; lga = logits[(t0_ + lane0) * 8 + 4 + h]; \
        _Pragma("unroll") for (int r = 0; r < 7; ++r) { const int sp_ = n_ * 64 + 4 * tg0 - 3 + r; \
            _Pragma("unroll") for (int a = 0; a < 3; ++a) pre[a][r] = (sp_ >= 0) ? *(const u32x2*)(proj + ((size_t)b * SEQ_ + sp_) * PJ_ + 1024 + a * 512 + h * 128 + ch0) : (u32x2){0u, 0u}; } } while (0)
        GA_PREFETCH(ub);
        for (int k = 0; k < 8; ++k) {
            const int unit = ub + k, n = unit & 127;
            int tid_o = tid; asm volatile("" : "+v"(tid_o));
            const int lane = tid_o & 63, r16 = lane & 15, kq = lane >> 4, cg4 = tid_o & 31, tg = tid_o >> 5, ch = cg4 * 4;
            unsigned char* gbase = ws + WS_R4 + (size_t)unit * GU_BYTES;
            const float betav = sigmoidf_(lgb);
            float gc = -Aexp * softplusf_(lga + dtb);
#pragma unroll
            for (int o = 1; o < 64; o <<= 1) { const float tmp = __shfl_up(gc, o); if (lane >= o) gc += tmp; }
            const float gclast = __shfl(gc, 63);
            if (wid == 0) { gcs[lane] = gc; betas[lane] = betav; kdec[lane] = __expf(gclast - gc); }
            {
                float x[7][4], o[4][4], bt[4], egt[4];
#pragma unroll
                for (int t = 0; t < 4; ++t) { bt[t] = __shfl(betav, 4 * tg + t); egt[t] = __expf(__shfl(gc, 4 * tg + t)); }
#pragma unroll
                for (int a = 0; a < 3; ++a) {
#pragma unroll
                    for (int r = 0; r < 7; ++r) { x[r][0] = __uint_as_float(pre[a][r].x << 16); x[r][1] = __uint_as_float(pre[a][r].x & 0xffff0000u); x[r][2] = __uint_as_float(pre[a][r].y << 16); x[r][3] = __uint_as_float(pre[a][r].y & 0xffff0000u); }
#pragma unroll
                    for (int t = 0; t < 4; ++t)
#pragma unroll
                        for (int e = 0; e < 4; ++e) { float acc = cw[a][0][e] * x[t][e]; acc += cw[a][1][e] * x[t + 1][e]; acc += cw[a][2][e] * x[t + 2][e]; acc += cw[a][3][e] * x[t + 3][e]; o[t][e] = siluf_(acc); }
                    if (a < 2) {
#pragma unroll
                        for (int t = 0; t < 4; ++t) { float ssq = (o[t][0] * o[t][0] + o[t][1] * o[t][1]) + (o[t][2] * o[t][2] + o[t][3] * o[t][3]);
                            ssq += dpp_f<0xB1>(ssq); ssq += dpp_f<0x4E>(ssq); ssq += dpp_f<0x141>(ssq); ssq += dpp_f<0x140>(ssq); ssq += __shfl_xor(ssq, 16);
                            const float rs = rsqrtf(ssq + EPS_) * (a == 0 ? 0.08838834764831845f : 1.0f);
#pragma unroll
                            for (int e = 0; e < 4; ++e) o[t][e] *= rs; }
                    }
                    if (a == 0) {
#pragma unroll
                        for (int t = 0; t < 4; ++t) { const int tok = 4 * tg + t; u32x2 w; w.x = cvt_pk_bf16(o[t][0], o[t][1]); w.y = cvt_pk_bf16(o[t][2], o[t][3]); *(u32x2*)(Qb + tok * 136 + ch) = w;
                            u32x2 wd; wd.x = cvt_pk_bf16(o[t][0] * egt[t], o[t][1] * egt[t]); wd.y = cvt_pk_bf16(o[t][2] * egt[t], o[t][3] * egt[t]);
                            *(u32x2*)((bf16_t*)gbase + (size_t)(64 + tok) * 128 + 32 * (cg4 >> 3) + 8 * (cg4 & 3) + 4 * ((cg4 >> 2) & 1)) = wd; }
                    } else if (a == 1) {
#pragma unroll
                        for (int t = 0; t < 4; ++t) { const int tok = 4 * tg + t; u32x2 w; w.x = cvt_pk_bf16(o[t][0], o[t][1]); w.y = cvt_pk_bf16(o[t][2], o[t][3]); *(u32x2*)(Kb + tok * 136 + ch) = w; }
#pragma unroll
                        for (int e = 0; e < 4; ++e) { u32x2 w; w.x = cvt_pk_bf16(o[0][e] * bt[0] * egt[0], o[1][e] * bt[1] * egt[1]); w.y = cvt_pk_bf16(o[2][e] * bt[2] * egt[2], o[3][e] * bt[3] * egt[3]); *(u32x2*)(KBGt + (ch + e) * 72 + (((tg >> 1) ^ (cg4 & 7)) << 3) + 4 * (tg & 1)) = w; }
                    } else {
#pragma unroll
                        for (int e = 0; e < 4; ++e) { u32x2 w; w.x = cvt_pk_bf16(o[0][e] * bt[0], o[1][e] * bt[1]); w.y = cvt_pk_bf16(o[2][e] * bt[2], o[3][e] * bt[3]); *(u32x2*)(VBt + (ch + e) * 72 + (((tg >> 1) ^ (cg4 & 7)) << 3) + 4 * (tg & 1)) = w; }
                    }
                }
            }
            if (k + 1 < 8) GA_PREFETCH(unit + 1);
            __syncthreads();
#pragma unroll
            for (int rep = 0; rep < 2; ++rep) {
                const int tl = wid + 8 * rep, jt = tl >> 2, it = tl & 3;
                f32x4 accQ = {0.f, 0.f, 0.f, 0.f}, accK = {0.f, 0.f, 0.f, 0.f};
#pragma unroll
                for (int ks = 0; ks < 4; ++ks) { const bf16x8 a = *(const bf16x8*)(Kb + (16 * jt + r16) * 136 + 32 * ks + 8 * kq);
                    const bf16x8 bq = *(const bf16x8*)(Qb + (16 * it + r16) * 136 + 32 * ks + 8 * kq), bk = *(const bf16x8*)(Kb + (16 * it + r16) * 136 + 32 * ks + 8 * kq);
                    accQ = MFMA16(a, bq, accQ); accK = MFMA16(a, bk, accK); }
                const int i = 16 * it + r16; const float gi = gcs[i], bi = betas[i]; float qv[4];
#pragma unroll
                for (int jj = 0; jj < 4; ++jj) { const int j = 16 * jt + 4 * kq + jj; const float d = __expf(fminf(gi - gcs[j], 0.f));
                    qv[jj] = (i >= j) ? accQ[jj] * d : 0.f; Lsw[i * 68 + (j & 7) * 8 + (j >> 3)] = (i > j) ? bi * accK[jj] * d : 0.f; }
                u32x2 w; w.x = cvt_pk_bf16(qv[0], qv[1]); w.y = cvt_pk_bf16(qv[2], qv[3]);
                *(u32x2*)((bf16_t*)(gbase + GU_QK) + i * 64 + 32 * (jt >> 1) + 8 * kq + 4 * (jt & 1)) = w;
            }
            __syncthreads();
            {
                const int s = lane & 7, c = 8 * wid + (lane >> 3); float t[8];
#pragma unroll
                for (int m = 0; m < 8; ++m) t[m] = 0.f;
                f32x4 la[2][2]; la[0][0] = *(const f32x4*)(Lsw + s * 8); la[0][1] = *(const f32x4*)(Lsw + s * 8 + 4);
#pragma unroll
                for (int i = 0; i < 64; ++i) {
                    if (i + 1 < 64) { la[(i + 1) & 1][0] = *(const f32x4*)(Lsw + (i + 1) * 68 + s * 8); la[(i + 1) & 1][1] = *(const f32x4*)(Lsw + (i + 1) * 68 + s * 8 + 4); }
                    asm volatile("" ::: "memory");
                    const f32x4 l0 = la[i & 1][0], l1 = la[i & 1][1];
                    float part = 0.f;
#pragma unroll
                    for (int m = 0; m < 8; ++m) if (8 * m <= i) part += ((m < 4) ? l0[m & 3] : l1[m & 3]) * t[m];
                    part = red8(part);
                    const float val = ((i == c) ? 1.0f : 0.0f) - part;
                    if (s == (i & 7)) t[i >> 3] = val;
                }
#pragma unroll
                for (int m = 0; m < 8; ++m) Tb[(8 * m + s) * 72 + c] = f2bf(t[m]);
            }
            __syncthreads();
            {
#pragma unroll
                for (int mt = 0; mt < 4; ++mt) { f32x4 acc = {0.f, 0.f, 0.f, 0.f};
#pragma unroll
                    for (int ks = 0; ks < 2; ++ks) { const bf16x8 a = *(const bf16x8*)(Tb + (16 * mt + r16) * 72 + 32 * ks + 8 * kq), bb = *(const bf16x8*)(VBt + (16 * wid + r16) * 72 + (((4 * ks + kq) ^ ((4 * wid + (r16 >> 2)) & 7)) << 3)); acc = MFMA16(a, bb, acc); }
                    u32x2 w; w.x = cvt_pk_bf16(acc[0], acc[1]); w.y = cvt_pk_bf16(acc[2], acc[3]);
                    *(u32x2*)((bf16_t*)(gbase + GU_U) + ((wid * 4 + mt) * 64 + lane) * 4) = w; }
#pragma unroll
                for (int it = 0; it < 4; ++it) { f32x4 acc = {0.f, 0.f, 0.f, 0.f};
#pragma unroll
                    for (int ks = 0; ks < 2; ++ks) { const bf16x8 a = *(const bf16x8*)(KBGt + (16 * wid + r16) * 72 + (((4 * ks + kq) ^ ((4 * wid + (r16 >> 2)) & 7)) << 3)), bb = *(const bf16x8*)(Tb + (16 * it + r16) * 72 + 32 * ks + 8 * kq); acc = MFMA16(a, bb, acc); }
                    u32x2 w; w.x = cvt_pk_bf16(acc[0], acc[1]); w.y = cvt_pk_bf16(acc[2], acc[3]);
                    *(u32x2*)((bf16_t*)gbase + (16 * it + r16) * 128 + 32 * (wid >> 1) + 8 * kq + 4 * (wid & 1)) = w; }
                const int dk = tid_o >> 2, pg = tid_o & 3; float v[16];
#pragma unroll
                for (int e = 0; e < 16; ++e) { const int tk = tok_of_pos(16 * pg + e); v[e] = bf2f(Kb[tk * 136 + dk]) * kdec[tk]; }
                u32x4 w0, w1; w0.x = cvt_pk_bf16(v[0], v[1]); w0.y = cvt_pk_bf16(v[2], v[3]); w0.z = cvt_pk_bf16(v[4], v[5]); w0.w = cvt_pk_bf16(v[6], v[7]);
                w1.x = cvt_pk_bf16(v[8], v[9]); w1.y = cvt_pk_bf16(v[10], v[11]); w1.z = cvt_pk_bf16(v[12], v[13]); w1.w = cvt_pk_bf16(v[14], v[15]);
                *(u32x4*)((bf16_t*)(gbase + GU_KDT) + dk * 64 + 16 * pg) = w0; *(u32x4*)((bf16_t*)(gbase + GU_KDT) + dk * 64 + 16 * pg + 8) = w1;
                if (tid == 0) gtot[unit] = __expf(gclast);
            }
            __syncthreads();
        }
    }
#undef GA_PREFETCH
}

constexpr int GB_BUF = 62464, GB_KDT = 34816, GB_QK = 53248, GB_BUF2 = GB_BUF + 4096 + 16;
__device__ __forceinline__ void gdn_pass_b(const Params& p, unsigned char* smem, int wg) {
    const int tid = threadIdx.x, wid = __builtin_amdgcn_readfirstlane(tid >> 6), lane = tid & 63, r16 = lane & 15, kq = lane >> 4;
    const int bh = wg >> 2, cgp = wg & 3, b = bh >> 2, h = bh & 3, nt = cgp * 2 + wid;
    unsigned char* ws = p.ws; const unsigned char* ubase = ws + WS_R4 + (size_t)(bh * 128) * GU_BYTES; const float* gtot = (const float*)(ws + WS_GTOT) + bh * 128;
    bf16_t* oraw = (bf16_t*)(ws + WS_ORAW);
#define GB_BAR() do { asm volatile("s_waitcnt lgkmcnt(0)" ::: "memory"); __builtin_amdgcn_s_barrier(); asm volatile("" ::: "memory"); } while (0)
    if (wid >= 2) {
        const int lt = tid - 128;
        int dsto[10]; size_t srco[10];
#pragma unroll
        for (int it = 0; it < 10; ++it) { const int q = lt + 384 * it;
            dsto[it] = (q < 2048) ? (q >> 4) * 272 + (q & 15) * 16 : (q < 3072) ? GB_KDT + ((q - 2048) >> 3) * 144 + ((q - 2048) & 7) * 16 : (q < 3584) ? GB_QK + ((q - 3072) >> 3) * 144 + ((q - 3072) & 7) * 16 : GB_BUF + (q - 3584) * 16;
            srco[it] = (q < 3584) ? (size_t)q * 16 : (size_t)(GU_U + cgp * 4096 + (q - 3584) * 16); }
        u32x4 sa[10], sb[10], sc[10]; float ga = 0.f, gb = 0.f, gc = 0.f;
#define GB_LD(st, g, n_) do { const unsigned char* rp_ = ubase + (size_t)(n_) * GU_BYTES; _Pragma("unroll") for (int it = 0; it < 10; ++it) st[it] = *(const u32x4*)(rp_ + srco[it]); if (lt == 0) g = gtot[n_]; } while (0)
#define GB_WR(st, g, bufi) do { unsigned char* bp_ = smem + (bufi) * GB_BUF2; _Pragma("unroll") for (int it = 0; it < 10; ++it) *(u32x4*)(bp_ + dsto[it]) = st[it]; if (lt == 0) *(float*)(bp_ + GB_BUF + 4096) = g; } while (0)
        GB_LD(sa, ga, 0); GB_WR(sa, ga, 0); GB_BAR();
        GB_LD(sa, ga, 1); GB_LD(sb, gb, 2); GB_LD(sc, gc, 3);
        for (int n0 = 0; n0 < NCH_; n0 += 3) {
            { const int n = n0;     if (n < NCH_) { if (n + 1 < NCH_) GB_WR(sa, ga, (n + 1) & 1); if (n + 4 < NCH_) GB_LD(sa, ga, n + 4); GB_BAR(); } }
            { const int n = n0 + 1; if (n < NCH_) { if (n + 1 < NCH_) GB_WR(sb, gb, (n + 1) & 1); if (n + 4 < NCH_) GB_LD(sb, gb, n + 4); GB_BAR(); } }
            { const int n = n0 + 2; if (n < NCH_) { if (n + 1 < NCH_) GB_WR(sc, gc, (n + 1) & 1); if (n + 4 < NCH_) GB_LD(sc, gc, n + 4); GB_BAR(); } }
        }
#undef GB_LD
#undef GB_WR
    } else {
        f32x4 S[8]; bf16x8 Sb[4];
#pragma unroll
        for (int d = 0; d < 8; ++d) S[d] = (f32x4){0.f, 0.f, 0.f, 0.f};
#pragma unroll
        for (int k = 0; k < 4; ++k) Sb[k] = (bf16x8){0, 0, 0, 0, 0, 0, 0, 0};
        GB_BAR();
        for (int n = 0; n < NCH_; ++n) {
            const unsigned char* L = smem + (n & 1) * GB_BUF2; const float gt = *(const float*)(L + GB_BUF + 4096); const size_t t0 = (size_t)b * SEQ_ + (size_t)n * 64;
            u32x2 uw[4];
#pragma unroll
            for (int tt = 0; tt < 4; ++tt) uw[tt] = *(const u32x2*)(L + GB_BUF + ((wid * 4 + tt) * 64 + lane) * 8);
            f32x4 P[8];
#pragma unroll
            for (int m = 0; m < 8; ++m) P[m] = (f32x4){0.f, 0.f, 0.f, 0.f};
#pragma unroll
            for (int ks = 0; ks < 4; ++ks)
#pragma unroll
                for (int mt = 0; mt < 8; ++mt) { const bf16x8 a = *(const bf16x8*)(L + (16 * mt + r16) * 272 + (32 * ks + 8 * kq) * 2); P[mt] = MFMA16(a, Sb[ks], P[mt]); }
            f32x4 vn[4];
#pragma unroll
            for (int tt = 0; tt < 4; ++tt) { const f32x4 u = {__uint_as_float(uw[tt].x << 16), __uint_as_float(uw[tt].x & 0xffff0000u), __uint_as_float(uw[tt].y << 16), __uint_as_float(uw[tt].y & 0xffff0000u)}; vn[tt] = u - P[tt]; }
            bf16x8 Vb[2]; Vb[0] = pack8(vn[0], vn[1]); Vb[1] = pack8(vn[2], vn[3]);
#pragma unroll
            for (int tt = 0; tt < 4; ++tt) { f32x4 O = P[4 + tt];
#pragma unroll
                for (int ks = 0; ks < 2; ++ks) { const bf16x8 a = *(const bf16x8*)(L + GB_QK + (16 * tt + r16) * 144 + (32 * ks + 8 * kq) * 2); O = MFMA16(a, Vb[ks], O); }
                bf16_t* op = oraw + (t0 + 16 * tt + 4 * kq) * 512 + h * 128 + 16 * nt + r16;
#pragma unroll
                for (int j = 0; j < 4; ++j) op[(size_t)j * 512] = f2bf(O[j]); }
#pragma unroll
            for (int dt = 0; dt < 8; ++dt) { f32x4 acc = S[dt] * gt;
#pragma unroll
                for (int ks = 0; ks < 2; ++ks) { const bf16x8 a = *(const bf16x8*)(L + GB_KDT + (16 * dt + r16) * 144 + (32 * ks + 8 * kq) * 2); acc = MFMA16(a, Vb[ks], acc); }
                S[dt] = acc; }
#pragma unroll
            for (int ks = 0; ks < 4; ++ks) Sb[ks] = pack8(S[2 * ks], S[2 * ks + 1]);
            GB_BAR();
        }
    }
#undef GB_BAR
}

__device__ __forceinline__ void gdn_norm(const Params& p) {
    unsigned char* ws = p.ws; const bf16_t* oraw = (const bf16_t*)(ws + WS_ORAW); const bf16_t* proj = (const bf16_t*)(ws + WS_PROJ); bf16_t* y = (bf16_t*)(ws + WS_Y);
    int tid_o = threadIdx.x; asm volatile("" : "+v"(tid_o));
    const int gtid = blockIdx.x * NTHREADS + tid_o, sub = gtid & 31; const f32x4 nwv = *(const f32x4*)(p.in[14] + sub * 4);
    const int stride = (gridDim.x * NTHREADS) >> 5;
    for (int item0 = gtid >> 5; item0 < T_ * 4; item0 += 4 * stride) {
        u32x2 ow[4], zw[4];
#pragma unroll
        for (int q = 0; q < 4; ++q) { const int item = item0 + q * stride; const int t = item >> 2, h = item & 3;
            if (item < T_ * 4) { ow[q] = *(const u32x2*)(oraw + (size_t)t * 512 + h * 128 + sub * 4); zw[q] = *(const u32x2*)(proj + (size_t)t * PJ_ + 2560 + h * 128 + sub * 4); } else { ow[q] = (u32x2){0u, 0u}; zw[q] = (u32x2){0u, 0u}; } }
#pragma unroll
        for (int q = 0; q < 4; ++q) { const int item = item0 + q * stride; const int t = item >> 2, h = item & 3;
            const f32x4 ov = {__uint_as_float(ow[q].x << 16), __uint_as_float(ow[q].x & 0xffff0000u), __uint_as_float(ow[q].y << 16), __uint_as_float(ow[q].y & 0xffff0000u)};
            float s = (ov[0] * ov[0] + ov[1] * ov[1]) + (ov[2] * ov[2] + ov[3] * ov[3]);
#pragma unroll
            for (int o = 1; o < 32; o <<= 1) s += __shfl_xor(s, o);
            const float rs = rsqrtf(s * (1.0f / 128.0f) + EPS_);
            const float z0 = __uint_as_float(zw[q].x << 16), z1 = __uint_as_float(zw[q].x & 0xffff0000u), z2 = __uint_as_float(zw[q].y << 16), z3 = __uint_as_float(zw[q].y & 0xffff0000u);
            u32x2 w; w.x = cvt_pk_bf16(ov[0] * rs * nwv[0] * siluf_(z0), ov[1] * rs * nwv[1] * siluf_(z1)); w.y = cvt_pk_bf16(ov[2] * rs * nwv[2] * siluf_(z2), ov[3] * rs * nwv[3] * siluf_(z3));
            if (item < T_ * 4) *(u32x2*)(y + (size_t)t * D_ + 512 + h * 128 + sub * 4) = w; }
    }
}

__device__ __forceinline__ void phase_final(const Params& p) {
    const int tid = threadIdx.x, wid = __builtin_amdgcn_readfirstlane(tid >> 6), lane = tid & 63;
    const float* ss = (const float*)(p.ws + WS_SSA); const float* nw = p.in[24]; float* out = p.out; const bf16_t* x3b = (const bf16_t*)(p.ws + WS_XB);
    f32x4 nwv[4];
#pragma unroll
    for (int i = 0; i < 4; ++i) nwv[i] = *(const f32x4*)(nw + 4 * (lane + 64 * i));
    u32x2 wn[4]; int row = blockIdx.x * 8 + wid;
    if (row < T_) {
#pragma unroll
        for (int i = 0; i < 4; ++i) wn[i] = *(const u32x2*)(x3b + (size_t)row * D_ + 4 * (lane + 64 * i)); }
    for (; row < T_; row += gridDim.x * 8) {
        const float rs = rstd16(ss, row);
        u32x2 wc[4];
#pragma unroll
        for (int i = 0; i < 4; ++i) wc[i] = wn[i];
        { const int nrow = row + gridDim.x * 8;
          if (nrow < T_) {
#pragma unroll
            for (int i = 0; i < 4; ++i) wn[i] = *(const u32x2*)(x3b + (size_t)nrow * D_ + 4 * (lane + 64 * i)); } }
#pragma unroll
        for (int i = 0; i < 4; ++i) { const u32x2 w = wc[i]; const f32x4 v = {__uint_as_float(w.x << 16), __uint_as_float(w.x & 0xffff0000u), __uint_as_float(w.y << 16), __uint_as_float(w.y & 0xffff0000u)};
            *(f32x4*)(out + (size_t)row * D_ + 4 * (lane + 64 * i)) = v * rs * nwv[i]; }
    }
}

constexpr int NPHASES = 11;
__global__ void __launch_bounds__(NTHREADS, 2) mega_fwd(Params p) {
    extern __shared__ __attribute__((aligned(16))) unsigned char smem[];
    PG8_LAS unsigned char* lds = (PG8_LAS unsigned char*)smem;
    cg::grid_group grid = cg::this_grid();
    unsigned char* ws = p.ws;
    bf16_t* hb = (bf16_t*)(ws + WS_XB); bf16_t* xb = (bf16_t*)(ws + WS_XB2); bf16_t* proj = (bf16_t*)(ws + WS_PROJ); bf16_t* ff = proj; bf16_t* y = (bf16_t*)(ws + WS_Y); bf16_t* pp = (bf16_t*)p.out;
    float* ssA = (float*)(ws + WS_SSA); float* ssB = (float*)(ws + WS_SSB);
#ifdef ONLY_PHASE
#define PH_ON(n) ((n) == ONLY_PHASE)
#else
#define PH_ON(n) ((n) >= p.ph_lo && (n) < p.ph_hi)
#endif
    volatile LAS unsigned* xst = (volatile LAS unsigned*)(lds + LDS_BYTES - 16);
    if (threadIdx.x == 0) { xst[0] = 0u; xst[1] = 0u; xst[2] = 0u; xst[3] = 0u; }
    __syncthreads();
    const XcdBarrier xbar = xcd_barrier_post((unsigned*)(ws + WS_BAR), xst);
    if (p.ph_lo == 0x7fffffff) grid.sync();
#define PH_SYNC(n) do { if ((n) > p.ph_lo && (n) < p.ph_hi) { xcd_barrier(xbar); } } while (0)
    if (PH_ON(0)) phase_prep(p, smem);
    PH_SYNC(1);
    if (PH_ON(1)) { EpiBf16Plain E; E.O = proj; E.ldc = PJ_; run_gemm(lds, hb, (const bf16_t*)(ws + WS_WIN), T_, PJ_, D_, E); }
    PH_SYNC(2);
    if (PH_ON(2)) { rg_pass_mfma<false>(p, smem, (int)blockIdx.x, (int)gridDim.x); __syncthreads(); gdn_pass_a(p, smem); }
    PH_SYNC(3);
    if (PH_ON(3)) {
        unsigned* flag = (unsigned*)ws + 16;
        if (blockIdx.x < 64) { const int xq = blockIdx.x & 7, kq8 = blockIdx.x >> 3;
            gdn_pass_b(p, smem, ((xq + 8 * (kq8 >> 2)) << 2) | (kq8 & 3)); }
        else {
            if (blockIdx.x < 68) { rg_carry(p, (blockIdx.x - 64) * NTHREADS + threadIdx.x); __threadfence(); __syncthreads();
                if (threadIdx.x == 0) __hip_atomic_fetch_add(flag, 1u, __ATOMIC_RELEASE, __HIP_MEMORY_SCOPE_AGENT); }
            prep_weights_late(p, smem, (int)blockIdx.x - 64, (int)gridDim.x - 64);
            if (threadIdx.x == 0) { while (__hip_atomic_load(flag, __ATOMIC_ACQUIRE, __HIP_MEMORY_SCOPE_AGENT) < 4u) __builtin_amdgcn_s_sleep(8); }
            __syncthreads(); __threadfence();
            rg_pass_mfma<true>(p, smem, (int)blockIdx.x - 64, (int)gridDim.x - 64);
            __syncthreads();
            { EpiBf16Plain E2; E2.O = pp; E2.ldc = D_; pg8::Gemm g2; g2.A = (const bf16_t*)(ws + WS_PB); g2.Bt = (const bf16_t*)(ws + WS_WPP); g2.M = T_; g2.N = D_; g2.K = PLE_;
              pg8::StaticOrder S2; S2.init(T_, D_, (int)gridDim.x - 64, (int)blockIdx.x - 64); pg8::gemm_phase<EpiBf16Plain, pg8::StaticOrder, GEMM_ALIGN, GEMM_SP2>(lds, g2, S2, E2); }
        }
    }
    PH_SYNC(4);
    if (PH_ON(4)) gdn_norm(p);
    PH_SYNC(5);
    if (PH_ON(5)) { EpiResid<false> E; E.res = p.in[0]; E.xb = xb; E.ss = ssA; run_gemm(lds, y, (const bf16_t*)(ws + WS_WOUT), T_, D_, D_, E); }
    PH_SYNC(6);
    if (PH_ON(6)) { EpiGateUp E; E.ff = ff; E.ss = ssA; run_gemm(lds, xb, (const bf16_t*)(ws + WS_WGU), T_, 2 * FF_, D_, E); }
    PH_SYNC(7);
    if (PH_ON(7)) { EpiResid<true> E; E.res = nullptr; E.xb = xb; E.ss = ssB; run_gemm(lds, ff, (const bf16_t*)(ws + WS_WD), T_, D_, FF_, E); }
    PH_SYNC(8);
    if (PH_ON(8)) { EpiPle E; E.x2b = xb; E.x3b = hb; E.pp = pp; E.bias = p.in[22]; E.ss_in = ssB; E.ss_out = ssA; run_gemm(lds, xb, (const bf16_t*)(ws + WS_WPG), T_, D_, D_, E); }
    PH_SYNC(9);
    if (PH_ON(9)) phase_final(p);
}

extern "C" void kernel_launch(void* const* d_in, const int* in_sizes, int n_in, void* d_out, int out_size, void* d_ws, size_t ws_size, hipStream_t stream) {
    static int grid = 0;
    if (grid == 0) {
        if (n_in != 25 || out_size != T_ * D_ || ws_size < WS_END) { fprintf(stderr, "kernel_launch: unexpected shapes: n_in %d out %d ws %zu (need %zu)\n", n_in, out_size, ws_size, (size_t)WS_END); grid = -1; return; }
        int dev = 0, cus = 0, per_cu = 0;
        hipGetDevice(&dev); hipDeviceGetAttribute(&cus, hipDeviceAttributeMultiprocessorCount, dev);
        if (hipFuncSetAttribute((const void*)mega_fwd, hipFuncAttributeMaxDynamicSharedMemorySize, LDS_BYTES) != hipSuccess) { fprintf(stderr, "kernel_launch: hipFuncSetAttribute failed\n"); grid = -1; return; }
        if (hipOccupancyMaxActiveBlocksPerMultiprocessor(&per_cu, (const void*)mega_fwd, NTHREADS, LDS_BYTES) != hipSuccess || per_cu < 1) { fprintf(stderr, "kernel_launch: occupancy query says %d\n", per_cu); per_cu = 1; }
        (void)hipGetLastError();
        grid = cus * 1;
        if (grid <= 0) grid = 256;
    }
    if (grid < 0) return;
    Params p{};
    for (int i = 0; i < 25; ++i) p.in[i] = (const float*)d_in[i];
    p.out = (float*)d_out; p.ws = (unsigned char*)d_ws; p.ph_lo = 0; p.ph_hi = NPHASES;
    if (hipMemsetAsync((char*)d_ws + WS_BAR, 0, XCD_BAR_WORDS * 4, stream) != hipSuccess) { fprintf(stderr, "kernel_launch: memset of the barrier words failed\n"); return; }
    void* args[] = {&p};
    hipError_t e = hipLaunchCooperativeKernel((const void*)mega_fwd, dim3(grid), dim3(NTHREADS), args, LDS_BYTES, stream);
    if (e != hipSuccess) fprintf(stderr, "cooperative launch failed: %s (grid %d)\n", hipGetErrorString(e), grid);
}
```

```cpp
#include <hip/hip_runtime.h>
#include <hip/hip_cooperative_groups.h>
#include <cstdio>
#include <cstdint>
namespace cg = cooperative_groups;
namespace pg8 {
#define PG8_LAS __attribute__((address_space(3)))
typedef unsigned short bf16_t;
typedef short bf16x8 __attribute__((ext_vector_type(8)));
typedef float f32x4 __attribute__((ext_vector_type(4)));
typedef unsigned u32x4 __attribute__((ext_vector_type(4)));
constexpr int BM = 256, BK = 64, HALF = 128, HTB = HALF * BK * 2  , STAGE_BYTES = 8 * HTB, NXCD = 8, WGM = 8;

__host__ __device__ __forceinline__ int lds_byte(int r, int c) { const int st = (r >> 4) * 2 + (c >> 5), rr = r & 15, cc = c & 31, ob = rr * 64 + cc * 2; return st * 1024 + (ob ^ (((ob >> 9) & 1) << 5)); }
__host__ __device__ __forceinline__ void stage_rc(int b, int& R, int& C) { const int st = b / 1024, sb = b % 1024, swz = sb ^ (((sb >> 9) & 1) << 5); R = (st >> 1) * 16 + swz / 64; C = (st & 1) * 32 + (swz % 64) / 2; }
__host__ __device__ __forceinline__ int perm32(int rho) { const int n = rho >> 4, i = rho & 15; return 8 * (i >> 2) + 4 * n + (i & 3); }

struct Unit { int pm, pn; };
struct Gemm { const bf16_t* A; const bf16_t* Bt; int M, N, K; };

struct StaticOrder {
    int nM, nN, nwg, G, c;
    __host__ __device__ void init(int M, int N, int G_, int c_) { nM = M / BM; nN = N / BM; nwg = nM * nN; G = G_; c = c_; }
    __host__ __device__ bool next(int i, Unit& u) const {
        const long L = (long)i * G + c; if (L >= nwg) return false;
        int wgid = (int)L; { const int q = nwg / NXCD, r = nwg % NXCD, xcd = wgid % NXCD, off = wgid / NXCD; wgid = (xcd < r ? xcd * (q + 1) : r * (q + 1) + (xcd - r) * q) + off; }
        const int nig = WGM * nN, gid = wgid / nig, fm = gid * WGM, gsz = (nM - fm) < WGM ? (nM - fm) : WGM;
        u.pm = fm + ((wgid % nig) % gsz); u.pn = (wgid % nig) / gsz; return true;
    }
    __device__ __forceinline__ void a_ready(const Unit&) const {}
    __device__ __forceinline__ void done(const Unit&) const {}
};
typedef __bf16 bf16v2_ __attribute__((ext_vector_type(2)));
typedef float f32v2_ __attribute__((ext_vector_type(2)));
__device__ __forceinline__ unsigned cvt_pk_bf16(float lo, float hi) { f32v2_ v = {lo, hi}; bf16v2_ b = __builtin_convertvector(v, bf16v2_); return __builtin_bit_cast(unsigned, b); }
typedef float f32x2 __attribute__((ext_vector_type(2)));
template <class Epi, class Sched, bool ALIGN_EPI = false, bool SP2 = false>
__device__ __forceinline__ void gemm_phase(PG8_LAS unsigned char* lds, const Gemm g, const Sched& S, const Epi& E) {
    int tid = threadIdx.x; asm volatile("" : "+v"(tid));
    const int wid = __builtin_amdgcn_readfirstlane(tid >> 6), lane = tid & 63, wr = wid >> 2, wc = wid & 3, fr = lane & 15, fq = lane >> 4;
    const int K = g.K, nt = K / BK;
    unsigned voffA[2], voffB[2];
#pragma unroll
    for (int i = 0; i < 2; ++i) { int R, C; stage_rc(tid * 16 + i * 8192, R, C); const int Rb = Epi::PERM ? ((R & ~31) + perm32(R & 31)) : R;
        voffA[i] = (unsigned)(R * K + C) * 2u; voffB[i] = (unsigned)(Rb * K + C) * 2u; }
    const size_t kstep = (size_t)(BK * 2);
    const size_t hstep = (size_t)HALF * K * 2;
    const size_t tstep = 2 * hstep;
    const unsigned ldsw = (unsigned)wid * 1024u;
    const int aoff = lds_byte(wr * 64 + fr, fq * 8), boff = lds_byte(wc * 32 + fr, fq * 8);
#define PG8_SA(b, h) (((b) * 2 + (h)) * HTB)
#define PG8_SB(b, h) ((4 + (b) * 2 + (h)) * HTB)
#define PG8_STAGE(bufoff, gbase, voff) do { _Pragma("unroll") for (int _i = 0; _i < 2; ++_i) \
        __builtin_amdgcn_global_load_lds((const unsigned*)((const char*)(gbase) + (voff)[_i]), (PG8_LAS unsigned*)(lds + (bufoff) + ldsw + _i * 8192), 16, 0, 0); } while (0)
#define PG8_LDA(dst, b, h) do { _Pragma("unroll") for (int m = 0; m < 4; ++m) _Pragma("unroll") for (int k = 0; k < 2; ++k) dst[m][k] = *(const PG8_LAS bf16x8*)(lds + PG8_SA(b, h) + aoff + m * 2048 + k * 1024); } while (0)
#define PG8_LDB(dst, b, h) do { _Pragma("unroll") for (int n = 0; n < 2; ++n) _Pragma("unroll") for (int k = 0; k < 2; ++k) dst[n][k] = *(const PG8_LAS bf16x8*)(lds + PG8_SB(b, h) + boff + n * 2048 + k * 1024); } while (0)
#define PG8_MMA(ai, bj, At, Bt) do { __builtin_amdgcn_s_setprio(1); _Pragma("unroll") for (int m = 0; m < 4; ++m) _Pragma("unroll") for (int n = 0; n < 2; ++n) _Pragma("unroll") for (int k = 0; k < 2; ++k) \
        acc[ai][bj][m][n] = __builtin_amdgcn_mfma_f32_16x16x32_bf16(Bt[n][k], At[m][k], acc[ai][bj][m][n], 0, 0, 0); __builtin_amdgcn_s_setprio(0); } while (0)
#define PG8_WAIT_V(n) asm volatile("s_waitcnt vmcnt(" #n ")" ::: "memory")
#define PG8_WAIT_L(n) asm volatile("s_waitcnt lgkmcnt(" #n ")" ::: "memory")
#define PG8_BAR __builtin_amdgcn_s_barrier()
#define PG8_SCHED __builtin_amdgcn_sched_barrier(0)
    Unit cur, nxt; int ui = 0;
    if (!S.next(0, cur)) return;
    f32x4 acc[2][2][4][2];
#pragma unroll
    for (int a = 0; a < 2; ++a)
#pragma unroll
        for (int b = 0; b < 2; ++b)
#pragma unroll
            for (int m = 0; m < 4; ++m)
#pragma unroll
                for (int n = 0; n < 2; ++n) acc[a][b][m][n] = (f32x4){0.f, 0.f, 0.f, 0.f};
    bf16x8 At[4][2], B0[2][2], B1[2][2];
    const char* cA = (const char*)g.A + (size_t)cur.pm * tstep; const char* cB = (const char*)g.Bt + (size_t)cur.pn * tstep;
    S.a_ready(cur);
    if constexpr (SP2) {
        PG8_STAGE(PG8_SB(0, 0), cB, voffB); PG8_STAGE(PG8_SB(0, 1), cB + hstep, voffB); PG8_STAGE(PG8_SA(0, 0), cA, voffA); PG8_STAGE(PG8_SA(0, 1), cA + hstep, voffA);
        if (wr == 1) PG8_BAR;
        PG8_WAIT_V(2); PG8_BAR;
        PG8_STAGE(PG8_SB(1, 0), cB + kstep, voffB); PG8_STAGE(PG8_SA(1, 0), cA + kstep, voffA); PG8_STAGE(PG8_SB(1, 1), cB + hstep + kstep, voffB);
        PG8_WAIT_V(6); PG8_BAR;
    } else {
        PG8_STAGE(PG8_SB(0, 0), cB, voffB); PG8_STAGE(PG8_SA(0, 0), cA, voffA); PG8_STAGE(PG8_SB(0, 1), cB + hstep, voffB); PG8_STAGE(PG8_SA(0, 1), cA + hstep, voffA);
        if (wr == 1) PG8_BAR;
        PG8_WAIT_V(4); PG8_BAR;
        PG8_STAGE(PG8_SB(1, 0), cB + kstep, voffB); PG8_STAGE(PG8_SA(1, 0), cA + kstep, voffA); PG8_STAGE(PG8_SB(1, 1), cB + hstep + kstep, voffB);
        PG8_WAIT_V(6); PG8_BAR;
    }
    for (;;) {
        const bool has_next = S.next(ui + 1, nxt);
        const char* nA = has_next ? (const char*)g.A + (size_t)nxt.pm * tstep : cA; const char* nB = has_next ? (const char*)g.Bt + (size_t)nxt.pn * tstep : cB;
        for (int t = 0; t < nt; t += 2) {
            const bool last = (t == nt - 2);
            const char* a1 = cA + (size_t)(t + 1) * kstep;
            const char* a2 = last ? nA : cA + (size_t)(t + 2) * kstep; const char* b2 = last ? nB : cB + (size_t)(t + 2) * kstep;
            const char* a3 = a2 + kstep; const char* b3 = b2 + kstep;
            if (last && has_next) S.a_ready(nxt);
            if constexpr (SP2) {
            PG8_LDB(B0, 0, 0); PG8_LDB(B1, 0, 1); PG8_SCHED; PG8_LDA(At, 0, 0); PG8_STAGE(PG8_SA(1, 1), a1 + hstep, voffA);
            PG8_WAIT_V(8); PG8_WAIT_L(0); PG8_BAR; PG8_MMA(0, 0, At, B0); PG8_MMA(0, 1, At, B1); PG8_BAR; PG8_SCHED;
            PG8_LDA(At, 0, 1); PG8_STAGE(PG8_SB(0, 0), b2, voffB); PG8_STAGE(PG8_SB(0, 1), b2 + hstep, voffB); PG8_STAGE(PG8_SA(0, 0), a2, voffA);
            PG8_WAIT_V(8); PG8_WAIT_L(0); PG8_BAR; PG8_MMA(1, 0, At, B0); PG8_MMA(1, 1, At, B1); PG8_BAR; PG8_SCHED;
            PG8_LDB(B0, 1, 0); PG8_LDB(B1, 1, 1); PG8_SCHED; PG8_LDA(At, 1, 0); PG8_STAGE(PG8_SA(0, 1), a2 + hstep, voffA);
            PG8_WAIT_V(8); PG8_WAIT_L(0); PG8_BAR; PG8_MMA(0, 0, At, B0); PG8_MMA(0, 1, At, B1); PG8_BAR; PG8_SCHED;
            PG8_LDA(At, 1, 1); PG8_STAGE(PG8_SB(1, 0), b3, voffB); PG8_STAGE(PG8_SB(1, 1), b3 + hstep, voffB); PG8_STAGE(PG8_SA(1, 0), a3, voffA);
            PG8_WAIT_V(8); PG8_WAIT_L(0); PG8_BAR; PG8_MMA(1, 0, At, B0); PG8_MMA(1, 1, At, B1); PG8_BAR; PG8_SCHED;
            } else {
            PG8_LDB(B0, 0, 0); PG8_SCHED; PG8_LDA(At, 0, 0); PG8_STAGE(PG8_SA(1, 1), a1 + hstep, voffA);
            PG8_WAIT_L(8); PG8_BAR; PG8_WAIT_L(0); PG8_MMA(0, 0, At, B0); PG8_BAR; PG8_SCHED;
            PG8_LDB(B1, 0, 1); PG8_STAGE(PG8_SB(0, 0), b2, voffB);
            PG8_BAR; PG8_WAIT_L(0); PG8_MMA(0, 1, At, B1); PG8_BAR;
            PG8_LDA(At, 0, 1); PG8_STAGE(PG8_SA(0, 0), a2, voffA);
            PG8_BAR; PG8_WAIT_L(0); PG8_MMA(1, 0, At, B0); PG8_BAR; PG8_SCHED;
            PG8_STAGE(PG8_SB(0, 1), b2 + hstep, voffB);
            PG8_WAIT_V(6); PG8_BAR; PG8_MMA(1, 1, At, B1); PG8_BAR;
            PG8_LDB(B0, 1, 0); PG8_SCHED; PG8_LDA(At, 1, 0); PG8_STAGE(PG8_SA(0, 1), a2 + hstep, voffA);
            PG8_WAIT_L(8); PG8_BAR; PG8_WAIT_L(0); PG8_MMA(0, 0, At, B0); PG8_BAR; PG8_SCHED;
            PG8_LDB(B1, 1, 1); PG8_STAGE(PG8_SB(1, 0), b3, voffB);
            PG8_BAR; PG8_WAIT_L(0); PG8_MMA(0, 1, At, B1); PG8_BAR;
            PG8_LDA(At, 1, 1); PG8_STAGE(PG8_SA(1, 0), a3, voffA);
            PG8_BAR; PG8_WAIT_L(0); PG8_MMA(1, 0, At, B0); PG8_BAR; PG8_SCHED;
            PG8_STAGE(PG8_SB(1, 1), b3 + hstep, voffB);
            PG8_WAIT_V(6); PG8_BAR; PG8_MMA(1, 1, At, B1); PG8_BAR;
            }
        }
        if constexpr (ALIGN_EPI) { if (wr == 0) PG8_BAR; }
        if constexpr (!Epi::AFTER_DRAIN) { E(acc, cur, wr, wc, fr, fq); S.done(cur); }
        if (!has_next) break;
#pragma unroll
        for (int a = 0; a < 2; ++a)
#pragma unroll
            for (int b = 0; b < 2; ++b)
#pragma unroll
                for (int m = 0; m < 4; ++m)
#pragma unroll
                    for (int n = 0; n < 2; ++n) acc[a][b][m][n] = (f32x4){0.f, 0.f, 0.f, 0.f};
        cur = nxt; cA = nA; cB = nB; ++ui;
        if constexpr (ALIGN_EPI) { if (wr == 1) PG8_BAR; }
    }
    PG8_WAIT_V(0);
    if constexpr (!ALIGN_EPI) { if (wr == 0) PG8_BAR; }
    PG8_BAR;
    if constexpr (Epi::AFTER_DRAIN) { E.fused(acc, cur, wr, wc, fr, fq, lds, wid, lane); S.done(cur); }
#undef PG8_SA
#undef PG8_SB
#undef PG8_STAGE
#undef PG8_LDA
#undef PG8_LDB
#undef PG8_MMA
#undef PG8_WAIT_V
#undef PG8_WAIT_L
#undef PG8_BAR
#undef PG8_SCHED
}
}
#define XB_TMO      128
#define XB_XCNT(j)  (256  + 64 * (j))
#define XB_XSUB(j)  (1280 + 64 * (j))
#define XB_XGEN(j)  (2304 + 64 * (j))
#define XB_TOP      3328
#define XB_TOPGEN   3392
#define XCD_BAR_WORDS 3456
#define XB_SPIN_CAP (1u << 18)
#define LAS __attribute__((address_space(3)))

__device__ __forceinline__ unsigned xb_ld(unsigned* p)              { return __hip_atomic_load(p, __ATOMIC_RELAXED, __HIP_MEMORY_SCOPE_AGENT); }
__device__ __forceinline__ unsigned xb_add(unsigned* p, unsigned v) { return __hip_atomic_fetch_add(p, v, __ATOMIC_RELAXED, __HIP_MEMORY_SCOPE_AGENT); }
__device__ __forceinline__ unsigned xb_xcc_id() { return (unsigned)__builtin_amdgcn_s_getreg((3 << 11) | 20) & 0xFu; }
#define XB_SPIN(cond, bar) do { unsigned _sp = 0; while (cond) { __builtin_amdgcn_s_sleep(1); \
    if ((++_sp & 255u) == 0u) { if (xb_ld(&(bar)[XB_TMO])) break; if (_sp > XB_SPIN_CAP) { atomicAdd(&(bar)[XB_TMO], 1u); break; } } } } while (0)

struct XcdBarrier {
    unsigned* bar; unsigned x;
    volatile LAS unsigned* st;
};

__device__ __forceinline__ XcdBarrier xcd_barrier_post(unsigned* bar, volatile LAS unsigned* st) {
    XcdBarrier b; b.bar = bar; b.x = xb_xcc_id(); b.st = st;
    if (threadIdx.x == 0) (void)xb_add(&bar[XB_XCNT(b.x)], 1u);
    return b;
}
__device__ __forceinline__ void xcd_barrier_complete(unsigned* bar, unsigned x, unsigned& nloc, unsigned& nx) {
    const unsigned G = gridDim.x * gridDim.y * gridDim.z;
    unsigned sum, cnt, mine, sp = 0u;
    for (;;) {
        sum = 0u; cnt = 0u; mine = 0u;
#pragma unroll
        for (unsigned j = 0; j < 16; ++j) { const unsigned c = xb_ld(&bar[XB_XCNT(j)]); sum += c; cnt += (c > 0u) ? 1u : 0u; mine = (j == x) ? c : mine; }
        if (sum == G) break;
        __builtin_amdgcn_s_sleep(1);
        if ((++sp & 255u) == 0u) { if (xb_ld(&bar[XB_TMO])) break; if (sp > XB_SPIN_CAP) { atomicAdd(&bar[XB_TMO], 1u); break; } }
    }
    nloc = mine > 0u ? mine : 1u; nx = cnt > 0u ? cnt : 1u;
}

__device__ __forceinline__ void xcd_barrier(const XcdBarrier& b) {
    asm volatile("s_waitcnt vmcnt(0)" ::: "memory");
    __syncthreads();
    if (threadIdx.x == 0) {
        unsigned* bar = b.bar;
        __builtin_amdgcn_s_waitcnt(0);
        unsigned nloc = b.st[0], nx = b.st[1];
        if (nloc == 0u) { xcd_barrier_complete(bar, b.x, nloc, nx); b.st[0] = nloc; b.st[1] = nx; }
        const unsigned old = xb_add(&bar[XB_XSUB(b.x)], 1u);
        const unsigned gen = old / nloc;
        if (old + 1u == (gen + 1u) * nloc) {
            __builtin_amdgcn_fence(__ATOMIC_RELEASE, "agent");
            asm volatile("s_waitcnt vmcnt(0)" ::: "memory");
            const unsigned og = xb_add(&bar[XB_TOP], 1u);
            const unsigned tg = og / nx;
            if (og + 1u == (tg + 1u) * nx) xb_add(&bar[XB_TOPGEN], 1u);
            else XB_SPIN(xb_ld(&bar[XB_TOPGEN]) == tg, bar);
            __builtin_amdgcn_fence(__ATOMIC_ACQUIRE, "agent");
            xb_add(&bar[XB_XGEN(b.x)], 1u);
            asm volatile("s_waitcnt vmcnt(0)" ::: "memory");
        } else {
            XB_SPIN(xb_ld(&bar[XB_XGEN(b.x)]) == gen, bar);
            __builtin_amdgcn_fence(__ATOMIC_ACQUIRE, "agent");
            asm volatile("s_waitcnt vmcnt(0)" ::: "memory");
        }
    }
    __syncthreads();
}

constexpr bool GEMM_SP2 = true, GEMM_ALIGN = true;
using pg8::bf16_t; using pg8::f32x4; using pg8::u32x4; using pg8::bf16x8; using pg8::cvt_pk_bf16; using pg8::Unit; using pg8::HALF; using pg8::BM;
typedef unsigned u32x2 __attribute__((ext_vector_type(2)));
constexpr int T_ = 32768, D_ = 1024, SEQ_ = 8192, NB_ = 4, INC_ = 3080, PJ_ = 3072, FF_ = 2816, PLE_ = 256, NCH_ = 128;
constexpr float EPS_ = 1e-6f;
constexpr int NTHREADS = 512;
constexpr int LDS_BYTES = 144 * 1024;

constexpr size_t WS_WIN = 4096;
constexpr size_t WS_WOUT = WS_WIN + (size_t)PJ_ * D_ * 2;
constexpr size_t WS_WGU = WS_WOUT + (size_t)D_ * D_ * 2;
constexpr size_t WS_WD = WS_WGU + (size_t)2 * FF_ * D_ * 2;
constexpr size_t WS_WPG = WS_WD + (size_t)D_ * FF_ * 2;
constexpr size_t WS_WPP = WS_WPG + (size_t)D_ * D_ * 2;
constexpr size_t WS_LOGITS = WS_WPP + (size_t)D_ * PLE_ * 2;
constexpr size_t WS_PB = WS_LOGITS + (size_t)T_ * 8 * 4;
constexpr size_t WS_SSA = WS_PB + (size_t)T_ * PLE_ * 2;
constexpr size_t WS_SSB = WS_SSA + (size_t)T_ * 16 * 4;
constexpr size_t WS_PTOT = WS_SSB + (size_t)T_ * 16 * 4;
constexpr size_t WS_HEND = WS_PTOT + (size_t)NB_ * NCH_ * 512 * 4;
constexpr size_t WS_CARRY = WS_HEND + (size_t)NB_ * NCH_ * 512 * 4;
constexpr size_t WS_GTOT = WS_CARRY + (size_t)NB_ * NCH_ * 512 * 4;
constexpr size_t WS_XB = WS_GTOT + 8192;
constexpr size_t WS_PROJ = WS_XB + (size_t)T_ * D_ * 2;
constexpr size_t WS_R4 = WS_PROJ + (size_t)T_ * PJ_ * 2;
constexpr size_t WS_Y = WS_XB;
constexpr size_t WS_XB2 = WS_R4;
constexpr size_t WS_PP = WS_R4 + (size_t)T_ * D_ * 2;
constexpr size_t WS_ORAW = WS_R4 + (size_t)2048 * 73728;
constexpr size_t WS_BAR = WS_R4 + (size_t)2048 * 73728 + (size_t)T_ * 512 * 2;
constexpr size_t WS_RGW = WS_BAR + 16384;
constexpr size_t WS_END = WS_RGW + 131072;

struct Params {
    const float* in[25];
    float* out; unsigned char* ws;
    int ph_lo, ph_hi;
};

__device__ __forceinline__ float bf2f(bf16_t b) { return __uint_as_float(((unsigned)b) << 16); }
__device__ __forceinline__ bf16_t f2bf(float f) { return (bf16_t)(cvt_pk_bf16(f, 0.f) & 0xffffu); }
__device__ __forceinline__ float sigmoidf_(float x) { return __builtin_amdgcn_rcpf(1.0f + __expf(-x)); }
__device__ __forceinline__ float siluf_(float x) { return x * __builtin_amdgcn_rcpf(1.0f + __expf(-x)); }
__device__ __forceinline__ float softplusf_(float x) { return fmaxf(x, 0.f) + log1pf(__expf(-fabsf(x))); }
__device__ __forceinline__ float gelu_tanhf_(float x) { const float u = 0.7978845608028654f * (x + 0.044715f * x * x * x); return x * __builtin_amdgcn_rcpf(1.0f + __expf(-2.0f * u)); }
__device__ __forceinline__ float rstd16(const float* ss, int r) {
    const f32x4 a = *(const f32x4*)(ss + (size_t)r * 16), b = *(const f32x4*)(ss + (size_t)r * 16 + 4), c = *(const f32x4*)(ss + (size_t)r * 16 + 8), d = *(const f32x4*)(ss + (size_t)r * 16 + 12);
    const float s = ((a[0] + a[1]) + (a[2] + a[3])) + ((b[0] + b[1]) + (b[2] + b[3])) + ((c[0] + c[1]) + (c[2] + c[3])) + ((d[0] + d[1]) + (d[2] + d[3]));
    return rsqrtf(s * (1.0f / 1024.0f) + EPS_);
}

template <int CTRL> __device__ __forceinline__ float dpp_f(float x) { return __int_as_float(__builtin_amdgcn_update_dpp(0, __float_as_int(x), CTRL, 0xf, 0xf, false)); }
__device__ __forceinline__ float red8(float x) { x += dpp_f<0xB1>(x); x += dpp_f<0x4E>(x); x += dpp_f<0x141>(x); return x; }
struct EpiBf16Plain {
    static constexpr bool PERM = true, AFTER_DRAIN = false;
    bf16_t* O; int ldc;
    __device__ __forceinline__ void operator()(const f32x4 (&acc)[2][2][4][2], const Unit& u, int wr, int wc, int fr, int fq) const {
        int row0 = u.pm * BM + wr * 64 + fr; asm volatile("" : "+v"(row0)); const int col0 = u.pn * BM + wc * 32 + 8 * fq;
#pragma unroll
        for (int ai = 0; ai < 2; ++ai)
#pragma unroll
            for (int m = 0; m < 4; ++m) { bf16_t* rowp = O + (size_t)(row0 + ai * HALF + m * 16) * ldc + col0;
#pragma unroll
                for (int bj = 0; bj < 2; ++bj) { const f32x4 v0 = acc[ai][bj][m][0], v1 = acc[ai][bj][m][1]; u32x4 w; w.x = cvt_pk_bf16(v0[0], v0[1]); w.y = cvt_pk_bf16(v0[2], v0[3]); w.z = cvt_pk_bf16(v1[0], v1[1]); w.w = cvt_pk_bf16(v1[2], v1[3]);
                    *(u32x4*)(rowp + bj * HALF) = w; } }
    }
};
__device__ __forceinline__ void rstd8(const float* ss, int row0, float (&rs)[8]) {
#pragma unroll
    for (int ai = 0; ai < 2; ++ai) { f32x4 t[4][4];
#pragma unroll
        for (int m = 0; m < 4; ++m)
#pragma unroll
            for (int q = 0; q < 4; ++q) t[m][q] = *(const f32x4*)(ss + (size_t)(row0 + ai * HALF + m * 16) * 16 + 4 * q);
#pragma unroll
        for (int m = 0; m < 4; ++m) { const float sm = (((t[m][0][0] + t[m][0][1]) + (t[m][0][2] + t[m][0][3])) + ((t[m][1][0] + t[m][1][1]) + (t[m][1][2] + t[m][1][3]))) + (((t[m][2][0] + t[m][2][1]) + (t[m][2][2] + t[m][2][3])) + ((t[m][3][0] + t[m][3][1]) + (t[m][3][2] + t[m][3][3])));
            rs[ai * 4 + m] = rsqrtf(sm * (1.0f / 1024.0f) + EPS_); }
        asm volatile("" ::: "memory"); }
}
template <bool RES_BF16>
struct EpiResid {
    static constexpr bool PERM = false, AFTER_DRAIN = false;
    const float* res; bf16_t* xb; float* ss;
    __device__ __forceinline__ void operator()(const f32x4 (&acc)[2][2][4][2], const Unit& u, int wr, int wc, int fr, int fq) const {
        int row0 = u.pm * BM + wr * 64 + fr; asm volatile("" : "+v"(row0)); const int col0 = u.pn * BM + wc * 32 + 4 * fq;
        const unsigned e0 = (unsigned)row0 * D_ + col0;
#pragma unroll
        for (int ai = 0; ai < 2; ++ai) {
            constexpr int NB = RES_BF16 ? 4 : 2;
#pragma unroll
            for (int mh = 0; mh < 4 / NB; ++mh) {
                f32x4 rv[NB][2][2];
#pragma unroll
                for (int mm = 0; mm < NB; ++mm)
#pragma unroll
                    for (int bj = 0; bj < 2; ++bj)
#pragma unroll
                        for (int n = 0; n < 2; ++n) { const unsigned e = e0 + (unsigned)((ai * HALF + (mh * NB + mm) * 16) * D_ + bj * HALF + n * 16);
                            if (RES_BF16) { const u32x2 w = *(const u32x2*)((const char*)xb + (size_t)(e * 2u)); rv[mm][bj][n] = (f32x4){__uint_as_float(w.x << 16), __uint_as_float(w.x & 0xffff0000u), __uint_as_float(w.y << 16), __uint_as_float(w.y & 0xffff0000u)}; }
                            else rv[mm][bj][n] = *(const f32x4*)((const char*)res + (size_t)(e * 4u)); }
#pragma unroll
                for (int mm = 0; mm < NB; ++mm) { const int m = mh * NB + mm, r = row0 + ai * HALF + m * 16; float s = 0.f;
#pragma unroll
                    for (int bj = 0; bj < 2; ++bj)
#pragma unroll
                        for (int n = 0; n < 2; ++n) { const unsigned e = e0 + (unsigned)((ai * HALF + m * 16) * D_ + bj * HALF + n * 16); const f32x4 v = rv[mm][bj][n] + acc[ai][bj][m][n];
                            s += (v[0] * v[0] + v[1] * v[1]) + (v[2] * v[2] + v[3] * v[3]); u32x2 w; w.x = cvt_pk_bf16(v[0], v[1]); w.y = cvt_pk_bf16(v[2], v[3]); *(u32x2*)((char*)xb + (size_t)(e * 2u)) = w; }
                    s += __shfl_xor(s, 16); s += __shfl_xor(s, 32);
                    if (fq == 0) ss[(size_t)r * 16 + u.pn * 4 + wc] = s; }
                asm volatile("" ::: "memory"); } }
    }
};
struct EpiGateUp {
    static constexpr bool PERM = true, AFTER_DRAIN = false;
    bf16_t* ff; const float* ss;
    __device__ __forceinline__ void operator()(const f32x4 (&acc)[2][2][4][2], const Unit& u, int wr, int wc, int fr, int fq) const {
        int row0 = u.pm * BM + wr * 64 + fr; asm volatile("" : "+v"(row0)); const int col0 = u.pn * HALF + wc * 32 + 8 * fq;
        float rsv[8]; rstd8(ss, row0, rsv);
#pragma unroll
        for (int ai = 0; ai < 2; ++ai)
#pragma unroll
            for (int m = 0; m < 4; ++m) { const int r = row0 + ai * HALF + m * 16; const float rs = rsv[ai * 4 + m];
                float o[8];
#pragma unroll
                for (int n = 0; n < 2; ++n)
#pragma unroll
                    for (int j = 0; j < 4; ++j) { const float g = acc[ai][0][m][n][j] * rs, up = acc[ai][1][m][n][j] * rs; o[n * 4 + j] = siluf_(g) * up; }
                u32x4 w; w.x = cvt_pk_bf16(o[0], o[1]); w.y = cvt_pk_bf16(o[2], o[3]); w.z = cvt_pk_bf16(o[4], o[5]); w.w = cvt_pk_bf16(o[6], o[7]);
                *(u32x4*)(ff + (size_t)r * FF_ + col0) = w; }
    }
};
struct EpiPle {
    static constexpr bool PERM = false, AFTER_DRAIN = false;
    const bf16_t* x2b; bf16_t* x3b; const bf16_t* pp; const float* bias; const float* ss_in; float* ss_out;
    __device__ __forceinline__ void operator()(const f32x4 (&acc)[2][2][4][2], const Unit& u, int wr, int wc, int fr, int fq) const {
        int row0 = u.pm * BM + wr * 64 + fr; asm volatile("" : "+v"(row0)); const int col0 = u.pn * BM + wc * 32 + 4 * fq;
        const unsigned b0 = ((unsigned)row0 * D_ + col0) * 2u;
        const unsigned s0 = (unsigned)row0 * 64u;
        u32x2 X[2][2][2], P[2][2][2]; f32x4 S[2][4];
#define EP_LOAD(set, g) do { const unsigned ro_ = (unsigned)(((g) >> 2) * HALF + ((g) & 3) * 16); \
        _Pragma("unroll") for (int bj = 0; bj < 2; ++bj) _Pragma("unroll") for (int n = 0; n < 2; ++n) { const unsigned bo_ = b0 + (ro_ * D_ + bj * HALF + n * 16) * 2u; \
            X[set][bj][n] = *(const u32x2*)((const char*)x2b + (size_t)bo_); P[set][bj][n] = *(const u32x2*)((const char*)pp + (size_t)bo_); } \
        _Pragma("unroll") for (int q = 0; q < 4; ++q) S[set][q] = *(const f32x4*)((const char*)ss_in + (size_t)(s0 + ro_ * 64u + q * 16u)); } while (0)
        EP_LOAD(0, 0);
#pragma unroll
        for (int g = 0; g < 8; ++g) { const int ai = g >> 2, m = g & 3, st = g & 1, r = row0 + ai * HALF + m * 16;
            if (g < 7) EP_LOAD((g + 1) & 1, g + 1);
            const float sm = (((S[st][0][0] + S[st][0][1]) + (S[st][0][2] + S[st][0][3])) + ((S[st][1][0] + S[st][1][1]) + (S[st][1][2] + S[st][1][3]))) + (((S[st][2][0] + S[st][2][1]) + (S[st][2][2] + S[st][2][3])) + ((S[st][3][0] + S[st][3][1]) + (S[st][3][2] + S[st][3][3])));
            const float rs = rsqrtf(sm * (1.0f / 1024.0f) + EPS_); float s = 0.f;
#pragma unroll
            for (int bj = 0; bj < 2; ++bj)
#pragma unroll
                for (int n = 0; n < 2; ++n) { const unsigned bo = b0 + (unsigned)(((ai * HALF + m * 16) * D_ + bj * HALF + n * 16) * 2); const u32x2 w2 = P[st][bj][n], x2 = X[st][bj][n]; const f32x4 a = acc[ai][bj][m][n]; const f32x4 bb = *(const f32x4*)(bias + col0 + bj * HALF + n * 16);
                    f32x4 v = {__uint_as_float(x2.x << 16), __uint_as_float(x2.x & 0xffff0000u), __uint_as_float(x2.y << 16), __uint_as_float(x2.y & 0xffff0000u)};
                    const float p0 = __uint_as_float(w2.x << 16), p1 = __uint_as_float(w2.x & 0xffff0000u), p2 = __uint_as_float(w2.y << 16), p3 = __uint_as_float(w2.y & 0xffff0000u);
                    v[0] += sigmoidf_(a[0] * rs + bb[0]) * p0; v[1] += sigmoidf_(a[1] * rs + bb[1]) * p1; v[2] += sigmoidf_(a[2] * rs + bb[2]) * p2; v[3] += sigmoidf_(a[3] * rs + bb[3]) * p3;
                    u32x2 xw; xw.x = cvt_pk_bf16(v[0], v[1]); xw.y = cvt_pk_bf16(v[2], v[3]); *(u32x2*)((char*)x3b + (size_t)bo) = xw; s += (v[0] * v[0] + v[1] * v[1]) + (v[2] * v[2] + v[3] * v[3]); }
            s += __shfl_xor(s, 16); s += __shfl_xor(s, 32);
            if (fq == 0) ss_out[(size_t)r * 16 + u.pn * 4 + wc] = s;
            asm volatile("" ::: "memory"); }
#undef EP_LOAD
    }
};

template <class Epi> __device__ __forceinline__ void run_gemm(PG8_LAS unsigned char* lds, const bf16_t* A, const bf16_t* Bt, int M, int N, int K, const Epi& E) {
    pg8::Gemm g; g.A = A; g.Bt = Bt; g.M = M; g.N = N; g.K = K;
    pg8::StaticOrder S; S.init(M, N, (int)gridDim.x, (int)blockIdx.x);
    pg8::gemm_phase<Epi, pg8::StaticOrder, GEMM_ALIGN, GEMM_SP2>(lds, g, S, E);
}

__device__ void prep_transpose(const float* __restrict__ W, int K, int ldw, int c0, int ncols, bf16_t* __restrict__ Wt, const float* __restrict__ ks, int mode, float* tile, int rot, int widx, int nw) {
    const int tid = threadIdx.x, nkt = K / 64, nct = ncols / 64, ntiles = nkt * nct;
    for (int tt = (widx + nw - (rot % nw)) % nw; tt < ntiles; tt += nw) {
        const int kt = tt / nct, ct = tt % nct, k0 = kt * 64, n0 = ct * 64;
        __syncthreads();
#pragma unroll
        for (int i = 0; i < 2; ++i) { const int r = (tid >> 4) + 32 * i, c4 = (tid & 15) * 4; const f32x4 v = *(const f32x4*)(W + (size_t)(k0 + r) * ldw + c0 + n0 + c4);
            const float s = ks ? ks[k0 + r] : 1.0f; tile[r * 65 + c4 + 0] = v[0] * s; tile[r * 65 + c4 + 1] = v[1] * s; tile[r * 65 + c4 + 2] = v[2] * s; tile[r * 65 + c4 + 3] = v[3] * s; }
        __syncthreads();
        const int n = tid >> 3, kseg = (tid & 7) * 8; float v[8];
#pragma unroll
        for (int e = 0; e < 8; ++e) v[e] = tile[(kseg + e) * 65 + n];
        u32x4 w; w.x = cvt_pk_bf16(v[0], v[1]); w.y = cvt_pk_bf16(v[2], v[3]); w.z = cvt_pk_bf16(v[4], v[5]); w.w = cvt_pk_bf16(v[6], v[7]);
        const int f = n0 + n; const int drow = (mode == 0) ? f : (256 * (f >> 7) + 128 * (mode - 1) + (f & 127));
        *(u32x4*)(Wt + (size_t)drow * K + k0 + kseg) = w;
    }
}


__device__ __forceinline__ void prep_weights_late(const Params& p, unsigned char* smem, int widx, int nw) {
    unsigned char* ws = p.ws; float* tile = (float*)smem;
    __syncthreads();
    prep_transpose(p.in[15], D_, D_, 0, D_, (bf16_t*)(ws + WS_WOUT), nullptr, 0, tile, 0, widx, nw);
    prep_transpose(p.in[17], D_, FF_, 0, FF_, (bf16_t*)(ws + WS_WGU), p.in[16], 1, tile, 256, widx, nw);
    prep_transpose(p.in[18], D_, FF_, 0, FF_, (bf16_t*)(ws + WS_WGU), p.in[16], 2, tile, 960, widx, nw);
    prep_transpose(p.in[19], FF_, D_, 0, D_, (bf16_t*)(ws + WS_WD), nullptr, 0, tile, 1664, widx, nw);
    prep_transpose(p.in[21], D_, D_, 0, D_, (bf16_t*)(ws + WS_WPG), p.in[20], 0, tile, 2368, widx, nw);
}

__device__ __forceinline__ void phase_prep(const Params& p, unsigned char* smem) {
    const int tid = threadIdx.x, wid = __builtin_amdgcn_readfirstlane(tid >> 6), lane = tid & 63;
    unsigned char* ws = p.ws;
    float* tile = (float*)smem;
    float* w8s = (float*)(smem + 20480);
    if (blockIdx.x == 0 && tid < 32) ((unsigned*)ws)[tid] = 0u;
    prep_transpose(p.in[3], D_, INC_, 0, PJ_, (bf16_t*)(ws + WS_WIN), nullptr, 0, tile, 0, (int)blockIdx.x, (int)gridDim.x);
    prep_transpose(p.in[23], PLE_, D_, 0, D_, (bf16_t*)(ws + WS_WPP), nullptr, 0, tile, 768, (int)blockIdx.x, (int)gridDim.x);
    if (blockIdx.x < 8) {
        const int hh = blockIdx.x;
        for (int item = tid; item < 1024; item += NTHREADS) { const int gate = item >> 9, fragi = (item >> 6) & 7, ln = item & 63, ntf = fragi >> 1, ksf = fragi & 1, n16f = ln & 15, fqf = ln >> 4;
            const float* wsrc = p.in[gate ? 8 : 6] + (size_t)(hh * 64 + 32 * ksf + 8 * fqf) * 64 + 16 * ntf + n16f;
            const f32x4 lo = {wsrc[0], wsrc[64], wsrc[128], wsrc[192]}, hi = {wsrc[256], wsrc[320], wsrc[384], wsrc[448]};
            u32x4 w; w.x = cvt_pk_bf16(lo[0], lo[1]); w.y = cvt_pk_bf16(lo[2], lo[3]); w.z = cvt_pk_bf16(hi[0], hi[1]); w.w = cvt_pk_bf16(hi[2], hi[3]);
            *(u32x4*)(ws + WS_RGW + ((size_t)((hh * 2 + gate) * 8 + fragi) * 64 + ln) * 16) = w; }
    }
    for (int i = tid; i < 1024 * 8; i += NTHREADS) { const int k = i >> 3, j = i & 7; w8s[i] = p.in[2][k] * p.in[3][(size_t)k * INC_ + PJ_ + j]; }
    __syncthreads();
    {
        const float* x = p.in[0]; const float* nw = p.in[2]; bf16_t* hb = (bf16_t*)(ws + WS_XB); float* logits = (float*)(ws + WS_LOGITS);
        f32x4 nwv[4];
#pragma unroll
        for (int i = 0; i < 4; ++i) nwv[i] = *(const f32x4*)(nw + 4 * (lane + 64 * i));
        f32x4 vn[4]; int row = blockIdx.x * 8 + wid;
        if (row < T_) {
#pragma unroll
            for (int i = 0; i < 4; ++i) vn[i] = *(const f32x4*)(x + (size_t)row * D_ + 4 * (lane + 64 * i)); }
        for (; row < T_; row += gridDim.x * 8) {
            f32x4 v[4]; float s = 0.f;
#pragma unroll
            for (int i = 0; i < 4; ++i) { v[i] = vn[i]; s += (v[i][0] * v[i][0] + v[i][1] * v[i][1]) + (v[i][2] * v[i][2] + v[i][3] * v[i][3]); }
            { const int nrow = row + gridDim.x * 8;
              if (nrow < T_) {
#pragma unroll
                for (int i = 0; i < 4; ++i) vn[i] = *(const f32x4*)(x + (size_t)nrow * D_ + 4 * (lane + 64 * i)); } }
            s = red8(s); s += dpp_f<0x140>(s); s += __shfl_xor(s, 16); s += __shfl_xor(s, 32);
            const float rs = rsqrtf(s * (1.0f / 1024.0f) + EPS_);
            float lg[8];
#pragma unroll
            for (int j = 0; j < 8; ++j) lg[j] = 0.f;
#pragma unroll
            for (int i = 0; i < 4; ++i) {
                const int k0 = 4 * (lane + 64 * i);
#pragma unroll
                for (int e = 0; e < 4; ++e) { const f32x4 wa = *(const f32x4*)(w8s + (k0 + e) * 8), wb = *(const f32x4*)(w8s + (k0 + e) * 8 + 4); const float xv = v[i][e];
                    lg[0] += xv * wa[0]; lg[1] += xv * wa[1]; lg[2] += xv * wa[2]; lg[3] += xv * wa[3]; lg[4] += xv * wb[0]; lg[5] += xv * wb[1]; lg[6] += xv * wb[2]; lg[7] += xv * wb[3]; }
                const f32x4 h = v[i] * rs * nwv[i]; u32x2 w; w.x = cvt_pk_bf16(h[0], h[1]); w.y = cvt_pk_bf16(h[2], h[3]);
                *(u32x2*)(hb + (size_t)row * D_ + k0) = w;
            }
            const bool b5 = (lane & 32) != 0, b4 = (lane & 16) != 0, b3 = (lane & 8) != 0;
            float k4[4], k2[2];
#pragma unroll
            for (int j = 0; j < 4; ++j) { const float send = b5 ? lg[j] : lg[j + 4]; const float keep = b5 ? lg[j + 4] : lg[j]; k4[j] = keep + __shfl_xor(send, 32); }
#pragma unroll
            for (int j = 0; j < 2; ++j) { const float send = b4 ? k4[j] : k4[j + 2]; const float keep = b4 ? k4[j + 2] : k4[j]; k2[j] = keep + __shfl_xor(send, 16); }
            float k1; { const float send = b3 ? k2[0] : k2[1]; const float keep = b3 ? k2[1] : k2[0]; k1 = keep + __shfl_xor(send, 8); }
            k1 = red8(k1);
            if ((lane & 7) == 0) logits[(size_t)row * 8 + ((lane >> 5) & 1) * 4 + ((lane >> 4) & 1) * 2 + ((lane >> 3) & 1)] = k1 * rs;
        }
    }
    {
        const f32x4* src = (const f32x4*)p.in[1]; u32x2* dst = (u32x2*)(ws + WS_PB); const size_t n4 = (size_t)T_ * PLE_ / 4;
        for (size_t i = (size_t)blockIdx.x * NTHREADS + tid; i < n4; i += (size_t)gridDim.x * NTHREADS) { const f32x4 v = src[i]; u32x2 w; w.x = cvt_pk_bf16(v[0], v[1]); w.y = cvt_pk_bf16(v[2], v[3]); dst[i] = w; }
    }
}
__device__ __forceinline__ bf16x8 pack8(const f32x4 a, const f32x4 b) { u32x4 w; w.x = cvt_pk_bf16(a[0], a[1]); w.y = cvt_pk_bf16(a[2], a[3]); w.z = cvt_pk_bf16(b[0], b[1]); w.w = cvt_pk_bf16(b[2], b[3]); return __builtin_bit_cast(bf16x8, w); }
#define MFMA16(a, b, c) __builtin_amdgcn_mfma_f32_16x16x32_bf16((a), (b), (c), 0, 0, 0)
__device__ __forceinline__ float neg_expm1_small(float x, float ehalf) {
    const float ps = -x * (1.0f + x * (0.5f + x * (0.16666667f + x * (0.041666668f + x * (0.008333334f + x * 0.0013888889f)))));
    return (x > -0.25f) ? ps : (1.0f - ehalf * ehalf);
}
template <bool FINAL>
__device__ __forceinline__ void rg_pass_mfma(const Params& p, unsigned char* smem, int widx, int nworkers) {
    const int tid = threadIdx.x, wid = __builtin_amdgcn_readfirstlane(tid >> 6), lane = tid & 63, n16o = lane & 15, fqo = lane >> 4, c = wid * 64 + lane;
    unsigned char* ws = p.ws;
    const bf16_t* proj = (const bf16_t*)(ws + WS_PROJ);
    float* U = (float*)smem + wid * 4352;
    float* ptot = (float*)(ws + WS_PTOT); float* hend = (float*)(ws + WS_HEND); const float* carry = (const float*)(ws + WS_CARRY);
    bf16_t* y = (bf16_t*)(ws + WS_Y);
    bf16x8 Bx[4][2], Ba[4][2];
#pragma unroll
    for (int nt = 0; nt < 4; ++nt)
#pragma unroll
        for (int ks = 0; ks < 2; ++ks) { const unsigned char* fb = ws + WS_RGW + ((size_t)(wid * 16 + nt * 2 + ks) * 64 + lane) * 16;
            Bx[nt][ks] = *(const bf16x8*)fb; Ba[nt][ks] = *(const bf16x8*)(fb + 8 * 64 * 16); }
    const float cw0 = p.in[4][c], cw1 = p.in[4][512 + c], cw2 = p.in[4][1024 + c], cw3 = p.in[4][1536 + c], cb = p.in[5][c];
    float bxv[4], bav[4], spv[4];
#pragma unroll
    for (int nt = 0; nt < 4; ++nt) { const int cgl = wid * 64 + 16 * nt + n16o; bxv[nt] = p.in[7][cgl]; bav[nt] = p.in[9][cgl]; spv[nt] = softplusf_(-p.in[10][cgl]); }
    for (int unit = widx; unit < NB_ * NCH_; unit += nworkers) {
        const int n = unit & (NCH_ - 1); const size_t t0 = (size_t)unit * 64;
        float xm3 = 0.f, xm2 = 0.f, xm1 = 0.f;
        if (n != 0) { xm3 = bf2f(proj[(t0 - 3) * PJ_ + c]); xm2 = bf2f(proj[(t0 - 2) * PJ_ + c]); xm1 = bf2f(proj[(t0 - 1) * PJ_ + c]); }
        __syncthreads();
        { bf16_t xr[16]; const bf16_t* xp0 = proj + t0 * PJ_ + c;
#pragma unroll
          for (int i = 0; i < 16; ++i) xr[i] = xp0[(size_t)i * PJ_];
#pragma unroll
          for (int tb = 0; tb < 4; ++tb) { bf16_t xn[16]; const bf16_t* xp = proj + (t0 + (tb + 1) * 16) * PJ_ + c;
            if (tb < 3) {
#pragma unroll
                for (int i = 0; i < 16; ++i) xn[i] = xp[(size_t)i * PJ_]; }
#pragma unroll
            for (int i = 0; i < 16; ++i) { const float xv = bf2f(xr[i]); U[(16 * ((i >> 2) & 3) + 4 * tb + (i & 3)) * 68 + lane] = cw0 * xm3 + cw1 * xm2 + cw2 * xm1 + cw3 * xv + cb; xm3 = xm2; xm2 = xm1; xm1 = xv; }
            if (tb < 3) {
#pragma unroll
                for (int i = 0; i < 16; ++i) xr[i] = xn[i]; } } }
        __syncthreads();
        const bf16_t* gub = proj + t0 * PJ_ + 512; bf16_t* yub = y + t0 * D_;
#pragma unroll
        for (int nt = 0; nt < 4; ++nt) {
            asm volatile("" ::: "memory");
            int lane_o = lane; asm volatile("" : "+v"(lane_o));
            const int n16 = lane_o & 15, fq = lane_o >> 4;
            const int chl = 16 * nt + n16, cgl = wid * 64 + chl;
            bf16x8 Af[4][2];
#pragma unroll
            for (int mt = 0; mt < 4; ++mt)
#pragma unroll
                for (int ks = 0; ks < 2; ++ks) { const float* up = U + (16 * mt + n16) * 68 + 32 * ks + 8 * fq; Af[mt][ks] = pack8(*(const f32x4*)up, *(const f32x4*)(up + 4)); }

            bf16_t gr[16];
            if (FINAL) {
#pragma unroll
                for (int i = 0; i < 16; ++i) gr[i] = gub[(16 * fq + i) * PJ_ + cgl]; }
            f32x4 ax[4], aa[4];
#pragma unroll
            for (int mt = 0; mt < 4; ++mt) { ax[mt] = (f32x4){bxv[nt], bxv[nt], bxv[nt], bxv[nt]}; aa[mt] = (f32x4){bav[nt], bav[nt], bav[nt], bav[nt]}; }
#pragma unroll
            for (int mt = 0; mt < 4; ++mt)
#pragma unroll
                for (int ks = 0; ks < 2; ++ks) { ax[mt] = MFMA16(Af[mt][ks], Bx[nt][ks], ax[mt]); aa[mt] = MFMA16(Af[mt][ks], Ba[nt][ks], aa[mt]); }
            float av[16], bv[16]; float hl = 0.f, Pl = 1.f;
#pragma unroll
            for (int i = 0; i < 16; ++i) { const int mt = i >> 2, j = i & 3, tok = 16 * fq + i; const float u = U[(16 * mt + 4 * fq + j) * 68 + chl];
                const float gx = sigmoidf_(ax[mt][j]), gg = sigmoidf_(aa[mt][j]); const float la = -8.0f * gg * spv[nt]; const float a = __expf(la);
                float mult = sqrtf(fmaxf(neg_expm1_small(2.0f * la, a), 0.f)); if (n == 0 && tok == 0) mult = 1.0f;
                av[i] = a; bv[i] = u * gx * mult; hl = a * hl + bv[i]; Pl *= a; }
            float Pg[4], Hg[4];
#pragma unroll
            for (int g = 0; g < 4; ++g) { Pg[g] = __shfl(Pl, n16 + 16 * g); Hg[g] = __shfl(hl, n16 + 16 * g); }
            if (FINAL) {
                float h = carry[(size_t)unit * 512 + cgl];
#pragma unroll
                for (int g = 0; g < 3; ++g) if (g < fq) h = Pg[g] * h + Hg[g];
#pragma unroll
                for (int i = 0; i < 16; ++i) { h = av[i] * h + bv[i]; yub[(16 * fq + i) * D_ + cgl] = f2bf(h * gelu_tanhf_(bf2f(gr[i]))); }
            } else {
                float cc = 0.f, Pp = 1.f;
#pragma unroll
                for (int g = 0; g < 4; ++g) { cc = Pg[g] * cc + Hg[g]; Pp *= Pg[g]; }
                if (fq == 0) { ptot[(size_t)unit * 512 + cgl] = Pp; hend[(size_t)unit * 512 + cgl] = cc; }
            }
        }
    }
}

__device__ __forceinline__ void rg_carry(const Params& p, int idx) {
    unsigned char* ws = p.ws; const float* ptot = (const float*)(ws + WS_PTOT); const float* hend = (const float*)(ws + WS_HEND); float* carry = (float*)(ws + WS_CARRY);
    const int b = idx >> 9, c = idx & 511; float hc = 0.f;
    for (int n0 = 0; n0 < NCH_; n0 += 8) { float P[8], H[8];
#pragma unroll
        for (int i = 0; i < 8; ++i) { const size_t o = (size_t)(b * NCH_ + n0 + i) * 512 + c; P[i] = ptot[o]; H[i] = hend[o]; }
#pragma unroll
        for (int i = 0; i < 8; ++i) { const size_t o = (size_t)(b * NCH_ + n0 + i) * 512 + c; carry[o] = hc; hc = P[i] * hc + H[i]; } }
}

constexpr int GU_BYTES = 73728, GU_KDT = 32768, GU_QK = 49152, GU_U = 57344;
typedef float f32x2_ __attribute__((ext_vector_type(2)));
__device__ __forceinline__ int tok_of_pos(int p) { return 16 * (2 * (p >> 5) + ((p >> 2) & 1)) + 4 * ((p >> 3) & 3) + (p & 3); }
__device__ __forceinline__ void unpack8(const u32x4 w, float* f) { f[0] = __uint_as_float(w.x << 16); f[1] = __uint_as_float(w.x & 0xffff0000u); f[2] = __uint_as_float(w.y << 16); f[3] = __uint_as_float(w.y & 0xffff0000u);
    f[4] = __uint_as_float(w.z << 16); f[5] = __uint_as_float(w.z & 0xffff0000u); f[6] = __uint_as_float(w.w << 16); f[7] = __uint_as_float(w.w & 0xffff0000u); }

__device__ __forceinline__ void gdn_pass_a(const Params& p, unsigned char* smem) {
    const int tid = threadIdx.x, wid = __builtin_amdgcn_readfirstlane(tid >> 6);
    unsigned char* ws = p.ws; const bf16_t* proj = (const bf16_t*)(ws + WS_PROJ); const float* logits = (const float*)(ws + WS_LOGITS); float* gtot = (float*)(ws + WS_GTOT);
    bf16_t* Kb = (bf16_t*)smem; bf16_t* Qb = (bf16_t*)(smem + 17408); bf16_t* VBt = (bf16_t*)(smem + 34816); bf16_t* KBGt = (bf16_t*)(smem + 53248);
    float* Lsw = (float*)(smem + 71680); bf16_t* Tb = (bf16_t*)(smem + 89088); float* gcs = (float*)(smem + 98304); float* betas = gcs + 64; float* kdec = gcs + 128;
    const int lane0 = tid & 63, tg0 = tid >> 5, ch0 = (tid & 31) * 4;
    for (int ub = blockIdx.x * 8; ub < 2048; ub += gridDim.x * 8) {
        const int bh = ub >> 7, b = bh >> 2, h = bh & 3;
        const float Aexp = __expf(p.in[12][h]), dtb = p.in[13][h];
        float cw[3][4][4];
#pragma unroll
        for (int a = 0; a < 3; ++a)
#pragma unroll
            for (int j = 0; j < 4; ++j) { const f32x4 w = *(const f32x4*)(p.in[11] + (size_t)j * 1536 + a * 512 + h * 128 + ch0); cw[a][j][0] = w[0]; cw[a][j][1] = w[1]; cw[a][j][2] = w[2]; cw[a][j][3] = w[3]; }
        u32x2 pre[3][7]; float lgb, lga;
#define GA_PREFETCH(unit_) do { const int n_ = (unit_) & 127; const size_t t0_ = (size_t)b * SEQ_ + (size_t)n_ * 64; \
        lgb = logits[(t0_ + lane0) * 8 + h]; lga = logits[(t0_ + lane0) * 8 + 4 + h]; \
        _Pragma("unroll") for (int r = 0; r < 7; ++r) { const int sp_ = n_ * 64 + 4 * tg0 - 3 + r; \
            _Pragma("unroll") for (int a = 0; a < 3; ++a) pre[a][r] = (sp_ >= 0) ? *(const u32x2*)(proj + ((size_t)b * SEQ_ + sp_) * PJ_ + 1024 + a * 512 + h * 128 + ch0) : (u32x2){0u, 0u}; } } while (0)
        GA_PREFETCH(ub);
        for (int k = 0; k < 8; ++k) {
            const int unit = ub + k, n = unit & 127;
            int tid_o = tid; asm volatile("" : "+v"(tid_o));
            const int lane = tid_o & 63, r16 = lane & 15, kq = lane >> 4, cg4 = tid_o & 31, tg = tid_o >> 5, ch = cg4 * 4;
            unsigned char* gbase = ws + WS_R4 + (size_t)unit * GU_BYTES;
            const float betav = sigmoidf_(lgb);
            float gc = -Aexp * softplusf_(lga + dtb);
#pragma unroll
            for (int o = 1; o < 64; o <<= 1) { const float tmp = __shfl_up(gc, o); if (lane >= o) gc += tmp; }
            const float gclast = __shfl(gc, 63);
            if (wid == 0) { gcs[lane] = gc; betas[lane] = betav; kdec[lane] = __expf(gclast - gc); }
            {
                float x[7][4], o[4][4], bt[4], egt[4];
#pragma unroll
                for (int t = 0; t < 4; ++t) { bt[t] = __shfl(betav, 4 * tg + t); egt[t] = __expf(__shfl(gc, 4 * tg + t)); }
#pragma unroll
                for (int a = 0; a < 3; ++a) {
#pragma unroll
                    for (int r = 0; r < 7; ++r) { x[r][0] = __uint_as_float(pre[a][r].x << 16); x[r][1] = __uint_as_float(pre[a][r].x & 0xffff0000u); x[r][2] = __uint_as_float(pre[a][r].y << 16); x[r][3] = __uint_as_float(pre[a][r].y & 0xffff0000u); }
#pragma unroll
                    for (int t = 0; t < 4; ++t)
#pragma unroll
                        for (int e = 0; e < 4; ++e) { float acc = cw[a][0][e] * x[t][e]; acc += cw[a][1][e] * x[t + 1][e]; acc += cw[a][2][e] * x[t + 2][e]; acc += cw[a][3][e] * x[t + 3][e]; o[t][e] = siluf_(acc); }
                    if (a < 2) {
#pragma unroll
                        for (int t = 0; t < 4; ++t) { float ssq = (o[t][0] * o[t][0] + o[t][1] * o[t][1]) + (o[t][2] * o[t][2] + o[t][3] * o[t][3]);
                            ssq += dpp_f<0xB1>(ssq); ssq += dpp_f<0x4E>(ssq); ssq += dpp_f<0x141>(ssq); ssq += dpp_f<0x140>(ssq); ssq += __shfl_xor(ssq, 16);
                            const float rs = rsqrtf(ssq + EPS_) * (a == 0 ? 0.08838834764831845f : 1.0f);
#pragma unroll
                            for (int e = 0; e < 4; ++e) o[t][e] *= rs; }
                    }
                    if (a == 0) {
#pragma unroll
                        for (int t = 0; t < 4; ++t) { const int tok = 4 * tg + t; u32x2 w; w.x = cvt_pk_bf16(o[t][0], o[t][1]); w.y = cvt_pk_bf16(o[t][2], o[t][3]); *(u32x2*)(Qb + tok * 136 + ch) = w;
                            u32x2 wd; wd.x = cvt_pk_bf16(o[t][0] * egt[t], o[t][1] * egt[t]); wd.y = cvt_pk_bf16(o[t][2] * egt[t], o[t][3] * egt[t]);
                            *(u32x2*)((bf16_t*)gbase + (size_t)(64 + tok) * 128 + 32 * (cg4 >> 3) + 8 * (cg4 & 3) + 4 * ((cg4 >> 2) & 1)) = wd; }
                    } else if (a == 1) {
#pragma unroll
                        for (int t = 0; t < 4; ++t) { const int tok = 4 * tg + t; u32x2 w; w.x = cvt_pk_bf16(o[t][0], o[t][1]); w.y = cvt_pk_bf16(o[t][2], o[t][3]); *(u32x2*)(Kb + tok * 136 + ch) = w; }
#pragma unroll
                        for (int e = 0; e < 4; ++e) { u32x2 w; w.x = cvt_pk_bf16(o[0][e] * bt[0] * egt[0], o[1][e] * bt[1] * egt[1]); w.y = cvt_pk_bf16(o[2][e] * bt[2] * egt[2], o[3][e] * bt[3] * egt[3]); *(u32x2*)(KBGt + (ch + e) * 72 + (((tg >> 1) ^ (cg4 & 7)) << 3) + 4 * (tg & 1)) = w; }
                    } else {
#pragma unroll
                        for (int e = 0; e < 4; ++e) { u32x2 w; w.x = cvt_pk_bf16(o[0][e] * bt[0], o[1][e] * bt[1]); w.y = cvt_pk_bf16(o[2][e] * bt[2], o[3][e] * bt[3]); *(u32x2*)(VBt + (ch + e) * 72 + (((tg >> 1) ^ (cg4 & 7)) << 3) + 4 * (tg & 1)) = w; }
                    }
                }
            }
            if (k + 1 < 8) GA_PREFETCH(unit + 1);
            __syncthreads();
#pragma unroll
            for (int rep = 0; rep < 2; ++rep) {
                const int tl = wid + 8 * rep, jt = tl >> 2, it = tl & 3;
                f32x4 accQ = {0.f, 0.f, 0.f, 0.f}, accK = {0.f, 0.f, 0.f, 0.f};
#pragma unroll
                for (int ks = 0; ks < 4; ++ks) { const bf16x8 a = *(const bf16x8*)(Kb + (16 * jt + r16) * 136 + 32 * ks + 8 * kq);
                    const bf16x8 bq = *(const bf16x8*)(Qb + (16 * it + r16) * 136 + 32 * ks + 8 * kq), bk = *(const bf16x8*)(Kb + (16 * it + r16) * 136 + 32 * ks + 8 * kq);
                    accQ = MFMA16(a, bq, accQ); accK = MFMA16(a, bk, accK); }
                const int i = 16 * it + r16; const float gi = gcs[i], bi = betas[i]; float qv[4];
#pragma unroll
                for (int jj = 0; jj < 4; ++jj) { const int j = 16 * jt + 4 * kq + jj; const float d = __expf(fminf(gi - gcs[j], 0.f));
                    qv[jj] = (i >= j) ? accQ[jj] * d : 0.f; Lsw[i * 68 + (j & 7) * 8 + (j >> 3)] = (i > j) ? bi * accK[jj] * d : 0.f; }
                u32x2 w; w.x = cvt_pk_bf16(qv[0], qv[1]); w.y = cvt_pk_bf16(qv[2], qv[3]);
                *(u32x2*)((bf16_t*)(gbase + GU_QK) + i * 64 + 32 * (jt >> 1) + 8 * kq + 4 * (jt & 1)) = w;
            }
            __syncthreads();
            {
                const int s = lane & 7, c = 8 * wid + (lane >> 3); float t[8];
#pragma unroll
                for (int m = 0; m < 8; ++m) t[m] = 0.f;
                f32x4 la[2][2]; la[0][0] = *(const f32x4*)(Lsw + s * 8); la[0][1] = *(const f32x4*)(Lsw + s * 8 + 4);
#pragma unroll
                for (int i = 0; i < 64; ++i) {
                    if (i + 1 < 64) { la[(i + 1) & 1][0] = *(const f32x4*)(Lsw + (i + 1) * 68 + s * 8); la[(i + 1) & 1][1] = *(const f32x4*)(Lsw + (i + 1) * 68 + s * 8 + 4); }
                    asm volatile("" ::: "memory");
                    const f32x4 l0 = la[i & 1][0], l1 = la[i & 1][1];
                    float part = 0.f;
#pragma unroll
                    for (int m = 0; m < 8; ++m) if (8 * m <= i) part += ((m < 4) ? l0[m & 3] : l1[m & 3]) * t[m];
                    part = red8(part);
                    const float val = ((i == c) ? 1.0f : 0.0f) - part;
                    if (s == (i & 7)) t[i >> 3] = val;
                }
#pragma unroll
                for (int m = 0; m < 8; ++m) Tb[(8 * m + s) * 72 + c] = f2bf(t[m]);
            }
            __syncthreads();
            {
#pragma unroll
                for (int mt = 0; mt < 4; ++mt) { f32x4 acc = {0.f, 0.f, 0.f, 0.f};
#pragma unroll
                    for (int ks = 0; ks < 2; ++ks) { const bf16x8 a = *(const bf16x8*)(Tb + (16 * mt + r16) * 72 + 32 * ks + 8 * kq), bb = *(const bf16x8*)(VBt + (16 * wid + r16) * 72 + (((4 * ks + kq) ^ ((4 * wid + (r16 >> 2)) & 7)) << 3)); acc = MFMA16(a, bb, acc); }
                    u32x2 w; w.x = cvt_pk_bf16(acc[0], acc[1]); w.y = cvt_pk_bf16(acc[2], acc[3]);
                    *(u32x2*)((bf16_t*)(gbase + GU_U) + ((wid * 4 + mt) * 64 + lane) * 4) = w; }
#pragma unroll
                for (int it = 0; it < 4; ++it) { f32x4 acc = {0.f, 0.f, 0.f, 0.f};
#pragma unroll
                    for (int ks = 0; ks < 2; ++ks) { const bf16x8 a = *(const bf16x8*)(KBGt + (16 * wid + r16) * 72 + (((4 * ks + kq) ^ ((4 * wid + (r16 >> 2)) & 7)) << 3)), bb = *(const bf16x8*)(Tb + (16 * it + r16) * 72 + 32 * ks + 8 * kq); acc = MFMA16(a, bb, acc); }
                    u32x2 w; w.x = cvt_pk_bf16(acc[0], acc[1]); w.y = cvt_pk_bf16(acc[2], acc[3]);
                    *(u32x2*)((bf16_t*)gbase + (16 * it + r16) * 128 + 32 * (wid >> 1) + 8 * kq + 4 * (wid & 1)) = w; }
                const int dk = tid_o >> 2, pg = tid_o & 3; float v[16];
#pragma unroll
                for (int e = 0; e < 16; ++e) { const int tk = tok_of_pos(16 * pg + e); v[e] = bf2f(Kb[tk * 136 + dk]) * kdec[tk]; }
                u32x4 w0, w1; w0.x = cvt_pk_bf16(v[0], v[1]); w0.y = cvt_pk_bf16(v[2], v[3]); w0.z = cvt_pk_bf16(v[4], v[5]); w0.w = cvt_pk_bf16(v[6], v[7]);
                w1.x = cvt_pk_bf16(v[8], v[9]); w1.y = cvt_pk_bf16(v[10], v[11]); w1.z = cvt_pk_bf16(v[12], v[13]); w1.w = cvt_pk_bf16(v[14], v[15]);
                *(u32x4*)((bf16_t*)(gbase + GU_KDT) + dk * 64 + 16 * pg) = w0; *(u32x4*)((bf16_t*)(gbase + GU_KDT) + dk * 64 + 16 * pg + 8) = w1;
                if (tid == 0) gtot[unit] = __expf(gclast);
            }
            __syncthreads();
        }
    }
#undef GA_PREFETCH
}

constexpr int GB_BUF = 62464, GB_KDT = 34816, GB_QK = 53248, GB_BUF2 = GB_BUF + 4096 + 16;
__device__ __forceinline__ void gdn_pass_b(const Params& p, unsigned char* smem, int wg) {
    const int tid = threadIdx.x, wid = __builtin_amdgcn_readfirstlane(tid >> 6), lane = tid & 63, r16 = lane & 15, kq = lane >> 4;
    const int bh = wg >> 2, cgp = wg & 3, b = bh >> 2, h = bh & 3, nt = cgp * 2 + wid;
    unsigned char* ws = p.ws; const unsigned char* ubase = ws + WS_R4 + (size_t)(bh * 128) * GU_BYTES; const float* gtot = (const float*)(ws + WS_GTOT) + bh * 128;
    bf16_t* oraw = (bf16_t*)(ws + WS_ORAW);
#define GB_BAR() do { asm volatile("s_waitcnt lgkmcnt(0)" ::: "memory"); __builtin_amdgcn_s_barrier(); asm volatile("" ::: "memory"); } while (0)
    if (wid >= 2) {
        const int lt = tid - 128;
        int dsto[10]; size_t srco[10];
#pragma unroll
        for (int it = 0; it < 10; ++it) { const int q = lt + 384 * it;
            dsto[it] = (q < 2048) ? (q >> 4) * 272 + (q & 15) * 16 : (q < 3072) ? GB_KDT + ((q - 2048) >> 3) * 144 + ((q - 2048) & 7) * 16 : (q < 3584) ? GB_QK + ((q - 3072) >> 3) * 144 + ((q - 3072) & 7) * 16 : GB_BUF + (q - 3584) * 16;
            srco[it] = (q < 3584) ? (size_t)q * 16 : (size_t)(GU_U + cgp * 4096 + (q - 3584) * 16); }
        u32x4 sa[10], sb[10], sc[10]; float ga = 0.f, gb = 0.f, gc = 0.f;
#define GB_LD(st, g, n_) do { const unsigned char* rp_ = ubase + (size_t)(n_) * GU_BYTES; _Pragma("unroll") for (int it = 0; it < 10; ++it) st[it] = *(const u32x4*)(rp_ + srco[it]); if (lt == 0) g = gtot[n_]; } while (0)
#define GB_WR(st, g, bufi) do { unsigned char* bp_ = smem + (bufi) * GB_BUF2; _Pragma("unroll") for (int it = 0; it < 10; ++it) *(u32x4*)(bp_ + dsto[it]) = st[it]; if (lt == 0) *(float*)(bp_ + GB_BUF + 4096) = g; } while (0)
        GB_LD(sa, ga, 0); GB_WR(sa, ga, 0); GB_BAR();
        GB_LD(sa, ga, 1); GB_LD(sb, gb, 2); GB_LD(sc, gc, 3);
        for (int n0 = 0; n0 < NCH_; n0 += 3) {
            { const int n = n0;     if (n < NCH_) { if (n + 1 < NCH_) GB_WR(sa, ga, (n + 1) & 1); if (n + 4 < NCH_) GB_LD(sa, ga, n + 4); GB_BAR(); } }
            { const int n = n0 + 1; if (n < NCH_) { if (n + 1 < NCH_) GB_WR(sb, gb, (n + 1) & 1); if (n + 4 < NCH_) GB_LD(sb, gb, n + 4); GB_BAR(); } }
            { const int n = n0 + 2; if (n < NCH_) { if (n + 1 < NCH_) GB_WR(sc, gc, (n + 1) & 1); if (n + 4 < NCH_) GB_LD(sc, gc, n + 4); GB_BAR(); } }
        }
#undef GB_LD
#undef GB_WR
    } else {
        __builtin_amdgcn_s_setprio(3);
        f32x4 S[8]; bf16x8 Sb[4];
#pragma unroll
        for (int d = 0; d < 8; ++d) S[d] = (f32x4){0.f, 0.f, 0.f, 0.f};
#pragma unroll
        for (int k = 0; k < 4; ++k) Sb[k] = (bf16x8){0, 0, 0, 0, 0, 0, 0, 0};
        GB_BAR();
        for (int n = 0; n < NCH_; ++n) {
            const unsigned char* L = smem + (n & 1) * GB_BUF2; const float gt = *(const float*)(L + GB_BUF + 4096); const size_t t0 = (size_t)b * SEQ_ + (size_t)n * 64;
            u32x2 uw[4];
#pragma unroll
            for (int tt = 0; tt < 4; ++tt) uw[tt] = *(const u32x2*)(L + GB_BUF + ((wid * 4 + tt) * 64 + lane) * 8);
            f32x4 P[8];
#pragma unroll
            for (int m = 0; m < 8; ++m) P[m] = (f32x4){0.f, 0.f, 0.f, 0.f};
#pragma unroll
            for (int ks = 0; ks < 4; ++ks)
#pragma unroll
                for (int mt = 0; mt < 8; ++mt) { const bf16x8 a = *(const bf16x8*)(L + (16 * mt + r16) * 272 + (32 * ks + 8 * kq) * 2); P[mt] = MFMA16(a, Sb[ks], P[mt]); }
            f32x4 vn[4];
#pragma unroll
            for (int tt = 0; tt < 4; ++tt) { const f32x4 u = {__uint_as_float(uw[tt].x << 16), __uint_as_float(uw[tt].x & 0xffff0000u), __uint_as_float(uw[tt].y << 16), __uint_as_float(uw[tt].y & 0xffff0000u)}; vn[tt] = u - P[tt]; }
            bf16x8 Vb[2]; Vb[0] = pack8(vn[0], vn[1]); Vb[1] = pack8(vn[2], vn[3]);
#pragma unroll
            for (int tt = 0; tt < 4; ++tt) { f32x4 O = P[4 + tt];
#pragma unroll
                for (int ks = 0; ks < 2; ++ks) { const bf16x8 a = *(const bf16x8*)(L + GB_QK + (16 * tt + r16) * 144 + (32 * ks + 8 * kq) * 2); O = MFMA16(a, Vb[ks], O); }
                bf16_t* op = oraw + (t0 + 16 * tt + 4 * kq) * 512 + h * 128 + 16 * nt + r16;
#pragma unroll
                for (int j = 0; j < 4; ++j) op[(size_t)j * 512] = f2bf(O[j]); }
#pragma unroll
            for (int dt = 0; dt < 8; ++dt) { f32x4 acc = S[dt] * gt;
#pragma unroll
                for (int ks = 0; ks < 2; ++ks) { const bf16x8 a = *(const bf16x8*)(L + GB_KDT + (16 * dt + r16) * 144 + (32 * ks + 8 * kq) * 2); acc = MFMA16(a, Vb[ks], acc); }
                S[dt] = acc; }
#pragma unroll
            for (int ks = 0; ks < 4; ++ks) Sb[ks] = pack8(S[2 * ks], S[2 * ks + 1]);
            GB_BAR();
        }
        __builtin_amdgcn_s_setprio(0);
    }
#undef GB_BAR
}

__device__ __forceinline__ void gdn_norm(const Params& p) {
    unsigned char* ws = p.ws; const bf16_t* oraw = (const bf16_t*)(ws + WS_ORAW); const bf16_t* proj = (const bf16_t*)(ws + WS_PROJ); bf16_t* y = (bf16_t*)(ws + WS_Y);
    int tid_o = threadIdx.x; asm volatile("" : "+v"(tid_o));
    const int gtid = blockIdx.x * NTHREADS + tid_o, sub = gtid & 31; const f32x4 nwv = *(const f32x4*)(p.in[14] + sub * 4);
    const int stride = (gridDim.x * NTHREADS) >> 5;
    for (int item0 = gtid >> 5; item0 < T_ * 4; item0 += 4 * stride) {
        u32x2 ow[4], zw[4];
#pragma unroll
        for (int q = 0; q < 4; ++q) { const int item = item0 + q * stride; const int t = item >> 2, h = item & 3;
            if (item < T_ * 4) { ow[q] = *(const u32x2*)(oraw + (size_t)t * 512 + h * 128 + sub * 4); zw[q] = *(const u32x2*)(proj + (size_t)t * PJ_ + 2560 + h * 128 + sub * 4); } else { ow[q] = (u32x2){0u, 0u}; zw[q] = (u32x2){0u, 0u}; } }
#pragma unroll
        for (int q = 0; q < 4; ++q) { const int item = item0 + q * stride; const int t = item >> 2, h = item & 3;
            const f32x4 ov = {__uint_as_float(ow[q].x << 16), __uint_as_float(ow[q].x & 0xffff0000u), __uint_as_float(ow[q].y << 16), __uint_as_float(ow[q].y & 0xffff0000u)};
            float s = (ov[0] * ov[0] + ov[1] * ov[1]) + (ov[2] * ov[2] + ov[3] * ov[3]);
#pragma unroll
            for (int o = 1; o < 32; o <<= 1) s += __shfl_xor(s, o);
            const float rs = rsqrtf(s * (1.0f / 128.0f) + EPS_);
            const float z0 = __uint_as_float(zw[q].x << 16), z1 = __uint_as_float(zw[q].x & 0xffff0000u), z2 = __uint_as_float(zw[q].y << 16), z3 = __uint_as_float(zw[q].y & 0xffff0000u);
            u32x2 w; w.x = cvt_pk_bf16(ov[0] * rs * nwv[0] * siluf_(z0), ov[1] * rs * nwv[1] * siluf_(z1)); w.y = cvt_pk_bf16(ov[2] * rs * nwv[2] * siluf_(z2), ov[3] * rs * nwv[3] * siluf_(z3));
            if (item < T_ * 4) *(u32x2*)(y + (size_t)t * D_ + 512 + h * 128 + sub * 4) = w; }
    }
}

__device__ __forceinline__ void phase_final(const Params& p) {
    const int tid = threadIdx.x, wid = __builtin_amdgcn_readfirstlane(tid >> 6), lane = tid & 63;
    const float* ss = (const float*)(p.ws + WS_SSA); const float* nw = p.in[24]; float* out = p.out; const bf16_t* x3b = (const bf16_t*)(p.ws + WS_XB);
    f32x4 nwv[4];
#pragma unroll
    for (int i = 0; i < 4; ++i) nwv[i] = *(const f32x4*)(nw + 4 * (lane + 64 * i));
    u32x2 wn[4]; int row = blockIdx.x * 8 + wid;
    if (row < T_) {
#pragma unroll
        for (int i = 0; i < 4; ++i) wn[i] = *(const u32x2*)(x3b + (size_t)row * D_ + 4 * (lane + 64 * i)); }
    for (; row < T_; row += gridDim.x * 8) {
        const float rs = rstd16(ss, row);
        u32x2 wc[4];
#pragma unroll
        for (int i = 0; i < 4; ++i) wc[i] = wn[i];
        { const int nrow = row + gridDim.x * 8;
          if (nrow < T_) {
#pragma unroll
            for (int i = 0; i < 4; ++i) wn[i] = *(const u32x2*)(x3b + (size_t)nrow * D_ + 4 * (lane + 64 * i)); } }
#pragma unroll
        for (int i = 0; i < 4; ++i) { const u32x2 w = wc[i]; const f32x4 v = {__uint_as_float(w.x << 16), __uint_as_float(w.x & 0xffff0000u), __uint_as_float(w.y << 16), __uint_as_float(w.y & 0xffff0000u)};
            __builtin_nontemporal_store(v * rs * nwv[i], (f32x4*)(out + (size_t)row * D_ + 4 * (lane + 64 * i))); }
    }
}

constexpr int NPHASES = 11;
__global__ void __launch_bounds__(NTHREADS, 2) mega_fwd(Params p) {
    extern __shared__ __attribute__((aligned(16))) unsigned char smem[];
    PG8_LAS unsigned char* lds = (PG8_LAS unsigned char*)smem;
    cg::grid_group grid = cg::this_grid();
    unsigned char* ws = p.ws;
    bf16_t* hb = (bf16_t*)(ws + WS_XB); bf16_t* xb = (bf16_t*)(ws + WS_XB2); bf16_t* proj = (bf16_t*)(ws + WS_PROJ); bf16_t* ff = proj; bf16_t* y = (bf16_t*)(ws + WS_Y); bf16_t* pp = (bf16_t*)p.out;
    float* ssA = (float*)(ws + WS_SSA); float* ssB = (float*)(ws + WS_SSB);
#ifdef ONLY_PHASE
#define PH_ON(n) ((n) == ONLY_PHASE)
#else
#define PH_ON(n) ((n) >= p.ph_lo && (n) < p.ph_hi)
#endif
    volatile LAS unsigned* xst = (volatile LAS unsigned*)(lds + LDS_BYTES - 16);
    if (threadIdx.x == 0) { xst[0] = 0u; xst[1] = 0u; xst[2] = 0u; xst[3] = 0u; }
    __syncthreads();
    const XcdBarrier xbar = xcd_barrier_post((unsigned*)(ws + WS_BAR), xst);
    if (p.ph_lo == 0x7fffffff) grid.sync();
#define PH_SYNC(n) do { if ((n) > p.ph_lo && (n) < p.ph_hi) { xcd_barrier(xbar); } } while (0)
    if (PH_ON(0)) phase_prep(p, smem);
    PH_SYNC(1);
    if (PH_ON(1)) { EpiBf16Plain E; E.O = proj; E.ldc = PJ_; run_gemm(lds, hb, (const bf16_t*)(ws + WS_WIN), T_, PJ_, D_, E); }
    PH_SYNC(2);
    if (PH_ON(2)) { rg_pass_mfma<false>(p, smem, (int)blockIdx.x, (int)gridDim.x); __syncthreads(); gdn_pass_a(p, smem); }
    PH_SYNC(3);
    if (PH_ON(3)) {
        unsigned* flag = (unsigned*)ws + 16;
        if (blockIdx.x < 64) { const int xq = blockIdx.x & 7, kq8 = blockIdx.x >> 3;
            gdn_pass_b(p, smem, ((xq + 8 * (kq8 >> 2)) << 2) | (kq8 & 3)); }
        else {
            if (blockIdx.x < 68) { rg_carry(p, (blockIdx.x - 64) * NTHREADS + threadIdx.x); __threadfence(); __syncthreads();
                if (threadIdx.x == 0) __hip_atomic_fetch_add(flag, 1u, __ATOMIC_RELEASE, __HIP_MEMORY_SCOPE_AGENT); }
            prep_weights_late(p, smem, (int)blockIdx.x - 64, (int)gridDim.x - 64);
            if (threadIdx.x == 0) { while (__hip_atomic_load(flag, __ATOMIC_ACQUIRE, __HIP_MEMORY_SCOPE_AGENT) < 4u) __builtin_amdgcn_s_sleep(8); }
            __syncthreads(); __threadfence();
            rg_pass_mfma<true>(p, smem, (int)blockIdx.x - 64, (int)gridDim.x - 64);
            __syncthreads();
            { EpiBf16Plain E2; E2.O = pp; E2.ldc = D_; pg8::Gemm g2; g2.A = (const bf16_t*)(ws + WS_PB); g2.Bt = (const bf16_t*)(ws + WS_WPP); g2.M = T_; g2.N = D_; g2.K = PLE_;
              pg8::StaticOrder S2; S2.init(T_, D_, (int)gridDim.x - 64, (int)blockIdx.x - 64); pg8::gemm_phase<EpiBf16Plain, pg8::StaticOrder, GEMM_ALIGN, GEMM_SP2>(lds, g2, S2, E2); }
        }
    }
    PH_SYNC(4);
    if (PH_ON(4)) gdn_norm(p);
    PH_SYNC(5);
    if (PH_ON(5)) { EpiResid<false> E; E.res = p.in[0]; E.xb = xb; E.ss = ssA; run_gemm(lds, y, (const bf16_t*)(ws + WS_WOUT), T_, D_, D_, E); }
    PH_SYNC(6);
    if (PH_ON(6)) { EpiGateUp E; E.ff = ff; E.ss = ssA; run_gemm(lds, xb, (const bf16_t*)(ws + WS_WGU), T_, 2 * FF_, D_, E); }
    PH_SYNC(7);
    if (PH_ON(7)) { EpiResid<true> E; E.res = nullptr; E.xb = xb; E.ss = ssB; run_gemm(lds, ff, (const bf16_t*)(ws + WS_WD), T_, D_, FF_, E); }
    PH_SYNC(8);
    if (PH_ON(8)) { EpiPle E; E.x2b = xb; E.x3b = hb; E.pp = pp; E.bias = p.in[22]; E.ss_in = ssB; E.ss_out = ssA; run_gemm(lds, xb, (const bf16_t*)(ws + WS_WPG), T_, D_, D_, E); }
    PH_SYNC(9);
    if (PH_ON(9)) phase_final(p);
}

extern "C" void kernel_launch(void* const* d_in, const int* in_sizes, int n_in, void* d_out, int out_size, void* d_ws, size_t ws_size, hipStream_t stream) {
    static int grid = 0;
    if (grid == 0) {
        if (n_in != 25 || out_size != T_ * D_ || ws_size < WS_END) { fprintf(stderr, "kernel_launch: unexpected shapes: n_in %d out %d ws %zu (need %zu)\n", n_in, out_size, ws_size, (size_t)WS_END); grid = -1; return; }
        int dev = 0, cus = 0, per_cu = 0;
        hipGetDevice(&dev); hipDeviceGetAttribute(&cus, hipDeviceAttributeMultiprocessorCount, dev);
        if (hipFuncSetAttribute((const void*)mega_fwd, hipFuncAttributeMaxDynamicSharedMemorySize, LDS_BYTES) != hipSuccess) { fprintf(stderr, "kernel_launch: hipFuncSetAttribute failed\n"); grid = -1; return; }
        if (hipOccupancyMaxActiveBlocksPerMultiprocessor(&per_cu, (const void*)mega_fwd, NTHREADS, LDS_BYTES) != hipSuccess || per_cu < 1) { fprintf(stderr, "kernel_launch: occupancy query says %d\n", per_cu); per_cu = 1; }
        (void)hipGetLastError();
        grid = cus * 1;
        if (grid <= 0) grid = 256;
    }
    if (grid < 0) return;
    Params p{};
    for (int i = 0; i < 25; ++i) p.in[i] = (const float*)d_in[i];
    p.out = (float*)d_out; p.ws = (unsigned char*)d_ws; p.ph_lo = 0; p.ph_hi = NPHASES;
    if (hipMemsetAsync((char*)d_ws + WS_BAR, 0, XCD_BAR_WORDS * 4, stream) != hipSuccess) { fprintf(stderr, "kernel_launch: memset of the barrier words failed\n"); return; }
    void* args[] = {&p};
    hipError_t e = hipLaunchCooperativeKernel((const void*)mega_fwd, dim3(grid), dim3(NTHREADS), args, LDS_BYTES, stream);
    if (e != hipSuccess) fprintf(stderr, "cooperative launch failed: %s (grid %d)\n", hipGetErrorString(e), grid);
}
```

```cpp
#include <hip/hip_runtime.h>
#include <hip/hip_cooperative_groups.h>
#include <cstdio>
#include <cstdint>
namespace cg = cooperative_groups;
namespace pg8 {
#define PG8_LAS __attribute__((address_space(3)))
typedef unsigned short bf16_t;
typedef short bf16x8 __attribute__((ext_vector_type(8)));
typedef float f32x4 __attribute__((ext_vector_type(4)));
typedef unsigned u32x4 __attribute__((ext_vector_type(4)));
constexpr int BM = 256, BK = 64, HALF = 128, HTB = HALF * BK * 2  , STAGE_BYTES = 8 * HTB, NXCD = 8, WGM = 8;

__host__ __device__ __forceinline__ int lds_byte(int r, int c) { const int st = (r >> 4) * 2 + (c >> 5), rr = r & 15, cc = c & 31, ob = rr * 64 + cc * 2; return st * 1024 + (ob ^ (((ob >> 9) & 1) << 5)); }
__host__ __device__ __forceinline__ void stage_rc(int b, int& R, int& C) { const int st = b / 1024, sb = b % 1024, swz = sb ^ (((sb >> 9) & 1) << 5); R = (st >> 1) * 16 + swz / 64; C = (st & 1) * 32 + (swz % 64) / 2; }
__host__ __device__ __forceinline__ int perm32(int rho) { const int n = rho >> 4, i = rho & 15; return 8 * (i >> 2) + 4 * n + (i & 3); }

struct Unit { int pm, pn; };
struct Gemm { const bf16_t* A; const bf16_t* Bt; int M, N, K; };

struct StaticOrder {
    int nM, nN, nwg, G, c;
    __host__ __device__ void init(int M, int N, int G_, int c_) { nM = M / BM; nN = N / BM; nwg = nM * nN; G = G_; c = c_; }
    __host__ __device__ bool next(int i, Unit& u) const {
        const long L = (long)i * G + c; if (L >= nwg) return false;
        int wgid = (int)L; { const int q = nwg / NXCD, r = nwg % NXCD, xcd = wgid % NXCD, off = wgid / NXCD; wgid = (xcd < r ? xcd * (q + 1) : r * (q + 1) + (xcd - r) * q) + off; }
        const int nig = WGM * nN, gid = wgid / nig, fm = gid * WGM, gsz = (nM - fm) < WGM ? (nM - fm) : WGM;
        u.pm = fm + ((wgid % nig) % gsz); u.pn = (wgid % nig) / gsz; return true;
    }
    __device__ __forceinline__ void a_ready(const Unit&) const {}
    __device__ __forceinline__ void done(const Unit&) const {}
};
typedef __bf16 bf16v2_ __attribute__((ext_vector_type(2)));
typedef float f32v2_ __attribute__((ext_vector_type(2)));
__device__ __forceinline__ unsigned cvt_pk_bf16(float lo, float hi) { f32v2_ v = {lo, hi}; bf16v2_ b = __builtin_convertvector(v, bf16v2_); return __builtin_bit_cast(unsigned, b); }
typedef float f32x2 __attribute__((ext_vector_type(2)));
template <class Epi, class Sched, bool ALIGN_EPI = false, bool SP2 = false>
__device__ __forceinline__ void gemm_phase(PG8_LAS unsigned char* lds, const Gemm g, const Sched& S, const Epi& E) {
    int tid = threadIdx.x; asm volatile("" : "+v"(tid));
    const int wid = __builtin_amdgcn_readfirstlane(tid >> 6), lane = tid & 63, wr = wid >> 2, wc = wid & 3, fr = lane & 15, fq = lane >> 4;
    const int K = g.K, nt = K / BK;
    unsigned voffA[2], voffB[2];
#pragma unroll
    for (int i = 0; i < 2; ++i) { int R, C; stage_rc(tid * 16 + i * 8192, R, C); const int Rb = Epi::PERM ? ((R & ~31) + perm32(R & 31)) : R;
        voffA[i] = (unsigned)(R * K + C) * 2u; voffB[i] = (unsigned)(Rb * K + C) * 2u; }
    const size_t kstep = (size_t)(BK * 2);
    const size_t hstep = (size_t)HALF * K * 2;
    const size_t tstep = 2 * hstep;
    const unsigned ldsw = (unsigned)wid * 1024u;
    const int aoff = lds_byte(wr * 64 + fr, fq * 8), boff = lds_byte(wc * 32 + fr, fq * 8);
#define PG8_SA(b, h) (((b) * 2 + (h)) * HTB)
#define PG8_SB(b, h) ((4 + (b) * 2 + (h)) * HTB)
#define PG8_STAGE(bufoff, gbase, voff) do { _Pragma("unroll") for (int _i = 0; _i < 2; ++_i) \
        __builtin_amdgcn_global_load_lds((const unsigned*)((const char*)(gbase) + (voff)[_i]), (PG8_LAS unsigned*)(lds + (bufoff) + ldsw + _i * 8192), 16, 0, 0); } while (0)
#define PG8_LDA(dst, b, h) do { _Pragma("unroll") for (int m = 0; m < 4; ++m) _Pragma("unroll") for (int k = 0; k < 2; ++k) dst[m][k] = *(const PG8_LAS bf16x8*)(lds + PG8_SA(b, h) + aoff + m * 2048 + k * 1024); } while (0)
#define PG8_LDB(dst, b, h) do { _Pragma("unroll") for (int n = 0; n < 2; ++n) _Pragma("unroll") for (int k = 0; k < 2; ++k) dst[n][k] = *(const PG8_LAS bf16x8*)(lds + PG8_SB(b, h) + boff + n * 2048 + k * 1024); } while (0)
#define PG8_MMA(ai, bj, At, Bt) do { __builtin_amdgcn_s_setprio(1); _Pragma("unroll") for (int m = 0; m < 4; ++m) _Pragma("unroll") for (int n = 0; n < 2; ++n) _Pragma("unroll") for (int k = 0; k < 2; ++k) \
        acc[ai][bj][m][n] = __builtin_amdgcn_mfma_f32_16x16x32_bf16(Bt[n][k], At[m][k], acc[ai][bj][m][n], 0, 0, 0); __builtin_amdgcn_s_setprio(0); } while (0)
#define PG8_WAIT_V(n) asm volatile("s_waitcnt vmcnt(" #n ")" ::: "memory")
#define PG8_WAIT_L(n) asm volatile("s_waitcnt lgkmcnt(" #n ")" ::: "memory")
#define PG8_BAR __builtin_amdgcn_s_barrier()
#define PG8_SCHED __builtin_amdgcn_sched_barrier(0)
    Unit cur, nxt; int ui = 0;
    if (!S.next(0, cur)) return;
    f32x4 acc[2][2][4][2];
#pragma unroll
    for (int a = 0; a < 2; ++a)
#pragma unroll
        for (int b = 0; b < 2; ++b)
#pragma unroll
            for (int m = 0; m < 4; ++m)
#pragma unroll
                for (int n = 0; n < 2; ++n) acc[a][b][m][n] = (f32x4){0.f, 0.f, 0.f, 0.f};
    bf16x8 At[4][2], B0[2][2], B1[2][2];
    const char* cA = (const char*)g.A + (size_t)cur.pm * tstep; const char* cB = (const char*)g.Bt + (size_t)cur.pn * tstep;
    S.a_ready(cur);
    if constexpr (SP2) {
        PG8_STAGE(PG8_SB(0, 0), cB, voffB); PG8_STAGE(PG8_SB(0, 1), cB + hstep, voffB); PG8_STAGE(PG8_SA(0, 0), cA, voffA); PG8_STAGE(PG8_SA(0, 1), cA + hstep, voffA);
        if (wr == 1) PG8_BAR;
        PG8_WAIT_V(2); PG8_BAR;
        PG8_STAGE(PG8_SB(1, 0), cB + kstep, voffB); PG8_STAGE(PG8_SA(1, 0), cA + kstep, voffA); PG8_STAGE(PG8_SB(1, 1), cB + hstep + kstep, voffB);
        PG8_WAIT_V(6); PG8_BAR;
    } else {
        PG8_STAGE(PG8_SB(0, 0), cB, voffB); PG8_STAGE(PG8_SA(0, 0), cA, voffA); PG8_STAGE(PG8_SB(0, 1), cB + hstep, voffB); PG8_STAGE(PG8_SA(0, 1), cA + hstep, voffA);
        if (wr == 1) PG8_BAR;
        PG8_WAIT_V(4); PG8_BAR;
        PG8_STAGE(PG8_SB(1, 0), cB + kstep, voffB); PG8_STAGE(PG8_SA(1, 0), cA + kstep, voffA); PG8_STAGE(PG8_SB(1, 1), cB + hstep + kstep, voffB);
        PG8_WAIT_V(6); PG8_BAR;
    }
    for (;;) {
        const bool has_next = S.next(ui + 1, nxt);
        const char* nA = has_next ? (const char*)g.A + (size_t)nxt.pm * tstep : cA; const char* nB = has_next ? (const char*)g.Bt + (size_t)nxt.pn * tstep : cB;
        for (int t = 0; t < nt; t += 2) {
            const bool last = (t == nt - 2);
            const char* a1 = cA + (size_t)(t + 1) * kstep;
            const char* a2 = last ? nA : cA + (size_t)(t + 2) * kstep; const char* b2 = last ? nB : cB + (size_t)(t + 2) * kstep;
            const char* a3 = a2 + kstep; const char* b3 = b2 + kstep;
            if (last && has_next) S.a_ready(nxt);
            if constexpr (SP2) {
            PG8_LDB(B0, 0, 0); PG8_LDB(B1, 0, 1); PG8_SCHED; PG8_LDA(At, 0, 0); PG8_STAGE(PG8_SA(1, 1), a1 + hstep, voffA);
            PG8_WAIT_V(8); PG8_WAIT_L(0); PG8_BAR; PG8_MMA(0, 0, At, B0); PG8_MMA(0, 1, At, B1); PG8_BAR; PG8_SCHED;
            PG8_LDA(At, 0, 1); PG8_STAGE(PG8_SB(0, 0), b2, voffB); PG8_STAGE(PG8_SB(0, 1), b2 + hstep, voffB); PG8_STAGE(PG8_SA(0, 0), a2, voffA);
            PG8_WAIT_V(8); PG8_WAIT_L(0); PG8_BAR; PG8_MMA(1, 0, At, B0); PG8_MMA(1, 1, At, B1); PG8_BAR; PG8_SCHED;
            PG8_LDB(B0, 1, 0); PG8_LDB(B1, 1, 1); PG8_SCHED; PG8_LDA(At, 1, 0); PG8_STAGE(PG8_SA(0, 1), a2 + hstep, voffA);
            PG8_WAIT_V(8); PG8_WAIT_L(0); PG8_BAR; PG8_MMA(0, 0, At, B0); PG8_MMA(0, 1, At, B1); PG8_BAR; PG8_SCHED;
            PG8_LDA(At, 1, 1); PG8_STAGE(PG8_SB(1, 0), b3, voffB); PG8_STAGE(PG8_SB(1, 1), b3 + hstep, voffB); PG8_STAGE(PG8_SA(1, 0), a3, voffA);
            PG8_WAIT_V(8); PG8_WAIT_L(0); PG8_BAR; PG8_MMA(1, 0, At, B0); PG8_MMA(1, 1, At, B1); PG8_BAR; PG8_SCHED;
            } else {
            PG8_LDB(B0, 0, 0); PG8_SCHED; PG8_LDA(At, 0, 0); PG8_STAGE(PG8_SA(1, 1), a1 + hstep, voffA);
            PG8_WAIT_L(8); PG8_BAR; PG8_WAIT_L(0); PG8_MMA(0, 0, At, B0); PG8_BAR; PG8_SCHED;
            PG8_LDB(B1, 0, 1); PG8_STAGE(PG8_SB(0, 0), b2, voffB);
            PG8_BAR; PG8_WAIT_L(0); PG8_MMA(0, 1, At, B1); PG8_BAR;
            PG8_LDA(At, 0, 1); PG8_STAGE(PG8_SA(0, 0), a2, voffA);
            PG8_BAR; PG8_WAIT_L(0); PG8_MMA(1, 0, At, B0); PG8_BAR; PG8_SCHED;
            PG8_STAGE(PG8_SB(0, 1), b2 + hstep, voffB);
            PG8_WAIT_V(6); PG8_BAR; PG8_MMA(1, 1, At, B1); PG8_BAR;
            PG8_LDB(B0, 1, 0); PG8_SCHED; PG8_LDA(At, 1, 0); PG8_STAGE(PG8_SA(0, 1), a2 + hstep, voffA);
            PG8_WAIT_L(8); PG8_BAR; PG8_WAIT_L(0); PG8_MMA(0, 0, At, B0); PG8_BAR; PG8_SCHED;
            PG8_LDB(B1, 1, 1); PG8_STAGE(PG8_SB(1, 0), b3, voffB);
            PG8_BAR; PG8_WAIT_L(0); PG8_MMA(0, 1, At, B1); PG8_BAR;
            PG8_LDA(At, 1, 1); PG8_STAGE(PG8_SA(1, 0), a3, voffA);
            PG8_BAR; PG8_WAIT_L(0); PG8_MMA(1, 0, At, B0); PG8_BAR; PG8_SCHED;
            PG8_STAGE(PG8_SB(1, 1), b3 + hstep, voffB);
            PG8_WAIT_V(6); PG8_BAR; PG8_MMA(1, 1, At, B1); PG8_BAR;
            }
        }
        if constexpr (ALIGN_EPI) { if (wr == 0) PG8_BAR; }
        if constexpr (!Epi::AFTER_DRAIN) { E(acc, cur, wr, wc, fr, fq); S.done(cur); }
        if (!has_next) break;
#pragma unroll
        for (int a = 0; a < 2; ++a)
#pragma unroll
            for (int b = 0; b < 2; ++b)
#pragma unroll
                for (int m = 0; m < 4; ++m)
#pragma unroll
                    for (int n = 0; n < 2; ++n) acc[a][b][m][n] = (f32x4){0.f, 0.f, 0.f, 0.f};
        cur = nxt; cA = nA; cB = nB; ++ui;
        if constexpr (ALIGN_EPI) { if (wr == 1) PG8_BAR; }
    }
    PG8_WAIT_V(0);
    if constexpr (!ALIGN_EPI) { if (wr == 0) PG8_BAR; }
    PG8_BAR;
    if constexpr (Epi::AFTER_DRAIN) { E.fused(acc, cur, wr, wc, fr, fq, lds, wid, lane); S.done(cur); }
#undef PG8_SA
#undef PG8_SB
#undef PG8_STAGE
#undef PG8_LDA
#undef PG8_LDB
#undef PG8_MMA
#undef PG8_WAIT_V
#undef PG8_WAIT_L
#undef PG8_BAR
#undef PG8_SCHED
}
}
#define XB_TMO      128
#define XB_XCNT(j)  (256  + 64 * (j))
#define XB_XSUB(j)  (1280 + 64 * (j))
#define XB_XGEN(j)  (2304 + 64 * (j))
#define XB_TOP      3328
#define XB_TOPGEN   3392
#define XCD_BAR_WORDS 3456
#define XB_SPIN_CAP (1u << 18)
#define LAS __attribute__((address_space(3)))

__device__ __forceinline__ unsigned xb_ld(unsigned* p)              { return __hip_atomic_load(p, __ATOMIC_RELAXED, __HIP_MEMORY_SCOPE_AGENT); }
__device__ __forceinline__ unsigned xb_add(unsigned* p, unsigned v) { return __hip_atomic_fetch_add(p, v, __ATOMIC_RELAXED, __HIP_MEMORY_SCOPE_AGENT); }
__device__ __forceinline__ unsigned xb_xcc_id() { return (unsigned)__builtin_amdgcn_s_getreg((3 << 11) | 20) & 0xFu; }
#define XB_SPIN(cond, bar) do { unsigned _sp = 0; while (cond) { __builtin_amdgcn_s_sleep(1); \
    if ((++_sp & 255u) == 0u) { if (xb_ld(&(bar)[XB_TMO])) break; if (_sp > XB_SPIN_CAP) { atomicAdd(&(bar)[XB_TMO], 1u); break; } } } } while (0)

struct XcdBarrier {
    unsigned* bar; unsigned x;
    volatile LAS unsigned* st;
};

__device__ __forceinline__ XcdBarrier xcd_barrier_post(unsigned* bar, volatile LAS unsigned* st) {
    XcdBarrier b; b.bar = bar; b.x = xb_xcc_id(); b.st = st;
    if (threadIdx.x == 0) (void)xb_add(&bar[XB_XCNT(b.x)], 1u);
    return b;
}
__device__ __forceinline__ void xcd_barrier_complete(unsigned* bar, unsigned x, unsigned& nloc, unsigned& nx) {
    const unsigned G = gridDim.x * gridDim.y * gridDim.z;
    unsigned sum, cnt, mine, sp = 0u;
    for (;;) {
        sum = 0u; cnt = 0u; mine = 0u;
#pragma unroll
        for (unsigned j = 0; j < 16; ++j) { const unsigned c = xb_ld(&bar[XB_XCNT(j)]); sum += c; cnt += (c > 0u) ? 1u : 0u; mine = (j == x) ? c : mine; }
        if (sum == G) break;
        __builtin_amdgcn_s_sleep(1);
        if ((++sp & 255u) == 0u) { if (xb_ld(&bar[XB_TMO])) break; if (sp > XB_SPIN_CAP) { atomicAdd(&bar[XB_TMO], 1u); break; } }
    }
    nloc = mine > 0u ? mine : 1u; nx = cnt > 0u ? cnt : 1u;
}

__device__ __forceinline__ void xcd_barrier(const XcdBarrier& b) {
    asm volatile("s_waitcnt vmcnt(0)" ::: "memory");
    __syncthreads();
    if (threadIdx.x == 0) {
        unsigned* bar = b.bar;
        __builtin_amdgcn_s_waitcnt(0);
        unsigned nloc = b.st[0], nx = b.st[1];
        if (nloc == 0u) { xcd_barrier_complete(bar, b.x, nloc, nx); b.st[0] = nloc; b.st[1] = nx; }
        const unsigned old = xb_add(&bar[XB_XSUB(b.x)], 1u);
        const unsigned gen = old / nloc;
        if (old + 1u == (gen + 1u) * nloc) {
            __builtin_amdgcn_fence(__ATOMIC_RELEASE, "agent");
            asm volatile("s_waitcnt vmcnt(0)" ::: "memory");
            const unsigned og = xb_add(&bar[XB_TOP], 1u);
            const unsigned tg = og / nx;
            if (og + 1u == (tg + 1u) * nx) xb_add(&bar[XB_TOPGEN], 1u);
            else XB_SPIN(xb_ld(&bar[XB_TOPGEN]) == tg, bar);
            __builtin_amdgcn_fence(__ATOMIC_ACQUIRE, "agent");
            xb_add(&bar[XB_XGEN(b.x)], 1u);
            asm volatile("s_waitcnt vmcnt(0)" ::: "memory");
        } else {
            XB_SPIN(xb_ld(&bar[XB_XGEN(b.x)]) == gen, bar);
            __builtin_amdgcn_fence(__ATOMIC_ACQUIRE, "agent");
            asm volatile("s_waitcnt vmcnt(0)" ::: "memory");
        }
    }
    __syncthreads();
}

constexpr bool GEMM_SP2 = true, GEMM_ALIGN = true;
using pg8::bf16_t; using pg8::f32x4; using pg8::u32x4; using pg8::bf16x8; using pg8::cvt_pk_bf16; using pg8::Unit; using pg8::HALF; using pg8::BM;
typedef unsigned u32x2 __attribute__((ext_vector_type(2)));
constexpr int T_ = 32768, D_ = 1024, SEQ_ = 8192, NB_ = 4, INC_ = 3080, PJ_ = 3072, FF_ = 2816, PLE_ = 256, NCH_ = 128;
constexpr float EPS_ = 1e-6f;
constexpr int NTHREADS = 512;
constexpr int LDS_BYTES = 144 * 1024;

constexpr size_t WS_WIN = 4096;
constexpr size_t WS_WOUT = WS_WIN + (size_t)PJ_ * D_ * 2;
constexpr size_t WS_WGU = WS_WOUT + (size_t)D_ * D_ * 2;
constexpr size_t WS_WD = WS_WGU + (size_t)2 * FF_ * D_ * 2;
constexpr size_t WS_WPG = WS_WD + (size_t)D_ * FF_ * 2;
constexpr size_t WS_WPP = WS_WPG + (size_t)D_ * D_ * 2;
constexpr size_t WS_LOGITS = WS_WPP + (size_t)D_ * PLE_ * 2;
constexpr size_t WS_PB = WS_LOGITS + (size_t)T_ * 8 * 4;
constexpr size_t WS_SSA = WS_PB + (size_t)T_ * PLE_ * 2;
constexpr size_t WS_SSB = WS_SSA + (size_t)T_ * 16 * 4;
constexpr size_t WS_PTOT = WS_SSB + (size_t)T_ * 16 * 4;
constexpr size_t WS_HEND = WS_PTOT + (size_t)NB_ * NCH_ * 512 * 4;
constexpr size_t WS_CARRY = WS_HEND + (size_t)NB_ * NCH_ * 512 * 4;
constexpr size_t WS_GTOT = WS_CARRY + (size_t)NB_ * NCH_ * 512 * 4;
constexpr size_t WS_XB = WS_GTOT + 8192;
constexpr size_t WS_PROJ = WS_XB + (size_t)T_ * D_ * 2;
constexpr size_t WS_R4 = WS_PROJ + (size_t)T_ * PJ_ * 2;
constexpr size_t WS_Y = WS_XB;
constexpr size_t WS_XB2 = WS_R4;
constexpr size_t WS_PP = WS_R4 + (size_t)T_ * D_ * 2;
constexpr size_t WS_ORAW = WS_R4 + (size_t)2048 * 73728;
constexpr size_t WS_BAR = WS_R4 + (size_t)2048 * 73728 + (size_t)T_ * 512 * 2;
constexpr size_t WS_RGW = WS_BAR + 16384;
constexpr size_t WS_END = WS_RGW + 131072;

struct Params {
    const float* in[25];
    float* out; unsigned char* ws;
    int ph_lo, ph_hi;
};

__device__ __forceinline__ float bf2f(bf16_t b) { return __uint_as_float(((unsigned)b) << 16); }
__device__ __forceinline__ bf16_t f2bf(float f) { return (bf16_t)(cvt_pk_bf16(f, 0.f) & 0xffffu); }
__device__ __forceinline__ float sigmoidf_(float x) { return __builtin_amdgcn_rcpf(1.0f + __expf(-x)); }
__device__ __forceinline__ float siluf_(float x) { return x * __builtin_amdgcn_rcpf(1.0f + __expf(-x)); }
__device__ __forceinline__ float softplusf_(float x) { return fmaxf(x, 0.f) + log1pf(__expf(-fabsf(x))); }
__device__ __forceinline__ float gelu_tanhf_(float x) { const float u = 0.7978845608028654f * (x + 0.044715f * x * x * x); return x * __builtin_amdgcn_rcpf(1.0f + __expf(-2.0f * u)); }
__device__ __forceinline__ float rstd16(const float* ss, int r) {
    const f32x4 a = *(const f32x4*)(ss + (size_t)r * 16), b = *(const f32x4*)(ss + (size_t)r * 16 + 4), c = *(const f32x4*)(ss + (size_t)r * 16 + 8), d = *(const f32x4*)(ss + (size_t)r * 16 + 12);
    const float s = ((a[0] + a[1]) + (a[2] + a[3])) + ((b[0] + b[1]) + (b[2] + b[3])) + ((c[0] + c[1]) + (c[2] + c[3])) + ((d[0] + d[1]) + (d[2] + d[3]));
    return rsqrtf(s * (1.0f / 1024.0f) + EPS_);
}

template <int CTRL> __device__ __forceinline__ float dpp_f(float x) { return __int_as_float(__builtin_amdgcn_update_dpp(0, __float_as_int(x), CTRL, 0xf, 0xf, false)); }
__device__ __forceinline__ float red8(float x) { x += dpp_f<0xB1>(x); x += dpp_f<0x4E>(x); x += dpp_f<0x141>(x); return x; }
struct EpiBf16Plain {
    static constexpr bool PERM = true, AFTER_DRAIN = false;
    bf16_t* O; int ldc;
    __device__ __forceinline__ void operator()(const f32x4 (&acc)[2][2][4][2], const Unit& u, int wr, int wc, int fr, int fq) const {
        int row0 = u.pm * BM + wr * 64 + fr; asm volatile("" : "+v"(row0)); const int col0 = u.pn * BM + wc * 32 + 8 * fq;
#pragma unroll
        for (int ai = 0; ai < 2; ++ai)
#pragma unroll
            for (int m = 0; m < 4; ++m) { bf16_t* rowp = O + (size_t)(row0 + ai * HALF + m * 16) * ldc + col0;
#pragma unroll
                for (int bj = 0; bj < 2; ++bj) { const f32x4 v0 = acc[ai][bj][m][0], v1 = acc[ai][bj][m][1]; u32x4 w; w.x = cvt_pk_bf16(v0[0], v0[1]); w.y = cvt_pk_bf16(v0[2], v0[3]); w.z = cvt_pk_bf16(v1[0], v1[1]); w.w = cvt_pk_bf16(v1[2], v1[3]);
                    *(u32x4*)(rowp + bj * HALF) = w; } }
    }
};
__device__ __forceinline__ void rstd8(const float* ss, int row0, float (&rs)[8]) {
#pragma unroll
    for (int ai = 0; ai < 2; ++ai) { f32x4 t[4][4];
#pragma unroll
        for (int m = 0; m < 4; ++m)
#pragma unroll
            for (int q = 0; q < 4; ++q) t[m][q] = *(const f32x4*)(ss + (size_t)(row0 + ai * HALF + m * 16) * 16 + 4 * q);
#pragma unroll
        for (int m = 0; m < 4; ++m) { const float sm = (((t[m][0][0] + t[m][0][1]) + (t[m][0][2] + t[m][0][3])) + ((t[m][1][0] + t[m][1][1]) + (t[m][1][2] + t[m][1][3]))) + (((t[m][2][0] + t[m][2][1]) + (t[m][2][2] + t[m][2][3])) + ((t[m][3][0] + t[m][3][1]) + (t[m][3][2] + t[m][3][3])));
            rs[ai * 4 + m] = rsqrtf(sm * (1.0f / 1024.0f) + EPS_); }
        asm volatile("" ::: "memory"); }
}
template <bool RES_BF16>
struct EpiResid {
    static constexpr bool PERM = true, AFTER_DRAIN = false;
    const float* res; bf16_t* xb; float* ss;
    __device__ __forceinline__ void operator()(const f32x4 (&acc)[2][2][4][2], const Unit& u, int wr, int wc, int fr, int fq) const {
        int row0 = u.pm * BM + wr * 64 + fr; asm volatile("" : "+v"(row0)); const int col0 = u.pn * BM + wc * 32 + 8 * fq;
        const unsigned e0 = (unsigned)row0 * D_ + col0;
#pragma unroll
        for (int ai = 0; ai < 2; ++ai) {
            constexpr int NB = RES_BF16 ? 4 : 2;
#pragma unroll
            for (int mh = 0; mh < 4 / NB; ++mh) {
                f32x4 rv[NB][2][2];
#pragma unroll
                for (int mm = 0; mm < NB; ++mm)
#pragma unroll
                    for (int bj = 0; bj < 2; ++bj) { const unsigned e = e0 + (unsigned)((ai * HALF + (mh * NB + mm) * 16) * D_ + bj * HALF);
                        if (RES_BF16) { const u32x4 w = *(const u32x4*)((const char*)xb + (size_t)(e * 2u));
                            rv[mm][bj][0] = (f32x4){__uint_as_float(w.x << 16), __uint_as_float(w.x & 0xffff0000u), __uint_as_float(w.y << 16), __uint_as_float(w.y & 0xffff0000u)};
                            rv[mm][bj][1] = (f32x4){__uint_as_float(w.z << 16), __uint_as_float(w.z & 0xffff0000u), __uint_as_float(w.w << 16), __uint_as_float(w.w & 0xffff0000u)}; }
                        else { rv[mm][bj][0] = *(const f32x4*)((const char*)res + (size_t)(e * 4u)); rv[mm][bj][1] = *(const f32x4*)((const char*)res + (size_t)(e * 4u) + 16); } }
#pragma unroll
                for (int mm = 0; mm < NB; ++mm) { const int m = mh * NB + mm, r = row0 + ai * HALF + m * 16; float s = 0.f;
#pragma unroll
                    for (int bj = 0; bj < 2; ++bj) { const unsigned e = e0 + (unsigned)((ai * HALF + m * 16) * D_ + bj * HALF);
                        const f32x4 v0 = rv[mm][bj][0] + acc[ai][bj][m][0], v1 = rv[mm][bj][1] + acc[ai][bj][m][1];
                        s += ((v0[0] * v0[0] + v0[1] * v0[1]) + (v0[2] * v0[2] + v0[3] * v0[3])) + ((v1[0] * v1[0] + v1[1] * v1[1]) + (v1[2] * v1[2] + v1[3] * v1[3]));
                        u32x4 w; w.x = cvt_pk_bf16(v0[0], v0[1]); w.y = cvt_pk_bf16(v0[2], v0[3]); w.z = cvt_pk_bf16(v1[0], v1[1]); w.w = cvt_pk_bf16(v1[2], v1[3]); *(u32x4*)((char*)xb + (size_t)(e * 2u)) = w; }
                    s += __shfl_xor(s, 16); s += __shfl_xor(s, 32);
                    if (fq == 0) ss[(size_t)r * 16 + u.pn * 4 + wc] = s; }
                asm volatile("" ::: "memory"); } }
    }
};
struct EpiGateUp {
    static constexpr bool PERM = true, AFTER_DRAIN = false;
    bf16_t* ff; const float* ss;
    __device__ __forceinline__ void operator()(const f32x4 (&acc)[2][2][4][2], const Unit& u, int wr, int wc, int fr, int fq) const {
        int row0 = u.pm * BM + wr * 64 + fr; asm volatile("" : "+v"(row0)); const int col0 = u.pn * HALF + wc * 32 + 8 * fq;
        float rsv[8]; rstd8(ss, row0, rsv);
#pragma unroll
        for (int ai = 0; ai < 2; ++ai)
#pragma unroll
            for (int m = 0; m < 4; ++m) { const int r = row0 + ai * HALF + m * 16; const float rs = rsv[ai * 4 + m];
                float o[8];
#pragma unroll
                for (int n = 0; n < 2; ++n)
#pragma unroll
                    for (int j = 0; j < 4; ++j) { const float g = acc[ai][0][m][n][j] * rs, up = acc[ai][1][m][n][j] * rs; o[n * 4 + j] = siluf_(g) * up; }
                u32x4 w; w.x = cvt_pk_bf16(o[0], o[1]); w.y = cvt_pk_bf16(o[2], o[3]); w.z = cvt_pk_bf16(o[4], o[5]); w.w = cvt_pk_bf16(o[6], o[7]);
                *(u32x4*)(ff + (size_t)r * FF_ + col0) = w; }
    }
};
struct EpiPle {
    static constexpr bool PERM = true, AFTER_DRAIN = false;
    const bf16_t* x2b; bf16_t* x3b; const bf16_t* pp; const float* bias; const float* ss_in; float* ss_out;
    __device__ __forceinline__ void operator()(const f32x4 (&acc)[2][2][4][2], const Unit& u, int wr, int wc, int fr, int fq) const {
        int row0 = u.pm * BM + wr * 64 + fr; asm volatile("" : "+v"(row0)); const int col0 = u.pn * BM + wc * 32 + 8 * fq;
        const unsigned b0 = ((unsigned)row0 * D_ + col0) * 2u;
        const unsigned s0 = (unsigned)row0 * 64u;
        u32x4 X[2][2], P[2][2]; f32x4 S[2][4];
#define EP_LOAD(set, g) do { const unsigned ro_ = (unsigned)(((g) >> 2) * HALF + ((g) & 3) * 16); \
        _Pragma("unroll") for (int bj = 0; bj < 2; ++bj) { const unsigned bo_ = b0 + (ro_ * D_ + bj * HALF) * 2u; \
            X[set][bj] = *(const u32x4*)((const char*)x2b + (size_t)bo_); P[set][bj] = *(const u32x4*)((const char*)pp + (size_t)bo_); } \
        _Pragma("unroll") for (int q = 0; q < 4; ++q) S[set][q] = *(const f32x4*)((const char*)ss_in + (size_t)(s0 + ro_ * 64u + q * 16u)); } while (0)
        EP_LOAD(0, 0);
#pragma unroll
        for (int g = 0; g < 8; ++g) { const int ai = g >> 2, m = g & 3, st = g & 1, r = row0 + ai * HALF + m * 16;
            if (g < 7) EP_LOAD((g + 1) & 1, g + 1);
            const float sm = (((S[st][0][0] + S[st][0][1]) + (S[st][0][2] + S[st][0][3])) + ((S[st][1][0] + S[st][1][1]) + (S[st][1][2] + S[st][1][3]))) + (((S[st][2][0] + S[st][2][1]) + (S[st][2][2] + S[st][2][3])) + ((S[st][3][0] + S[st][3][1]) + (S[st][3][2] + S[st][3][3])));
            const float rs = rsqrtf(sm * (1.0f / 1024.0f) + EPS_); float s = 0.f;
#pragma unroll
            for (int bj = 0; bj < 2; ++bj) { const unsigned bo = b0 + (unsigned)(((ai * HALF + m * 16) * D_ + bj * HALF) * 2); const u32x4 pw = P[st][bj], xw = X[st][bj];
                const unsigned pwa[4] = {pw.x, pw.y, pw.z, pw.w}, xwa[4] = {xw.x, xw.y, xw.z, xw.w}; unsigned ow[4];
#pragma unroll
                for (int n = 0; n < 2; ++n) { const f32x4 a = acc[ai][bj][m][n]; const f32x4 bb = *(const f32x4*)(bias + col0 + bj * HALF + 4 * n);
#pragma unroll
                    for (int hh = 0; hh < 2; ++hh) { const unsigned xq = xwa[2 * n + hh], pq = pwa[2 * n + hh];
                        const float v0 = __uint_as_float(xq << 16) + sigmoidf_(a[2 * hh] * rs + bb[2 * hh]) * __uint_as_float(pq << 16);
                        const float v1 = __uint_as_float(xq & 0xffff0000u) + sigmoidf_(a[2 * hh + 1] * rs + bb[2 * hh + 1]) * __uint_as_float(pq & 0xffff0000u);
                        ow[2 * n + hh] = cvt_pk_bf16(v0, v1); s += v0 * v0 + v1 * v1; } }
                *(u32x4*)((char*)x3b + (size_t)bo) = (u32x4){ow[0], ow[1], ow[2], ow[3]}; }
            s += __shfl_xor(s, 16); s += __shfl_xor(s, 32);
            if (fq == 0) ss_out[(size_t)r * 16 + u.pn * 4 + wc] = s;
            asm volatile("" ::: "memory"); }
#undef EP_LOAD
    }
};

template <class Epi> __device__ __forceinline__ void run_gemm(PG8_LAS unsigned char* lds, const bf16_t* A, const bf16_t* Bt, int M, int N, int K, const Epi& E) {
    pg8::Gemm g; g.A = A; g.Bt = Bt; g.M = M; g.N = N; g.K = K;
    pg8::StaticOrder S; S.init(M, N, (int)gridDim.x, (int)blockIdx.x);
    pg8::gemm_phase<Epi, pg8::StaticOrder, GEMM_ALIGN, GEMM_SP2>(lds, g, S, E);
}

__device__ void prep_transpose(const float* __restrict__ W, int K, int ldw, int c0, int ncols, bf16_t* __restrict__ Wt, const float* __restrict__ ks, int mode, float* tile, int rot, int widx, int nw) {
    const int tid = threadIdx.x, nkt = K / 64, nct = ncols / 64, ntiles = nkt * nct;
    for (int tt = (widx + nw - (rot % nw)) % nw; tt < ntiles; tt += nw) {
        const int kt = tt / nct, ct = tt % nct, k0 = kt * 64, n0 = ct * 64;
        __syncthreads();
#pragma unroll
        for (int i = 0; i < 2; ++i) { const int r = (tid >> 4) + 32 * i, c4 = (tid & 15) * 4; const f32x4 v = *(const f32x4*)(W + (size_t)(k0 + r) * ldw + c0 + n0 + c4);
            const float s = ks ? ks[k0 + r] : 1.0f; tile[r * 65 + c4 + 0] = v[0] * s; tile[r * 65 + c4 + 1] = v[1] * s; tile[r * 65 + c4 + 2] = v[2] * s; tile[r * 65 + c4 + 3] = v[3] * s; }
        __syncthreads();
        const int n = tid >> 3, kseg = (tid & 7) * 8; float v[8];
#pragma unroll
        for (int e = 0; e < 8; ++e) v[e] = tile[(kseg + e) * 65 + n];
        u32x4 w; w.x = cvt_pk_bf16(v[0], v[1]); w.y = cvt_pk_bf16(v[2], v[3]); w.z = cvt_pk_bf16(v[4], v[5]); w.w = cvt_pk_bf16(v[6], v[7]);
        const int f = n0 + n; const int drow = (mode == 0) ? f : (256 * (f >> 7) + 128 * (mode - 1) + (f & 127));
        *(u32x4*)(Wt + (size_t)drow * K + k0 + kseg) = w;
    }
}


__device__ __forceinline__ void prep_weights_late(const Params& p, unsigned char* smem, int widx, int nw) {
    unsigned char* ws = p.ws; float* tile = (float*)smem;
    __syncthreads();
    prep_transpose(p.in[15], D_, D_, 0, D_, (bf16_t*)(ws + WS_WOUT), nullptr, 0, tile, 0, widx, nw);
    prep_transpose(p.in[17], D_, FF_, 0, FF_, (bf16_t*)(ws + WS_WGU), p.in[16], 1, tile, 256, widx, nw);
    prep_transpose(p.in[18], D_, FF_, 0, FF_, (bf16_t*)(ws + WS_WGU), p.in[16], 2, tile, 960, widx, nw);
    prep_transpose(p.in[19], FF_, D_, 0, D_, (bf16_t*)(ws + WS_WD), nullptr, 0, tile, 1664, widx, nw);
    prep_transpose(p.in[21], D_, D_, 0, D_, (bf16_t*)(ws + WS_WPG), p.in[20], 0, tile, 2368, widx, nw);
}

__device__ __forceinline__ void phase_prep(const Params& p, unsigned char* smem) {
    const int tid = threadIdx.x, wid = __builtin_amdgcn_readfirstlane(tid >> 6), lane = tid & 63;
    unsigned char* ws = p.ws;
    float* tile = (float*)smem;
    float* w8s = (float*)(smem + 20480);
    if (blockIdx.x == 0 && tid < 32) ((unsigned*)ws)[tid] = 0u;
    prep_transpose(p.in[3], D_, INC_, 0, PJ_, (bf16_t*)(ws + WS_WIN), nullptr, 0, tile, 0, (int)blockIdx.x, (int)gridDim.x);
    prep_transpose(p.in[23], PLE_, D_, 0, D_, (bf16_t*)(ws + WS_WPP), nullptr, 0, tile, 768, (int)blockIdx.x, (int)gridDim.x);
    if (blockIdx.x < 8) {
        const int hh = blockIdx.x;
        for (int item = tid; item < 1024; item += NTHREADS) { const int gate = item >> 9, fragi = (item >> 6) & 7, ln = item & 63, ntf = fragi >> 1, ksf = fragi & 1, n16f = ln & 15, fqf = ln >> 4;
            const float* wsrc = p.in[gate ? 8 : 6] + (size_t)(hh * 64 + 32 * ksf + 8 * fqf) * 64 + 16 * ntf + n16f;
            const f32x4 lo = {wsrc[0], wsrc[64], wsrc[128], wsrc[192]}, hi = {wsrc[256], wsrc[320], wsrc[384], wsrc[448]};
            u32x4 w; w.x = cvt_pk_bf16(lo[0], lo[1]); w.y = cvt_pk_bf16(lo[2], lo[3]); w.z = cvt_pk_bf16(hi[0], hi[1]); w.w = cvt_pk_bf16(hi[2], hi[3]);
            *(u32x4*)(ws + WS_RGW + ((size_t)((hh * 2 + gate) * 8 + fragi) * 64 + ln) * 16) = w; }
    }
    for (int i = tid; i < 1024 * 8; i += NTHREADS) { const int k = i >> 3, j = i & 7; w8s[i] = p.in[2][k] * p.in[3][(size_t)k * INC_ + PJ_ + j]; }
    __syncthreads();
    {
        const float* x = p.in[0]; const float* nw = p.in[2]; bf16_t* hb = (bf16_t*)(ws + WS_XB); float* logits = (float*)(ws + WS_LOGITS);
        f32x4 nwv[4];
#pragma unroll
        for (int i = 0; i < 4; ++i) nwv[i] = *(const f32x4*)(nw + 4 * (lane + 64 * i));
        f32x4 vn[4]; int row = blockIdx.x * 8 + wid;
        if (row < T_) {
#pragma unroll
            for (int i = 0; i < 4; ++i) vn[i] = *(const f32x4*)(x + (size_t)row * D_ + 4 * (lane + 64 * i)); }
        for (; row < T_; row += gridDim.x * 8) {
            f32x4 v[4]; float s = 0.f;
#pragma unroll
            for (int i = 0; i < 4; ++i) { v[i] = vn[i]; s += (v[i][0] * v[i][0] + v[i][1] * v[i][1]) + (v[i][2] * v[i][2] + v[i][3] * v[i][3]); }
            { const int nrow = row + gridDim.x * 8;
              if (nrow < T_) {
#pragma unroll
                for (int i = 0; i < 4; ++i) vn[i] = *(const f32x4*)(x + (size_t)nrow * D_ + 4 * (lane + 64 * i)); } }
            s = red8(s); s += dpp_f<0x140>(s); s += __shfl_xor(s, 16); s += __shfl_xor(s, 32);
            const float rs = rsqrtf(s * (1.0f / 1024.0f) + EPS_);
            float lg[8];
#pragma unroll
            for (int j = 0; j < 8; ++j) lg[j] = 0.f;
#pragma unroll
            for (int i = 0; i < 4; ++i) {
                const int k0 = 4 * (lane + 64 * i);
#pragma unroll
                for (int e = 0; e < 4; ++e) { const f32x4 wa = *(const f32x4*)(w8s + (k0 + e) * 8), wb = *(const f32x4*)(w8s + (k0 + e) * 8 + 4); const float xv = v[i][e];
                    lg[0] += xv * wa[0]; lg[1] += xv * wa[1]; lg[2] += xv * wa[2]; lg[3] += xv * wa[3]; lg[4] += xv * wb[0]; lg[5] += xv * wb[1]; lg[6] += xv * wb[2]; lg[7] += xv * wb[3]; }
                const f32x4 h = v[i] * rs * nwv[i]; u32x2 w; w.x = cvt_pk_bf16(h[0], h[1]); w.y = cvt_pk_bf16(h[2], h[3]);
                *(u32x2*)(hb + (size_t)row * D_ + k0) = w;
            }
            const bool b5 = (lane & 32) != 0, b4 = (lane & 16) != 0, b3 = (lane & 8) != 0;
            float k4[4], k2[2];
#pragma unroll
            for (int j = 0; j < 4; ++j) { const float send = b5 ? lg[j] : lg[j + 4]; const float keep = b5 ? lg[j + 4] : lg[j]; k4[j] = keep + __shfl_xor(send, 32); }
#pragma unroll
            for (int j = 0; j < 2; ++j) { const float send = b4 ? k4[j] : k4[j + 2]; const float keep = b4 ? k4[j + 2] : k4[j]; k2[j] = keep + __shfl_xor(send, 16); }
            float k1; { const float send = b3 ? k2[0] : k2[1]; const float keep = b3 ? k2[1] : k2[0]; k1 = keep + __shfl_xor(send, 8); }
            k1 = red8(k1);
            if ((lane & 7) == 0) logits[(size_t)row * 8 + ((lane >> 5) & 1) * 4 + ((lane >> 4) & 1) * 2 + ((lane >> 3) & 1)] = k1 * rs;
        }
    }
    {
        const f32x4* src = (const f32x4*)p.in[1]; u32x2* dst = (u32x2*)(ws + WS_PB); const size_t n4 = (size_t)T_ * PLE_ / 4;
        for (size_t i = (size_t)blockIdx.x * NTHREADS + tid; i < n4; i += (size_t)gridDim.x * NTHREADS) { const f32x4 v = src[i]; u32x2 w; w.x = cvt_pk_bf16(v[0], v[1]); w.y = cvt_pk_bf16(v[2], v[3]); dst[i] = w; }
    }
}
__device__ __forceinline__ bf16x8 pack8(const f32x4 a, const f32x4 b) { u32x4 w; w.x = cvt_pk_bf16(a[0], a[1]); w.y = cvt_pk_bf16(a[2], a[3]); w.z = cvt_pk_bf16(b[0], b[1]); w.w = cvt_pk_bf16(b[2], b[3]); return __builtin_bit_cast(bf16x8, w); }
#define MFMA16(a, b, c) __builtin_amdgcn_mfma_f32_16x16x32_bf16((a), (b), (c), 0, 0, 0)
__device__ __forceinline__ float neg_expm1_small(float x, float ehalf) {
    const float ps = -x * (1.0f + x * (0.5f + x * (0.16666667f + x * (0.041666668f + x * (0.008333334f + x * 0.0013888889f)))));
    return (x > -0.25f) ? ps : (1.0f - ehalf * ehalf);
}
template <bool FINAL>
__device__ __forceinline__ void rg_pass_mfma(const Params& p, unsigned char* smem, int widx, int nworkers) {
    const int tid = threadIdx.x, wid = __builtin_amdgcn_readfirstlane(tid >> 6), lane = tid & 63, n16o = lane & 15, fqo = lane >> 4, c = wid * 64 + lane;
    unsigned char* ws = p.ws;
    const bf16_t* proj = (const bf16_t*)(ws + WS_PROJ);
    float* U = (float*)smem + wid * 4352;
    float* ptot = (float*)(ws + WS_PTOT); float* hend = (float*)(ws + WS_HEND); const float* carry = (const float*)(ws + WS_CARRY);
    bf16_t* y = (bf16_t*)(ws + WS_Y);
    bf16x8 Bx[4][2], Ba[4][2];
#pragma unroll
    for (int nt = 0; nt < 4; ++nt)
#pragma unroll
        for (int ks = 0; ks < 2; ++ks) { const unsigned char* fb = ws + WS_RGW + ((size_t)(wid * 16 + nt * 2 + ks) * 64 + lane) * 16;
            Bx[nt][ks] = *(const bf16x8*)fb; Ba[nt][ks] = *(const bf16x8*)(fb + 8 * 64 * 16); }
    const float cw0 = p.in[4][c], cw1 = p.in[4][512 + c], cw2 = p.in[4][1024 + c], cw3 = p.in[4][1536 + c], cb = p.in[5][c];
    float bxv[4], bav[4], spv[4];
#pragma unroll
    for (int nt = 0; nt < 4; ++nt) { const int cgl = wid * 64 + 16 * nt + n16o; bxv[nt] = p.in[7][cgl]; bav[nt] = p.in[9][cgl]; spv[nt] = softplusf_(-p.in[10][cgl]); }
    for (int unit = widx; unit < NB_ * NCH_; unit += nworkers) {
        const int n = unit & (NCH_ - 1); const size_t t0 = (size_t)unit * 64;
        float xm3 = 0.f, xm2 = 0.f, xm1 = 0.f;
        if (n != 0) { xm3 = bf2f(proj[(t0 - 3) * PJ_ + c]); xm2 = bf2f(proj[(t0 - 2) * PJ_ + c]); xm1 = bf2f(proj[(t0 - 1) * PJ_ + c]); }
        __syncthreads();
        { bf16_t xr[16]; const bf16_t* xp0 = proj + t0 * PJ_ + c;
#pragma unroll
          for (int i = 0; i < 16; ++i) xr[i] = xp0[(size_t)i * PJ_];
#pragma unroll
          for (int tb = 0; tb < 4; ++tb) { bf16_t xn[16]; const bf16_t* xp = proj + (t0 + (tb + 1) * 16) * PJ_ + c;
            if (tb < 3) {
#pragma unroll
                for (int i = 0; i < 16; ++i) xn[i] = xp[(size_t)i * PJ_]; }
#pragma unroll
            for (int i = 0; i < 16; ++i) { const float xv = bf2f(xr[i]); U[(16 * ((i >> 2) & 3) + 4 * tb + (i & 3)) * 68 + lane] = cw0 * xm3 + cw1 * xm2 + cw2 * xm1 + cw3 * xv + cb; xm3 = xm2; xm2 = xm1; xm1 = xv; }
            if (tb < 3) {
#pragma unroll
                for (int i = 0; i < 16; ++i) xr[i] = xn[i]; } } }
        __syncthreads();
        const bf16_t* gub = proj + t0 * PJ_ + 512; bf16_t* yub = y + t0 * D_;
#pragma unroll
        for (int nt = 0; nt < 4; ++nt) {
            asm volatile("" ::: "memory");
            int lane_o = lane; asm volatile("" : "+v"(lane_o));
            const int n16 = lane_o & 15, fq = lane_o >> 4;
            const int chl = 16 * nt + n16, cgl = wid * 64 + chl;
            bf16x8 Af[4][2];
#pragma unroll
            for (int mt = 0; mt < 4; ++mt)
#pragma unroll
                for (int ks = 0; ks < 2; ++ks) { const float* up = U + (16 * mt + n16) * 68 + 32 * ks + 8 * fq; Af[mt][ks] = pack8(*(const f32x4*)up, *(const f32x4*)(up + 4)); }

            bf16_t gr[16];
            if (FINAL) {
#pragma unroll
                for (int i = 0; i < 16; ++i) gr[i] = gub[(16 * fq + i) * PJ_ + cgl]; }
            f32x4 ax[4], aa[4];
#pragma unroll
            for (int mt = 0; mt < 4; ++mt) { ax[mt] = (f32x4){bxv[nt], bxv[nt], bxv[nt], bxv[nt]}; aa[mt] = (f32x4){bav[nt], bav[nt], bav[nt], bav[nt]}; }
#pragma unroll
            for (int mt = 0; mt < 4; ++mt)
#pragma unroll
                for (int ks = 0; ks < 2; ++ks) { ax[mt] = MFMA16(Af[mt][ks], Bx[nt][ks], ax[mt]); aa[mt] = MFMA16(Af[mt][ks], Ba[nt][ks], aa[mt]); }
            float av[16], bv[16]; float hl = 0.f, Pl = 1.f;
#pragma unroll
            for (int i = 0; i < 16; ++i) { const int mt = i >> 2, j = i & 3, tok = 16 * fq + i; const float u = U[(16 * mt + 4 * fq + j) * 68 + chl];
                const float gx = sigmoidf_(ax[mt][j]), gg = sigmoidf_(aa[mt][j]); const float la = -8.0f * gg * spv[nt]; const float a = __expf(la);
                float mult = sqrtf(fmaxf(neg_expm1_small(2.0f * la, a), 0.f)); if (n == 0 && tok == 0) mult = 1.0f;
                av[i] = a; bv[i] = u * gx * mult; hl = a * hl + bv[i]; Pl *= a; }
            float Pg[4], Hg[4];
#pragma unroll
            for (int g = 0; g < 4; ++g) { Pg[g] = __shfl(Pl, n16 + 16 * g); Hg[g] = __shfl(hl, n16 + 16 * g); }
            if (FINAL) {
                float h = carry[(size_t)unit * 512 + cgl];
#pragma unroll
                for (int g = 0; g < 3; ++g) if (g < fq) h = Pg[g] * h + Hg[g];
#pragma unroll
                for (int i = 0; i < 16; ++i) { h = av[i] * h + bv[i]; yub[(16 * fq + i) * D_ + cgl] = f2bf(h * gelu_tanhf_(bf2f(gr[i]))); }
            } else {
                float cc = 0.f, Pp = 1.f;
#pragma unroll
                for (int g = 0; g < 4; ++g) { cc = Pg[g] * cc + Hg[g]; Pp *= Pg[g]; }
                if (fq == 0) { ptot[(size_t)unit * 512 + cgl] = Pp; hend[(size_t)unit * 512 + cgl] = cc; }
            }
        }
    }
}

__device__ __forceinline__ void rg_carry(const Params& p, int idx) {
    unsigned char* ws = p.ws; const float* ptot = (const float*)(ws + WS_PTOT); const float* hend = (const float*)(ws + WS_HEND); float* carry = (float*)(ws + WS_CARRY);
    const int b = idx >> 9, c = idx & 511; float hc = 0.f;
    for (int n0 = 0; n0 < NCH_; n0 += 8) { float P[8], H[8];
#pragma unroll
        for (int i = 0; i < 8; ++i) { const size_t o = (size_t)(b * NCH_ + n0 + i) * 512 + c; P[i] = ptot[o]; H[i] = hend[o]; }
#pragma unroll
        for (int i = 0; i < 8; ++i) { const size_t o = (size_t)(b * NCH_ + n0 + i) * 512 + c; carry[o] = hc; hc = P[i] * hc + H[i]; } }
}

constexpr int GU_BYTES = 73728, GU_KDT = 32768, GU_QK = 49152, GU_U = 57344;
typedef float f32x2_ __attribute__((ext_vector_type(2)));
__device__ __forceinline__ int tok_of_pos(int p) { return 16 * (2 * (p >> 5) + ((p >> 2) & 1)) + 4 * ((p >> 3) & 3) + (p & 3); }
__device__ __forceinline__ void unpack8(const u32x4 w, float* f) { f[0] = __uint_as_float(w.x << 16); f[1] = __uint_as_float(w.x & 0xffff0000u); f[2] = __uint_as_float(w.y << 16); f[3] = __uint_as_float(w.y & 0xffff0000u);
    f[4] = __uint_as_float(w.z << 16); f[5] = __uint_as_float(w.z & 0xffff0000u); f[6] = __uint_as_float(w.w << 16); f[7] = __uint_as_float(w.w & 0xffff0000u); }

__device__ __forceinline__ void gdn_pass_a(const Params& p, unsigned char* smem) {
    const int tid = threadIdx.x, wid = __builtin_amdgcn_readfirstlane(tid >> 6);
    unsigned char* ws = p.ws; const bf16_t* proj = (const bf16_t*)(ws + WS_PROJ); const float* logits = (const float*)(ws + WS_LOGITS); float* gtot = (float*)(ws + WS_GTOT);
    bf16_t* Kb = (bf16_t*)smem; bf16_t* Qb = (bf16_t*)(smem + 17408); bf16_t* VBt = (bf16_t*)(smem + 34816); bf16_t* KBGt = (bf16_t*)(smem + 53248);
    float* Lsw = (float*)(smem + 71680); bf16_t* Tb = (bf16_t*)(smem + 89088); float* gcs = (float*)(smem + 98304); float* betas = gcs + 64; float* kdec = gcs + 128;
    const int lane0 = tid & 63, tg0 = tid >> 5, ch0 = (tid & 31) * 4;
    for (int ub = blockIdx.x * 8; ub < 2048; ub += gridDim.x * 8) {
        const int bh = ub >> 7, b = bh >> 2, h = bh & 3;
        const float Aexp = __expf(p.in[12][h]), dtb = p.in[13][h];
        float cw[3][4][4];
#pragma unroll
        for (int a = 0; a < 3; ++a)
#pragma unroll
            for (int j = 0; j < 4; ++j) { const f32x4 w = *(const f32x4*)(p.in[11] + (size_t)j * 1536 + a * 512 + h * 128 + ch0); cw[a][j][0] = w[0]; cw[a][j][1] = w[1]; cw[a][j][2] = w[2]; cw[a][j][3] = w[3]; }
        u32x2 pre[3][7]; float lgb, lga;
#define GA_PREFETCH(unit_) do { const int n_ = (unit_) & 127; const size_t t0_ = (size_t)b * SEQ_ + (size_t)n_ * 64; \
        lgb = logits[(t0_ + lane0) * 8 + h]; lga = logits[(t0_ + lane0) * 8 + 4 + h]; \
        _Pragma("unroll") for (int r = 0; r < 7; ++r) { const int sp_ = n_ * 64 + 4 * tg0 - 3 + r; \
            _Pragma("unroll") for (int a = 0; a < 3; ++a) pre[a][r] = (sp_ >= 0) ? *(const u32x2*)(proj + ((size_t)b * SEQ_ + sp_) * PJ_ + 1024 + a * 512 + h * 128 + ch0) : (u32x2){0u, 0u}; } } while (0)
        GA_PREFETCH(ub);
        for (int k = 0; k < 8; ++k) {
            const int unit = ub + k, n = unit & 127;
            int tid_o = tid; asm volatile("" : "+v"(tid_o));
            const int lane = tid_o & 63, r16 = lane & 15, kq = lane >> 4, cg4 = tid_o & 31, tg = tid_o >> 5, ch = cg4 * 4;
            unsigned char* gbase = ws + WS_R4 + (size_t)unit * GU_BYTES;
            const float betav = sigmoidf_(lgb);
            float gc = -Aexp * softplusf_(lga + dtb);
#pragma unroll
            for (int o = 1; o < 64; o <<= 1) { const float tmp = __shfl_up(gc, o); if (lane >= o) gc += tmp; }
            const float gclast = __shfl(gc, 63);
            if (wid == 0) { gcs[lane] = gc; betas[lane] = betav; kdec[lane] = __expf(gclast - gc); }
            {
                float x[7][4], o[4][4], bt[4], egt[4];
#pragma unroll
                for (int t = 0; t < 4; ++t) { bt[t] = __shfl(betav, 4 * tg + t); egt[t] = __expf(__shfl(gc, 4 * tg + t)); }
#pragma unroll
                for (int a = 0; a < 3; ++a) {
#pragma unroll
                    for (int r = 0; r < 7; ++r) { x[r][0] = __uint_as_float(pre[a][r].x << 16); x[r][1] = __uint_as_float(pre[a][r].x & 0xffff0000u); x[r][2] = __uint_as_float(pre[a][r].y << 16); x[r][3] = __uint_as_float(pre[a][r].y & 0xffff0000u); }
#pragma unroll
                    for (int t = 0; t < 4; ++t)
#pragma unroll
                        for (int e = 0; e < 4; ++e) { float acc = cw[a][0][e] * x[t][e]; acc += cw[a][1][e] * x[t + 1][e]; acc += cw[a][2][e] * x[t + 2][e]; acc += cw[a][3][e] * x[t + 3][e]; o[t][e] = siluf_(acc); }
                    if (a < 2) {
#pragma unroll
                        for (int t = 0; t < 4; ++t) { float ssq = (o[t][0] * o[t][0] + o[t][1] * o[t][1]) + (o[t][2] * o[t][2] + o[t][3] * o[t][3]);
                            ssq += dpp_f<0xB1>(ssq); ssq += dpp_f<0x4E>(ssq); ssq += dpp_f<0x141>(ssq); ssq += dpp_f<0x140>(ssq); ssq += __shfl_xor(ssq, 16);
                            const float rs = rsqrtf(ssq + EPS_) * (a == 0 ? 0.08838834764831845f : 1.0f);
#pragma unroll
                            for (int e = 0; e < 4; ++e) o[t][e] *= rs; }
                    }
                    if (a == 0) {
#pragma unroll
                        for (int t = 0; t < 4; ++t) { const int tok = 4 * tg + t; u32x2 w; w.x = cvt_pk_bf16(o[t][0], o[t][1]); w.y = cvt_pk_bf16(o[t][2], o[t][3]); *(u32x2*)(Qb + tok * 136 + ch) = w;
                            u32x2 wd; wd.x = cvt_pk_bf16(o[t][0] * egt[t], o[t][1] * egt[t]); wd.y = cvt_pk_bf16(o[t][2] * egt[t], o[t][3] * egt[t]);
                            *(u32x2*)((bf16_t*)gbase + (size_t)(64 + tok) * 128 + 32 * (cg4 >> 3) + 8 * (cg4 & 3) + 4 * ((cg4 >> 2) & 1)) = wd; }
                    } else if (a == 1) {
#pragma unroll
                        for (int t = 0; t < 4; ++t) { const int tok = 4 * tg + t; u32x2 w; w.x = cvt_pk_bf16(o[t][0], o[t][1]); w.y = cvt_pk_bf16(o[t][2], o[t][3]); *(u32x2*)(Kb + tok * 136 + ch) = w; }
#pragma unroll
                        for (int e = 0; e < 4; ++e) { u32x2 w; w.x = cvt_pk_bf16(o[0][e] * bt[0] * egt[0], o[1][e] * bt[1] * egt[1]); w.y = cvt_pk_bf16(o[2][e] * bt[2] * egt[2], o[3][e] * bt[3] * egt[3]); *(u32x2*)(KBGt + (ch + e) * 72 + (((tg >> 1) ^ (cg4 & 7)) << 3) + 4 * (tg & 1)) = w; }
                    } else {
#pragma unroll
                        for (int e = 0; e < 4; ++e) { u32x2 w; w.x = cvt_pk_bf16(o[0][e] * bt[0], o[1][e] * bt[1]); w.y = cvt_pk_bf16(o[2][e] * bt[2], o[3][e] * bt[3]); *(u32x2*)(VBt + (ch + e) * 72 + (((tg >> 1) ^ (cg4 & 7)) << 3) + 4 * (tg & 1)) = w; }
                    }
                }
            }
            if (k + 1 < 8) GA_PREFETCH(unit + 1);
            __syncthreads();
#pragma unroll
            for (int rep = 0; rep < 2; ++rep) {
                const int tl = wid + 8 * rep, jt = tl >> 2, it = tl & 3;
                f32x4 accQ = {0.f, 0.f, 0.f, 0.f}, accK = {0.f, 0.f, 0.f, 0.f};
#pragma unroll
                for (int ks = 0; ks < 4; ++ks) { const bf16x8 a = *(const bf16x8*)(Kb + (16 * jt + r16) * 136 + 32 * ks + 8 * kq);
                    const bf16x8 bq = *(const bf16x8*)(Qb + (16 * it + r16) * 136 + 32 * ks + 8 * kq), bk = *(const bf16x8*)(Kb + (16 * it + r16) * 136 + 32 * ks + 8 * kq);
                    accQ = MFMA16(a, bq, accQ); accK = MFMA16(a, bk, accK); }
                const int i = 16 * it + r16; const float gi = gcs[i], bi = betas[i]; float qv[4];
#pragma unroll
                for (int jj = 0; jj < 4; ++jj) { const int j = 16 * jt + 4 * kq + jj; const float d = __expf(fminf(gi - gcs[j], 0.f));
                    qv[jj] = (i >= j) ? accQ[jj] * d : 0.f; Lsw[i * 68 + (j & 7) * 8 + (j >> 3)] = (i > j) ? bi * accK[jj] * d : 0.f; }
                u32x2 w; w.x = cvt_pk_bf16(qv[0], qv[1]); w.y = cvt_pk_bf16(qv[2], qv[3]);
                *(u32x2*)((bf16_t*)(gbase + GU_QK) + i * 64 + 32 * (jt >> 1) + 8 * kq + 4 * (jt & 1)) = w;
            }
            __syncthreads();
            {
                const int s = lane & 7, c = 8 * wid + (lane >> 3); float t[8];
#pragma unroll
                for (int m = 0; m < 8; ++m) t[m] = 0.f;
                f32x4 la[2][2]; la[0][0] = *(const f32x4*)(Lsw + s * 8); la[0][1] = *(const f32x4*)(Lsw + s * 8 + 4);
#pragma unroll
                for (int i = 0; i < 64; ++i) {
                    if (i + 1 < 64) { la[(i + 1) & 1][0] = *(const f32x4*)(Lsw + (i + 1) * 68 + s * 8); la[(i + 1) & 1][1] = *(const f32x4*)(Lsw + (i + 1) * 68 + s * 8 + 4); }
                    asm volatile("" ::: "memory");
                    const f32x4 l0 = la[i & 1][0], l1 = la[i & 1][1];
                    float part = 0.f;
#pragma unroll
                    for (int m = 0; m < 8; ++m) if (8 * m <= i) part += ((m < 4) ? l0[m & 3] : l1[m & 3]) * t[m];
                    part = red8(part);
                    const float val = ((i == c) ? 1.0f : 0.0f) - part;
                    if (s == (i & 7)) t[i >> 3] = val;
                }
#pragma unroll
                for (int m = 0; m < 8; ++m) Tb[(8 * m + s) * 72 + c] = f2bf(t[m]);
            }
            __syncthreads();
            {
#pragma unroll
                for (int mt = 0; mt < 4; ++mt) { f32x4 acc = {0.f, 0.f, 0.f, 0.f};
#pragma unroll
                    for (int ks = 0; ks < 2; ++ks) { const bf16x8 a = *(const bf16x8*)(Tb + (16 * mt + r16) * 72 + 32 * ks + 8 * kq), bb = *(const bf16x8*)(VBt + (16 * wid + r16) * 72 + (((4 * ks + kq) ^ ((4 * wid + (r16 >> 2)) & 7)) << 3)); acc = MFMA16(a, bb, acc); }
                    u32x2 w; w.x = cvt_pk_bf16(acc[0], acc[1]); w.y = cvt_pk_bf16(acc[2], acc[3]);
                    *(u32x2*)((bf16_t*)(gbase + GU_U) + ((wid * 4 + mt) * 64 + lane) * 4) = w; }
#pragma unroll
                for (int it = 0; it < 4; ++it) { f32x4 acc = {0.f, 0.f, 0.f, 0.f};
#pragma unroll
                    for (int ks = 0; ks < 2; ++ks) { const bf16x8 a = *(const bf16x8*)(KBGt + (16 * wid + r16) * 72 + (((4 * ks + kq) ^ ((4 * wid + (r16 >> 2)) & 7)) << 3)), bb = *(const bf16x8*)(Tb + (16 * it + r16) * 72 + 32 * ks + 8 * kq); acc = MFMA16(a, bb, acc); }
                    u32x2 w; w.x = cvt_pk_bf16(acc[0], acc[1]); w.y = cvt_pk_bf16(acc[2], acc[3]);
                    *(u32x2*)((bf16_t*)gbase + (16 * it + r16) * 128 + 32 * (wid >> 1) + 8 * kq + 4 * (wid & 1)) = w; }
                const int dk = tid_o >> 2, pg = tid_o & 3; float v[16];
#pragma unroll
                for (int e = 0; e < 16; ++e) { const int tk = tok_of_pos(16 * pg + e); v[e] = bf2f(Kb[tk * 136 + dk]) * kdec[tk]; }
                u32x4 w0, w1; w0.x = cvt_pk_bf16(v[0], v[1]); w0.y = cvt_pk_bf16(v[2], v[3]); w0.z = cvt_pk_bf16(v[4], v[5]); w0.w = cvt_pk_bf16(v[6], v[7]);
                w1.x = cvt_pk_bf16(v[8], v[9]); w1.y = cvt_pk_bf16(v[10], v[11]); w1.z = cvt_pk_bf16(v[12], v[13]); w1.w = cvt_pk_bf16(v[14], v[15]);
                *(u32x4*)((bf16_t*)(gbase + GU_KDT) + dk * 64 + 16 * pg) = w0; *(u32x4*)((bf16_t*)(gbase + GU_KDT) + dk * 64 + 16 * pg + 8) = w1;
                if (tid == 0) gtot[unit] = __expf(gclast);
            }
            __syncthreads();
        }
    }
#undef GA_PREFETCH
}

constexpr int GB_BUF = 62464, GB_KDT = 34816, GB_QK = 53248, GB_BUF2 = GB_BUF + 4096 + 16;
__device__ __forceinline__ void gdn_pass_b(const Params& p, unsigned char* smem, int wg) {
    const int tid = threadIdx.x, wid = __builtin_amdgcn_readfirstlane(tid >> 6), lane = tid & 63, r16 = lane & 15, kq = lane >> 4;
    const int bh = wg >> 2, cgp = wg & 3, b = bh >> 2, h = bh & 3, nt = cgp * 2 + wid;
    unsigned char* ws = p.ws; const unsigned char* ubase = ws + WS_R4 + (size_t)(bh * 128) * GU_BYTES; const float* gtot = (const float*)(ws + WS_GTOT) + bh * 128;
    bf16_t* oraw = (bf16_t*)(ws + WS_ORAW);
#define GB_BAR() do { asm volatile("s_waitcnt lgkmcnt(0)" ::: "memory"); __builtin_amdgcn_s_barrier(); asm volatile("" ::: "memory"); } while (0)
    if (wid >= 2) {
        const int lt = tid - 128;
        int dsto[10]; size_t srco[10];
#pragma unroll
        for (int it = 0; it < 10; ++it) { const int q = lt + 384 * it;
            dsto[it] = (q < 2048) ? (q >> 4) * 272 + (q & 15) * 16 : (q < 3072) ? GB_KDT + ((q - 2048) >> 3) * 144 + ((q - 2048) & 7) * 16 : (q < 3584) ? GB_QK + ((q - 3072) >> 3) * 144 + ((q - 3072) & 7) * 16 : GB_BUF + (q - 3584) * 16;
            srco[it] = (q < 3584) ? (size_t)q * 16 : (size_t)(GU_U + cgp * 4096 + (q - 3584) * 16); }
        u32x4 sa[10], sb[10], sc[10]; float ga = 0.f, gb = 0.f, gc = 0.f;
#define GB_LD(st, g, n_) do { const unsigned char* rp_ = ubase + (size_t)(n_) * GU_BYTES; _Pragma("unroll") for (int it = 0; it < 10; ++it) st[it] = *(const u32x4*)(rp_ + srco[it]); if (lt == 0) g = gtot[n_]; } while (0)
#define GB_WR(st, g, bufi) do { unsigned char* bp_ = smem + (bufi) * GB_BUF2; _Pragma("unroll") for (int it = 0; it < 10; ++it) *(u32x4*)(bp_ + dsto[it]) = st[it]; if (lt == 0) *(float*)(bp_ + GB_BUF + 4096) = g; } while (0)
        GB_LD(sa, ga, 0); GB_WR(sa, ga, 0); GB_BAR();
        GB_LD(sa, ga, 1); GB_LD(sb, gb, 2); GB_LD(sc, gc, 3);
        for (int n0 = 0; n0 < NCH_; n0 += 3) {
            { const int n = n0;     if (n < NCH_) { if (n + 1 < NCH_) GB_WR(sa, ga, (n + 1) & 1); if (n + 4 < NCH_) GB_LD(sa, ga, n + 4); GB_BAR(); } }
            { const int n = n0 + 1; if (n < NCH_) { if (n + 1 < NCH_) GB_WR(sb, gb, (n + 1) & 1); if (n + 4 < NCH_) GB_LD(sb, gb, n + 4); GB_BAR(); } }
            { const int n = n0 + 2; if (n < NCH_) { if (n + 1 < NCH_) GB_WR(sc, gc, (n + 1) & 1); if (n + 4 < NCH_) GB_LD(sc, gc, n + 4); GB_BAR(); } }
        }
#undef GB_LD
#undef GB_WR
    } else {
        __builtin_amdgcn_s_setprio(3);
        f32x4 S[8]; bf16x8 Sb[4];
#pragma unroll
        for (int d = 0; d < 8; ++d) S[d] = (f32x4){0.f, 0.f, 0.f, 0.f};
#pragma unroll
        for (int k = 0; k < 4; ++k) Sb[k] = (bf16x8){0, 0, 0, 0, 0, 0, 0, 0};
        GB_BAR();
        for (int n = 0; n < NCH_; ++n) {
            const unsigned char* L = smem + (n & 1) * GB_BUF2; const float gt = *(const float*)(L + GB_BUF + 4096); const size_t t0 = (size_t)b * SEQ_ + (size_t)n * 64;
            u32x2 uw[4];
#pragma unroll
            for (int tt = 0; tt < 4; ++tt) uw[tt] = *(const u32x2*)(L + GB_BUF + ((wid * 4 + tt) * 64 + lane) * 8);
            f32x4 P[8];
#pragma unroll
            for (int m = 0; m < 8; ++m) P[m] = (f32x4){0.f, 0.f, 0.f, 0.f};
#pragma unroll
            for (int ks = 0; ks < 4; ++ks)
#pragma unroll
                for (int mt = 0; mt < 8; ++mt) { const bf16x8 a = *(const bf16x8*)(L + (16 * mt + r16) * 272 + (32 * ks + 8 * kq) * 2); P[mt] = MFMA16(a, Sb[ks], P[mt]); }
            f32x4 vn[4];
#pragma unroll
            for (int tt = 0; tt < 4; ++tt) { const f32x4 u = {__uint_as_float(uw[tt].x << 16), __uint_as_float(uw[tt].x & 0xffff0000u), __uint_as_float(uw[tt].y << 16), __uint_as_float(uw[tt].y & 0xffff0000u)}; vn[tt] = u - P[tt]; }
            bf16x8 Vb[2]; Vb[0] = pack8(vn[0], vn[1]); Vb[1] = pack8(vn[2], vn[3]);
#pragma unroll
            for (int tt = 0; tt < 4; ++tt) { f32x4 O = P[4 + tt];
#pragma unroll
                for (int ks = 0; ks < 2; ++ks) { const bf16x8 a = *(const bf16x8*)(L + GB_QK + (16 * tt + r16) * 144 + (32 * ks + 8 * kq) * 2); O = MFMA16(a, Vb[ks], O); }
                bf16_t* op = oraw + (t0 + 16 * tt + 4 * kq) * 512 + h * 128 + 16 * nt + r16;
#pragma unroll
                for (int j = 0; j < 4; ++j) op[(size_t)j * 512] = f2bf(O[j]); }
#pragma unroll
            for (int dt = 0; dt < 8; ++dt) { f32x4 acc = S[dt] * gt;
#pragma unroll
                for (int ks = 0; ks < 2; ++ks) { const bf16x8 a = *(const bf16x8*)(L + GB_KDT + (16 * dt + r16) * 144 + (32 * ks + 8 * kq) * 2); acc = MFMA16(a, Vb[ks], acc); }
                S[dt] = acc; }
#pragma unroll
            for (int ks = 0; ks < 4; ++ks) Sb[ks] = pack8(S[2 * ks], S[2 * ks + 1]);
            GB_BAR();
        }
        __builtin_amdgcn_s_setprio(0);
    }
#undef GB_BAR
}

__device__ __forceinline__ void gdn_norm(const Params& p) {
    unsigned char* ws = p.ws; const bf16_t* oraw = (const bf16_t*)(ws + WS_ORAW); const bf16_t* proj = (const bf16_t*)(ws + WS_PROJ); bf16_t* y = (bf16_t*)(ws + WS_Y);
    int tid_o = threadIdx.x; asm volatile("" : "+v"(tid_o));
    const int gtid = blockIdx.x * NTHREADS + tid_o, sub = gtid & 31; const f32x4 nwv = *(const f32x4*)(p.in[14] + sub * 4);
    const int stride = (gridDim.x * NTHREADS) >> 5;
    for (int item0 = gtid >> 5; item0 < T_ * 4; item0 += 4 * stride) {
        u32x2 ow[4], zw[4];
#pragma unroll
        for (int q = 0; q < 4; ++q) { const int item = item0 + q * stride; const int t = item >> 2, h = item & 3;
            if (item < T_ * 4) { ow[q] = *(const u32x2*)(oraw + (size_t)t * 512 + h * 128 + sub * 4); zw[q] = *(const u32x2*)(proj + (size_t)t * PJ_ + 2560 + h * 128 + sub * 4); } else { ow[q] = (u32x2){0u, 0u}; zw[q] = (u32x2){0u, 0u}; } }
#pragma unroll
        for (int q = 0; q < 4; ++q) { const int item = item0 + q * stride; const int t = item >> 2, h = item & 3;
            const f32x4 ov = {__uint_as_float(ow[q].x << 16), __uint_as_float(ow[q].x & 0xffff0000u), __uint_as_float(ow[q].y << 16), __uint_as_float(ow[q].y & 0xffff0000u)};
            float s = (ov[0] * ov[0] + ov[1] * ov[1]) + (ov[2] * ov[2] + ov[3] * ov[3]);
#pragma unroll
            for (int o = 1; o < 32; o <<= 1) s += __shfl_xor(s, o);
            const float rs = rsqrtf(s * (1.0f / 128.0f) + EPS_);
            const float z0 = __uint_as_float(zw[q].x << 16), z1 = __uint_as_float(zw[q].x & 0xffff0000u), z2 = __uint_as_float(zw[q].y << 16), z3 = __uint_as_float(zw[q].y & 0xffff0000u);
            u32x2 w; w.x = cvt_pk_bf16(ov[0] * rs * nwv[0] * siluf_(z0), ov[1] * rs * nwv[1] * siluf_(z1)); w.y = cvt_pk_bf16(ov[2] * rs * nwv[2] * siluf_(z2), ov[3] * rs * nwv[3] * siluf_(z3));
            if (item < T_ * 4) *(u32x2*)(y + (size_t)t * D_ + 512 + h * 128 + sub * 4) = w; }
    }
}

__device__ __forceinline__ void phase_final(const Params& p) {
    const int tid = threadIdx.x, wid = __builtin_amdgcn_readfirstlane(tid >> 6), lane = tid & 63;
    const float* ss = (const float*)(p.ws + WS_SSA); const float* nw = p.in[24]; float* out = p.out; const bf16_t* x3b = (const bf16_t*)(p.ws + WS_XB);
    f32x4 nwv[4];
#pragma unroll
    for (int i = 0; i < 4; ++i) nwv[i] = *(const f32x4*)(nw + 4 * (lane + 64 * i));
    u32x2 wn[4]; int row = blockIdx.x * 8 + wid;
    if (row < T_) {
#pragma unroll
        for (int i = 0; i < 4; ++i) wn[i] = *(const u32x2*)(x3b + (size_t)row * D_ + 4 * (lane + 64 * i)); }
    for (; row < T_; row += gridDim.x * 8) {
        const float rs = rstd16(ss, row);
        u32x2 wc[4];
#pragma unroll
        for (int i = 0; i < 4; ++i) wc[i] = wn[i];
        { const int nrow = row + gridDim.x * 8;
          if (nrow < T_) {
#pragma unroll
            for (int i = 0; i < 4; ++i) wn[i] = *(const u32x2*)(x3b + (size_t)nrow * D_ + 4 * (lane + 64 * i)); } }
#pragma unroll
        for (int i = 0; i < 4; ++i) { const u32x2 w = wc[i]; const f32x4 v = {__uint_as_float(w.x << 16), __uint_as_float(w.x & 0xffff0000u), __uint_as_float(w.y << 16), __uint_as_float(w.y & 0xffff0000u)};
            __builtin_nontemporal_store(v * rs * nwv[i], (f32x4*)(out + (size_t)row * D_ + 4 * (lane + 64 * i))); }
    }
}

constexpr int NPHASES = 11;
__global__ void __launch_bounds__(NTHREADS, 2) mega_fwd(Params p) {
    extern __shared__ __attribute__((aligned(16))) unsigned char smem[];
    PG8_LAS unsigned char* lds = (PG8_LAS unsigned char*)smem;
    cg::grid_group grid = cg::this_grid();
    unsigned char* ws = p.ws;
    bf16_t* hb = (bf16_t*)(ws + WS_XB); bf16_t* xb = (bf16_t*)(ws + WS_XB2); bf16_t* proj = (bf16_t*)(ws + WS_PROJ); bf16_t* ff = proj; bf16_t* y = (bf16_t*)(ws + WS_Y); bf16_t* pp = (bf16_t*)p.out;
    float* ssA = (float*)(ws + WS_SSA); float* ssB = (float*)(ws + WS_SSB);
#ifdef ONLY_PHASE
#define PH_ON(n) ((n) == ONLY_PHASE)
#else
#define PH_ON(n) ((n) >= p.ph_lo && (n) < p.ph_hi)
#endif
    volatile LAS unsigned* xst = (volatile LAS unsigned*)(lds + LDS_BYTES - 16);
    if (threadIdx.x == 0) { xst[0] = 0u; xst[1] = 0u; xst[2] = 0u; xst[3] = 0u; }
    __syncthreads();
    const XcdBarrier xbar = xcd_barrier_post((unsigned*)(ws + WS_BAR), xst);
    if (p.ph_lo == 0x7fffffff) grid.sync();
#define PH_SYNC(n) do { if ((n) > p.ph_lo && (n) < p.ph_hi) { xcd_barrier(xbar); } } while (0)
    if (PH_ON(0)) phase_prep(p, smem);
    PH_SYNC(1);
    if (PH_ON(1)) { EpiBf16Plain E; E.O = proj; E.ldc = PJ_; run_gemm(lds, hb, (const bf16_t*)(ws + WS_WIN), T_, PJ_, D_, E); }
    PH_SYNC(2);
    if (PH_ON(2)) { rg_pass_mfma<false>(p, smem, (int)blockIdx.x, (int)gridDim.x); __syncthreads(); gdn_pass_a(p, smem); }
    PH_SYNC(3);
    if (PH_ON(3)) {
        unsigned* flag = (unsigned*)ws + 16;
        if (blockIdx.x < 64) { const int xq = blockIdx.x & 7, kq8 = blockIdx.x >> 3;
            gdn_pass_b(p, smem, ((xq + 8 * (kq8 >> 2)) << 2) | (kq8 & 3)); }
        else {
            if (blockIdx.x < 68) { rg_carry(p, (blockIdx.x - 64) * NTHREADS + threadIdx.x); __threadfence(); __syncthreads();
                if (threadIdx.x == 0) __hip_atomic_fetch_add(flag, 1u, __ATOMIC_RELEASE, __HIP_MEMORY_SCOPE_AGENT); }
            prep_weights_late(p, smem, (int)blockIdx.x - 64, (int)gridDim.x - 64);
            if (threadIdx.x == 0) { while (__hip_atomic_load(flag, __ATOMIC_ACQUIRE, __HIP_MEMORY_SCOPE_AGENT) < 4u) __builtin_amdgcn_s_sleep(8); }
            __syncthreads(); __threadfence();
            rg_pass_mfma<true>(p, smem, (int)blockIdx.x - 64, (int)gridDim.x - 64);
            __syncthreads();
            { EpiBf16Plain E2; E2.O = pp; E2.ldc = D_; pg8::Gemm g2; g2.A = (const bf16_t*)(ws + WS_PB); g2.Bt = (const bf16_t*)(ws + WS_WPP); g2.M = T_; g2.N = D_; g2.K = PLE_;
              pg8::StaticOrder S2; S2.init(T_, D_, (int)gridDim.x - 64, (int)blockIdx.x - 64); pg8::gemm_phase<EpiBf16Plain, pg8::StaticOrder, GEMM_ALIGN, GEMM_SP2>(lds, g2, S2, E2); }
        }
    }
    PH_SYNC(4);
    if (PH_ON(4)) gdn_norm(p);
    PH_SYNC(5);
    if (PH_ON(5)) { EpiResid<false> E; E.res = p.in[0]; E.xb = xb; E.ss = ssA; run_gemm(lds, y, (const bf16_t*)(ws + WS_WOUT), T_, D_, D_, E); }
    PH_SYNC(6);
    if (PH_ON(6)) { EpiGateUp E; E.ff = ff; E.ss = ssA; run_gemm(lds, xb, (const bf16_t*)(ws + WS_WGU), T_, 2 * FF_, D_, E); }
    PH_SYNC(7);
    if (PH_ON(7)) { EpiResid<true> E; E.res = nullptr; E.xb = xb; E.ss = ssB; run_gemm(lds, ff, (const bf16_t*)(ws + WS_WD), T_, D_, FF_, E); }
    PH_SYNC(8);
    if (PH_ON(8)) { EpiPle E; E.x2b = xb; E.x3b = hb; E.pp = pp; E.bias = p.in[22]; E.ss_in = ssB; E.ss_out = ssA; run_gemm(lds, xb, (const bf16_t*)(ws + WS_WPG), T_, D_, D_, E); }
    PH_SYNC(9);
    if (PH_ON(9)) phase_final(p);
}

extern "C" void kernel_launch(void* const* d_in, const int* in_sizes, int n_in, void* d_out, int out_size, void* d_ws, size_t ws_size, hipStream_t stream) {
    static int grid = 0;
    if (grid == 0) {
        if (n_in != 25 || out_size != T_ * D_ || ws_size < WS_END) { fprintf(stderr, "kernel_launch: unexpected shapes: n_in %d out %d ws %zu (need %zu)\n", n_in, out_size, ws_size, (size_t)WS_END); grid = -1; return; }
        int dev = 0, cus = 0, per_cu = 0;
        hipGetDevice(&dev); hipDeviceGetAttribute(&cus, hipDeviceAttributeMultiprocessorCount, dev);
        if (hipFuncSetAttribute((const void*)mega_fwd, hipFuncAttributeMaxDynamicSharedMemorySize, LDS_BYTES) != hipSuccess) { fprintf(stderr, "kernel_launch: hipFuncSetAttribute failed\n"); grid = -1; return; }
        if (hipOccupancyMaxActiveBlocksPerMultiprocessor(&per_cu, (const void*)mega_fwd, NTHREADS, LDS_BYTES) != hipSuccess || per_cu < 1) { fprintf(stderr, "kernel_launch: occupancy query says %d\n", per_cu); per_cu = 1; }
        (void)hipGetLastError();
        grid = cus * 1;
        if (grid <= 0) grid = 256;
    }
    if (grid < 0) return;
    Params p{};
    for (int i = 0; i < 25; ++i) p.in[i] = (const float*)d_in[i];
    p.out = (float*)d_out; p.ws = (unsigned char*)d_ws; p.ph_lo = 0; p.ph_hi = NPHASES;
    if (hipMemsetAsync((char*)d_ws + WS_BAR, 0, XCD_BAR_WORDS * 4, stream) != hipSuccess) { fprintf(stderr, "kernel_launch: memset of the barrier words failed\n"); return; }
    void* args[] = {&p};
    hipError_t e = hipLaunchCooperativeKernel((const void*)mega_fwd, dim3(grid), dim3(NTHREADS), args, LDS_BYTES, stream);
    if (e != hipSuccess) fprintf(stderr, "cooperative launch failed: %s (grid %d)\n", hipGetErrorString(e), grid);
}
```

```cpp
#include <hip/hip_runtime.h>
#include <hip/hip_cooperative_groups.h>
#include <cstdio>
#include <cstdint>
namespace cg = cooperative_groups;
namespace pg8 {
#define PG8_LAS __attribute__((address_space(3)))
typedef unsigned short bf16_t;
typedef short bf16x8 __attribute__((ext_vector_type(8)));
typedef float f32x4 __attribute__((ext_vector_type(4)));
typedef unsigned u32x4 __attribute__((ext_vector_type(4)));
constexpr int BM = 256, BK = 64, HALF = 128, HTB = HALF * BK * 2  , STAGE_BYTES = 8 * HTB, NXCD = 8, WGM = 8;

__host__ __device__ __forceinline__ int lds_byte(int r, int c) { const int st = (r >> 4) * 2 + (c >> 5), rr = r & 15, cc = c & 31, ob = rr * 64 + cc * 2; return st * 1024 + (ob ^ (((ob >> 9) & 1) << 5)); }
__host__ __device__ __forceinline__ void stage_rc(int b, int& R, int& C) { const int st = b / 1024, sb = b % 1024, swz = sb ^ (((sb >> 9) & 1) << 5); R = (st >> 1) * 16 + swz / 64; C = (st & 1) * 32 + (swz % 64) / 2; }
__host__ __device__ __forceinline__ int perm32(int rho) { const int n = rho >> 4, i = rho & 15; return 8 * (i >> 2) + 4 * n + (i & 3); }

struct Unit { int pm, pn; };
struct Gemm { const bf16_t* A; const bf16_t* Bt; int M, N, K; };

struct StaticOrder {
    int nM, nN, nwg, G, c;
    __host__ __device__ void init(int M, int N, int G_, int c_) { nM = M / BM; nN = N / BM; nwg = nM * nN; G = G_; c = c_; }
    __host__ __device__ bool next(int i, Unit& u) const {
        const long L = (long)i * G + c; if (L >= nwg) return false;
        int wgid = (int)L; { const int q = nwg / NXCD, r = nwg % NXCD, xcd = wgid % NXCD, off = wgid / NXCD; wgid = (xcd < r ? xcd * (q + 1) : r * (q + 1) + (xcd - r) * q) + off; }
        const int nig = WGM * nN, gid = wgid / nig, fm = gid * WGM, gsz = (nM - fm) < WGM ? (nM - fm) : WGM;
        u.pm = fm + ((wgid % nig) % gsz); u.pn = (wgid % nig) / gsz; return true;
    }
    __device__ __forceinline__ void a_ready(const Unit&) const {}
    __device__ __forceinline__ void done(const Unit&) const {}
};
typedef __bf16 bf16v2_ __attribute__((ext_vector_type(2)));
typedef float f32v2_ __attribute__((ext_vector_type(2)));
__device__ __forceinline__ unsigned cvt_pk_bf16(float lo, float hi) { f32v2_ v = {lo, hi}; bf16v2_ b = __builtin_convertvector(v, bf16v2_); return __builtin_bit_cast(unsigned, b); }
typedef float f32x2 __attribute__((ext_vector_type(2)));
template <class Epi, class Sched, bool ALIGN_EPI = false, bool SP2 = false>
__device__ __forceinline__ void gemm_phase(PG8_LAS unsigned char* lds, const Gemm g, const Sched& S, const Epi& E) {
    int tid = threadIdx.x; asm volatile("" : "+v"(tid));
    const int wid = __builtin_amdgcn_readfirstlane(tid >> 6), lane = tid & 63, wr = wid >> 2, wc = wid & 3, fr = lane & 15, fq = lane >> 4;
    const int K = g.K, nt = K / BK;
    unsigned voffA[2], voffB[2];
#pragma unroll
    for (int i = 0; i < 2; ++i) { int R, C; stage_rc(tid * 16 + i * 8192, R, C); const int Rb = Epi::PERM ? ((R & ~31) + perm32(R & 31)) : R;
        voffA[i] = (unsigned)(R * K + C) * 2u; voffB[i] = (unsigned)(Rb * K + C) * 2u; }
    const size_t kstep = (size_t)(BK * 2);
    const size_t hstep = (size_t)HALF * K * 2;
    const size_t tstep = 2 * hstep;
    const unsigned ldsw = (unsigned)wid * 1024u;
    const int aoff = lds_byte(wr * 64 + fr, fq * 8), boff = lds_byte(wc * 32 + fr, fq * 8);
#define PG8_SA(b, h) (((b) * 2 + (h)) * HTB)
#define PG8_SB(b, h) ((4 + (b) * 2 + (h)) * HTB)
#define PG8_STAGE(bufoff, gbase, voff) do { _Pragma("unroll") for (int _i = 0; _i < 2; ++_i) \
        __builtin_amdgcn_global_load_lds((const unsigned*)((const char*)(gbase) + (voff)[_i]), (PG8_LAS unsigned*)(lds + (bufoff) + ldsw + _i * 8192), 16, 0, 0); } while (0)
#define PG8_LDA(dst, b, h) do { _Pragma("unroll") for (int m = 0; m < 4; ++m) _Pragma("unroll") for (int k = 0; k < 2; ++k) dst[m][k] = *(const PG8_LAS bf16x8*)(lds + PG8_SA(b, h) + aoff + m * 2048 + k * 1024); } while (0)
#define PG8_LDB(dst, b, h) do { _Pragma("unroll") for (int n = 0; n < 2; ++n) _Pragma("unroll") for (int k = 0; k < 2; ++k) dst[n][k] = *(const PG8_LAS bf16x8*)(lds + PG8_SB(b, h) + boff + n * 2048 + k * 1024); } while (0)
#define PG8_MMA(ai, bj, At, Bt) do { __builtin_amdgcn_s_setprio(1); _Pragma("unroll") for (int m = 0; m < 4; ++m) _Pragma("unroll") for (int n = 0; n < 2; ++n) _Pragma("unroll") for (int k = 0; k < 2; ++k) \
        acc[ai][bj][m][n] = __builtin_amdgcn_mfma_f32_16x16x32_bf16(Bt[n][k], At[m][k], acc[ai][bj][m][n], 0, 0, 0); __builtin_amdgcn_s_setprio(0); } while (0)
#define PG8_WAIT_V(n) asm volatile("s_waitcnt vmcnt(" #n ")" ::: "memory")
#define PG8_WAIT_L(n) asm volatile("s_waitcnt lgkmcnt(" #n ")" ::: "memory")
#define PG8_BAR __builtin_amdgcn_s_barrier()
#define PG8_SCHED __builtin_amdgcn_sched_barrier(0)
    Unit cur, nxt; int ui = 0;
    if (!S.next(0, cur)) return;
    f32x4 acc[2][2][4][2];
#pragma unroll
    for (int a = 0; a < 2; ++a)
#pragma unroll
        for (int b = 0; b < 2; ++b)
#pragma unroll
            for (int m = 0; m < 4; ++m)
#pragma unroll
                for (int n = 0; n < 2; ++n) acc[a][b][m][n] = (f32x4){0.f, 0.f, 0.f, 0.f};
    bf16x8 At[4][2], B0[2][2], B1[2][2];
    const char* cA = (const char*)g.A + (size_t)cur.pm * tstep; const char* cB = (const char*)g.Bt + (size_t)cur.pn * tstep;
    S.a_ready(cur);
    if constexpr (SP2) {
        PG8_STAGE(PG8_SB(0, 0), cB, voffB); PG8_STAGE(PG8_SB(0, 1), cB + hstep, voffB); PG8_STAGE(PG8_SA(0, 0), cA, voffA); PG8_STAGE(PG8_SA(0, 1), cA + hstep, voffA);
        if (wr == 1) PG8_BAR;
        PG8_WAIT_V(2); PG8_BAR;
        PG8_STAGE(PG8_SB(1, 0), cB + kstep, voffB); PG8_STAGE(PG8_SA(1, 0), cA + kstep, voffA); PG8_STAGE(PG8_SB(1, 1), cB + hstep + kstep, voffB);
        PG8_WAIT_V(6); PG8_BAR;
    } else {
        PG8_STAGE(PG8_SB(0, 0), cB, voffB); PG8_STAGE(PG8_SA(0, 0), cA, voffA); PG8_STAGE(PG8_SB(0, 1), cB + hstep, voffB); PG8_STAGE(PG8_SA(0, 1), cA + hstep, voffA);
        if (wr == 1) PG8_BAR;
        PG8_WAIT_V(4); PG8_BAR;
        PG8_STAGE(PG8_SB(1, 0), cB + kstep, voffB); PG8_STAGE(PG8_SA(1, 0), cA + kstep, voffA); PG8_STAGE(PG8_SB(1, 1), cB + hstep + kstep, voffB);
        PG8_WAIT_V(6); PG8_BAR;
    }
    for (;;) {
        const bool has_next = S.next(ui + 1, nxt);
        const char* nA = has_next ? (const char*)g.A + (size_t)nxt.pm * tstep : cA; const char* nB = has_next ? (const char*)g.Bt + (size_t)nxt.pn * tstep : cB;
        for (int t = 0; t < nt; t += 2) {
            const bool last = (t == nt - 2);
            const char* a1 = cA + (size_t)(t + 1) * kstep;
            const char* a2 = last ? nA : cA + (size_t)(t + 2) * kstep; const char* b2 = last ? nB : cB + (size_t)(t + 2) * kstep;
            const char* a3 = a2 + kstep; const char* b3 = b2 + kstep;
            if (last && has_next) S.a_ready(nxt);
            if constexpr (SP2) {
            PG8_LDB(B0, 0, 0); PG8_LDB(B1, 0, 1); PG8_SCHED; PG8_LDA(At, 0, 0); PG8_STAGE(PG8_SA(1, 1), a1 + hstep, voffA);
            PG8_WAIT_V(8); PG8_WAIT_L(0); PG8_BAR; PG8_MMA(0, 0, At, B0); PG8_MMA(0, 1, At, B1); PG8_BAR; PG8_SCHED;
            PG8_LDA(At, 0, 1); PG8_STAGE(PG8_SB(0, 0), b2, voffB); PG8_STAGE(PG8_SB(0, 1), b2 + hstep, voffB); PG8_STAGE(PG8_SA(0, 0), a2, voffA);
            PG8_WAIT_V(8); PG8_WAIT_L(0); PG8_BAR; PG8_MMA(1, 0, At, B0); PG8_MMA(1, 1, At, B1); PG8_BAR; PG8_SCHED;
            PG8_LDB(B0, 1, 0); PG8_LDB(B1, 1, 1); PG8_SCHED; PG8_LDA(At, 1, 0); PG8_STAGE(PG8_SA(0, 1), a2 + hstep, voffA);
            PG8_WAIT_V(8); PG8_WAIT_L(0); PG8_BAR; PG8_MMA(0, 0, At, B0); PG8_MMA(0, 1, At, B1); PG8_BAR; PG8_SCHED;
            PG8_LDA(At, 1, 1); PG8_STAGE(PG8_SB(1, 0), b3, voffB); PG8_STAGE(PG8_SB(1, 1), b3 + hstep, voffB); PG8_STAGE(PG8_SA(1, 0), a3, voffA);
            PG8_WAIT_V(8); PG8_WAIT_L(0); PG8_BAR; PG8_MMA(1, 0, At, B0); PG8_MMA(1, 1, At, B1); PG8_BAR; PG8_SCHED;
            } else {
            PG8_LDB(B0, 0, 0); PG8_SCHED; PG8_LDA(At, 0, 0); PG8_STAGE(PG8_SA(1, 1), a1 + hstep, voffA);
            PG8_WAIT_L(8); PG8_BAR; PG8_WAIT_L(0); PG8_MMA(0, 0, At, B0); PG8_BAR; PG8_SCHED;
            PG8_LDB(B1, 0, 1); PG8_STAGE(PG8_SB(0, 0), b2, voffB);
            PG8_BAR; PG8_WAIT_L(0); PG8_MMA(0, 1, At, B1); PG8_BAR;
            PG8_LDA(At, 0, 1); PG8_STAGE(PG8_SA(0, 0), a2, voffA);
            PG8_BAR; PG8_WAIT_L(0); PG8_MMA(1, 0, At, B0); PG8_BAR; PG8_SCHED;
            PG8_STAGE(PG8_SB(0, 1), b2 + hstep, voffB);
            PG8_WAIT_V(6); PG8_BAR; PG8_MMA(1, 1, At, B1); PG8_BAR;
            PG8_LDB(B0, 1, 0); PG8_SCHED; PG8_LDA(At, 1, 0); PG8_STAGE(PG8_SA(0, 1), a2 + hstep, voffA);
            PG8_WAIT_L(8); PG8_BAR; PG8_WAIT_L(0); PG8_MMA(0, 0, At, B0); PG8_BAR; PG8_SCHED;
            PG8_LDB(B1, 1, 1); PG8_STAGE(PG8_SB(1, 0), b3, voffB);
            PG8_BAR; PG8_WAIT_L(0); PG8_MMA(0, 1, At, B1); PG8_BAR;
            PG8_LDA(At, 1, 1); PG8_STAGE(PG8_SA(1, 0), a3, voffA);
            PG8_BAR; PG8_WAIT_L(0); PG8_MMA(1, 0, At, B0); PG8_BAR; PG8_SCHED;
            PG8_STAGE(PG8_SB(1, 1), b3 + hstep, voffB);
            PG8_WAIT_V(6); PG8_BAR; PG8_MMA(1, 1, At, B1); PG8_BAR;
            }
        }
        if constexpr (ALIGN_EPI) { if (wr == 0) PG8_BAR; }
        if constexpr (!Epi::AFTER_DRAIN) { E(acc, cur, wr, wc, fr, fq); S.done(cur); }
        if (!has_next) break;
#pragma unroll
        for (int a = 0; a < 2; ++a)
#pragma unroll
            for (int b = 0; b < 2; ++b)
#pragma unroll
                for (int m = 0; m < 4; ++m)
#pragma unroll
                    for (int n = 0; n < 2; ++n) acc[a][b][m][n] = (f32x4){0.f, 0.f, 0.f, 0.f};
        cur = nxt; cA = nA; cB = nB; ++ui;
        if constexpr (ALIGN_EPI) { if (wr == 1) PG8_BAR; }
    }
    PG8_WAIT_V(0);
    if constexpr (!ALIGN_EPI) { if (wr == 0) PG8_BAR; }
    PG8_BAR;
    if constexpr (Epi::AFTER_DRAIN) { E.fused(acc, cur, wr, wc, fr, fq, lds, wid, lane); S.done(cur); }
#undef PG8_SA
#undef PG8_SB
#undef PG8_STAGE
#undef PG8_LDA
#undef PG8_LDB
#undef PG8_MMA
#undef PG8_WAIT_V
#undef PG8_WAIT_L
#undef PG8_BAR
#undef PG8_SCHED
}
}
#define XB_TMO      128
#define XB_XCNT(j)  (256  + 64 * (j))
#define XB_XSUB(j)  (1280 + 64 * (j))
#define XB_XGEN(j)  (2304 + 64 * (j))
#define XB_TOP      3328
#define XB_TOPGEN   3392
#define XCD_BAR_WORDS 3456
#define XB_SPIN_CAP (1u << 18)
#define LAS __attribute__((address_space(3)))

__device__ __forceinline__ unsigned xb_ld(unsigned* p)              { return __hip_atomic_load(p, __ATOMIC_RELAXED, __HIP_MEMORY_SCOPE_AGENT); }
__device__ __forceinline__ unsigned xb_add(unsigned* p, unsigned v) { return __hip_atomic_fetch_add(p, v, __ATOMIC_RELAXED, __HIP_MEMORY_SCOPE_AGENT); }
__device__ __forceinline__ unsigned xb_xcc_id() { return (unsigned)__builtin_amdgcn_s_getreg((3 << 11) | 20) & 0xFu; }
#define XB_SPIN(cond, bar) do { unsigned _sp = 0; while (cond) { __builtin_amdgcn_s_sleep(1); \
    if ((++_sp & 255u) == 0u) { if (xb_ld(&(bar)[XB_TMO])) break; if (_sp > XB_SPIN_CAP) { atomicAdd(&(bar)[XB_TMO], 1u); break; } } } } while (0)

struct XcdBarrier {
    unsigned* bar; unsigned x;
    volatile LAS unsigned* st;
};

__device__ __forceinline__ XcdBarrier xcd_barrier_post(unsigned* bar, volatile LAS unsigned* st) {
    XcdBarrier b; b.bar = bar; b.x = xb_xcc_id(); b.st = st;
    if (threadIdx.x == 0) (void)xb_add(&bar[XB_XCNT(b.x)], 1u);
    return b;
}
__device__ __forceinline__ void xcd_barrier_complete(unsigned* bar, unsigned x, unsigned& nloc, unsigned& nx) {
    const unsigned G = gridDim.x * gridDim.y * gridDim.z;
    unsigned sum, cnt, mine, sp = 0u;
    for (;;) {
        sum = 0u; cnt = 0u; mine = 0u;
#pragma unroll
        for (unsigned j = 0; j < 16; ++j) { const unsigned c = xb_ld(&bar[XB_XCNT(j)]); sum += c; cnt += (c > 0u) ? 1u : 0u; mine = (j == x) ? c : mine; }
        if (sum == G) break;
        __builtin_amdgcn_s_sleep(1);
        if ((++sp & 255u) == 0u) { if (xb_ld(&bar[XB_TMO])) break; if (sp > XB_SPIN_CAP) { atomicAdd(&bar[XB_TMO], 1u); break; } }
    }
    nloc = mine > 0u ? mine : 1u; nx = cnt > 0u ? cnt : 1u;
}

__device__ __forceinline__ void xcd_barrier(const XcdBarrier& b) {
    asm volatile("s_waitcnt vmcnt(0)" ::: "memory");
    __syncthreads();
    if (threadIdx.x == 0) {
        unsigned* bar = b.bar;
        __builtin_amdgcn_s_waitcnt(0);
        unsigned nloc = b.st[0], nx = b.st[1];
        if (nloc == 0u) { xcd_barrier_complete(bar, b.x, nloc, nx); b.st[0] = nloc; b.st[1] = nx; }
        const unsigned old = xb_add(&bar[XB_XSUB(b.x)], 1u);
        const unsigned gen = old / nloc;
        if (old + 1u == (gen + 1u) * nloc) {
            __builtin_amdgcn_fence(__ATOMIC_RELEASE, "agent");
            asm volatile("s_waitcnt vmcnt(0)" ::: "memory");
            const unsigned og = xb_add(&bar[XB_TOP], 1u);
            const unsigned tg = og / nx;
            if (og + 1u == (tg + 1u) * nx) xb_add(&bar[XB_TOPGEN], 1u);
            else XB_SPIN(xb_ld(&bar[XB_TOPGEN]) == tg, bar);
            __builtin_amdgcn_fence(__ATOMIC_ACQUIRE, "agent");
            xb_add(&bar[XB_XGEN(b.x)], 1u);
            asm volatile("s_waitcnt vmcnt(0)" ::: "memory");
        } else {
            XB_SPIN(xb_ld(&bar[XB_XGEN(b.x)]) == gen, bar);
            __builtin_amdgcn_fence(__ATOMIC_ACQUIRE, "agent");
            asm volatile("s_waitcnt vmcnt(0)" ::: "memory");
        }
    }
    __syncthreads();
}

constexpr bool GEMM_SP2 = true, GEMM_ALIGN = true;
using pg8::bf16_t; using pg8::f32x4; using pg8::u32x4; using pg8::bf16x8; using pg8::cvt_pk_bf16; using pg8::Unit; using pg8::HALF; using pg8::BM;
typedef unsigned u32x2 __attribute__((ext_vector_type(2)));
constexpr int T_ = 32768, D_ = 1024, SEQ_ = 8192, NB_ = 4, INC_ = 3080, PJ_ = 3072, FF_ = 2816, PLE_ = 256, NCH_ = 128;
constexpr float EPS_ = 1e-6f;
constexpr int NTHREADS = 512;
constexpr int LDS_BYTES = 144 * 1024;

constexpr size_t WS_WIN = 4096;
constexpr size_t WS_WOUT = WS_WIN + (size_t)PJ_ * D_ * 2;
constexpr size_t WS_WGU = WS_WOUT + (size_t)D_ * D_ * 2;
constexpr size_t WS_WD = WS_WGU + (size_t)2 * FF_ * D_ * 2;
constexpr size_t WS_WPG = WS_WD + (size_t)D_ * FF_ * 2;
constexpr size_t WS_WPP = WS_WPG + (size_t)D_ * D_ * 2;
constexpr size_t WS_LOGITS = WS_WPP + (size_t)D_ * PLE_ * 2;
constexpr size_t WS_PB = WS_LOGITS + (size_t)T_ * 8 * 4;
constexpr size_t WS_SSA = WS_PB + (size_t)T_ * PLE_ * 2;
constexpr size_t WS_SSB = WS_SSA + (size_t)T_ * 16 * 4;
constexpr size_t WS_PTOT = WS_SSB + (size_t)T_ * 16 * 4;
constexpr size_t WS_HEND = WS_PTOT + (size_t)NB_ * NCH_ * 512 * 4;
constexpr size_t WS_CARRY = WS_HEND + (size_t)NB_ * NCH_ * 512 * 4;
constexpr size_t WS_GTOT = WS_CARRY + (size_t)NB_ * NCH_ * 512 * 4;
constexpr size_t WS_XB = WS_GTOT + 8192;
constexpr size_t WS_PROJ = WS_XB + (size_t)T_ * D_ * 2;
constexpr size_t WS_R4 = WS_PROJ + (size_t)T_ * PJ_ * 2;
constexpr size_t WS_Y = WS_XB;
constexpr size_t WS_XB2 = WS_R4;
constexpr size_t WS_PP = WS_R4 + (size_t)T_ * D_ * 2;
constexpr size_t WS_ORAW = WS_R4 + (size_t)2048 * 73728;
constexpr size_t WS_BAR = WS_R4 + (size_t)2048 * 73728 + (size_t)T_ * 512 * 2;
constexpr size_t WS_RGW = WS_BAR + 16384;
constexpr size_t WS_END = WS_RGW + 131072;

struct Params {
    const float* in[25];
    float* out; unsigned char* ws;
    int ph_lo, ph_hi;
};

__device__ __forceinline__ float bf2f(bf16_t b) { return __uint_as_float(((unsigned)b) << 16); }
__device__ __forceinline__ bf16_t f2bf(float f) { return (bf16_t)(cvt_pk_bf16(f, 0.f) & 0xffffu); }
__device__ __forceinline__ float sigmoidf_(float x) { return __builtin_amdgcn_rcpf(1.0f + __expf(-x)); }
__device__ __forceinline__ float siluf_(float x) { return x * __builtin_amdgcn_rcpf(1.0f + __expf(-x)); }
__device__ __forceinline__ float softplusf_(float x) { return fmaxf(x, 0.f) + log1pf(__expf(-fabsf(x))); }
__device__ __forceinline__ float gelu_tanhf_(float x) { const float u = 0.7978845608028654f * (x + 0.044715f * x * x * x); return x * __builtin_amdgcn_rcpf(1.0f + __expf(-2.0f * u)); }
__device__ __forceinline__ float rstd16(const float* ss, int r) {
    const f32x4 a = *(const f32x4*)(ss + (size_t)r * 16), b = *(const f32x4*)(ss + (size_t)r * 16 + 4), c = *(const f32x4*)(ss + (size_t)r * 16 + 8), d = *(const f32x4*)(ss + (size_t)r * 16 + 12);
    const float s = ((a[0] + a[1]) + (a[2] + a[3])) + ((b[0] + b[1]) + (b[2] + b[3])) + ((c[0] + c[1]) + (c[2] + c[3])) + ((d[0] + d[1]) + (d[2] + d[3]));
    return rsqrtf(s * (1.0f / 1024.0f) + EPS_);
}

template <int CTRL> __device__ __forceinline__ float dpp_f(float x) { return __int_as_float(__builtin_amdgcn_update_dpp(0, __float_as_int(x), CTRL, 0xf, 0xf, false)); }
__device__ __forceinline__ float red8(float x) { x += dpp_f<0xB1>(x); x += dpp_f<0x4E>(x); x += dpp_f<0x141>(x); return x; }
struct EpiBf16Plain {
    static constexpr bool PERM = true, AFTER_DRAIN = false;
    bf16_t* O; int ldc;
    __device__ __forceinline__ void operator()(const f32x4 (&acc)[2][2][4][2], const Unit& u, int wr, int wc, int fr, int fq) const {
        int row0 = u.pm * BM + wr * 64 + fr; asm volatile("" : "+v"(row0)); const int col0 = u.pn * BM + wc * 32 + 8 * fq;
#pragma unroll
        for (int ai = 0; ai < 2; ++ai)
#pragma unroll
            for (int m = 0; m < 4; ++m) { bf16_t* rowp = O + (size_t)(row0 + ai * HALF + m * 16) * ldc + col0;
#pragma unroll
                for (int bj = 0; bj < 2; ++bj) { const f32x4 v0 = acc[ai][bj][m][0], v1 = acc[ai][bj][m][1]; u32x4 w; w.x = cvt_pk_bf16(v0[0], v0[1]); w.y = cvt_pk_bf16(v0[2], v0[3]); w.z = cvt_pk_bf16(v1[0], v1[1]); w.w = cvt_pk_bf16(v1[2], v1[3]);
                    *(u32x4*)(rowp + bj * HALF) = w; } }
    }
};
__device__ __forceinline__ void rstd8(const float* ss, int row0, int fq, float (&rs)[8]) {
    f32x4 t[8];
#pragma unroll
    for (int g = 0; g < 8; ++g) t[g] = *(const f32x4*)(ss + (size_t)(row0 + (g >> 2) * HALF + (g & 3) * 16) * 16 + 4 * fq);
#pragma unroll
    for (int g = 0; g < 8; ++g) { float sm = (t[g][0] + t[g][1]) + (t[g][2] + t[g][3]); sm += __shfl_xor(sm, 16); sm += __shfl_xor(sm, 32); rs[g] = rsqrtf(sm * (1.0f / 1024.0f) + EPS_); }
    asm volatile("" ::: "memory");
}
template <bool RES_BF16>
struct EpiResid {
    static constexpr bool PERM = true, AFTER_DRAIN = false;
    const float* res; bf16_t* xb; float* ss;
    __device__ __forceinline__ void operator()(const f32x4 (&acc)[2][2][4][2], const Unit& u, int wr, int wc, int fr, int fq) const {
        int row0 = u.pm * BM + wr * 64 + fr; asm volatile("" : "+v"(row0)); const int col0 = u.pn * BM + wc * 32 + 8 * fq;
        const unsigned e0 = (unsigned)row0 * D_ + col0;
#pragma unroll
        for (int ai = 0; ai < 2; ++ai) {
            constexpr int NB = RES_BF16 ? 4 : 2;
#pragma unroll
            for (int mh = 0; mh < 4 / NB; ++mh) {
                f32x4 rv[NB][2][2];
#pragma unroll
                for (int mm = 0; mm < NB; ++mm)
#pragma unroll
                    for (int bj = 0; bj < 2; ++bj) { const unsigned e = e0 + (unsigned)((ai * HALF + (mh * NB + mm) * 16) * D_ + bj * HALF);
                        if (RES_BF16) { const u32x4 w = *(const u32x4*)((const char*)xb + (size_t)(e * 2u));
                            rv[mm][bj][0] = (f32x4){__uint_as_float(w.x << 16), __uint_as_float(w.x & 0xffff0000u), __uint_as_float(w.y << 16), __uint_as_float(w.y & 0xffff0000u)};
                            rv[mm][bj][1] = (f32x4){__uint_as_float(w.z << 16), __uint_as_float(w.z & 0xffff0000u), __uint_as_float(w.w << 16), __uint_as_float(w.w & 0xffff0000u)}; }
                        else { rv[mm][bj][0] = *(const f32x4*)((const char*)res + (size_t)(e * 4u)); rv[mm][bj][1] = *(const f32x4*)((const char*)res + (size_t)(e * 4u) + 16); } }
#pragma unroll
                for (int mm = 0; mm < NB; ++mm) { const int m = mh * NB + mm, r = row0 + ai * HALF + m * 16; float s = 0.f;
#pragma unroll
                    for (int bj = 0; bj < 2; ++bj) { const unsigned e = e0 + (unsigned)((ai * HALF + m * 16) * D_ + bj * HALF);
                        const f32x4 v0 = rv[mm][bj][0] + acc[ai][bj][m][0], v1 = rv[mm][bj][1] + acc[ai][bj][m][1];
                        s += ((v0[0] * v0[0] + v0[1] * v0[1]) + (v0[2] * v0[2] + v0[3] * v0[3])) + ((v1[0] * v1[0] + v1[1] * v1[1]) + (v1[2] * v1[2] + v1[3] * v1[3]));
                        u32x4 w; w.x = cvt_pk_bf16(v0[0], v0[1]); w.y = cvt_pk_bf16(v0[2], v0[3]); w.z = cvt_pk_bf16(v1[0], v1[1]); w.w = cvt_pk_bf16(v1[2], v1[3]); *(u32x4*)((char*)xb + (size_t)(e * 2u)) = w; }
                    s += __shfl_xor(s, 16); s += __shfl_xor(s, 32);
                    if (fq == 0) ss[(size_t)r * 16 + u.pn * 4 + wc] = s; }
                asm volatile("" ::: "memory"); } }
    }
};
struct EpiGateUp {
    static constexpr bool PERM = true, AFTER_DRAIN = false;
    bf16_t* ff; const float* ss;
    __device__ __forceinline__ void operator()(const f32x4 (&acc)[2][2][4][2], const Unit& u, int wr, int wc, int fr, int fq) const {
        int row0 = u.pm * BM + wr * 64 + fr; asm volatile("" : "+v"(row0)); const int col0 = u.pn * HALF + wc * 32 + 8 * fq;
        float rsv[8]; rstd8(ss, row0, fq, rsv);
#pragma unroll
        for (int ai = 0; ai < 2; ++ai)
#pragma unroll
            for (int m = 0; m < 4; ++m) { const int r = row0 + ai * HALF + m * 16; const float rs = rsv[ai * 4 + m];
                float o[8];
#pragma unroll
                for (int n = 0; n < 2; ++n)
#pragma unroll
                    for (int j = 0; j < 4; ++j) { const float g = acc[ai][0][m][n][j] * rs, up = acc[ai][1][m][n][j] * rs; o[n * 4 + j] = siluf_(g) * up; }
                u32x4 w; w.x = cvt_pk_bf16(o[0], o[1]); w.y = cvt_pk_bf16(o[2], o[3]); w.z = cvt_pk_bf16(o[4], o[5]); w.w = cvt_pk_bf16(o[6], o[7]);
                *(u32x4*)(ff + (size_t)r * FF_ + col0) = w; }
    }
};
struct EpiPle {
    static constexpr bool PERM = true, AFTER_DRAIN = false;
    const bf16_t* x2b; bf16_t* x3b; const bf16_t* pp; const float* bias; const float* ss_in; float* ss_out;
    __device__ __forceinline__ void operator()(const f32x4 (&acc)[2][2][4][2], const Unit& u, int wr, int wc, int fr, int fq) const {
        int row0 = u.pm * BM + wr * 64 + fr; asm volatile("" : "+v"(row0)); const int col0 = u.pn * BM + wc * 32 + 8 * fq;
        const unsigned b0 = ((unsigned)row0 * D_ + col0) * 2u;
        const unsigned s0 = (unsigned)row0 * 64u;
        u32x4 X[2][2], P[2][2]; f32x4 S[2];
#define EP_LOAD(set, g) do { const unsigned ro_ = (unsigned)(((g) >> 2) * HALF + ((g) & 3) * 16); \
        _Pragma("unroll") for (int bj = 0; bj < 2; ++bj) { const unsigned bo_ = b0 + (ro_ * D_ + bj * HALF) * 2u; \
            X[set][bj] = *(const u32x4*)((const char*)x2b + (size_t)bo_); P[set][bj] = *(const u32x4*)((const char*)pp + (size_t)bo_); } \
        S[set] = *(const f32x4*)((const char*)ss_in + (size_t)(s0 + ro_ * 64u + (unsigned)fq * 16u)); } while (0)
        EP_LOAD(0, 0);
#pragma unroll
        for (int g = 0; g < 8; ++g) { const int ai = g >> 2, m = g & 3, st = g & 1, r = row0 + ai * HALF + m * 16;
            if (g < 7) EP_LOAD((g + 1) & 1, g + 1);
            float sm = (S[st][0] + S[st][1]) + (S[st][2] + S[st][3]); sm += __shfl_xor(sm, 16); sm += __shfl_xor(sm, 32);
            const float rs = rsqrtf(sm * (1.0f / 1024.0f) + EPS_); float s = 0.f;
#pragma unroll
            for (int bj = 0; bj < 2; ++bj) { const unsigned bo = b0 + (unsigned)(((ai * HALF + m * 16) * D_ + bj * HALF) * 2); const u32x4 pw = P[st][bj], xw = X[st][bj];
                const unsigned pwa[4] = {pw.x, pw.y, pw.z, pw.w}, xwa[4] = {xw.x, xw.y, xw.z, xw.w}; unsigned ow[4];
#pragma unroll
                for (int n = 0; n < 2; ++n) { const f32x4 a = acc[ai][bj][m][n]; const f32x4 bb = *(const f32x4*)(bias + col0 + bj * HALF + 4 * n);
#pragma unroll
                    for (int hh = 0; hh < 2; ++hh) { const unsigned xq = xwa[2 * n + hh], pq = pwa[2 * n + hh];
                        const float v0 = __uint_as_float(xq << 16) + sigmoidf_(a[2 * hh] * rs + bb[2 * hh]) * __uint_as_float(pq << 16);
                        const float v1 = __uint_as_float(xq & 0xffff0000u) + sigmoidf_(a[2 * hh + 1] * rs + bb[2 * hh + 1]) * __uint_as_float(pq & 0xffff0000u);
                        ow[2 * n + hh] = cvt_pk_bf16(v0, v1); s += v0 * v0 + v1 * v1; } }
                *(u32x4*)((char*)x3b + (size_t)bo) = (u32x4){ow[0], ow[1], ow[2], ow[3]}; }
            s += __shfl_xor(s, 16); s += __shfl_xor(s, 32);
            if (fq == 0) ss_out[(size_t)r * 16 + u.pn * 4 + wc] = s;
            asm volatile("" ::: "memory"); }
#undef EP_LOAD
    }
};

template <class Epi> __device__ __forceinline__ void run_gemm(PG8_LAS unsigned char* lds, const bf16_t* A, const bf16_t* Bt, int M, int N, int K, const Epi& E) {
    pg8::Gemm g; g.A = A; g.Bt = Bt; g.M = M; g.N = N; g.K = K;
    pg8::StaticOrder S; S.init(M, N, (int)gridDim.x, (int)blockIdx.x);
    pg8::gemm_phase<Epi, pg8::StaticOrder, GEMM_ALIGN, GEMM_SP2>(lds, g, S, E);
}

__device__ void prep_transpose(const float* __restrict__ W, int K, int ldw, int c0, int ncols, bf16_t* __restrict__ Wt, const float* __restrict__ ks, int mode, float* tile, int rot, int widx, int nw) {
    const int tid = threadIdx.x, nkt = K / 64, nct = ncols / 64, ntiles = nkt * nct;
    for (int tt = (widx + nw - (rot % nw)) % nw; tt < ntiles; tt += nw) {
        const int kt = tt / nct, ct = tt % nct, k0 = kt * 64, n0 = ct * 64;
        __syncthreads();
#pragma unroll
        for (int i = 0; i < 2; ++i) { const int r = (tid >> 4) + 32 * i, c4 = (tid & 15) * 4; const f32x4 v = *(const f32x4*)(W + (size_t)(k0 + r) * ldw + c0 + n0 + c4);
            const float s = ks ? ks[k0 + r] : 1.0f; tile[r * 65 + c4 + 0] = v[0] * s; tile[r * 65 + c4 + 1] = v[1] * s; tile[r * 65 + c4 + 2] = v[2] * s; tile[r * 65 + c4 + 3] = v[3] * s; }
        __syncthreads();
        const int n = tid >> 3, kseg = (tid & 7) * 8; float v[8];
#pragma unroll
        for (int e = 0; e < 8; ++e) v[e] = tile[(kseg + e) * 65 + n];
        u32x4 w; w.x = cvt_pk_bf16(v[0], v[1]); w.y = cvt_pk_bf16(v[2], v[3]); w.z = cvt_pk_bf16(v[4], v[5]); w.w = cvt_pk_bf16(v[6], v[7]);
        const int f = n0 + n; const int drow = (mode == 0) ? f : (256 * (f >> 7) + 128 * (mode - 1) + (f & 127));
        *(u32x4*)(Wt + (size_t)drow * K + k0 + kseg) = w;
    }
}


__device__ __forceinline__ void prep_weights_late(const Params& p, unsigned char* smem, int widx, int nw) {
    unsigned char* ws = p.ws; float* tile = (float*)smem;
    __syncthreads();
    prep_transpose(p.in[15], D_, D_, 0, D_, (bf16_t*)(ws + WS_WOUT), nullptr, 0, tile, 0, widx, nw);
    prep_transpose(p.in[17], D_, FF_, 0, FF_, (bf16_t*)(ws + WS_WGU), p.in[16], 1, tile, 256, widx, nw);
    prep_transpose(p.in[18], D_, FF_, 0, FF_, (bf16_t*)(ws + WS_WGU), p.in[16], 2, tile, 960, widx, nw);
    prep_transpose(p.in[19], FF_, D_, 0, D_, (bf16_t*)(ws + WS_WD), nullptr, 0, tile, 1664, widx, nw);
    prep_transpose(p.in[21], D_, D_, 0, D_, (bf16_t*)(ws + WS_WPG), p.in[20], 0, tile, 2368, widx, nw);
}

__device__ __forceinline__ void phase_prep(const Params& p, unsigned char* smem) {
    const int tid = threadIdx.x, wid = __builtin_amdgcn_readfirstlane(tid >> 6), lane = tid & 63;
    unsigned char* ws = p.ws;
    float* tile = (float*)smem;
    float* w8s = (float*)(smem + 20480);
    if (blockIdx.x == 0 && tid < 32) ((unsigned*)ws)[tid] = 0u;
    prep_transpose(p.in[3], D_, INC_, 0, PJ_, (bf16_t*)(ws + WS_WIN), nullptr, 0, tile, 0, (int)blockIdx.x, (int)gridDim.x);
    prep_transpose(p.in[23], PLE_, D_, 0, D_, (bf16_t*)(ws + WS_WPP), nullptr, 0, tile, 768, (int)blockIdx.x, (int)gridDim.x);
    if (blockIdx.x < 8) {
        const int hh = blockIdx.x;
        for (int item = tid; item < 1024; item += NTHREADS) { const int gate = item >> 9, fragi = (item >> 6) & 7, ln = item & 63, ntf = fragi >> 1, ksf = fragi & 1, n16f = ln & 15, fqf = ln >> 4;
            const float* wsrc = p.in[gate ? 8 : 6] + (size_t)(hh * 64 + 32 * ksf + 8 * fqf) * 64 + 16 * ntf + n16f;
            const f32x4 lo = {wsrc[0], wsrc[64], wsrc[128], wsrc[192]}, hi = {wsrc[256], wsrc[320], wsrc[384], wsrc[448]};
            u32x4 w; w.x = cvt_pk_bf16(lo[0], lo[1]); w.y = cvt_pk_bf16(lo[2], lo[3]); w.z = cvt_pk_bf16(hi[0], hi[1]); w.w = cvt_pk_bf16(hi[2], hi[3]);
            *(u32x4*)(ws + WS_RGW + ((size_t)((hh * 2 + gate) * 8 + fragi) * 64 + ln) * 16) = w; }
    }
    for (int i = tid; i < 1024 * 8; i += NTHREADS) { const int k = i >> 3, j = i & 7; w8s[i] = p.in[2][k] * p.in[3][(size_t)k * INC_ + PJ_ + j]; }
    __syncthreads();
    {
        const float* x = p.in[0]; const float* nw = p.in[2]; bf16_t* hb = (bf16_t*)(ws + WS_XB); float* logits = (float*)(ws + WS_LOGITS);
        f32x4 nwv[4];
#pragma unroll
        for (int i = 0; i < 4; ++i) nwv[i] = *(const f32x4*)(nw + 4 * (lane + 64 * i));
        f32x4 vn[4]; int row = blockIdx.x * 8 + wid;
        if (row < T_) {
#pragma unroll
            for (int i = 0; i < 4; ++i) vn[i] = *(const f32x4*)(x + (size_t)row * D_ + 4 * (lane + 64 * i)); }
        for (; row < T_; row += gridDim.x * 8) {
            f32x4 v[4]; float s = 0.f;
#pragma unroll
            for (int i = 0; i < 4; ++i) { v[i] = vn[i]; s += (v[i][0] * v[i][0] + v[i][1] * v[i][1]) + (v[i][2] * v[i][2] + v[i][3] * v[i][3]); }
            { const int nrow = row + gridDim.x * 8;
              if (nrow < T_) {
#pragma unroll
                for (int i = 0; i < 4; ++i) vn[i] = *(const f32x4*)(x + (size_t)nrow * D_ + 4 * (lane + 64 * i)); } }
            s = red8(s); s += dpp_f<0x140>(s); s += __shfl_xor(s, 16); s += __shfl_xor(s, 32);
            const float rs = rsqrtf(s * (1.0f / 1024.0f) + EPS_);
            float lg[8];
#pragma unroll
            for (int j = 0; j < 8; ++j) lg[j] = 0.f;
#pragma unroll
            for (int i = 0; i < 4; ++i) {
                const int k0 = 4 * (lane + 64 * i);
#pragma unroll
                for (int e = 0; e < 4; ++e) { const f32x4 wa = *(const f32x4*)(w8s + (k0 + e) * 8), wb = *(const f32x4*)(w8s + (k0 + e) * 8 + 4); const float xv = v[i][e];
                    lg[0] += xv * wa[0]; lg[1] += xv * wa[1]; lg[2] += xv * wa[2]; lg[3] += xv * wa[3]; lg[4] += xv * wb[0]; lg[5] += xv * wb[1]; lg[6] += xv * wb[2]; lg[7] += xv * wb[3]; }
                const f32x4 h = v[i] * rs * nwv[i]; u32x2 w; w.x = cvt_pk_bf16(h[0], h[1]); w.y = cvt_pk_bf16(h[2], h[3]);
                *(u32x2*)(hb + (size_t)row * D_ + k0) = w;
            }
            const bool b5 = (lane & 32) != 0, b4 = (lane & 16) != 0, b3 = (lane & 8) != 0;
            float k4[4], k2[2];
#pragma unroll
            for (int j = 0; j < 4; ++j) { const float send = b5 ? lg[j] : lg[j + 4]; const float keep = b5 ? lg[j + 4] : lg[j]; k4[j] = keep + __shfl_xor(send, 32); }
#pragma unroll
            for (int j = 0; j < 2; ++j) { const float send = b4 ? k4[j] : k4[j + 2]; const float keep = b4 ? k4[j + 2] : k4[j]; k2[j] = keep + __shfl_xor(send, 16); }
            float k1; { const float send = b3 ? k2[0] : k2[1]; const float keep = b3 ? k2[1] : k2[0]; k1 = keep + __shfl_xor(send, 8); }
            k1 = red8(k1);
            if ((lane & 7) == 0) logits[(size_t)row * 8 + ((lane >> 5) & 1) * 4 + ((lane >> 4) & 1) * 2 + ((lane >> 3) & 1)] = k1 * rs;
        }
    }
    {
        const f32x4* src = (const f32x4*)p.in[1]; u32x2* dst = (u32x2*)(ws + WS_PB); const size_t n4 = (size_t)T_ * PLE_ / 4;
        for (size_t i = (size_t)blockIdx.x * NTHREADS + tid; i < n4; i += (size_t)gridDim.x * NTHREADS) { const f32x4 v = src[i]; u32x2 w; w.x = cvt_pk_bf16(v[0], v[1]); w.y = cvt_pk_bf16(v[2], v[3]); dst[i] = w; }
    }
}
__device__ __forceinline__ bf16x8 pack8(const f32x4 a, const f32x4 b) { u32x4 w; w.x = cvt_pk_bf16(a[0], a[1]); w.y = cvt_pk_bf16(a[2], a[3]); w.z = cvt_pk_bf16(b[0], b[1]); w.w = cvt_pk_bf16(b[2], b[3]); return __builtin_bit_cast(bf16x8, w); }
#define MFMA16(a, b, c) __builtin_amdgcn_mfma_f32_16x16x32_bf16((a), (b), (c), 0, 0, 0)
__device__ __forceinline__ float neg_expm1_small(float x, float ehalf) {
    const float ps = -x * (1.0f + x * (0.5f + x * (0.16666667f + x * (0.041666668f + x * (0.008333334f + x * 0.0013888889f)))));
    return (x > -0.25f) ? ps : (1.0f - ehalf * ehalf);
}
template <bool FINAL>
__device__ __forceinline__ void rg_pass_mfma(const Params& p, unsigned char* smem, int widx, int nworkers) {
    const int tid = threadIdx.x, wid = __builtin_amdgcn_readfirstlane(tid >> 6), lane = tid & 63, n16o = lane & 15, fqo = lane >> 4, c = wid * 64 + lane;
    unsigned char* ws = p.ws;
    const bf16_t* proj = (const bf16_t*)(ws + WS_PROJ);
    float* U = (float*)smem + wid * 4352;
    float* ptot = (float*)(ws + WS_PTOT); float* hend = (float*)(ws + WS_HEND); const float* carry = (const float*)(ws + WS_CARRY);
    bf16_t* y = (bf16_t*)(ws + WS_Y);
    bf16x8 Bx[4][2], Ba[4][2];
#pragma unroll
    for (int nt = 0; nt < 4; ++nt)
#pragma unroll
        for (int ks = 0; ks < 2; ++ks) { const unsigned char* fb = ws + WS_RGW + ((size_t)(wid * 16 + nt * 2 + ks) * 64 + lane) * 16;
            Bx[nt][ks] = *(const bf16x8*)fb; Ba[nt][ks] = *(const bf16x8*)(fb + 8 * 64 * 16); }
    const float cw0 = p.in[4][c], cw1 = p.in[4][512 + c], cw2 = p.in[4][1024 + c], cw3 = p.in[4][1536 + c], cb = p.in[5][c];
    float bxv[4], bav[4], spv[4];
#pragma unroll
    for (int nt = 0; nt < 4; ++nt) { const int cgl = wid * 64 + 16 * nt + n16o; bxv[nt] = p.in[7][cgl]; bav[nt] = p.in[9][cgl]; spv[nt] = softplusf_(-p.in[10][cgl]); }
    for (int unit = widx; unit < NB_ * NCH_; unit += nworkers) {
        const int n = unit & (NCH_ - 1); const size_t t0 = (size_t)unit * 64;
        float xm3 = 0.f, xm2 = 0.f, xm1 = 0.f;
        if (n != 0) { xm3 = bf2f(proj[(t0 - 3) * PJ_ + c]); xm2 = bf2f(proj[(t0 - 2) * PJ_ + c]); xm1 = bf2f(proj[(t0 - 1) * PJ_ + c]); }
        __syncthreads();
        { bf16_t xr[16]; const bf16_t* xp0 = proj + t0 * PJ_ + c;
#pragma unroll
          for (int i = 0; i < 16; ++i) xr[i] = xp0[(size_t)i * PJ_];
#pragma unroll
          for (int tb = 0; tb < 4; ++tb) { bf16_t xn[16]; const bf16_t* xp = proj + (t0 + (tb + 1) * 16) * PJ_ + c;
            if (tb < 3) {
#pragma unroll
                for (int i = 0; i < 16; ++i) xn[i] = xp[(size_t)i * PJ_]; }
#pragma unroll
            for (int i = 0; i < 16; ++i) { const float xv = bf2f(xr[i]); U[(16 * ((i >> 2) & 3) + 4 * tb + (i & 3)) * 68 + lane] = cw0 * xm3 + cw1 * xm2 + cw2 * xm1 + cw3 * xv + cb; xm3 = xm2; xm2 = xm1; xm1 = xv; }
            if (tb < 3) {
#pragma unroll
                for (int i = 0; i < 16; ++i) xr[i] = xn[i]; } } }
        __syncthreads();
        const bf16_t* gub = proj + t0 * PJ_ + 512; bf16_t* yub = y + t0 * D_;
#pragma unroll
        for (int nt = 0; nt < 4; ++nt) {
            asm volatile("" ::: "memory");
            int lane_o = lane; asm volatile("" : "+v"(lane_o));
            const int n16 = lane_o & 15, fq = lane_o >> 4;
            const int chl = 16 * nt + n16, cgl = wid * 64 + chl;
            bf16x8 Af[4][2];
#pragma unroll
            for (int mt = 0; mt < 4; ++mt)
#pragma unroll
                for (int ks = 0; ks < 2; ++ks) { const float* up = U + (16 * mt + n16) * 68 + 32 * ks + 8 * fq; Af[mt][ks] = pack8(*(const f32x4*)up, *(const f32x4*)(up + 4)); }

            bf16_t gr[16];
            if (FINAL) {
#pragma unroll
                for (int i = 0; i < 16; ++i) gr[i] = gub[(16 * fq + i) * PJ_ + cgl]; }
            f32x4 ax[4], aa[4];
#pragma unroll
            for (int mt = 0; mt < 4; ++mt) { ax[mt] = (f32x4){bxv[nt], bxv[nt], bxv[nt], bxv[nt]}; aa[mt] = (f32x4){bav[nt], bav[nt], bav[nt], bav[nt]}; }
#pragma unroll
            for (int mt = 0; mt < 4; ++mt)
#pragma unroll
                for (int ks = 0; ks < 2; ++ks) { ax[mt] = MFMA16(Af[mt][ks], Bx[nt][ks], ax[mt]); aa[mt] = MFMA16(Af[mt][ks], Ba[nt][ks], aa[mt]); }
            float av[16], bv[16]; float hl = 0.f, Pl = 1.f;
#pragma unroll
            for (int i = 0; i < 16; ++i) { const int mt = i >> 2, j = i & 3, tok = 16 * fq + i; const float u = U[(16 * mt + 4 * fq + j) * 68 + chl];
                const float gx = sigmoidf_(ax[mt][j]), gg = sigmoidf_(aa[mt][j]); const float la = -8.0f * gg * spv[nt]; const float a = __expf(la);
                float mult = sqrtf(fmaxf(neg_expm1_small(2.0f * la, a), 0.f)); if (n == 0 && tok == 0) mult = 1.0f;
                av[i] = a; bv[i] = u * gx * mult; hl = a * hl + bv[i]; Pl *= a; }
            float Pg[4], Hg[4];
#pragma unroll
            for (int g = 0; g < 4; ++g) { Pg[g] = __shfl(Pl, n16 + 16 * g); Hg[g] = __shfl(hl, n16 + 16 * g); }
            if (FINAL) {
                float h = carry[(size_t)unit * 512 + cgl];
#pragma unroll
                for (int g = 0; g < 3; ++g) if (g < fq) h = Pg[g] * h + Hg[g];
#pragma unroll
                for (int i = 0; i < 16; ++i) { h = av[i] * h + bv[i]; yub[(16 * fq + i) * D_ + cgl] = f2bf(h * gelu_tanhf_(bf2f(gr[i]))); }
            } else {
                float cc = 0.f, Pp = 1.f;
#pragma unroll
                for (int g = 0; g < 4; ++g) { cc = Pg[g] * cc + Hg[g]; Pp *= Pg[g]; }
                if (fq == 0) { ptot[(size_t)unit * 512 + cgl] = Pp; hend[(size_t)unit * 512 + cgl] = cc; }
            }
        }
    }
}

__device__ __forceinline__ void rg_carry(const Params& p, int idx) {
    unsigned char* ws = p.ws; const float* ptot = (const float*)(ws + WS_PTOT); const float* hend = (const float*)(ws + WS_HEND); float* carry = (float*)(ws + WS_CARRY);
    const int b = idx >> 9, c = idx & 511; float hc = 0.f;
    for (int n0 = 0; n0 < NCH_; n0 += 8) { float P[8], H[8];
#pragma unroll
        for (int i = 0; i < 8; ++i) { const size_t o = (size_t)(b * NCH_ + n0 + i) * 512 + c; P[i] = ptot[o]; H[i] = hend[o]; }
#pragma unroll
        for (int i = 0; i < 8; ++i) { const size_t o = (size_t)(b * NCH_ + n0 + i) * 512 + c; carry[o] = hc; hc = P[i] * hc + H[i]; } }
}

constexpr int GU_BYTES = 73728, GU_KDT = 32768, GU_QK = 49152, GU_U = 57344;
typedef float f32x2_ __attribute__((ext_vector_type(2)));
__device__ __forceinline__ int tok_of_pos(int p) { return 16 * (2 * (p >> 5) + ((p >> 2) & 1)) + 4 * ((p >> 3) & 3) + (p & 3); }
__device__ __forceinline__ void unpack8(const u32x4 w, float* f) { f[0] = __uint_as_float(w.x << 16); f[1] = __uint_as_float(w.x & 0xffff0000u); f[2] = __uint_as_float(w.y << 16); f[3] = __uint_as_float(w.y & 0xffff0000u);
    f[4] = __uint_as_float(w.z << 16); f[5] = __uint_as_float(w.z & 0xffff0000u); f[6] = __uint_as_float(w.w << 16); f[7] = __uint_as_float(w.w & 0xffff0000u); }

__device__ __forceinline__ void gdn_pass_a(const Params& p, unsigned char* smem) {
    const int tid = threadIdx.x, wid = __builtin_amdgcn_readfirstlane(tid >> 6);
    unsigned char* ws = p.ws; const bf16_t* proj = (const bf16_t*)(ws + WS_PROJ); const float* logits = (const float*)(ws + WS_LOGITS); float* gtot = (float*)(ws + WS_GTOT);
    bf16_t* Kb = (bf16_t*)smem; bf16_t* Qb = (bf16_t*)(smem + 17408); bf16_t* VBt = (bf16_t*)(smem + 34816); bf16_t* KBGt = (bf16_t*)(smem + 53248);
    float* Lsw = (float*)(smem + 71680); bf16_t* Tb = (bf16_t*)(smem + 89088); float* gcs = (float*)(smem + 98304); float* betas = gcs + 64; float* kdec = gcs + 128;
    const int lane0 = tid & 63, tg0 = tid >> 5, ch0 = (tid & 31) * 4;
    for (int ub = blockIdx.x * 8; ub < 2048; ub += gridDim.x * 8) {
        const int bh = ub >> 7, b = bh >> 2, h = bh & 3;
        const float Aexp = __expf(p.in[12][h]), dtb = p.in[13][h];
        float cw[3][4][4];
#pragma unroll
        for (int a = 0; a < 3; ++a)
#pragma unroll
            for (int j = 0; j < 4; ++j) { const f32x4 w = *(const f32x4*)(p.in[11] + (size_t)j * 1536 + a * 512 + h * 128 + ch0); cw[a][j][0] = w[0]; cw[a][j][1] = w[1]; cw[a][j][2] = w[2]; cw[a][j][3] = w[3]; }
        u32x2 pre[3][7]; float lgb, lga;
#define GA_PREFETCH(unit_) do { const int n_ = (unit_) & 127; const size_t t0_ = (size_t)b * SEQ_ + (size_t)n_ * 64; \
        lgb = logits[(t0_ + lane0) * 8 + h]; lga = logits[(t0_ + lane0) * 8 + 4 + h]; \
        _Pragma("unroll") for (int r = 0; r < 7; ++r) { const int sp_ = n_ * 64 + 4 * tg0 - 3 + r; \
            _Pragma("unroll") for (int a = 0; a < 3; ++a) pre[a][r] = (sp_ >= 0) ? *(const u32x2*)(proj + ((size_t)b * SEQ_ + sp_) * PJ_ + 1024 + a * 512 + h * 128 + ch0) : (u32x2){0u, 0u}; } } while (0)
        GA_PREFETCH(ub);
        for (int k = 0; k < 8; ++k) {
            const int unit = ub + k, n = unit & 127;
            int tid_o = tid; asm volatile("" : "+v"(tid_o));
            const int lane = tid_o & 63, r16 = lane & 15, kq = lane >> 4, cg4 = tid_o & 31, tg = tid_o >> 5, ch = cg4 * 4;
            unsigned char* gbase = ws + WS_R4 + (size_t)unit * GU_BYTES;
            const float betav = sigmoidf_(lgb);
            float gc = -Aexp * softplusf_(lga + dtb);
#pragma unroll
            for (int o = 1; o < 64; o <<= 1) { const float tmp = __shfl_up(gc, o); if (lane >= o) gc += tmp; }
            const float gclast = __shfl(gc, 63);
            if (wid == 0) { gcs[lane] = gc; betas[lane] = betav; kdec[lane] = __expf(gclast - gc); }
            {
                float x[7][4], o[4][4], bt[4], egt[4];
#pragma unroll
                for (int t = 0; t < 4; ++t) { bt[t] = __shfl(betav, 4 * tg + t); egt[t] = __expf(__shfl(gc, 4 * tg + t)); }
#pragma unroll
                for (int a = 0; a < 3; ++a) {
#pragma unroll
                    for (int r = 0; r < 7; ++r) { x[r][0] = __uint_as_float(pre[a][r].x << 16); x[r][1] = __uint_as_float(pre[a][r].x & 0xffff0000u); x[r][2] = __uint_as_float(pre[a][r].y << 16); x[r][3] = __uint_as_float(pre[a][r].y & 0xffff0000u); }
#pragma unroll
                    for (int t = 0; t < 4; ++t)
#pragma unroll
                        for (int e = 0; e < 4; ++e) { float acc = cw[a][0][e] * x[t][e]; acc += cw[a][1][e] * x[t + 1][e]; acc += cw[a][2][e] * x[t + 2][e]; acc += cw[a][3][e] * x[t + 3][e]; o[t][e] = siluf_(acc); }
                    if (a < 2) {
#pragma unroll
                        for (int t = 0; t < 4; ++t) { float ssq = (o[t][0] * o[t][0] + o[t][1] * o[t][1]) + (o[t][2] * o[t][2] + o[t][3] * o[t][3]);
                            ssq += dpp_f<0xB1>(ssq); ssq += dpp_f<0x4E>(ssq); ssq += dpp_f<0x141>(ssq); ssq += dpp_f<0x140>(ssq); ssq += __shfl_xor(ssq, 16);
                            const float rs = rsqrtf(ssq + EPS_) * (a == 0 ? 0.08838834764831845f : 1.0f);
#pragma unroll
                            for (int e = 0; e < 4; ++e) o[t][e] *= rs; }
                    }
                    if (a == 0) {
#pragma unroll
                        for (int t = 0; t < 4; ++t) { const int tok = 4 * tg + t; u32x2 w; w.x = cvt_pk_bf16(o[t][0], o[t][1]); w.y = cvt_pk_bf16(o[t][2], o[t][3]); *(u32x2*)(Qb + tok * 136 + ch) = w;
                            u32x2 wd; wd.x = cvt_pk_bf16(o[t][0] * egt[t], o[t][1] * egt[t]); wd.y = cvt_pk_bf16(o[t][2] * egt[t], o[t][3] * egt[t]);
                            *(u32x2*)((bf16_t*)gbase + (size_t)(64 + tok) * 128 + 32 * (cg4 >> 3) + 8 * (cg4 & 3) + 4 * ((cg4 >> 2) & 1)) = wd; }
                    } else if (a == 1) {
#pragma unroll
                        for (int t = 0; t < 4; ++t) { const int tok = 4 * tg + t; u32x2 w; w.x = cvt_pk_bf16(o[t][0], o[t][1]); w.y = cvt_pk_bf16(o[t][2], o[t][3]); *(u32x2*)(Kb + tok * 136 + ch) = w; }
#pragma unroll
                        for (int e = 0; e < 4; ++e) { u32x2 w; w.x = cvt_pk_bf16(o[0][e] * bt[0] * egt[0], o[1][e] * bt[1] * egt[1]); w.y = cvt_pk_bf16(o[2][e] * bt[2] * egt[2], o[3][e] * bt[3] * egt[3]); *(u32x2*)(KBGt + (ch + e) * 72 + (((tg >> 1) ^ (cg4 & 7)) << 3) + 4 * (tg & 1)) = w; }
                    } else {
#pragma unroll
                        for (int e = 0; e < 4; ++e) { u32x2 w; w.x = cvt_pk_bf16(o[0][e] * bt[0], o[1][e] * bt[1]); w.y = cvt_pk_bf16(o[2][e] * bt[2], o[3][e] * bt[3]); *(u32x2*)(VBt + (ch + e) * 72 + (((tg >> 1) ^ (cg4 & 7)) << 3) + 4 * (tg & 1)) = w; }
                    }
                }
            }
            if (k + 1 < 8) GA_PREFETCH(unit + 1);
            __syncthreads();
#pragma unroll
            for (int rep = 0; rep < 2; ++rep) {
                const int tl = wid + 8 * rep, jt = tl >> 2, it = tl & 3;
                f32x4 accQ = {0.f, 0.f, 0.f, 0.f}, accK = {0.f, 0.f, 0.f, 0.f};
#pragma unroll
                for (int ks = 0; ks < 4; ++ks) { const bf16x8 a = *(const bf16x8*)(Kb + (16 * jt + r16) * 136 + 32 * ks + 8 * kq);
                    const bf16x8 bq = *(const bf16x8*)(Qb + (16 * it + r16) * 136 + 32 * ks + 8 * kq), bk = *(const bf16x8*)(Kb + (16 * it + r16) * 136 + 32 * ks + 8 * kq);
                    accQ = MFMA16(a, bq, accQ); accK = MFMA16(a, bk, accK); }
                const int i = 16 * it + r16; const float gi = gcs[i], bi = betas[i]; float qv[4];
#pragma unroll
                for (int jj = 0; jj < 4; ++jj) { const int j = 16 * jt + 4 * kq + jj; const float d = __expf(fminf(gi - gcs[j], 0.f));
                    qv[jj] = (i >= j) ? accQ[jj] * d : 0.f; Lsw[i * 68 + (j & 7) * 8 + (j >> 3)] = (i > j) ? bi * accK[jj] * d : 0.f; }
                u32x2 w; w.x = cvt_pk_bf16(qv[0], qv[1]); w.y = cvt_pk_bf16(qv[2], qv[3]);
                *(u32x2*)((bf16_t*)(gbase + GU_QK) + i * 64 + 32 * (jt >> 1) + 8 * kq + 4 * (jt & 1)) = w;
            }
            __syncthreads();
            {
                const int s = lane & 7, c = 8 * wid + (lane >> 3); float t[8];
#pragma unroll
                for (int m = 0; m < 8; ++m) t[m] = 0.f;
                f32x4 la[2][2]; la[0][0] = *(const f32x4*)(Lsw + s * 8); la[0][1] = *(const f32x4*)(Lsw + s * 8 + 4);
#pragma unroll
                for (int i = 0; i < 64; ++i) {
                    if (i + 1 < 64) { la[(i + 1) & 1][0] = *(const f32x4*)(Lsw + (i + 1) * 68 + s * 8); la[(i + 1) & 1][1] = *(const f32x4*)(Lsw + (i + 1) * 68 + s * 8 + 4); }
                    asm volatile("" ::: "memory");
                    const f32x4 l0 = la[i & 1][0], l1 = la[i & 1][1];
                    float part = 0.f;
#pragma unroll
                    for (int m = 0; m < 8; ++m) if (8 * m <= i) part += ((m < 4) ? l0[m & 3] : l1[m & 3]) * t[m];
                    part = red8(part);
                    const float val = ((i == c) ? 1.0f : 0.0f) - part;
                    if (s == (i & 7)) t[i >> 3] = val;
                }
#pragma unroll
                for (int m = 0; m < 8; ++m) Tb[(8 * m + s) * 72 + c] = f2bf(t[m]);
            }
            __syncthreads();
            {
#pragma unroll
                for (int mt = 0; mt < 4; ++mt) { f32x4 acc = {0.f, 0.f, 0.f, 0.f};
#pragma unroll
                    for (int ks = 0; ks < 2; ++ks) { const bf16x8 a = *(const bf16x8*)(Tb + (16 * mt + r16) * 72 + 32 * ks + 8 * kq), bb = *(const bf16x8*)(VBt + (16 * wid + r16) * 72 + (((4 * ks + kq) ^ ((4 * wid + (r16 >> 2)) & 7)) << 3)); acc = MFMA16(a, bb, acc); }
                    u32x2 w; w.x = cvt_pk_bf16(acc[0], acc[1]); w.y = cvt_pk_bf16(acc[2], acc[3]);
                    *(u32x2*)((bf16_t*)(gbase + GU_U) + ((wid * 4 + mt) * 64 + lane) * 4) = w; }
#pragma unroll
                for (int it = 0; it < 4; ++it) { f32x4 acc = {0.f, 0.f, 0.f, 0.f};
#pragma unroll
                    for (int ks = 0; ks < 2; ++ks) { const bf16x8 a = *(const bf16x8*)(KBGt + (16 * wid + r16) * 72 + (((4 * ks + kq) ^ ((4 * wid + (r16 >> 2)) & 7)) << 3)), bb = *(const bf16x8*)(Tb + (16 * it + r16) * 72 + 32 * ks + 8 * kq); acc = MFMA16(a, bb, acc); }
                    u32x2 w; w.x = cvt_pk_bf16(acc[0], acc[1]); w.y = cvt_pk_bf16(acc[2], acc[3]);
                    *(u32x2*)((bf16_t*)gbase + (16 * it + r16) * 128 + 32 * (wid >> 1) + 8 * kq + 4 * (wid & 1)) = w; }
                const int dk = tid_o >> 2, pg = tid_o & 3; float v[16];
#pragma unroll
                for (int e = 0; e < 16; ++e) { const int tk = tok_of_pos(16 * pg + e); v[e] = bf2f(Kb[tk * 136 + dk]) * kdec[tk]; }
                u32x4 w0, w1; w0.x = cvt_pk_bf16(v[0], v[1]); w0.y = cvt_pk_bf16(v[2], v[3]); w0.z = cvt_pk_bf16(v[4], v[5]); w0.w = cvt_pk_bf16(v[6], v[7]);
                w1.x = cvt_pk_bf16(v[8], v[9]); w1.y = cvt_pk_bf16(v[10], v[11]); w1.z = cvt_pk_bf16(v[12], v[13]); w1.w = cvt_pk_bf16(v[14], v[15]);
                *(u32x4*)((bf16_t*)(gbase + GU_KDT) + dk * 64 + 16 * pg) = w0; *(u32x4*)((bf16_t*)(gbase + GU_KDT) + dk * 64 + 16 * pg + 8) = w1;
                if (tid == 0) gtot[unit] = __expf(gclast);
            }
            __syncthreads();
        }
    }
#undef GA_PREFETCH
}

constexpr int GB_BUF = 62464, GB_KDT = 34816, GB_QK = 53248, GB_BUF2 = GB_BUF + 4096 + 16;
__device__ __forceinline__ void gdn_pass_b(const Params& p, unsigned char* smem, int wg) {
    const int tid = threadIdx.x, wid = __builtin_amdgcn_readfirstlane(tid >> 6), lane = tid & 63, r16 = lane & 15, kq = lane >> 4;
    const int bh = wg >> 2, cgp = wg & 3, b = bh >> 2, h = bh & 3, nt = cgp * 2 + wid;
    unsigned char* ws = p.ws; const unsigned char* ubase = ws + WS_R4 + (size_t)(bh * 128) * GU_BYTES; const float* gtot = (const float*)(ws + WS_GTOT) + bh * 128;
    bf16_t* oraw = (bf16_t*)(ws + WS_ORAW);
#define GB_BAR() do { asm volatile("s_waitcnt lgkmcnt(0)" ::: "memory"); __builtin_amdgcn_s_barrier(); asm volatile("" ::: "memory"); } while (0)
    if (wid >= 2) {
        const int lt = tid - 128;
        int dsto[10]; size_t srco[10];
#pragma unroll
        for (int it = 0; it < 10; ++it) { const int q = lt + 384 * it;
            dsto[it] = (q < 2048) ? (q >> 4) * 272 + (q & 15) * 16 : (q < 3072) ? GB_KDT + ((q - 2048) >> 3) * 144 + ((q - 2048) & 7) * 16 : (q < 3584) ? GB_QK + ((q - 3072) >> 3) * 144 + ((q - 3072) & 7) * 16 : GB_BUF + (q - 3584) * 16;
            srco[it] = (q < 3584) ? (size_t)q * 16 : (size_t)(GU_U + cgp * 4096 + (q - 3584) * 16); }
        u32x4 sa[10], sb[10], sc[10]; float ga = 0.f, gb = 0.f, gc = 0.f;
#define GB_LD(st, g, n_) do { const unsigned char* rp_ = ubase + (size_t)(n_) * GU_BYTES; _Pragma("unroll") for (int it = 0; it < 10; ++it) st[it] = *(const u32x4*)(rp_ + srco[it]); if (lt == 0) g = gtot[n_]; } while (0)
#define GB_WR(st, g, bufi) do { unsigned char* bp_ = smem + (bufi) * GB_BUF2; _Pragma("unroll") for (int it = 0; it < 10; ++it) *(u32x4*)(bp_ + dsto[it]) = st[it]; if (lt == 0) *(float*)(bp_ + GB_BUF + 4096) = g; } while (0)
        GB_LD(sa, ga, 0); GB_WR(sa, ga, 0); GB_BAR();
        GB_LD(sa, ga, 1); GB_LD(sb, gb, 2); GB_LD(sc, gc, 3);
        for (int n0 = 0; n0 < NCH_; n0 += 3) {
            { const int n = n0;     if (n < NCH_) { if (n + 1 < NCH_) GB_WR(sa, ga, (n + 1) & 1); if (n + 4 < NCH_) GB_LD(sa, ga, n + 4); GB_BAR(); } }
            { const int n = n0 + 1; if (n < NCH_) { if (n + 1 < NCH_) GB_WR(sb, gb, (n + 1) & 1); if (n + 4 < NCH_) GB_LD(sb, gb, n + 4); GB_BAR(); } }
            { const int n = n0 + 2; if (n < NCH_) { if (n + 1 < NCH_) GB_WR(sc, gc, (n + 1) & 1); if (n + 4 < NCH_) GB_LD(sc, gc, n + 4); GB_BAR(); } }
        }
#undef GB_LD
#undef GB_WR
    } else {
        __builtin_amdgcn_s_setprio(3);
        f32x4 S[8]; bf16x8 Sb[4];
#pragma unroll
        for (int d = 0; d < 8; ++d) S[d] = (f32x4){0.f, 0.f, 0.f, 0.f};
#pragma unroll
        for (int k = 0; k < 4; ++k) Sb[k] = (bf16x8){0, 0, 0, 0, 0, 0, 0, 0};
        GB_BAR();
        for (int n = 0; n < NCH_; ++n) {
            const unsigned char* L = smem + (n & 1) * GB_BUF2; const float gt = *(const float*)(L + GB_BUF + 4096); const size_t t0 = (size_t)b * SEQ_ + (size_t)n * 64;
            u32x2 uw[4];
#pragma unroll
            for (int tt = 0; tt < 4; ++tt) uw[tt] = *(const u32x2*)(L + GB_BUF + ((wid * 4 + tt) * 64 + lane) * 8);
            f32x4 P[8];
#pragma unroll
            for (int m = 0; m < 8; ++m) P[m] = (f32x4){0.f, 0.f, 0.f, 0.f};
#pragma unroll
            for (int ks = 0; ks < 4; ++ks)
#pragma unroll
                for (int mt = 0; mt < 8; ++mt) { const bf16x8 a = *(const bf16x8*)(L + (16 * mt + r16) * 272 + (32 * ks + 8 * kq) * 2); P[mt] = MFMA16(a, Sb[ks], P[mt]); }
            f32x4 vn[4];
#pragma unroll
            for (int tt = 0; tt < 4; ++tt) { const f32x4 u = {__uint_as_float(uw[tt].x << 16), __uint_as_float(uw[tt].x & 0xffff0000u), __uint_as_float(uw[tt].y << 16), __uint_as_float(uw[tt].y & 0xffff0000u)}; vn[tt] = u - P[tt]; }
            bf16x8 Vb[2]; Vb[0] = pack8(vn[0], vn[1]); Vb[1] = pack8(vn[2], vn[3]);
#pragma unroll
            for (int tt = 0; tt < 4; ++tt) { f32x4 O = P[4 + tt];
#pragma unroll
                for (int ks = 0; ks < 2; ++ks) { const bf16x8 a = *(const bf16x8*)(L + GB_QK + (16 * tt + r16) * 144 + (32 * ks + 8 * kq) * 2); O = MFMA16(a, Vb[ks], O); }
                bf16_t* op = oraw + (t0 + 16 * tt + 4 * kq) * 512 + h * 128 + 16 * nt + r16;
#pragma unroll
                for (int j = 0; j < 4; ++j) op[(size_t)j * 512] = f2bf(O[j]); }
#pragma unroll
            for (int dt = 0; dt < 8; ++dt) { f32x4 acc = S[dt] * gt;
#pragma unroll
                for (int ks = 0; ks < 2; ++ks) { const bf16x8 a = *(const bf16x8*)(L + GB_KDT + (16 * dt + r16) * 144 + (32 * ks + 8 * kq) * 2); acc = MFMA16(a, Vb[ks], acc); }
                S[dt] = acc; }
#pragma unroll
            for (int ks = 0; ks < 4; ++ks) Sb[ks] = pack8(S[2 * ks], S[2 * ks + 1]);
            GB_BAR();
        }
        __builtin_amdgcn_s_setprio(0);
    }
#undef GB_BAR
}

__device__ __forceinline__ void gdn_norm(const Params& p) {
    unsigned char* ws = p.ws; const bf16_t* oraw = (const bf16_t*)(ws + WS_ORAW); const bf16_t* proj = (const bf16_t*)(ws + WS_PROJ); bf16_t* y = (bf16_t*)(ws + WS_Y);
    int tid_o = threadIdx.x; asm volatile("" : "+v"(tid_o));
    const int gtid = blockIdx.x * NTHREADS + tid_o, sub = gtid & 31; const f32x4 nwv = *(const f32x4*)(p.in[14] + sub * 4);
    const int stride = (gridDim.x * NTHREADS) >> 5;
    for (int item0 = gtid >> 5; item0 < T_ * 4; item0 += 4 * stride) {
        u32x2 ow[4], zw[4];
#pragma unroll
        for (int q = 0; q < 4; ++q) { const int item = item0 + q * stride; const int t = item >> 2, h = item & 3;
            if (item < T_ * 4) { ow[q] = *(const u32x2*)(oraw + (size_t)t * 512 + h * 128 + sub * 4); zw[q] = *(const u32x2*)(proj + (size_t)t * PJ_ + 2560 + h * 128 + sub * 4); } else { ow[q] = (u32x2){0u, 0u}; zw[q] = (u32x2){0u, 0u}; } }
#pragma unroll
        for (int q = 0; q < 4; ++q) { const int item = item0 + q * stride; const int t = item >> 2, h = item & 3;
            const f32x4 ov = {__uint_as_float(ow[q].x << 16), __uint_as_float(ow[q].x & 0xffff0000u), __uint_as_float(ow[q].y << 16), __uint_as_float(ow[q].y & 0xffff0000u)};
            float s = (ov[0] * ov[0] + ov[1] * ov[1]) + (ov[2] * ov[2] + ov[3] * ov[3]);
#pragma unroll
            for (int o = 1; o < 32; o <<= 1) s += __shfl_xor(s, o);
            const float rs = rsqrtf(s * (1.0f / 128.0f) + EPS_);
            const float z0 = __uint_as_float(zw[q].x << 16), z1 = __uint_as_float(zw[q].x & 0xffff0000u), z2 = __uint_as_float(zw[q].y << 16), z3 = __uint_as_float(zw[q].y & 0xffff0000u);
            u32x2 w; w.x = cvt_pk_bf16(ov[0] * rs * nwv[0] * siluf_(z0), ov[1] * rs * nwv[1] * siluf_(z1)); w.y = cvt_pk_bf16(ov[2] * rs * nwv[2] * siluf_(z2), ov[3] * rs * nwv[3] * siluf_(z3));
            if (item < T_ * 4) *(u32x2*)(y + (size_t)t * D_ + 512 + h * 128 + sub * 4) = w; }
    }
}

__device__ __forceinline__ void phase_final(const Params& p) {
    const int tid = threadIdx.x, wid = __builtin_amdgcn_readfirstlane(tid >> 6), lane = tid & 63;
    const float* ss = (const float*)(p.ws + WS_SSA); const float* nw = p.in[24]; float* out = p.out; const bf16_t* x3b = (const bf16_t*)(p.ws + WS_XB);
    f32x4 nwv[4];
#pragma unroll
    for (int i = 0; i < 4; ++i) nwv[i] = *(const f32x4*)(nw + 4 * (lane + 64 * i));
    u32x2 wn[4]; int row = blockIdx.x * 8 + wid;
    if (row < T_) {
#pragma unroll
        for (int i = 0; i < 4; ++i) wn[i] = *(const u32x2*)(x3b + (size_t)row * D_ + 4 * (lane + 64 * i)); }
    for (; row < T_; row += gridDim.x * 8) {
        const float rs = rstd16(ss, row);
        u32x2 wc[4];
#pragma unroll
        for (int i = 0; i < 4; ++i) wc[i] = wn[i];
        { const int nrow = row + gridDim.x * 8;
          if (nrow < T_) {
#pragma unroll
            for (int i = 0; i < 4; ++i) wn[i] = *(const u32x2*)(x3b + (size_t)nrow * D_ + 4 * (lane + 64 * i)); } }
#pragma unroll
        for (int i = 0; i < 4; ++i) { const u32x2 w = wc[i]; const f32x4 v = {__uint_as_float(w.x << 16), __uint_as_float(w.x & 0xffff0000u), __uint_as_float(w.y << 16), __uint_as_float(w.y & 0xffff0000u)};
            __builtin_nontemporal_store(v * rs * nwv[i], (f32x4*)(out + (size_t)row * D_ + 4 * (lane + 64 * i))); }
    }
}

constexpr int NPHASES = 11;
__global__ void __launch_bounds__(NTHREADS, 2) mega_fwd(Params p) {
    extern __shared__ __attribute__((aligned(16))) unsigned char smem[];
    PG8_LAS unsigned char* lds = (PG8_LAS unsigned char*)smem;
    cg::grid_group grid = cg::this_grid();
    unsigned char* ws = p.ws;
    bf16_t* hb = (bf16_t*)(ws + WS_XB); bf16_t* xb = (bf16_t*)(ws + WS_XB2); bf16_t* proj = (bf16_t*)(ws + WS_PROJ); bf16_t* ff = proj; bf16_t* y = (bf16_t*)(ws + WS_Y); bf16_t* pp = (bf16_t*)p.out;
    float* ssA = (float*)(ws + WS_SSA); float* ssB = (float*)(ws + WS_SSB);
#ifdef ONLY_PHASE
#define PH_ON(n) ((n) == ONLY_PHASE)
#else
#define PH_ON(n) ((n) >= p.ph_lo && (n) < p.ph_hi)
#endif
    volatile LAS unsigned* xst = (volatile LAS unsigned*)(lds + LDS_BYTES - 16);
    if (threadIdx.x == 0) { xst[0] = 0u; xst[1] = 0u; xst[2] = 0u; xst[3] = 0u; }
    __syncthreads();
    const XcdBarrier xbar = xcd_barrier_post((unsigned*)(ws + WS_BAR), xst);
    if (p.ph_lo == 0x7fffffff) grid.sync();
#define PH_SYNC(n) do { if ((n) > p.ph_lo && (n) < p.ph_hi) { xcd_barrier(xbar); } } while (0)
    if (PH_ON(0)) phase_prep(p, smem);
    PH_SYNC(1);
    if (PH_ON(1)) { EpiBf16Plain E; E.O = proj; E.ldc = PJ_; run_gemm(lds, hb, (const bf16_t*)(ws + WS_WIN), T_, PJ_, D_, E); }
    PH_SYNC(2);
    if (PH_ON(2)) { rg_pass_mfma<false>(p, smem, (int)blockIdx.x, (int)gridDim.x); __syncthreads(); gdn_pass_a(p, smem); }
    PH_SYNC(3);
    if (PH_ON(3)) {
        unsigned* flag = (unsigned*)ws + 16;
        if (blockIdx.x < 64) { const int xq = blockIdx.x & 7, kq8 = blockIdx.x >> 3;
            gdn_pass_b(p, smem, ((xq + 8 * (kq8 >> 2)) << 2) | (kq8 & 3)); }
        else {
            if (blockIdx.x < 68) { rg_carry(p, (blockIdx.x - 64) * NTHREADS + threadIdx.x); __threadfence(); __syncthreads();
                if (threadIdx.x == 0) __hip_atomic_fetch_add(flag, 1u, __ATOMIC_RELEASE, __HIP_MEMORY_SCOPE_AGENT); }
            prep_weights_late(p, smem, (int)blockIdx.x - 64, (int)gridDim.x - 64);
            if (threadIdx.x == 0) { while (__hip_atomic_load(flag, __ATOMIC_ACQUIRE, __HIP_MEMORY_SCOPE_AGENT) < 4u) __builtin_amdgcn_s_sleep(8); }
            __syncthreads(); __threadfence();
            rg_pass_mfma<true>(p, smem, (int)blockIdx.x - 64, (int)gridDim.x - 64);
            __syncthreads();
            { EpiBf16Plain E2; E2.O = pp; E2.ldc = D_; pg8::Gemm g2; g2.A = (const bf16_t*)(ws + WS_PB); g2.Bt = (const bf16_t*)(ws + WS_WPP); g2.M = T_; g2.N = D_; g2.K = PLE_;
              pg8::StaticOrder S2; S2.init(T_, D_, (int)gridDim.x - 64, (int)blockIdx.x - 64); pg8::gemm_phase<EpiBf16Plain, pg8::StaticOrder, GEMM_ALIGN, GEMM_SP2>(lds, g2, S2, E2); }
        }
    }
    PH_SYNC(4);
    if (PH_ON(4)) gdn_norm(p);
    PH_SYNC(5);
    if (PH_ON(5)) { EpiResid<false> E; E.res = p.in[0]; E.xb = xb; E.ss = ssA; run_gemm(lds, y, (const bf16_t*)(ws + WS_WOUT), T_, D_, D_, E); }
    PH_SYNC(6);
    if (PH_ON(6)) { EpiGateUp E; E.ff = ff; E.ss = ssA; run_gemm(lds, xb, (const bf16_t*)(ws + WS_WGU), T_, 2 * FF_, D_, E); }
    PH_SYNC(7);
    if (PH_ON(7)) { EpiResid<true> E; E.res = nullptr; E.xb = xb; E.ss = ssB; run_gemm(lds, ff, (const bf16_t*)(ws + WS_WD), T_, D_, FF_, E); }
    PH_SYNC(8);
    if (PH_ON(8)) { EpiPle E; E.x2b = xb; E.x3b = hb; E.pp = pp; E.bias = p.in[22]; E.ss_in = ssB; E.ss_out = ssA; run_gemm(lds, xb, (const bf16_t*)(ws + WS_WPG), T_, D_, D_, E); }
    PH_SYNC(9);
    if (PH_ON(9)) phase_final(p);
}

extern "C" void kernel_launch(void* const* d_in, const int* in_sizes, int n_in, void* d_out, int out_size, void* d_ws, size_t ws_size, hipStream_t stream) {
    static int grid = 0;
    if (grid == 0) {
        if (n_in != 25 || out_size != T_ * D_ || ws_size < WS_END) { fprintf(stderr, "kernel_launch: unexpected shapes: n_in %d out %d ws %zu (need %zu)\n", n_in, out_size, ws_size, (size_t)WS_END); grid = -1; return; }
        int dev = 0, cus = 0, per_cu = 0;
        hipGetDevice(&dev); hipDeviceGetAttribute(&cus, hipDeviceAttributeMultiprocessorCount, dev);
        if (hipFuncSetAttribute((const void*)mega_fwd, hipFuncAttributeMaxDynamicSharedMemorySize, LDS_BYTES) != hipSuccess) { fprintf(stderr, "kernel_launch: hipFuncSetAttribute failed\n"); grid = -1; return; }
        if (hipOccupancyMaxActiveBlocksPerMultiprocessor(&per_cu, (const void*)mega_fwd, NTHREADS, LDS_BYTES) != hipSuccess || per_cu < 1) { fprintf(stderr, "kernel_launch: occupancy query says %d\n", per_cu); per_cu = 1; }
        (void)hipGetLastError();
        grid = cus * 1;
        if (grid <= 0) grid = 256;
    }
    if (grid < 0) return;
    Params p{};
    for (int i = 0; i < 25; ++i) p.in[i] = (const float*)d_in[i];
    p.out = (float*)d_out; p.ws = (unsigned char*)d_ws; p.ph_lo = 0; p.ph_hi = NPHASES;
    if (hipMemsetAsync((char*)d_ws + WS_BAR, 0, XCD_BAR_WORDS * 4, stream) != hipSuccess) { fprintf(stderr, "kernel_launch: memset of the barrier words failed\n"); return; }
    void* args[] = {&p};
    hipError_t e = hipLaunchCooperativeKernel((const void*)mega_fwd, dim3(grid), dim3(NTHREADS), args, LDS_BYTES, stream);
    if (e != hipSuccess) fprintf(stderr, "cooperative launch failed: %s (grid %d)\n", hipGetErrorString(e), grid);
}
```

```cpp
#include <hip/hip_runtime.h>
#include <hip/hip_cooperative_groups.h>
#include <cstdio>
#include <cstdint>
namespace cg = cooperative_groups;
namespace pg8 {
#define PG8_LAS __attribute__((address_space(3)))
typedef unsigned short bf16_t;
typedef short bf16x8 __attribute__((ext_vector_type(8)));
typedef float f32x4 __attribute__((ext_vector_type(4)));
typedef unsigned u32x4 __attribute__((ext_vector_type(4)));
constexpr int BM = 256, BK = 64, HALF = 128, HTB = HALF * BK * 2  , STAGE_BYTES = 8 * HTB, NXCD = 8, WGM = 8;

__host__ __device__ __forceinline__ int lds_byte(int r, int c) { const int st = (r >> 4) * 2 + (c >> 5), rr = r & 15, cc = c & 31, ob = rr * 64 + cc * 2; return st * 1024 + (ob ^ (((ob >> 9) & 1) << 5)); }
__host__ __device__ __forceinline__ void stage_rc(int b, int& R, int& C) { const int st = b / 1024, sb = b % 1024, swz = sb ^ (((sb >> 9) & 1) << 5); R = (st >> 1) * 16 + swz / 64; C = (st & 1) * 32 + (swz % 64) / 2; }
__host__ __device__ __forceinline__ int perm32(int rho) { const int n = rho >> 4, i = rho & 15; return 8 * (i >> 2) + 4 * n + (i & 3); }

struct Unit { int pm, pn; };
struct Gemm { const bf16_t* A; const bf16_t* Bt; int M, N, K; };

struct StaticOrder {
    int nM, nN, nwg, G, c;
    __host__ __device__ void init(int M, int N, int G_, int c_) { nM = M / BM; nN = N / BM; nwg = nM * nN; G = G_; c = c_; }
    __host__ __device__ bool next(int i, Unit& u) const {
        const long L = (long)i * G + c; if (L >= nwg) return false;
        int wgid = (int)L; { const int q = nwg / NXCD, r = nwg % NXCD, xcd = wgid % NXCD, off = wgid / NXCD; wgid = (xcd < r ? xcd * (q + 1) : r * (q + 1) + (xcd - r) * q) + off; }
        const int nig = WGM * nN, gid = wgid / nig, fm = gid * WGM, gsz = (nM - fm) < WGM ? (nM - fm) : WGM;
        u.pm = fm + ((wgid % nig) % gsz); u.pn = (wgid % nig) / gsz; return true;
    }
    __device__ __forceinline__ void a_ready(const Unit&) const {}
    __device__ __forceinline__ void done(const Unit&) const {}
};
typedef __bf16 bf16v2_ __attribute__((ext_vector_type(2)));
typedef float f32v2_ __attribute__((ext_vector_type(2)));
__device__ __forceinline__ unsigned cvt_pk_bf16(float lo, float hi) { f32v2_ v = {lo, hi}; bf16v2_ b = __builtin_convertvector(v, bf16v2_); return __builtin_bit_cast(unsigned, b); }
typedef float f32x2 __attribute__((ext_vector_type(2)));
template <class Epi, class Sched, bool ALIGN_EPI = false, bool SP2 = false>
__device__ __forceinline__ void gemm_phase(PG8_LAS unsigned char* lds, const Gemm g, const Sched& S, const Epi& E) {
    int tid = threadIdx.x; asm volatile("" : "+v"(tid));
    const int wid = __builtin_amdgcn_readfirstlane(tid >> 6), lane = tid & 63, wr = wid >> 2, wc = wid & 3, fr = lane & 15, fq = lane >> 4;
    const int K = g.K, nt = K / BK;
    unsigned voffA[2], voffB[2];
#pragma unroll
    for (int i = 0; i < 2; ++i) { int R, C; stage_rc(tid * 16 + i * 8192, R, C); const int Rb = Epi::PERM ? ((R & ~31) + perm32(R & 31)) : R;
        voffA[i] = (unsigned)(R * K + C) * 2u; voffB[i] = (unsigned)(Rb * K + C) * 2u; }
    const size_t kstep = (size_t)(BK * 2);
    const size_t hstep = (size_t)HALF * K * 2;
    const size_t tstep = 2 * hstep;
    const unsigned ldsw = (unsigned)wid * 1024u;
    const int aoff = lds_byte(wr * 64 + fr, fq * 8), boff = lds_byte(wc * 32 + fr, fq * 8);
#define PG8_SA(b, h) (((b) * 2 + (h)) * HTB)
#define PG8_SB(b, h) ((4 + (b) * 2 + (h)) * HTB)
#define PG8_STAGE(bufoff, gbase, voff) do { _Pragma("unroll") for (int _i = 0; _i < 2; ++_i) \
        __builtin_amdgcn_global_load_lds((const unsigned*)((const char*)(gbase) + (voff)[_i]), (PG8_LAS unsigned*)(lds + (bufoff) + ldsw + _i * 8192), 16, 0, 0); } while (0)
#define PG8_LDA(dst, b, h) do { _Pragma("unroll") for (int m = 0; m < 4; ++m) _Pragma("unroll") for (int k = 0; k < 2; ++k) dst[m][k] = *(const PG8_LAS bf16x8*)(lds + PG8_SA(b, h) + aoff + m * 2048 + k * 1024); } while (0)
#define PG8_LDB(dst, b, h) do { _Pragma("unroll") for (int n = 0; n < 2; ++n) _Pragma("unroll") for (int k = 0; k < 2; ++k) dst[n][k] = *(const PG8_LAS bf16x8*)(lds + PG8_SB(b, h) + boff + n * 2048 + k * 1024); } while (0)
#define PG8_MMA(ai, bj, At, Bt) do { __builtin_amdgcn_s_setprio(1); _Pragma("unroll") for (int m = 0; m < 4; ++m) _Pragma("unroll") for (int n = 0; n < 2; ++n) _Pragma("unroll") for (int k = 0; k < 2; ++k) \
        acc[ai][bj][m][n] = __builtin_amdgcn_mfma_f32_16x16x32_bf16(Bt[n][k], At[m][k], acc[ai][bj][m][n], 0, 0, 0); __builtin_amdgcn_s_setprio(0); } while (0)
#define PG8_WAIT_V(n) asm volatile("s_waitcnt vmcnt(" #n ")" ::: "memory")
#define PG8_WAIT_L(n) asm volatile("s_waitcnt lgkmcnt(" #n ")" ::: "memory")
#define PG8_BAR __builtin_amdgcn_s_barrier()
#define PG8_SCHED __builtin_amdgcn_sched_barrier(0)
    Unit cur, nxt; int ui = 0;
    if (!S.next(0, cur)) return;
    f32x4 acc[2][2][4][2];
#pragma unroll
    for (int a = 0; a < 2; ++a)
#pragma unroll
        for (int b = 0; b < 2; ++b)
#pragma unroll
            for (int m = 0; m < 4; ++m)
#pragma unroll
                for (int n = 0; n < 2; ++n) acc[a][b][m][n] = (f32x4){0.f, 0.f, 0.f, 0.f};
    bf16x8 At[4][2], B0[2][2], B1[2][2];
    const char* cA = (const char*)g.A + (size_t)cur.pm * tstep; const char* cB = (const char*)g.Bt + (size_t)cur.pn * tstep;
    S.a_ready(cur);
    if constexpr (SP2) {
        PG8_STAGE(PG8_SB(0, 0), cB, voffB); PG8_STAGE(PG8_SB(0, 1), cB + hstep, voffB); PG8_STAGE(PG8_SA(0, 0), cA, voffA); PG8_STAGE(PG8_SA(0, 1), cA + hstep, voffA);
        if (wr == 1) PG8_BAR;
        PG8_WAIT_V(2); PG8_BAR;
        PG8_STAGE(PG8_SB(1, 0), cB + kstep, voffB); PG8_STAGE(PG8_SA(1, 0), cA + kstep, voffA); PG8_STAGE(PG8_SB(1, 1), cB + hstep + kstep, voffB);
        PG8_WAIT_V(6); PG8_BAR;
    } else {
        PG8_STAGE(PG8_SB(0, 0), cB, voffB); PG8_STAGE(PG8_SA(0, 0), cA, voffA); PG8_STAGE(PG8_SB(0, 1), cB + hstep, voffB); PG8_STAGE(PG8_SA(0, 1), cA + hstep, voffA);
        if (wr == 1) PG8_BAR;
        PG8_WAIT_V(4); PG8_BAR;
        PG8_STAGE(PG8_SB(1, 0), cB + kstep, voffB); PG8_STAGE(PG8_SA(1, 0), cA + kstep, voffA); PG8_STAGE(PG8_SB(1, 1), cB + hstep + kstep, voffB);
        PG8_WAIT_V(6); PG8_BAR;
    }
    for (;;) {
        const bool has_next = S.next(ui + 1, nxt);
        const char* nA = has_next ? (const char*)g.A + (size_t)nxt.pm * tstep : cA; const char* nB = has_next ? (const char*)g.Bt + (size_t)nxt.pn * tstep : cB;
        for (int t = 0; t < nt; t += 2) {
            const bool last = (t == nt - 2);
            const char* a1 = cA + (size_t)(t + 1) * kstep;
            const char* a2 = last ? nA : cA + (size_t)(t + 2) * kstep; const char* b2 = last ? nB : cB + (size_t)(t + 2) * kstep;
            const char* a3 = a2 + kstep; const char* b3 = b2 + kstep;
            if (last && has_next) S.a_ready(nxt);
            if constexpr (SP2) {
            PG8_LDB(B0, 0, 0); PG8_LDB(B1, 0, 1); PG8_SCHED; PG8_LDA(At, 0, 0); PG8_STAGE(PG8_SA(1, 1), a1 + hstep, voffA);
            PG8_WAIT_V(8); PG8_WAIT_L(0); PG8_BAR; PG8_MMA(0, 0, At, B0); PG8_MMA(0, 1, At, B1); PG8_BAR; PG8_SCHED;
            PG8_LDA(At, 0, 1); PG8_STAGE(PG8_SB(0, 0), b2, voffB); PG8_STAGE(PG8_SB(0, 1), b2 + hstep, voffB); PG8_STAGE(PG8_SA(0, 0), a2, voffA);
            PG8_WAIT_V(8); PG8_WAIT_L(0); PG8_BAR; PG8_MMA(1, 0, At, B0); PG8_MMA(1, 1, At, B1); PG8_BAR; PG8_SCHED;
            PG8_LDB(B0, 1, 0); PG8_LDB(B1, 1, 1); PG8_SCHED; PG8_LDA(At, 1, 0); PG8_STAGE(PG8_SA(0, 1), a2 + hstep, voffA);
            PG8_WAIT_V(8); PG8_WAIT_L(0); PG8_BAR; PG8_MMA(0, 0, At, B0); PG8_MMA(0, 1, At, B1); PG8_BAR; PG8_SCHED;
            PG8_LDA(At, 1, 1); PG8_STAGE(PG8_SB(1, 0), b3, voffB); PG8_STAGE(PG8_SB(1, 1), b3 + hstep, voffB); PG8_STAGE(PG8_SA(1, 0), a3, voffA);
            PG8_WAIT_V(8); PG8_WAIT_L(0); PG8_BAR; PG8_MMA(1, 0, At, B0); PG8_MMA(1, 1, At, B1); PG8_BAR; PG8_SCHED;
            } else {
            PG8_LDB(B0, 0, 0); PG8_SCHED; PG8_LDA(At, 0, 0); PG8_STAGE(PG8_SA(1, 1), a1 + hstep, voffA);
            PG8_WAIT_L(8); PG8_BAR; PG8_WAIT_L(0); PG8_MMA(0, 0, At, B0); PG8_BAR; PG8_SCHED;
            PG8_LDB(B1, 0, 1); PG8_STAGE(PG8_SB(0, 0), b2, voffB);
            PG8_BAR; PG8_WAIT_L(0); PG8_MMA(0, 1, At, B1); PG8_BAR;
            PG8_LDA(At, 0, 1); PG8_STAGE(PG8_SA(0, 0), a2, voffA);
            PG8_BAR; PG8_WAIT_L(0); PG8_MMA(1, 0, At, B0); PG8_BAR; PG8_SCHED;
            PG8_STAGE(PG8_SB(0, 1), b2 + hstep, voffB);
            PG8_WAIT_V(6); PG8_BAR; PG8_MMA(1, 1, At, B1); PG8_BAR;
            PG8_LDB(B0, 1, 0); PG8_SCHED; PG8_LDA(At, 1, 0); PG8_STAGE(PG8_SA(0, 1), a2 + hstep, voffA);
            PG8_WAIT_L(8); PG8_BAR; PG8_WAIT_L(0); PG8_MMA(0, 0, At, B0); PG8_BAR; PG8_SCHED;
            PG8_LDB(B1, 1, 1); PG8_STAGE(PG8_SB(1, 0), b3, voffB);
            PG8_BAR; PG8_WAIT_L(0); PG8_MMA(0, 1, At, B1); PG8_BAR;
            PG8_LDA(At, 1, 1); PG8_STAGE(PG8_SA(1, 0), a3, voffA);
            PG8_BAR; PG8_WAIT_L(0); PG8_MMA(1, 0, At, B0); PG8_BAR; PG8_SCHED;
            PG8_STAGE(PG8_SB(1, 1), b3 + hstep, voffB);
            PG8_WAIT_V(6); PG8_BAR; PG8_MMA(1, 1, At, B1); PG8_BAR;
            }
        }
        if constexpr (ALIGN_EPI) { if (wr == 0) PG8_BAR; }
        if constexpr (!Epi::AFTER_DRAIN) { E(acc, cur, wr, wc, fr, fq); S.done(cur); }
        if (!has_next) break;
#pragma unroll
        for (int a = 0; a < 2; ++a)
#pragma unroll
            for (int b = 0; b < 2; ++b)
#pragma unroll
                for (int m = 0; m < 4; ++m)
#pragma unroll
                    for (int n = 0; n < 2; ++n) acc[a][b][m][n] = (f32x4){0.f, 0.f, 0.f, 0.f};
        cur = nxt; cA = nA; cB = nB; ++ui;
        if constexpr (ALIGN_EPI) { if (wr == 1) PG8_BAR; }
    }
    PG8_WAIT_V(0);
    if constexpr (!ALIGN_EPI) { if (wr == 0) PG8_BAR; }
    PG8_BAR;
    if constexpr (Epi::AFTER_DRAIN) { E.fused(acc, cur, wr, wc, fr, fq, lds, wid, lane); S.done(cur); }
#undef PG8_SA
#undef PG8_SB
#undef PG8_STAGE
#undef PG8_LDA
#undef PG8_LDB
#undef PG8_MMA
#undef PG8_WAIT_V
#undef PG8_WAIT_L
#undef PG8_BAR
#undef PG8_SCHED
}
}
#define XB_TMO      128
#define XB_XCNT(j)  (256  + 64 * (j))
#define XB_XSUB(j)  (1280 + 64 * (j))
#define XB_XGEN(j)  (2304 + 64 * (j))
#define XB_TOP      3328
#define XB_TOPGEN   3392
#define XCD_BAR_WORDS 3456
#define XB_SPIN_CAP (1u << 18)
#define LAS __attribute__((address_space(3)))

__device__ __forceinline__ unsigned xb_ld(unsigned* p)              { return __hip_atomic_load(p, __ATOMIC_RELAXED, __HIP_MEMORY_SCOPE_AGENT); }
__device__ __forceinline__ unsigned xb_add(unsigned* p, unsigned v) { return __hip_atomic_fetch_add(p, v, __ATOMIC_RELAXED, __HIP_MEMORY_SCOPE_AGENT); }
__device__ __forceinline__ unsigned xb_xcc_id() { return (unsigned)__builtin_amdgcn_s_getreg((3 << 11) | 20) & 0xFu; }
#define XB_SPIN(cond, bar) do { unsigned _sp = 0; while (cond) { __builtin_amdgcn_s_sleep(1); \
    if ((++_sp & 255u) == 0u) { if (xb_ld(&(bar)[XB_TMO])) break; if (_sp > XB_SPIN_CAP) { atomicAdd(&(bar)[XB_TMO], 1u); break; } } } } while (0)

struct XcdBarrier {
    unsigned* bar; unsigned x;
    volatile LAS unsigned* st;
};

__device__ __forceinline__ XcdBarrier xcd_barrier_post(unsigned* bar, volatile LAS unsigned* st) {
    XcdBarrier b; b.bar = bar; b.x = xb_xcc_id(); b.st = st;
    if (threadIdx.x == 0) (void)xb_add(&bar[XB_XCNT(b.x)], 1u);
    return b;
}
__device__ __forceinline__ void xcd_barrier_complete(unsigned* bar, unsigned x, unsigned& nloc, unsigned& nx) {
    const unsigned G = gridDim.x * gridDim.y * gridDim.z;
    unsigned sum, cnt, mine, sp = 0u;
    for (;;) {
        sum = 0u; cnt = 0u; mine = 0u;
#pragma unroll
        for (unsigned j = 0; j < 16; ++j) { const unsigned c = xb_ld(&bar[XB_XCNT(j)]); sum += c; cnt += (c > 0u) ? 1u : 0u; mine = (j == x) ? c : mine; }
        if (sum == G) break;
        __builtin_amdgcn_s_sleep(1);
        if ((++sp & 255u) == 0u) { if (xb_ld(&bar[XB_TMO])) break; if (sp > XB_SPIN_CAP) { atomicAdd(&bar[XB_TMO], 1u); break; } }
    }
    nloc = mine > 0u ? mine : 1u; nx = cnt > 0u ? cnt : 1u;
}

__device__ __forceinline__ void xcd_barrier(const XcdBarrier& b) {
    asm volatile("s_waitcnt vmcnt(0)" ::: "memory");
    __syncthreads();
    if (threadIdx.x == 0) {
        unsigned* bar = b.bar;
        __builtin_amdgcn_s_waitcnt(0);
        unsigned nloc = b.st[0], nx = b.st[1];
        if (nloc == 0u) { xcd_barrier_complete(bar, b.x, nloc, nx); b.st[0] = nloc; b.st[1] = nx; }
        const unsigned old = xb_add(&bar[XB_XSUB(b.x)], 1u);
        const unsigned gen = old / nloc;
        if (old + 1u == (gen + 1u) * nloc) {
            __builtin_amdgcn_fence(__ATOMIC_RELEASE, "agent");
            asm volatile("s_waitcnt vmcnt(0)" ::: "memory");
            const unsigned og = xb_add(&bar[XB_TOP], 1u);
            const unsigned tg = og / nx;
            if (og + 1u == (tg + 1u) * nx) xb_add(&bar[XB_TOPGEN], 1u);
            else XB_SPIN(xb_ld(&bar[XB_TOPGEN]) == tg, bar);
            __builtin_amdgcn_fence(__ATOMIC_ACQUIRE, "agent");
            xb_add(&bar[XB_XGEN(b.x)], 1u);
            asm volatile("s_waitcnt vmcnt(0)" ::: "memory");
        } else {
            XB_SPIN(xb_ld(&bar[XB_XGEN(b.x)]) == gen, bar);
            __builtin_amdgcn_fence(__ATOMIC_ACQUIRE, "agent");
            asm volatile("s_waitcnt vmcnt(0)" ::: "memory");
        }
    }
    __syncthreads();
}

constexpr bool GEMM_SP2 = true, GEMM_ALIGN = true;
using pg8::bf16_t; using pg8::f32x4; using pg8::u32x4; using pg8::bf16x8; using pg8::cvt_pk_bf16; using pg8::Unit; using pg8::HALF; using pg8::BM;
typedef unsigned u32x2 __attribute__((ext_vector_type(2)));
constexpr int T_ = 32768, D_ = 1024, SEQ_ = 8192, NB_ = 4, INC_ = 3080, PJ_ = 3072, FF_ = 2816, PLE_ = 256, NCH_ = 128;
constexpr float EPS_ = 1e-6f;
constexpr int NTHREADS = 512;
constexpr int LDS_BYTES = 144 * 1024;

constexpr size_t WS_WIN = 4096;
constexpr size_t WS_WOUT = WS_WIN + (size_t)PJ_ * D_ * 2;
constexpr size_t WS_WGU = WS_WOUT + (size_t)D_ * D_ * 2;
constexpr size_t WS_WD = WS_WGU + (size_t)2 * FF_ * D_ * 2;
constexpr size_t WS_WPG = WS_WD + (size_t)D_ * FF_ * 2;
constexpr size_t WS_WPP = WS_WPG + (size_t)D_ * D_ * 2;
constexpr size_t WS_LOGITS = WS_WPP + (size_t)D_ * PLE_ * 2;
constexpr size_t WS_PB = WS_LOGITS + (size_t)T_ * 8 * 4;
constexpr size_t WS_SSA = WS_PB + (size_t)T_ * PLE_ * 2;
constexpr size_t WS_SSB = WS_SSA + (size_t)T_ * 16 * 4;
constexpr size_t WS_PTOT = WS_SSB + (size_t)T_ * 16 * 4;
constexpr size_t WS_HEND = WS_PTOT + (size_t)NB_ * NCH_ * 512 * 4;
constexpr size_t WS_CARRY = WS_HEND + (size_t)NB_ * NCH_ * 512 * 4;
constexpr size_t WS_GTOT = WS_CARRY + (size_t)NB_ * NCH_ * 512 * 4;
constexpr size_t WS_XB = WS_GTOT + 8192;
constexpr size_t WS_PROJ = WS_XB + (size_t)T_ * D_ * 2;
constexpr size_t WS_R4 = WS_PROJ + (size_t)T_ * PJ_ * 2;
constexpr size_t WS_Y = WS_XB;
constexpr size_t WS_XB2 = WS_R4;
constexpr size_t WS_PP = WS_R4 + (size_t)T_ * D_ * 2;
constexpr size_t WS_ORAW = WS_R4 + (size_t)2048 * 73728;
constexpr size_t WS_BAR = WS_R4 + (size_t)2048 * 73728 + (size_t)T_ * 512 * 2;
constexpr size_t WS_RGW = WS_BAR + 16384;
constexpr size_t WS_END = WS_RGW + 131072;

struct Params {
    const float* in[25];
    float* out; unsigned char* ws;
    int ph_lo, ph_hi;
};

__device__ __forceinline__ float bf2f(bf16_t b) { return __uint_as_float(((unsigned)b) << 16); }
__device__ __forceinline__ bf16_t f2bf(float f) { return (bf16_t)(cvt_pk_bf16(f, 0.f) & 0xffffu); }
__device__ __forceinline__ float sigmoidf_(float x) { return __builtin_amdgcn_rcpf(1.0f + __expf(-x)); }
__device__ __forceinline__ float siluf_(float x) { return x * __builtin_amdgcn_rcpf(1.0f + __expf(-x)); }
__device__ __forceinline__ float softplusf_(float x) { return fmaxf(x, 0.f) + log1pf(__expf(-fabsf(x))); }
__device__ __forceinline__ float gelu_tanhf_(float x) { const float u = 0.7978845608028654f * (x + 0.044715f * x * x * x); return x * __builtin_amdgcn_rcpf(1.0f + __expf(-2.0f * u)); }
__device__ __forceinline__ float rstd16(const float* ss, int r) {
    const f32x4 a = *(const f32x4*)(ss + (size_t)r * 16), b = *(const f32x4*)(ss + (size_t)r * 16 + 4), c = *(const f32x4*)(ss + (size_t)r * 16 + 8), d = *(const f32x4*)(ss + (size_t)r * 16 + 12);
    const float s = ((a[0] + a[1]) + (a[2] + a[3])) + ((b[0] + b[1]) + (b[2] + b[3])) + ((c[0] + c[1]) + (c[2] + c[3])) + ((d[0] + d[1]) + (d[2] + d[3]));
    return rsqrtf(s * (1.0f / 1024.0f) + EPS_);
}

template <int CTRL> __device__ __forceinline__ float dpp_f(float x) { return __int_as_float(__builtin_amdgcn_update_dpp(0, __float_as_int(x), CTRL, 0xf, 0xf, false)); }
__device__ __forceinline__ float red8(float x) { x += dpp_f<0xB1>(x); x += dpp_f<0x4E>(x); x += dpp_f<0x141>(x); return x; }
struct EpiBf16Plain {
    static constexpr bool PERM = true, AFTER_DRAIN = false;
    bf16_t* O; int ldc;
    __device__ __forceinline__ void operator()(const f32x4 (&acc)[2][2][4][2], const Unit& u, int wr, int wc, int fr, int fq) const {
        int row0 = u.pm * BM + wr * 64 + fr; asm volatile("" : "+v"(row0)); const int col0 = u.pn * BM + wc * 32 + 8 * fq;
#pragma unroll
        for (int ai = 0; ai < 2; ++ai)
#pragma unroll
            for (int m = 0; m < 4; ++m) { bf16_t* rowp = O + (size_t)(row0 + ai * HALF + m * 16) * ldc + col0;
#pragma unroll
                for (int bj = 0; bj < 2; ++bj) { const f32x4 v0 = acc[ai][bj][m][0], v1 = acc[ai][bj][m][1]; u32x4 w; w.x = cvt_pk_bf16(v0[0], v0[1]); w.y = cvt_pk_bf16(v0[2], v0[3]); w.z = cvt_pk_bf16(v1[0], v1[1]); w.w = cvt_pk_bf16(v1[2], v1[3]);
                    *(u32x4*)(rowp + bj * HALF) = w; } }
    }
};
__device__ __forceinline__ void rstd8(const float* ss, int row0, int fq, float (&rs)[8]) {
    f32x4 t[8];
#pragma unroll
    for (int g = 0; g < 8; ++g) t[g] = *(const f32x4*)(ss + (size_t)(row0 + (g >> 2) * HALF + (g & 3) * 16) * 16 + 4 * fq);
#pragma unroll
    for (int g = 0; g < 8; ++g) { float sm = (t[g][0] + t[g][1]) + (t[g][2] + t[g][3]); sm += __shfl_xor(sm, 16); sm += __shfl_xor(sm, 32); rs[g] = rsqrtf(sm * (1.0f / 1024.0f) + EPS_); }
    asm volatile("" ::: "memory");
}
template <bool RES_BF16>
struct EpiResid {
    static constexpr bool PERM = true, AFTER_DRAIN = false;
    const float* res; bf16_t* xb; float* ss;
    __device__ __forceinline__ void operator()(const f32x4 (&acc)[2][2][4][2], const Unit& u, int wr, int wc, int fr, int fq) const {
        int row0 = u.pm * BM + wr * 64 + fr; asm volatile("" : "+v"(row0)); const int col0 = u.pn * BM + wc * 32 + 8 * fq;
        const unsigned e0 = (unsigned)row0 * D_ + col0;
#pragma unroll
        for (int ai = 0; ai < 2; ++ai) {
            constexpr int NB = 4;
#pragma unroll
            for (int mh = 0; mh < 4 / NB; ++mh) {
                f32x4 rv[NB][2][2];
#pragma unroll
                for (int mm = 0; mm < NB; ++mm)
#pragma unroll
                    for (int bj = 0; bj < 2; ++bj) { const unsigned e = e0 + (unsigned)((ai * HALF + (mh * NB + mm) * 16) * D_ + bj * HALF);
                        if (RES_BF16) { const u32x4 w = *(const u32x4*)((const char*)xb + (size_t)(e * 2u));
                            rv[mm][bj][0] = (f32x4){__uint_as_float(w.x << 16), __uint_as_float(w.x & 0xffff0000u), __uint_as_float(w.y << 16), __uint_as_float(w.y & 0xffff0000u)};
                            rv[mm][bj][1] = (f32x4){__uint_as_float(w.z << 16), __uint_as_float(w.z & 0xffff0000u), __uint_as_float(w.w << 16), __uint_as_float(w.w & 0xffff0000u)}; }
                        else { rv[mm][bj][0] = *(const f32x4*)((const char*)res + (size_t)(e * 4u)); rv[mm][bj][1] = *(const f32x4*)((const char*)res + (size_t)(e * 4u) + 16); } }
#pragma unroll
                for (int mm = 0; mm < NB; ++mm) { const int m = mh * NB + mm, r = row0 + ai * HALF + m * 16; float s = 0.f;
#pragma unroll
                    for (int bj = 0; bj < 2; ++bj) { const unsigned e = e0 + (unsigned)((ai * HALF + m * 16) * D_ + bj * HALF);
                        const f32x4 v0 = rv[mm][bj][0] + acc[ai][bj][m][0], v1 = rv[mm][bj][1] + acc[ai][bj][m][1];
                        s += ((v0[0] * v0[0] + v0[1] * v0[1]) + (v0[2] * v0[2] + v0[3] * v0[3])) + ((v1[0] * v1[0] + v1[1] * v1[1]) + (v1[2] * v1[2] + v1[3] * v1[3]));
                        u32x4 w; w.x = cvt_pk_bf16(v0[0], v0[1]); w.y = cvt_pk_bf16(v0[2], v0[3]); w.z = cvt_pk_bf16(v1[0], v1[1]); w.w = cvt_pk_bf16(v1[2], v1[3]); *(u32x4*)((char*)xb + (size_t)(e * 2u)) = w; }
                    s += __shfl_xor(s, 16); s += __shfl_xor(s, 32);
                    if (fq == 0) ss[(size_t)r * 16 + u.pn * 4 + wc] = s; }
                asm volatile("" ::: "memory"); } }
    }
};
struct EpiGateUp {
    static constexpr bool PERM = true, AFTER_DRAIN = false;
    bf16_t* ff; const float* ss;
    __device__ __forceinline__ void operator()(const f32x4 (&acc)[2][2][4][2], const Unit& u, int wr, int wc, int fr, int fq) const {
        int row0 = u.pm * BM + wr * 64 + fr; asm volatile("" : "+v"(row0)); const int col0 = u.pn * HALF + wc * 32 + 8 * fq;
        float rsv[8]; rstd8(ss, row0, fq, rsv);
#pragma unroll
        for (int ai = 0; ai < 2; ++ai)
#pragma unroll
            for (int m = 0; m < 4; ++m) { const int r = row0 + ai * HALF + m * 16; const float rs = rsv[ai * 4 + m];
                float o[8];
#pragma unroll
                for (int n = 0; n < 2; ++n)
#pragma unroll
                    for (int j = 0; j < 4; ++j) { const float g = acc[ai][0][m][n][j] * rs, up = acc[ai][1][m][n][j] * rs; o[n * 4 + j] = siluf_(g) * up; }
                u32x4 w; w.x = cvt_pk_bf16(o[0], o[1]); w.y = cvt_pk_bf16(o[2], o[3]); w.z = cvt_pk_bf16(o[4], o[5]); w.w = cvt_pk_bf16(o[6], o[7]);
                *(u32x4*)(ff + (size_t)r * FF_ + col0) = w; }
    }
};
struct EpiPle {
    static constexpr bool PERM = true, AFTER_DRAIN = false;
    const bf16_t* x2b; bf16_t* x3b; const bf16_t* pp; const float* bias; const float* ss_in; float* ss_out;
    __device__ __forceinline__ void operator()(const f32x4 (&acc)[2][2][4][2], const Unit& u, int wr, int wc, int fr, int fq) const {
        int row0 = u.pm * BM + wr * 64 + fr; asm volatile("" : "+v"(row0)); const int col0 = u.pn * BM + wc * 32 + 8 * fq;
        const unsigned b0 = ((unsigned)row0 * D_ + col0) * 2u;
        const unsigned s0 = (unsigned)row0 * 64u;
        u32x4 X[2][2], P[2][2]; f32x4 S[2];
#define EP_LOAD(set, g) do { const unsigned ro_ = (unsigned)(((g) >> 2) * HALF + ((g) & 3) * 16); \
        _Pragma("unroll") for (int bj = 0; bj < 2; ++bj) { const unsigned bo_ = b0 + (ro_ * D_ + bj * HALF) * 2u; \
            X[set][bj] = *(const u32x4*)((const char*)x2b + (size_t)bo_); P[set][bj] = *(const u32x4*)((const char*)pp + (size_t)bo_); } \
        S[set] = *(const f32x4*)((const char*)ss_in + (size_t)(s0 + ro_ * 64u + (unsigned)fq * 16u)); } while (0)
        f32x4 bv[2][2];
#pragma unroll
        for (int bj = 0; bj < 2; ++bj)
#pragma unroll
            for (int n = 0; n < 2; ++n) bv[bj][n] = *(const f32x4*)(bias + col0 + bj * HALF + 4 * n);
        EP_LOAD(0, 0);
#pragma unroll
        for (int g = 0; g < 8; ++g) { const int ai = g >> 2, m = g & 3, st = g & 1, r = row0 + ai * HALF + m * 16;
            if (g < 7) EP_LOAD((g + 1) & 1, g + 1);
            float sm = (S[st][0] + S[st][1]) + (S[st][2] + S[st][3]); sm += __shfl_xor(sm, 16); sm += __shfl_xor(sm, 32);
            const float rs = rsqrtf(sm * (1.0f / 1024.0f) + EPS_); float s = 0.f;
#pragma unroll
            for (int bj = 0; bj < 2; ++bj) { const unsigned bo = b0 + (unsigned)(((ai * HALF + m * 16) * D_ + bj * HALF) * 2); const u32x4 pw = P[st][bj], xw = X[st][bj];
                const unsigned pwa[4] = {pw.x, pw.y, pw.z, pw.w}, xwa[4] = {xw.x, xw.y, xw.z, xw.w}; unsigned ow[4];
#pragma unroll
                for (int n = 0; n < 2; ++n) { const f32x4 a = acc[ai][bj][m][n]; const f32x4 bb = bv[bj][n];
#pragma unroll
                    for (int hh = 0; hh < 2; ++hh) { const unsigned xq = xwa[2 * n + hh], pq = pwa[2 * n + hh];
                        const float v0 = __uint_as_float(xq << 16) + sigmoidf_(a[2 * hh] * rs + bb[2 * hh]) * __uint_as_float(pq << 16);
                        const float v1 = __uint_as_float(xq & 0xffff0000u) + sigmoidf_(a[2 * hh + 1] * rs + bb[2 * hh + 1]) * __uint_as_float(pq & 0xffff0000u);
                        ow[2 * n + hh] = cvt_pk_bf16(v0, v1); s += v0 * v0 + v1 * v1; } }
                *(u32x4*)((char*)x3b + (size_t)bo) = (u32x4){ow[0], ow[1], ow[2], ow[3]}; }
            s += __shfl_xor(s, 16); s += __shfl_xor(s, 32);
            if (fq == 0) ss_out[(size_t)r * 16 + u.pn * 4 + wc] = s;
            asm volatile("" ::: "memory"); }
#undef EP_LOAD
    }
};

template <class Epi> __device__ __forceinline__ void run_gemm(PG8_LAS unsigned char* lds, const bf16_t* A, const bf16_t* Bt, int M, int N, int K, const Epi& E) {
    pg8::Gemm g; g.A = A; g.Bt = Bt; g.M = M; g.N = N; g.K = K;
    pg8::StaticOrder S; S.init(M, N, (int)gridDim.x, (int)blockIdx.x);
    pg8::gemm_phase<Epi, pg8::StaticOrder, GEMM_ALIGN, GEMM_SP2>(lds, g, S, E);
}

__device__ void prep_transpose(const float* __restrict__ W, int K, int ldw, int c0, int ncols, bf16_t* __restrict__ Wt, const float* __restrict__ ks, int mode, float* tile, int rot, int widx, int nw) {
    const int tid = threadIdx.x, nkt = K / 64, nct = ncols / 64, ntiles = nkt * nct;
    for (int tt = (widx + nw - (rot % nw)) % nw; tt < ntiles; tt += nw) {
        const int kt = tt / nct, ct = tt % nct, k0 = kt * 64, n0 = ct * 64;
        __syncthreads();
#pragma unroll
        for (int i = 0; i < 2; ++i) { const int r = (tid >> 4) + 32 * i, c4 = (tid & 15) * 4; const f32x4 v = *(const f32x4*)(W + (size_t)(k0 + r) * ldw + c0 + n0 + c4);
            const float s = ks ? ks[k0 + r] : 1.0f; tile[r * 65 + c4 + 0] = v[0] * s; tile[r * 65 + c4 + 1] = v[1] * s; tile[r * 65 + c4 + 2] = v[2] * s; tile[r * 65 + c4 + 3] = v[3] * s; }
        __syncthreads();
        const int n = tid >> 3, kseg = (tid & 7) * 8; float v[8];
#pragma unroll
        for (int e = 0; e < 8; ++e) v[e] = tile[(kseg + e) * 65 + n];
        u32x4 w; w.x = cvt_pk_bf16(v[0], v[1]); w.y = cvt_pk_bf16(v[2], v[3]); w.z = cvt_pk_bf16(v[4], v[5]); w.w = cvt_pk_bf16(v[6], v[7]);
        const int f = n0 + n; const int drow = (mode == 0) ? f : (256 * (f >> 7) + 128 * (mode - 1) + (f & 127));
        *(u32x4*)(Wt + (size_t)drow * K + k0 + kseg) = w;
    }
}


__device__ __forceinline__ void prep_weights_late(const Params& p, unsigned char* smem, int widx, int nw) {
    unsigned char* ws = p.ws; float* tile = (float*)smem;
    __syncthreads();
    prep_transpose(p.in[15], D_, D_, 0, D_, (bf16_t*)(ws + WS_WOUT), nullptr, 0, tile, 0, widx, nw);
    prep_transpose(p.in[17], D_, FF_, 0, FF_, (bf16_t*)(ws + WS_WGU), p.in[16], 1, tile, 256, widx, nw);
    prep_transpose(p.in[18], D_, FF_, 0, FF_, (bf16_t*)(ws + WS_WGU), p.in[16], 2, tile, 960, widx, nw);
    prep_transpose(p.in[19], FF_, D_, 0, D_, (bf16_t*)(ws + WS_WD), nullptr, 0, tile, 1664, widx, nw);
    prep_transpose(p.in[21], D_, D_, 0, D_, (bf16_t*)(ws + WS_WPG), p.in[20], 0, tile, 2368, widx, nw);
}

__device__ __forceinline__ void phase_prep(const Params& p, unsigned char* smem) {
    const int tid = threadIdx.x, wid = __builtin_amdgcn_readfirstlane(tid >> 6), lane = tid & 63;
    unsigned char* ws = p.ws;
    float* tile = (float*)smem;
    float* w8s = (float*)(smem + 20480);
    if (blockIdx.x == 0 && tid < 32) ((unsigned*)ws)[tid] = 0u;
    prep_transpose(p.in[3], D_, INC_, 0, PJ_, (bf16_t*)(ws + WS_WIN), nullptr, 0, tile, 0, (int)blockIdx.x, (int)gridDim.x);
    prep_transpose(p.in[23], PLE_, D_, 0, D_, (bf16_t*)(ws + WS_WPP), nullptr, 0, tile, 768, (int)blockIdx.x, (int)gridDim.x);
    if (blockIdx.x < 8) {
        const int hh = blockIdx.x;
        for (int item = tid; item < 1024; item += NTHREADS) { const int gate = item >> 9, fragi = (item >> 6) & 7, ln = item & 63, ntf = fragi >> 1, ksf = fragi & 1, n16f = ln & 15, fqf = ln >> 4;
            const float* wsrc = p.in[gate ? 8 : 6] + (size_t)(hh * 64 + 32 * ksf + 8 * fqf) * 64 + 16 * ntf + n16f;
            const f32x4 lo = {wsrc[0], wsrc[64], wsrc[128], wsrc[192]}, hi = {wsrc[256], wsrc[320], wsrc[384], wsrc[448]};
            u32x4 w; w.x = cvt_pk_bf16(lo[0], lo[1]); w.y = cvt_pk_bf16(lo[2], lo[3]); w.z = cvt_pk_bf16(hi[0], hi[1]); w.w = cvt_pk_bf16(hi[2], hi[3]);
            *(u32x4*)(ws + WS_RGW + ((size_t)((hh * 2 + gate) * 8 + fragi) * 64 + ln) * 16) = w; }
    }
    for (int i = tid; i < 1024 * 8; i += NTHREADS) { const int k = i >> 3, j = i & 7; w8s[i] = p.in[2][k] * p.in[3][(size_t)k * INC_ + PJ_ + j]; }
    __syncthreads();
    {
        const float* x = p.in[0]; const float* nw = p.in[2]; bf16_t* hb = (bf16_t*)(ws + WS_XB); float* logits = (float*)(ws + WS_LOGITS);
        f32x4 nwv[4];
#pragma unroll
        for (int i = 0; i < 4; ++i) nwv[i] = *(const f32x4*)(nw + 4 * (lane + 64 * i));
        f32x4 vn[4]; int row = blockIdx.x * 8 + wid;
        if (row < T_) {
#pragma unroll
            for (int i = 0; i < 4; ++i) vn[i] = *(const f32x4*)(x + (size_t)row * D_ + 4 * (lane + 64 * i)); }
        for (; row < T_; row += gridDim.x * 8) {
            f32x4 v[4]; float s = 0.f;
#pragma unroll
            for (int i = 0; i < 4; ++i) { v[i] = vn[i]; s += (v[i][0] * v[i][0] + v[i][1] * v[i][1]) + (v[i][2] * v[i][2] + v[i][3] * v[i][3]); }
            { const int nrow = row + gridDim.x * 8;
              if (nrow < T_) {
#pragma unroll
                for (int i = 0; i < 4; ++i) vn[i] = *(const f32x4*)(x + (size_t)nrow * D_ + 4 * (lane + 64 * i)); } }
            s = red8(s); s += dpp_f<0x140>(s); s += __shfl_xor(s, 16); s += __shfl_xor(s, 32);
            const float rs = rsqrtf(s * (1.0f / 1024.0f) + EPS_);
            float lg[8];
#pragma unroll
            for (int j = 0; j < 8; ++j) lg[j] = 0.f;
#pragma unroll
            for (int i = 0; i < 4; ++i) {
                const int k0 = 4 * (lane + 64 * i);
#pragma unroll
                for (int e = 0; e < 4; ++e) { const f32x4 wa = *(const f32x4*)(w8s + (k0 + e) * 8), wb = *(const f32x4*)(w8s + (k0 + e) * 8 + 4); const float xv = v[i][e];
                    lg[0] += xv * wa[0]; lg[1] += xv * wa[1]; lg[2] += xv * wa[2]; lg[3] += xv * wa[3]; lg[4] += xv * wb[0]; lg[5] += xv * wb[1]; lg[6] += xv * wb[2]; lg[7] += xv * wb[3]; }
                const f32x4 h = v[i] * rs * nwv[i]; u32x2 w; w.x = cvt_pk_bf16(h[0], h[1]); w.y = cvt_pk_bf16(h[2], h[3]);
                *(u32x2*)(hb + (size_t)row * D_ + k0) = w;
            }
            const bool b5 = (lane & 32) != 0, b4 = (lane & 16) != 0, b3 = (lane & 8) != 0;
            float k4[4], k2[2];
#pragma unroll
            for (int j = 0; j < 4; ++j) { const float send = b5 ? lg[j] : lg[j + 4]; const float keep = b5 ? lg[j + 4] : lg[j]; k4[j] = keep + __shfl_xor(send, 32); }
#pragma unroll
            for (int j = 0; j < 2; ++j) { const float send = b4 ? k4[j] : k4[j + 2]; const float keep = b4 ? k4[j + 2] : k4[j]; k2[j] = keep + __shfl_xor(send, 16); }
            float k1; { const float send = b3 ? k2[0] : k2[1]; const float keep = b3 ? k2[1] : k2[0]; k1 = keep + __shfl_xor(send, 8); }
            k1 = red8(k1);
            if ((lane & 7) == 0) logits[(size_t)row * 8 + ((lane >> 5) & 1) * 4 + ((lane >> 4) & 1) * 2 + ((lane >> 3) & 1)] = k1 * rs;
        }
    }
    {
        const f32x4* src = (const f32x4*)p.in[1]; u32x2* dst = (u32x2*)(ws + WS_PB); const size_t n4 = (size_t)T_ * PLE_ / 4;
        for (size_t i = (size_t)blockIdx.x * NTHREADS + tid; i < n4; i += (size_t)gridDim.x * NTHREADS) { const f32x4 v = src[i]; u32x2 w; w.x = cvt_pk_bf16(v[0], v[1]); w.y = cvt_pk_bf16(v[2], v[3]); dst[i] = w; }
    }
}
__device__ __forceinline__ bf16x8 pack8(const f32x4 a, const f32x4 b) { u32x4 w; w.x = cvt_pk_bf16(a[0], a[1]); w.y = cvt_pk_bf16(a[2], a[3]); w.z = cvt_pk_bf16(b[0], b[1]); w.w = cvt_pk_bf16(b[2], b[3]); return __builtin_bit_cast(bf16x8, w); }
#define MFMA16(a, b, c) __builtin_amdgcn_mfma_f32_16x16x32_bf16((a), (b), (c), 0, 0, 0)
__device__ __forceinline__ float neg_expm1_small(float x, float ehalf) {
    const float ps = -x * (1.0f + x * (0.5f + x * (0.16666667f + x * (0.041666668f + x * (0.008333334f + x * 0.0013888889f)))));
    return (x > -0.25f) ? ps : (1.0f - ehalf * ehalf);
}
template <bool FINAL>
__device__ __forceinline__ void rg_pass_mfma(const Params& p, unsigned char* smem, int widx, int nworkers) {
    const int tid = threadIdx.x, wid = __builtin_amdgcn_readfirstlane(tid >> 6), lane = tid & 63, n16o = lane & 15, fqo = lane >> 4, c = wid * 64 + lane;
    unsigned char* ws = p.ws;
    const bf16_t* proj = (const bf16_t*)(ws + WS_PROJ);
    float* U = (float*)smem + wid * 4352;
    float* ptot = (float*)(ws + WS_PTOT); float* hend = (float*)(ws + WS_HEND); const float* carry = (const float*)(ws + WS_CARRY);
    bf16_t* y = (bf16_t*)(ws + WS_Y);
    bf16x8 Bx[4][2], Ba[4][2];
#pragma unroll
    for (int nt = 0; nt < 4; ++nt)
#pragma unroll
        for (int ks = 0; ks < 2; ++ks) { const unsigned char* fb = ws + WS_RGW + ((size_t)(wid * 16 + nt * 2 + ks) * 64 + lane) * 16;
            Bx[nt][ks] = *(const bf16x8*)fb; Ba[nt][ks] = *(const bf16x8*)(fb + 8 * 64 * 16); }
    const float cw0 = p.in[4][c], cw1 = p.in[4][512 + c], cw2 = p.in[4][1024 + c], cw3 = p.in[4][1536 + c], cb = p.in[5][c];
    float bxv[4], bav[4], spv[4];
#pragma unroll
    for (int nt = 0; nt < 4; ++nt) { const int cgl = wid * 64 + 16 * nt + n16o; bxv[nt] = p.in[7][cgl]; bav[nt] = p.in[9][cgl]; spv[nt] = softplusf_(-p.in[10][cgl]); }
    for (int unit = widx; unit < NB_ * NCH_; unit += nworkers) {
        const int n = unit & (NCH_ - 1); const size_t t0 = (size_t)unit * 64;
        float xm3 = 0.f, xm2 = 0.f, xm1 = 0.f;
        if (n != 0) { xm3 = bf2f(proj[(t0 - 3) * PJ_ + c]); xm2 = bf2f(proj[(t0 - 2) * PJ_ + c]); xm1 = bf2f(proj[(t0 - 1) * PJ_ + c]); }
        __syncthreads();
        { bf16_t xr[16]; const bf16_t* xp0 = proj + t0 * PJ_ + c;
#pragma unroll
          for (int i = 0; i < 16; ++i) xr[i] = xp0[(size_t)i * PJ_];
#pragma unroll
          for (int tb = 0; tb < 4; ++tb) { bf16_t xn[16]; const bf16_t* xp = proj + (t0 + (tb + 1) * 16) * PJ_ + c;
            if (tb < 3) {
#pragma unroll
                for (int i = 0; i < 16; ++i) xn[i] = xp[(size_t)i * PJ_]; }
#pragma unroll
            for (int i = 0; i < 16; ++i) { const float xv = bf2f(xr[i]); U[(16 * ((i >> 2) & 3) + 4 * tb + (i & 3)) * 68 + lane] = cw0 * xm3 + cw1 * xm2 + cw2 * xm1 + cw3 * xv + cb; xm3 = xm2; xm2 = xm1; xm1 = xv; }
            if (tb < 3) {
#pragma unroll
                for (int i = 0; i < 16; ++i) xr[i] = xn[i]; } } }
        __syncthreads();
        const bf16_t* gub = proj + t0 * PJ_ + 512; bf16_t* yub = y + t0 * D_;
#pragma unroll
        for (int nt = 0; nt < 4; ++nt) {
            asm volatile("" ::: "memory");
            int lane_o = lane; asm volatile("" : "+v"(lane_o));
            const int n16 = lane_o & 15, fq = lane_o >> 4;
            const int chl = 16 * nt + n16, cgl = wid * 64 + chl;
            bf16x8 Af[4][2];
#pragma unroll
            for (int mt = 0; mt < 4; ++mt)
#pragma unroll
                for (int ks = 0; ks < 2; ++ks) { const float* up = U + (16 * mt + n16) * 68 + 32 * ks + 8 * fq; Af[mt][ks] = pack8(*(const f32x4*)up, *(const f32x4*)(up + 4)); }

            bf16_t gr[16];
            if (FINAL) {
#pragma unroll
                for (int i = 0; i < 16; ++i) gr[i] = gub[(16 * fq + i) * PJ_ + cgl]; }
            f32x4 ax[4], aa[4];
#pragma unroll
            for (int mt = 0; mt < 4; ++mt) { ax[mt] = (f32x4){bxv[nt], bxv[nt], bxv[nt], bxv[nt]}; aa[mt] = (f32x4){bav[nt], bav[nt], bav[nt], bav[nt]}; }
#pragma unroll
            for (int mt = 0; mt < 4; ++mt)
#pragma unroll
                for (int ks = 0; ks < 2; ++ks) { ax[mt] = MFMA16(Af[mt][ks], Bx[nt][ks], ax[mt]); aa[mt] = MFMA16(Af[mt][ks], Ba[nt][ks], aa[mt]); }
            float av[16], bv[16]; float hl = 0.f, Pl = 1.f;
#pragma unroll
            for (int i = 0; i < 16; ++i) { const int mt = i >> 2, j = i & 3, tok = 16 * fq + i; const float u = U[(16 * mt + 4 * fq + j) * 68 + chl];
                const float gx = sigmoidf_(ax[mt][j]), gg = sigmoidf_(aa[mt][j]); const float la = -8.0f * gg * spv[nt]; const float a = __expf(la);
                float mult = sqrtf(fmaxf(neg_expm1_small(2.0f * la, a), 0.f)); if (n == 0 && tok == 0) mult = 1.0f;
                av[i] = a; bv[i] = u * gx * mult; hl = a * hl + bv[i]; Pl *= a; }
            float Pg[4], Hg[4];
#pragma unroll
            for (int g = 0; g < 4; ++g) { Pg[g] = __shfl(Pl, n16 + 16 * g); Hg[g] = __shfl(hl, n16 + 16 * g); }
            if (FINAL) {
                float h = carry[(size_t)unit * 512 + cgl];
#pragma unroll
                for (int g = 0; g < 3; ++g) if (g < fq) h = Pg[g] * h + Hg[g];
#pragma unroll
                for (int i = 0; i < 16; ++i) { h = av[i] * h + bv[i]; yub[(16 * fq + i) * D_ + cgl] = f2bf(h * gelu_tanhf_(bf2f(gr[i]))); }
            } else {
                float cc = 0.f, Pp = 1.f;
#pragma unroll
                for (int g = 0; g < 4; ++g) { cc = Pg[g] * cc + Hg[g]; Pp *= Pg[g]; }
                if (fq == 0) { ptot[(size_t)unit * 512 + cgl] = Pp; hend[(size_t)unit * 512 + cgl] = cc; }
            }
        }
    }
}

__device__ __forceinline__ void rg_carry(const Params& p, int idx) {
    unsigned char* ws = p.ws; const float* ptot = (const float*)(ws + WS_PTOT); const float* hend = (const float*)(ws + WS_HEND); float* carry = (float*)(ws + WS_CARRY);
    const int b = idx >> 9, c = idx & 511; float hc = 0.f;
    for (int n0 = 0; n0 < NCH_; n0 += 8) { float P[8], H[8];
#pragma unroll
        for (int i = 0; i < 8; ++i) { const size_t o = (size_t)(b * NCH_ + n0 + i) * 512 + c; P[i] = ptot[o]; H[i] = hend[o]; }
#pragma unroll
        for (int i = 0; i < 8; ++i) { const size_t o = (size_t)(b * NCH_ + n0 + i) * 512 + c; carry[o] = hc; hc = P[i] * hc + H[i]; } }
}

constexpr int GU_BYTES = 73728, GU_KDT = 32768, GU_QK = 49152, GU_U = 57344;
typedef float f32x2_ __attribute__((ext_vector_type(2)));
__device__ __forceinline__ int tok_of_pos(int p) { return 16 * (2 * (p >> 5) + ((p >> 2) & 1)) + 4 * ((p >> 3) & 3) + (p & 3); }
__device__ __forceinline__ void unpack8(const u32x4 w, float* f) { f[0] = __uint_as_float(w.x << 16); f[1] = __uint_as_float(w.x & 0xffff0000u); f[2] = __uint_as_float(w.y << 16); f[3] = __uint_as_float(w.y & 0xffff0000u);
    f[4] = __uint_as_float(w.z << 16); f[5] = __uint_as_float(w.z & 0xffff0000u); f[6] = __uint_as_float(w.w << 16); f[7] = __uint_as_float(w.w & 0xffff0000u); }

__device__ __forceinline__ void gdn_pass_a(const Params& p, unsigned char* smem) {
    const int tid = threadIdx.x, wid = __builtin_amdgcn_readfirstlane(tid >> 6);
    unsigned char* ws = p.ws; const bf16_t* proj = (const bf16_t*)(ws + WS_PROJ); const float* logits = (const float*)(ws + WS_LOGITS); float* gtot = (float*)(ws + WS_GTOT);
    bf16_t* Kb = (bf16_t*)smem; bf16_t* Qb = (bf16_t*)(smem + 17408); bf16_t* VBt = (bf16_t*)(smem + 34816); bf16_t* KBGt = (bf16_t*)(smem + 53248);
    float* Lsw = (float*)(smem + 71680); bf16_t* Tb = (bf16_t*)(smem + 89088); float* gcs = (float*)(smem + 98304); float* betas = gcs + 64; float* kdec = gcs + 128;
    const int lane0 = tid & 63, tg0 = tid >> 5, ch0 = (tid & 31) * 4;
    for (int ub = blockIdx.x * 8; ub < 2048; ub += gridDim.x * 8) {
        const int bh = ub >> 7, b = bh >> 2, h = bh & 3;
        const float Aexp = __expf(p.in[12][h]), dtb = p.in[13][h];
        float cw[3][4][4];
#pragma unroll
        for (int a = 0; a < 3; ++a)
#pragma unroll
            for (int j = 0; j < 4; ++j) { const f32x4 w = *(const f32x4*)(p.in[11] + (size_t)j * 1536 + a * 512 + h * 128 + ch0); cw[a][j][0] = w[0]; cw[a][j][1] = w[1]; cw[a][j][2] = w[2]; cw[a][j][3] = w[3]; }
        u32x2 pre[3][7]; float lgb, lga;
#define GA_PREFETCH(unit_) do { const int n_ = (unit_) & 127; const size_t t0_ = (size_t)b * SEQ_ + (size_t)n_ * 64; \
        lgb = logits[(t0_ + lane0) * 8 + h]; lga = logits[(t0_ + lane0) * 8 + 4 + h]; \
        _Pragma("unroll") for (int r = 0; r < 7; ++r) { const int sp_ = n_ * 64 + 4 * tg0 - 3 + r; \
            _Pragma("unroll") for (int a = 0; a < 3; ++a) pre[a][r] = (sp_ >= 0) ? *(const u32x2*)(proj + ((size_t)b * SEQ_ + sp_) * PJ_ + 1024 + a * 512 + h * 128 + ch0) : (u32x2){0u, 0u}; } } while (0)
        GA_PREFETCH(ub);
        for (int k = 0; k < 8; ++k) {
            const int unit = ub + k, n = unit & 127;
            int tid_o = tid; asm volatile("" : "+v"(tid_o));
            const int lane = tid_o & 63, r16 = lane & 15, kq = lane >> 4, cg4 = tid_o & 31, tg = tid_o >> 5, ch = cg4 * 4;
            unsigned char* gbase = ws + WS_R4 + (size_t)unit * GU_BYTES;
            const float betav = sigmoidf_(lgb);
            float gc = -Aexp * softplusf_(lga + dtb);
#pragma unroll
            for (int o = 1; o < 64; o <<= 1) { const float tmp = __shfl_up(gc, o); if (lane >= o) gc += tmp; }
            const float gclast = __shfl(gc, 63);
            if (wid == 0) { gcs[lane] = gc; betas[lane] = betav; kdec[lane] = __expf(gclast - gc); }
            {
                float x[7][4], o[4][4], bt[4], egt[4];
#pragma unroll
                for (int t = 0; t < 4; ++t) { bt[t] = __shfl(betav, 4 * tg + t); egt[t] = __expf(__shfl(gc, 4 * tg + t)); }
#pragma unroll
                for (int a = 0; a < 3; ++a) {
#pragma unroll
                    for (int r = 0; r < 7; ++r) { x[r][0] = __uint_as_float(pre[a][r].x << 16); x[r][1] = __uint_as_float(pre[a][r].x & 0xffff0000u); x[r][2] = __uint_as_float(pre[a][r].y << 16); x[r][3] = __uint_as_float(pre[a][r].y & 0xffff0000u); }
#pragma unroll
                    for (int t = 0; t < 4; ++t)
#pragma unroll
                        for (int e = 0; e < 4; ++e) { float acc = cw[a][0][e] * x[t][e]; acc += cw[a][1][e] * x[t + 1][e]; acc += cw[a][2][e] * x[t + 2][e]; acc += cw[a][3][e] * x[t + 3][e]; o[t][e] = siluf_(acc); }
                    if (a < 2) {
#pragma unroll
                        for (int t = 0; t < 4; ++t) { float ssq = (o[t][0] * o[t][0] + o[t][1] * o[t][1]) + (o[t][2] * o[t][2] + o[t][3] * o[t][3]);
                            ssq += dpp_f<0xB1>(ssq); ssq += dpp_f<0x4E>(ssq); ssq += dpp_f<0x141>(ssq); ssq += dpp_f<0x140>(ssq); ssq += __shfl_xor(ssq, 16);
                            const float rs = rsqrtf(ssq + EPS_) * (a == 0 ? 0.08838834764831845f : 1.0f);
#pragma unroll
                            for (int e = 0; e < 4; ++e) o[t][e] *= rs; }
                    }
                    if (a == 0) {
#pragma unroll
                        for (int t = 0; t < 4; ++t) { const int tok = 4 * tg + t; u32x2 w; w.x = cvt_pk_bf16(o[t][0], o[t][1]); w.y = cvt_pk_bf16(o[t][2], o[t][3]); *(u32x2*)(Qb + tok * 136 + ch) = w;
                            u32x2 wd; wd.x = cvt_pk_bf16(o[t][0] * egt[t], o[t][1] * egt[t]); wd.y = cvt_pk_bf16(o[t][2] * egt[t], o[t][3] * egt[t]);
                            *(u32x2*)((bf16_t*)gbase + (size_t)(64 + tok) * 128 + 32 * (cg4 >> 3) + 8 * (cg4 & 3) + 4 * ((cg4 >> 2) & 1)) = wd; }
                    } else if (a == 1) {
#pragma unroll
                        for (int t = 0; t < 4; ++t) { const int tok = 4 * tg + t; u32x2 w; w.x = cvt_pk_bf16(o[t][0], o[t][1]); w.y = cvt_pk_bf16(o[t][2], o[t][3]); *(u32x2*)(Kb + tok * 136 + ch) = w; }
#pragma unroll
                        for (int e = 0; e < 4; ++e) { u32x2 w; w.x = cvt_pk_bf16(o[0][e] * bt[0] * egt[0], o[1][e] * bt[1] * egt[1]); w.y = cvt_pk_bf16(o[2][e] * bt[2] * egt[2], o[3][e] * bt[3] * egt[3]); *(u32x2*)(KBGt + (ch + e) * 72 + (((tg >> 1) ^ (cg4 & 7)) << 3) + 4 * (tg & 1)) = w; }
                    } else {
#pragma unroll
                        for (int e = 0; e < 4; ++e) { u32x2 w; w.x = cvt_pk_bf16(o[0][e] * bt[0], o[1][e] * bt[1]); w.y = cvt_pk_bf16(o[2][e] * bt[2], o[3][e] * bt[3]); *(u32x2*)(VBt + (ch + e) * 72 + (((tg >> 1) ^ (cg4 & 7)) << 3) + 4 * (tg & 1)) = w; }
                    }
                }
            }
            if (k + 1 < 8) GA_PREFETCH(unit + 1);
            __syncthreads();
#pragma unroll
            for (int rep = 0; rep < 2; ++rep) {
                const int tl = wid + 8 * rep, jt = tl >> 2, it = tl & 3;
                f32x4 accQ = {0.f, 0.f, 0.f, 0.f}, accK = {0.f, 0.f, 0.f, 0.f};
#pragma unroll
                for (int ks = 0; ks < 4; ++ks) { const bf16x8 a = *(const bf16x8*)(Kb + (16 * jt + r16) * 136 + 32 * ks + 8 * kq);
                    const bf16x8 bq = *(const bf16x8*)(Qb + (16 * it + r16) * 136 + 32 * ks + 8 * kq), bk = *(const bf16x8*)(Kb + (16 * it + r16) * 136 + 32 * ks + 8 * kq);
                    accQ = MFMA16(a, bq, accQ); accK = MFMA16(a, bk, accK); }
                const int i = 16 * it + r16; const float gi = gcs[i], bi = betas[i]; float qv[4];
#pragma unroll
                for (int jj = 0; jj < 4; ++jj) { const int j = 16 * jt + 4 * kq + jj; const float d = __expf(fminf(gi - gcs[j], 0.f));
                    qv[jj] = (i >= j) ? accQ[jj] * d : 0.f; Lsw[i * 68 + (j & 7) * 8 + (j >> 3)] = (i > j) ? bi * accK[jj] * d : 0.f; }
                u32x2 w; w.x = cvt_pk_bf16(qv[0], qv[1]); w.y = cvt_pk_bf16(qv[2], qv[3]);
                *(u32x2*)((bf16_t*)(gbase + GU_QK) + i * 64 + 32 * (jt >> 1) + 8 * kq + 4 * (jt & 1)) = w;
            }
            __syncthreads();
            {
                const int s = lane & 7, c = 8 * wid + (lane >> 3); float t[8];
#pragma unroll
                for (int m = 0; m < 8; ++m) t[m] = 0.f;
                f32x4 la[2][2]; la[0][0] = *(const f32x4*)(Lsw + s * 8); la[0][1] = *(const f32x4*)(Lsw + s * 8 + 4);
#pragma unroll
                for (int i = 0; i < 64; ++i) {
                    if (i + 1 < 64) { la[(i + 1) & 1][0] = *(const f32x4*)(Lsw + (i + 1) * 68 + s * 8); la[(i + 1) & 1][1] = *(const f32x4*)(Lsw + (i + 1) * 68 + s * 8 + 4); }
                    asm volatile("" ::: "memory");
                    const f32x4 l0 = la[i & 1][0], l1 = la[i & 1][1];
                    float part = 0.f;
#pragma unroll
                    for (int m = 0; m < 8; ++m) if (8 * m <= i) part += ((m < 4) ? l0[m & 3] : l1[m & 3]) * t[m];
                    part = red8(part);
                    const float val = ((i == c) ? 1.0f : 0.0f) - part;
                    if (s == (i & 7)) t[i >> 3] = val;
                }
#pragma unroll
                for (int m = 0; m < 8; ++m) Tb[(8 * m + s) * 72 + c] = f2bf(t[m]);
            }
            __syncthreads();
            {
#pragma unroll
                for (int mt = 0; mt < 4; ++mt) { f32x4 acc = {0.f, 0.f, 0.f, 0.f};
#pragma unroll
                    for (int ks = 0; ks < 2; ++ks) { const bf16x8 a = *(const bf16x8*)(Tb + (16 * mt + r16) * 72 + 32 * ks + 8 * kq), bb = *(const bf16x8*)(VBt + (16 * wid + r16) * 72 + (((4 * ks + kq) ^ ((4 * wid + (r16 >> 2)) & 7)) << 3)); acc = MFMA16(a, bb, acc); }
                    u32x2 w; w.x = cvt_pk_bf16(acc[0], acc[1]); w.y = cvt_pk_bf16(acc[2], acc[3]);
                    *(u32x2*)((bf16_t*)(gbase + GU_U) + ((wid * 4 + mt) * 64 + lane) * 4) = w; }
#pragma unroll
                for (int it = 0; it < 4; ++it) { f32x4 acc = {0.f, 0.f, 0.f, 0.f};
#pragma unroll
                    for (int ks = 0; ks < 2; ++ks) { const bf16x8 a = *(const bf16x8*)(KBGt + (16 * wid + r16) * 72 + (((4 * ks + kq) ^ ((4 * wid + (r16 >> 2)) & 7)) << 3)), bb = *(const bf16x8*)(Tb + (16 * it + r16) * 72 + 32 * ks + 8 * kq); acc = MFMA16(a, bb, acc); }
                    u32x2 w; w.x = cvt_pk_bf16(acc[0], acc[1]); w.y = cvt_pk_bf16(acc[2], acc[3]);
                    *(u32x2*)((bf16_t*)gbase + (16 * it + r16) * 128 + 32 * (wid >> 1) + 8 * kq + 4 * (wid & 1)) = w; }
                const int dk = tid_o >> 2, pg = tid_o & 3; float v[16];
#pragma unroll
                for (int e = 0; e < 16; ++e) { const int tk = tok_of_pos(16 * pg + e); v[e] = bf2f(Kb[tk * 136 + dk]) * kdec[tk]; }
                u32x4 w0, w1; w0.x = cvt_pk_bf16(v[0], v[1]); w0.y = cvt_pk_bf16(v[2], v[3]); w0.z = cvt_pk_bf16(v[4], v[5]); w0.w = cvt_pk_bf16(v[6], v[7]);
                w1.x = cvt_pk_bf16(v[8], v[9]); w1.y = cvt_pk_bf16(v[10], v[11]); w1.z = cvt_pk_bf16(v[12], v[13]); w1.w = cvt_pk_bf16(v[14], v[15]);
                *(u32x4*)((bf16_t*)(gbase + GU_KDT) + dk * 64 + 16 * pg) = w0; *(u32x4*)((bf16_t*)(gbase + GU_KDT) + dk * 64 + 16 * pg + 8) = w1;
                if (tid == 0) gtot[unit] = __expf(gclast);
            }
            __syncthreads();
        }
    }
#undef GA_PREFETCH
}

constexpr int GB_BUF = 62464, GB_KDT = 34816, GB_QK = 53248, GB_BUF2 = GB_BUF + 4096 + 16;
__device__ __forceinline__ void gdn_pass_b(const Params& p, unsigned char* smem, int wg) {
    const int tid = threadIdx.x, wid = __builtin_amdgcn_readfirstlane(tid >> 6), lane = tid & 63, r16 = lane & 15, kq = lane >> 4;
    const int bh = wg >> 2, cgp = wg & 3, b = bh >> 2, h = bh & 3, nt = cgp * 2 + wid;
    unsigned char* ws = p.ws; const unsigned char* ubase = ws + WS_R4 + (size_t)(bh * 128) * GU_BYTES; const float* gtot = (const float*)(ws + WS_GTOT) + bh * 128;
    bf16_t* oraw = (bf16_t*)(ws + WS_ORAW);
#define GB_BAR() do { asm volatile("s_waitcnt lgkmcnt(0)" ::: "memory"); __builtin_amdgcn_s_barrier(); asm volatile("" ::: "memory"); } while (0)
    if (wid >= 2) {
        const int lt = tid - 128;
        int dsto[10]; size_t srco[10];
#pragma unroll
        for (int it = 0; it < 10; ++it) { const int q = lt + 384 * it;
            dsto[it] = (q < 2048) ? (q >> 4) * 272 + (q & 15) * 16 : (q < 3072) ? GB_KDT + ((q - 2048) >> 3) * 144 + ((q - 2048) & 7) * 16 : (q < 3584) ? GB_QK + ((q - 3072) >> 3) * 144 + ((q - 3072) & 7) * 16 : GB_BUF + (q - 3584) * 16;
            srco[it] = (q < 3584) ? (size_t)q * 16 : (size_t)(GU_U + cgp * 4096 + (q - 3584) * 16); }
        u32x4 sa[10], sb[10], sc[10]; float ga = 0.f, gb = 0.f, gc = 0.f;
#define GB_LD(st, g, n_) do { const unsigned char* rp_ = ubase + (size_t)(n_) * GU_BYTES; _Pragma("unroll") for (int it = 0; it < 10; ++it) st[it] = *(const u32x4*)(rp_ + srco[it]); if (lt == 0) g = gtot[n_]; } while (0)
#define GB_WR(st, g, bufi) do { unsigned char* bp_ = smem + (bufi) * GB_BUF2; _Pragma("unroll") for (int it = 0; it < 10; ++it) *(u32x4*)(bp_ + dsto[it]) = st[it]; if (lt == 0) *(float*)(bp_ + GB_BUF + 4096) = g; } while (0)
        GB_LD(sa, ga, 0); GB_WR(sa, ga, 0); GB_BAR();
        GB_LD(sa, ga, 1); GB_LD(sb, gb, 2); GB_LD(sc, gc, 3);
        for (int n0 = 0; n0 < NCH_; n0 += 3) {
            { const int n = n0;     if (n < NCH_) { if (n + 1 < NCH_) GB_WR(sa, ga, (n + 1) & 1); if (n + 4 < NCH_) GB_LD(sa, ga, n + 4); GB_BAR(); } }
            { const int n = n0 + 1; if (n < NCH_) { if (n + 1 < NCH_) GB_WR(sb, gb, (n + 1) & 1); if (n + 4 < NCH_) GB_LD(sb, gb, n + 4); GB_BAR(); } }
            { const int n = n0 + 2; if (n < NCH_) { if (n + 1 < NCH_) GB_WR(sc, gc, (n + 1) & 1); if (n + 4 < NCH_) GB_LD(sc, gc, n + 4); GB_BAR(); } }
        }
#undef GB_LD
#undef GB_WR
    } else {
        __builtin_amdgcn_s_setprio(3);
        f32x4 S[8]; bf16x8 Sb[4];
#pragma unroll
        for (int d = 0; d < 8; ++d) S[d] = (f32x4){0.f, 0.f, 0.f, 0.f};
#pragma unroll
        for (int k = 0; k < 4; ++k) Sb[k] = (bf16x8){0, 0, 0, 0, 0, 0, 0, 0};
        GB_BAR();
        for (int n = 0; n < NCH_; ++n) {
            const unsigned char* L = smem + (n & 1) * GB_BUF2; const float gt = *(const float*)(L + GB_BUF + 4096); const size_t t0 = (size_t)b * SEQ_ + (size_t)n * 64;
            u32x2 uw[4];
#pragma unroll
            for (int tt = 0; tt < 4; ++tt) uw[tt] = *(const u32x2*)(L + GB_BUF + ((wid * 4 + tt) * 64 + lane) * 8);
            f32x4 P[8];
#pragma unroll
            for (int m = 0; m < 8; ++m) P[m] = (f32x4){0.f, 0.f, 0.f, 0.f};
#pragma unroll
            for (int ks = 0; ks < 4; ++ks)
#pragma unroll
                for (int mt = 0; mt < 8; ++mt) { const bf16x8 a = *(const bf16x8*)(L + (16 * mt + r16) * 272 + (32 * ks + 8 * kq) * 2); P[mt] = MFMA16(a, Sb[ks], P[mt]); }
            f32x4 vn[4];
#pragma unroll
            for (int tt = 0; tt < 4; ++tt) { const f32x4 u = {__uint_as_float(uw[tt].x << 16), __uint_as_float(uw[tt].x & 0xffff0000u), __uint_as_float(uw[tt].y << 16), __uint_as_float(uw[tt].y & 0xffff0000u)}; vn[tt] = u - P[tt]; }
            bf16x8 Vb[2]; Vb[0] = pack8(vn[0], vn[1]); Vb[1] = pack8(vn[2], vn[3]);
#pragma unroll
            for (int tt = 0; tt < 4; ++tt) { f32x4 O = P[4 + tt];
#pragma unroll
                for (int ks = 0; ks < 2; ++ks) { const bf16x8 a = *(const bf16x8*)(L + GB_QK + (16 * tt + r16) * 144 + (32 * ks + 8 * kq) * 2); O = MFMA16(a, Vb[ks], O); }
                bf16_t* op = oraw + (t0 + 16 * tt + 4 * kq) * 512 + h * 128 + 16 * nt + r16;
#pragma unroll
                for (int j = 0; j < 4; ++j) op[(size_t)j * 512] = f2bf(O[j]); }
#pragma unroll
            for (int dt = 0; dt < 8; ++dt) { f32x4 acc = S[dt] * gt;
#pragma unroll
                for (int ks = 0; ks < 2; ++ks) { const bf16x8 a = *(const bf16x8*)(L + GB_KDT + (16 * dt + r16) * 144 + (32 * ks + 8 * kq) * 2); acc = MFMA16(a, Vb[ks], acc); }
                S[dt] = acc; }
#pragma unroll
            for (int ks = 0; ks < 4; ++ks) Sb[ks] = pack8(S[2 * ks], S[2 * ks + 1]);
            GB_BAR();
        }
        __builtin_amdgcn_s_setprio(0);
    }
#undef GB_BAR
}

__device__ __forceinline__ void gdn_norm(const Params& p) {
    unsigned char* ws = p.ws; const bf16_t* oraw = (const bf16_t*)(ws + WS_ORAW); const bf16_t* proj = (const bf16_t*)(ws + WS_PROJ); bf16_t* y = (bf16_t*)(ws + WS_Y);
    int tid_o = threadIdx.x; asm volatile("" : "+v"(tid_o));
    const int gtid = blockIdx.x * NTHREADS + tid_o, sub = gtid & 31; const f32x4 nwv = *(const f32x4*)(p.in[14] + sub * 4);
    const int stride = (gridDim.x * NTHREADS) >> 5;
    for (int item0 = gtid >> 5; item0 < T_ * 4; item0 += 4 * stride) {
        u32x2 ow[4], zw[4];
#pragma unroll
        for (int q = 0; q < 4; ++q) { const int item = item0 + q * stride; const int t = item >> 2, h = item & 3;
            if (item < T_ * 4) { ow[q] = *(const u32x2*)(oraw + (size_t)t * 512 + h * 128 + sub * 4); zw[q] = *(const u32x2*)(proj + (size_t)t * PJ_ + 2560 + h * 128 + sub * 4); } else { ow[q] = (u32x2){0u, 0u}; zw[q] = (u32x2){0u, 0u}; } }
#pragma unroll
        for (int q = 0; q < 4; ++q) { const int item = item0 + q * stride; const int t = item >> 2, h = item & 3;
            const f32x4 ov = {__uint_as_float(ow[q].x << 16), __uint_as_float(ow[q].x & 0xffff0000u), __uint_as_float(ow[q].y << 16), __uint_as_float(ow[q].y & 0xffff0000u)};
            float s = (ov[0] * ov[0] + ov[1] * ov[1]) + (ov[2] * ov[2] + ov[3] * ov[3]);
#pragma unroll
            for (int o = 1; o < 32; o <<= 1) s += __shfl_xor(s, o);
            const float rs = rsqrtf(s * (1.0f / 128.0f) + EPS_);
            const float z0 = __uint_as_float(zw[q].x << 16), z1 = __uint_as_float(zw[q].x & 0xffff0000u), z2 = __uint_as_float(zw[q].y << 16), z3 = __uint_as_float(zw[q].y & 0xffff0000u);
            u32x2 w; w.x = cvt_pk_bf16(ov[0] * rs * nwv[0] * siluf_(z0), ov[1] * rs * nwv[1] * siluf_(z1)); w.y = cvt_pk_bf16(ov[2] * rs * nwv[2] * siluf_(z2), ov[3] * rs * nwv[3] * siluf_(z3));
            if (item < T_ * 4) *(u32x2*)(y + (size_t)t * D_ + 512 + h * 128 + sub * 4) = w; }
    }
}

__device__ __forceinline__ void phase_final(const Params& p) {
    const int tid = threadIdx.x, wid = __builtin_amdgcn_readfirstlane(tid >> 6), lane = tid & 63;
    const float* ss = (const float*)(p.ws + WS_SSA); const float* nw = p.in[24]; float* out = p.out; const bf16_t* x3b = (const bf16_t*)(p.ws + WS_XB);
    f32x4 nwv[4];
#pragma unroll
    for (int i = 0; i < 4; ++i) nwv[i] = *(const f32x4*)(nw + 4 * (lane + 64 * i));
    u32x2 wn[4]; int row = blockIdx.x * 8 + wid;
    if (row < T_) {
#pragma unroll
        for (int i = 0; i < 4; ++i) wn[i] = *(const u32x2*)(x3b + (size_t)row * D_ + 4 * (lane + 64 * i)); }
    for (; row < T_; row += gridDim.x * 8) {
        const float rs = rstd16(ss, row);
        u32x2 wc[4];
#pragma unroll
        for (int i = 0; i < 4; ++i) wc[i] = wn[i];
        { const int nrow = row + gridDim.x * 8;
          if (nrow < T_) {
#pragma unroll
            for (int i = 0; i < 4; ++i) wn[i] = *(const u32x2*)(x3b + (size_t)nrow * D_ + 4 * (lane + 64 * i)); } }
#pragma unroll
        for (int i = 0; i < 4; ++i) { const u32x2 w = wc[i]; const f32x4 v = {__uint_as_float(w.x << 16), __uint_as_float(w.x & 0xffff0000u), __uint_as_float(w.y << 16), __uint_as_float(w.y & 0xffff0000u)};
            __builtin_nontemporal_store(v * rs * nwv[i], (f32x4*)(out + (size_t)row * D_ + 4 * (lane + 64 * i))); }
    }
}

constexpr int NPHASES = 11;
__global__ void __launch_bounds__(NTHREADS, 2) mega_fwd(Params p) {
    extern __shared__ __attribute__((aligned(16))) unsigned char smem[];
    PG8_LAS unsigned char* lds = (PG8_LAS unsigned char*)smem;
    cg::grid_group grid = cg::this_grid();
    unsigned char* ws = p.ws;
    bf16_t* hb = (bf16_t*)(ws + WS_XB); bf16_t* xb = (bf16_t*)(ws + WS_XB2); bf16_t* proj = (bf16_t*)(ws + WS_PROJ); bf16_t* ff = proj; bf16_t* y = (bf16_t*)(ws + WS_Y); bf16_t* pp = (bf16_t*)p.out;
    float* ssA = (float*)(ws + WS_SSA); float* ssB = (float*)(ws + WS_SSB);
#ifdef ONLY_PHASE
#define PH_ON(n) ((n) == ONLY_PHASE)
#else
#define PH_ON(n) ((n) >= p.ph_lo && (n) < p.ph_hi)
#endif
    volatile LAS unsigned* xst = (volatile LAS unsigned*)(lds + LDS_BYTES - 16);
    if (threadIdx.x == 0) { xst[0] = 0u; xst[1] = 0u; xst[2] = 0u; xst[3] = 0u; }
    __syncthreads();
    const XcdBarrier xbar = xcd_barrier_post((unsigned*)(ws + WS_BAR), xst);
    if (p.ph_lo == 0x7fffffff) grid.sync();
#define PH_SYNC(n) do { if ((n) > p.ph_lo && (n) < p.ph_hi) { xcd_barrier(xbar); } } while (0)
    if (PH_ON(0)) phase_prep(p, smem);
    PH_SYNC(1);
    if (PH_ON(1)) { EpiBf16Plain E; E.O = proj; E.ldc = PJ_; run_gemm(lds, hb, (const bf16_t*)(ws + WS_WIN), T_, PJ_, D_, E); }
    PH_SYNC(2);
    if (PH_ON(2)) { rg_pass_mfma<false>(p, smem, (int)blockIdx.x, (int)gridDim.x); __syncthreads(); gdn_pass_a(p, smem); }
    PH_SYNC(3);
    if (PH_ON(3)) {
        unsigned* flag = (unsigned*)ws + 16;
        if (blockIdx.x < 64) { const int xq = blockIdx.x & 7, kq8 = blockIdx.x >> 3;
            gdn_pass_b(p, smem, ((xq + 8 * (kq8 >> 2)) << 2) | (kq8 & 3)); }
        else {
            if (blockIdx.x < 68) { rg_carry(p, (blockIdx.x - 64) * NTHREADS + threadIdx.x); __threadfence(); __syncthreads();
                if (threadIdx.x == 0) __hip_atomic_fetch_add(flag, 1u, __ATOMIC_RELEASE, __HIP_MEMORY_SCOPE_AGENT); }
            prep_weights_late(p, smem, (int)blockIdx.x - 64, (int)gridDim.x - 64);
            if (threadIdx.x == 0) { while (__hip_atomic_load(flag, __ATOMIC_ACQUIRE, __HIP_MEMORY_SCOPE_AGENT) < 4u) __builtin_amdgcn_s_sleep(8); }
            __syncthreads(); __threadfence();
            rg_pass_mfma<true>(p, smem, (int)blockIdx.x - 64, (int)gridDim.x - 64);
            __syncthreads();
            { EpiBf16Plain E2; E2.O = pp; E2.ldc = D_; pg8::Gemm g2; g2.A = (const bf16_t*)(ws + WS_PB); g2.Bt = (const bf16_t*)(ws + WS_WPP); g2.M = T_; g2.N = D_; g2.K = PLE_;
              pg8::StaticOrder S2; S2.init(T_, D_, (int)gridDim.x - 64, (int)blockIdx.x - 64); pg8::gemm_phase<EpiBf16Plain, pg8::StaticOrder, GEMM_ALIGN, GEMM_SP2>(lds, g2, S2, E2); }
        }
    }
    PH_SYNC(4);
    if (PH_ON(4)) gdn_norm(p);
    PH_SYNC(5);
    if (PH_ON(5)) { EpiResid<false> E; E.res = p.in[0]; E.xb = xb; E.ss = ssA; run_gemm(lds, y, (const bf16_t*)(ws + WS_WOUT), T_, D_, D_, E); }
    PH_SYNC(6);
    if (PH_ON(6)) { EpiGateUp E; E.ff = ff; E.ss = ssA; run_gemm(lds, xb, (const bf16_t*)(ws + WS_WGU), T_, 2 * FF_, D_, E); }
    PH_SYNC(7);
    if (PH_ON(7)) { EpiResid<true> E; E.res = nullptr; E.xb = xb; E.ss = ssB; run_gemm(lds, ff, (const bf16_t*)(ws + WS_WD), T_, D_, FF_, E); }
    PH_SYNC(8);
    if (PH_ON(8)) { EpiPle E; E.x2b = xb; E.x3b = hb; E.pp = pp; E.bias = p.in[22]; E.ss_in = ssB; E.ss_out = ssA; run_gemm(lds, xb, (const bf16_t*)(ws + WS_WPG), T_, D_, D_, E); }
    PH_SYNC(9);
    if (PH_ON(9)) phase_final(p);
}

extern "C" void kernel_launch(void* const* d_in, const int* in_sizes, int n_in, void* d_out, int out_size, void* d_ws, size_t ws_size, hipStream_t stream) {
    static int grid = 0;
    if (grid == 0) {
        if (n_in != 25 || out_size != T_ * D_ || ws_size < WS_END) { fprintf(stderr, "kernel_launch: unexpected shapes: n_in %d out %d ws %zu (need %zu)\n", n_in, out_size, ws_size, (size_t)WS_END); grid = -1; return; }
        int dev = 0, cus = 0, per_cu = 0;
        hipGetDevice(&dev); hipDeviceGetAttribute(&cus, hipDeviceAttributeMultiprocessorCount, dev);
        if (hipFuncSetAttribute((const void*)mega_fwd, hipFuncAttributeMaxDynamicSharedMemorySize, LDS_BYTES) != hipSuccess) { fprintf(stderr, "kernel_launch: hipFuncSetAttribute failed\n"); grid = -1; return; }
        if (hipOccupancyMaxActiveBlocksPerMultiprocessor(&per_cu, (const void*)mega_fwd, NTHREADS, LDS_BYTES) != hipSuccess || per_cu < 1) { fprintf(stderr, "kernel_launch: occupancy query says %d\n", per_cu); per_cu = 1; }
        (void)hipGetLastError();
        grid = cus * 1;
        if (grid <= 0) grid = 256;
    }
    if (grid < 0) return;
    Params p{};
    for (int i = 0; i < 25; ++i) p.in[i] = (const float*)d_in[i];
    p.out = (float*)d_out; p.ws = (unsigned char*)d_ws; p.ph_lo = 0; p.ph_hi = NPHASES;
    if (hipMemsetAsync((char*)d_ws + WS_BAR, 0, XCD_BAR_WORDS * 4, stream) != hipSuccess) { fprintf(stderr, "kernel_launch: memset of the barrier words failed\n"); return; }
    void* args[] = {&p};
    hipError_t e = hipLaunchCooperativeKernel((const void*)mega_fwd, dim3(grid), dim3(NTHREADS), args, LDS_BYTES, stream);
    if (e != hipSuccess) fprintf(stderr, "cooperative launch failed: %s (grid %d)\n", hipGetErrorString(e), grid);
}
```

```cpp
#include <hip/hip_runtime.h>
#include <hip/hip_cooperative_groups.h>
#include <cstdio>
#include <cstdint>
namespace cg = cooperative_groups;
namespace pg8 {
#define PG8_LAS __attribute__((address_space(3)))
typedef unsigned short bf16_t;
typedef short bf16x8 __attribute__((ext_vector_type(8)));
typedef float f32x4 __attribute__((ext_vector_type(4)));
typedef unsigned u32x4 __attribute__((ext_vector_type(4)));
constexpr int BM = 256, BK = 64, HALF = 128, HTB = HALF * BK * 2  , STAGE_BYTES = 8 * HTB, NXCD = 8, WGM = 8;

__host__ __device__ __forceinline__ int lds_byte(int r, int c) { const int st = (r >> 4) * 2 + (c >> 5), rr = r & 15, cc = c & 31, ob = rr * 64 + cc * 2; return st * 1024 + (ob ^ (((ob >> 9) & 1) << 5)); }
__host__ __device__ __forceinline__ void stage_rc(int b, int& R, int& C) { const int st = b / 1024, sb = b % 1024, swz = sb ^ (((sb >> 9) & 1) << 5); R = (st >> 1) * 16 + swz / 64; C = (st & 1) * 32 + (swz % 64) / 2; }
__host__ __device__ __forceinline__ int perm32(int rho) { const int n = rho >> 4, i = rho & 15; return 8 * (i >> 2) + 4 * n + (i & 3); }

struct Unit { int pm, pn; };
struct Gemm { const bf16_t* A; const bf16_t* Bt; int M, N, K; };

struct StaticOrder {
    int nM, nN, nwg, G, c;
    __host__ __device__ void init(int M, int N, int G_, int c_) { nM = M / BM; nN = N / BM; nwg = nM * nN; G = G_; c = c_; }
    __host__ __device__ bool next(int i, Unit& u) const {
        const long L = (long)i * G + c; if (L >= nwg) return false;
        int wgid = (int)L; { const int q = nwg / NXCD, r = nwg % NXCD, xcd = wgid % NXCD, off = wgid / NXCD; wgid = (xcd < r ? xcd * (q + 1) : r * (q + 1) + (xcd - r) * q) + off; }
        const int nig = WGM * nN, gid = wgid / nig, fm = gid * WGM, gsz = (nM - fm) < WGM ? (nM - fm) : WGM;
        u.pm = fm + ((wgid % nig) % gsz); u.pn = (wgid % nig) / gsz; return true;
    }
    __device__ __forceinline__ void a_ready(const Unit&) const {}
    __device__ __forceinline__ void done(const Unit&) const {}
};
typedef __bf16 bf16v2_ __attribute__((ext_vector_type(2)));
typedef float f32v2_ __attribute__((ext_vector_type(2)));
__device__ __forceinline__ unsigned cvt_pk_bf16(float lo, float hi) { f32v2_ v = {lo, hi}; bf16v2_ b = __builtin_convertvector(v, bf16v2_); return __builtin_bit_cast(unsigned, b); }
typedef float f32x2 __attribute__((ext_vector_type(2)));
template <class Epi, class Sched, bool ALIGN_EPI = false, bool SP2 = false>
__device__ __forceinline__ void gemm_phase(PG8_LAS unsigned char* lds, const Gemm g, const Sched& S, const Epi& E) {
    int tid = threadIdx.x; asm volatile("" : "+v"(tid));
    const int wid = __builtin_amdgcn_readfirstlane(tid >> 6), lane = tid & 63, wr = wid >> 2, wc = wid & 3, fr = lane & 15, fq = lane >> 4;
    const int K = g.K, nt = K / BK;
    unsigned voffA[2], voffB[2];
#pragma unroll
    for (int i = 0; i < 2; ++i) { int R, C; stage_rc(tid * 16 + i * 8192, R, C); const int Rb = Epi::PERM ? ((R & ~31) + perm32(R & 31)) : R;
        voffA[i] = (unsigned)(R * K + C) * 2u; voffB[i] = (unsigned)(Rb * K + C) * 2u; }
    const size_t kstep = (size_t)(BK * 2);
    const size_t hstep = (size_t)HALF * K * 2;
    const size_t tstep = 2 * hstep;
    const unsigned ldsw = (unsigned)wid * 1024u;
    const int aoff = lds_byte(wr * 64 + fr, fq * 8), boff = lds_byte(wc * 32 + fr, fq * 8);
#define PG8_SA(b, h) (((b) * 2 + (h)) * HTB)
#define PG8_SB(b, h) ((4 + (b) * 2 + (h)) * HTB)
#define PG8_STAGE(bufoff, gbase, voff) do { _Pragma("unroll") for (int _i = 0; _i < 2; ++_i) \
        __builtin_amdgcn_global_load_lds((const unsigned*)((const char*)(gbase) + (voff)[_i]), (PG8_LAS unsigned*)(lds + (bufoff) + ldsw + _i * 8192), 16, 0, 0); } while (0)
#define PG8_LDA(dst, b, h) do { _Pragma("unroll") for (int m = 0; m < 4; ++m) _Pragma("unroll") for (int k = 0; k < 2; ++k) dst[m][k] = *(const PG8_LAS bf16x8*)(lds + PG8_SA(b, h) + aoff + m * 2048 + k * 1024); } while (0)
#define PG8_LDB(dst, b, h) do { _Pragma("unroll") for (int n = 0; n < 2; ++n) _Pragma("unroll") for (int k = 0; k < 2; ++k) dst[n][k] = *(const PG8_LAS bf16x8*)(lds + PG8_SB(b, h) + boff + n * 2048 + k * 1024); } while (0)
#define PG8_MMA(ai, bj, At, Bt) do { __builtin_amdgcn_s_setprio(1); _Pragma("unroll") for (int m = 0; m < 4; ++m) _Pragma("unroll") for (int n = 0; n < 2; ++n) _Pragma("unroll") for (int k = 0; k < 2; ++k) \
        acc[ai][bj][m][n] = __builtin_amdgcn_mfma_f32_16x16x32_bf16(Bt[n][k], At[m][k], acc[ai][bj][m][n], 0, 0, 0); __builtin_amdgcn_s_setprio(0); } while (0)
#define PG8_WAIT_V(n) asm volatile("s_waitcnt vmcnt(" #n ")" ::: "memory")
#define PG8_WAIT_L(n) asm volatile("s_waitcnt lgkmcnt(" #n ")" ::: "memory")
#define PG8_BAR __builtin_amdgcn_s_barrier()
#define PG8_SCHED __builtin_amdgcn_sched_barrier(0)
    Unit cur, nxt; int ui = 0;
    if (!S.next(0, cur)) return;
    f32x4 acc[2][2][4][2];
#pragma unroll
    for (int a = 0; a < 2; ++a)
#pragma unroll
        for (int b = 0; b < 2; ++b)
#pragma unroll
            for (int m = 0; m < 4; ++m)
#pragma unroll
                for (int n = 0; n < 2; ++n) acc[a][b][m][n] = (f32x4){0.f, 0.f, 0.f, 0.f};
    bf16x8 At[4][2], B0[2][2], B1[2][2];
    const char* cA = (const char*)g.A + (size_t)cur.pm * tstep; const char* cB = (const char*)g.Bt + (size_t)cur.pn * tstep;
    S.a_ready(cur);
    if constexpr (SP2) {
        PG8_STAGE(PG8_SB(0, 0), cB, voffB); PG8_STAGE(PG8_SB(0, 1), cB + hstep, voffB); PG8_STAGE(PG8_SA(0, 0), cA, voffA); PG8_STAGE(PG8_SA(0, 1), cA + hstep, voffA);
        if (wr == 1) PG8_BAR;
        PG8_WAIT_V(2); PG8_BAR;
        PG8_STAGE(PG8_SB(1, 0), cB + kstep, voffB); PG8_STAGE(PG8_SA(1, 0), cA + kstep, voffA); PG8_STAGE(PG8_SB(1, 1), cB + hstep + kstep, voffB);
        PG8_WAIT_V(6); PG8_BAR;
    } else {
        PG8_STAGE(PG8_SB(0, 0), cB, voffB); PG8_STAGE(PG8_SA(0, 0), cA, voffA); PG8_STAGE(PG8_SB(0, 1), cB + hstep, voffB); PG8_STAGE(PG8_SA(0, 1), cA + hstep, voffA);
        if (wr == 1) PG8_BAR;
        PG8_WAIT_V(4); PG8_BAR;
        PG8_STAGE(PG8_SB(1, 0), cB + kstep, voffB); PG8_STAGE(PG8_SA(1, 0), cA + kstep, voffA); PG8_STAGE(PG8_SB(1, 1), cB + hstep + kstep, voffB);
        PG8_WAIT_V(6); PG8_BAR;
    }
    for (;;) {
        const bool has_next = S.next(ui + 1, nxt);
        const char* nA = has_next ? (const char*)g.A + (size_t)nxt.pm * tstep : cA; const char* nB = has_next ? (const char*)g.Bt + (size_t)nxt.pn * tstep : cB;
        for (int t = 0; t < nt; t += 2) {
            const bool last = (t == nt - 2);
            const char* a1 = cA + (size_t)(t + 1) * kstep;
            const char* a2 = last ? nA : cA + (size_t)(t + 2) * kstep; const char* b2 = last ? nB : cB + (size_t)(t + 2) * kstep;
            const char* a3 = a2 + kstep; const char* b3 = b2 + kstep;
            if (last && has_next) S.a_ready(nxt);
            if constexpr (SP2) {
            PG8_LDB(B0, 0, 0); PG8_LDB(B1, 0, 1); PG8_SCHED; PG8_LDA(At, 0, 0); PG8_STAGE(PG8_SA(1, 1), a1 + hstep, voffA);
            PG8_WAIT_V(8); PG8_WAIT_L(0); PG8_BAR; PG8_MMA(0, 0, At, B0); PG8_MMA(0, 1, At, B1); PG8_BAR; PG8_SCHED;
            PG8_LDA(At, 0, 1); PG8_STAGE(PG8_SB(0, 0), b2, voffB); PG8_STAGE(PG8_SB(0, 1), b2 + hstep, voffB); PG8_STAGE(PG8_SA(0, 0), a2, voffA);
            PG8_WAIT_V(8); PG8_WAIT_L(0); PG8_BAR; PG8_MMA(1, 0, At, B0); PG8_MMA(1, 1, At, B1); PG8_BAR; PG8_SCHED;
            PG8_LDB(B0, 1, 0); PG8_LDB(B1, 1, 1); PG8_SCHED; PG8_LDA(At, 1, 0); PG8_STAGE(PG8_SA(0, 1), a2 + hstep, voffA);
            PG8_WAIT_V(8); PG8_WAIT_L(0); PG8_BAR; PG8_MMA(0, 0, At, B0); PG8_MMA(0, 1, At, B1); PG8_BAR; PG8_SCHED;
            PG8_LDA(At, 1, 1); PG8_STAGE(PG8_SB(1, 0), b3, voffB); PG8_STAGE(PG8_SB(1, 1), b3 + hstep, voffB); PG8_STAGE(PG8_SA(1, 0), a3, voffA);
            PG8_WAIT_V(8); PG8_WAIT_L(0); PG8_BAR; PG8_MMA(1, 0, At, B0); PG8_MMA(1, 1, At, B1); PG8_BAR; PG8_SCHED;
            } else {
            PG8_LDB(B0, 0, 0); PG8_SCHED; PG8_LDA(At, 0, 0); PG8_STAGE(PG8_SA(1, 1), a1 + hstep, voffA);
            PG8_WAIT_L(8); PG8_BAR; PG8_WAIT_L(0); PG8_MMA(0, 0, At, B0); PG8_BAR; PG8_SCHED;
            PG8_LDB(B1, 0, 1); PG8_STAGE(PG8_SB(0, 0), b2, voffB);
            PG8_BAR; PG8_WAIT_L(0); PG8_MMA(0, 1, At, B1); PG8_BAR;
            PG8_LDA(At, 0, 1); PG8_STAGE(PG8_SA(0, 0), a2, voffA);
            PG8_BAR; PG8_WAIT_L(0); PG8_MMA(1, 0, At, B0); PG8_BAR; PG8_SCHED;
            PG8_STAGE(PG8_SB(0, 1), b2 + hstep, voffB);
            PG8_WAIT_V(6); PG8_BAR; PG8_MMA(1, 1, At, B1); PG8_BAR;
            PG8_LDB(B0, 1, 0); PG8_SCHED; PG8_LDA(At, 1, 0); PG8_STAGE(PG8_SA(0, 1), a2 + hstep, voffA);
            PG8_WAIT_L(8); PG8_BAR; PG8_WAIT_L(0); PG8_MMA(0, 0, At, B0); PG8_BAR; PG8_SCHED;
            PG8_LDB(B1, 1, 1); PG8_STAGE(PG8_SB(1, 0), b3, voffB);
            PG8_BAR; PG8_WAIT_L(0); PG8_MMA(0, 1, At, B1); PG8_BAR;
            PG8_LDA(At, 1, 1); PG8_STAGE(PG8_SA(1, 0), a3, voffA);
            PG8_BAR; PG8_WAIT_L(0); PG8_MMA(1, 0, At, B0); PG8_BAR; PG8_SCHED;
            PG8_STAGE(PG8_SB(1, 1), b3 + hstep, voffB);
            PG8_WAIT_V(6); PG8_BAR; PG8_MMA(1, 1, At, B1); PG8_BAR;
            }
        }
        if constexpr (ALIGN_EPI) { if (wr == 0) PG8_BAR; }
        if constexpr (!Epi::AFTER_DRAIN) { E(acc, cur, wr, wc, fr, fq); S.done(cur); }
        if (!has_next) break;
#pragma unroll
        for (int a = 0; a < 2; ++a)
#pragma unroll
            for (int b = 0; b < 2; ++b)
#pragma unroll
                for (int m = 0; m < 4; ++m)
#pragma unroll
                    for (int n = 0; n < 2; ++n) acc[a][b][m][n] = (f32x4){0.f, 0.f, 0.f, 0.f};
        cur = nxt; cA = nA; cB = nB; ++ui;
        if constexpr (ALIGN_EPI) { if (wr == 1) PG8_BAR; }
    }
    PG8_WAIT_V(0);
    if constexpr (!ALIGN_EPI) { if (wr == 0) PG8_BAR; }
    PG8_BAR;
    if constexpr (Epi::AFTER_DRAIN) { E.fused(acc, cur, wr, wc, fr, fq, lds, wid, lane); S.done(cur); }
#undef PG8_SA
#undef PG8_SB
#undef PG8_STAGE
#undef PG8_LDA
#undef PG8_LDB
#undef PG8_MMA
#undef PG8_WAIT_V
#undef PG8_WAIT_L
#undef PG8_BAR
#undef PG8_SCHED
}
}
#define XB_TMO      128
#define XB_XCNT(j)  (256  + 64 * (j))
#define XB_XSUB(j)  (1280 + 64 * (j))
#define XB_XGEN(j)  (2304 + 64 * (j))
#define XB_TOP      3328
#define XB_TOPGEN   3392
#define XCD_BAR_WORDS 3456
#define XB_SPIN_CAP (1u << 18)
#define LAS __attribute__((address_space(3)))

__device__ __forceinline__ unsigned xb_ld(unsigned* p)              { return __hip_atomic_load(p, __ATOMIC_RELAXED, __HIP_MEMORY_SCOPE_AGENT); }
__device__ __forceinline__ unsigned xb_add(unsigned* p, unsigned v) { return __hip_atomic_fetch_add(p, v, __ATOMIC_RELAXED, __HIP_MEMORY_SCOPE_AGENT); }
__device__ __forceinline__ unsigned xb_xcc_id() { return (unsigned)__builtin_amdgcn_s_getreg((3 << 11) | 20) & 0xFu; }
#define XB_SPIN(cond, bar) do { unsigned _sp = 0; while (cond) { __builtin_amdgcn_s_sleep(1); \
    if ((++_sp & 255u) == 0u) { if (xb_ld(&(bar)[XB_TMO])) break; if (_sp > XB_SPIN_CAP) { atomicAdd(&(bar)[XB_TMO], 1u); break; } } } } while (0)

struct XcdBarrier {
    unsigned* bar; unsigned x;
    volatile LAS unsigned* st;
};

__device__ __forceinline__ XcdBarrier xcd_barrier_post(unsigned* bar, volatile LAS unsigned* st) {
    XcdBarrier b; b.bar = bar; b.x = xb_xcc_id(); b.st = st;
    if (threadIdx.x == 0) (void)xb_add(&bar[XB_XCNT(b.x)], 1u);
    return b;
}
__device__ __forceinline__ void xcd_barrier_complete(unsigned* bar, unsigned x, unsigned& nloc, unsigned& nx) {
    const unsigned G = gridDim.x * gridDim.y * gridDim.z;
    unsigned sum, cnt, mine, sp = 0u;
    for (;;) {
        sum = 0u; cnt = 0u; mine = 0u;
#pragma unroll
        for (unsigned j = 0; j < 16; ++j) { const unsigned c = xb_ld(&bar[XB_XCNT(j)]); sum += c; cnt += (c > 0u) ? 1u : 0u; mine = (j == x) ? c : mine; }
        if (sum == G) break;
        __builtin_amdgcn_s_sleep(1);
        if ((++sp & 255u) == 0u) { if (xb_ld(&bar[XB_TMO])) break; if (sp > XB_SPIN_CAP) { atomicAdd(&bar[XB_TMO], 1u); break; } }
    }
    nloc = mine > 0u ? mine : 1u; nx = cnt > 0u ? cnt : 1u;
}

__device__ __forceinline__ void xcd_barrier(const XcdBarrier& b) {
    asm volatile("s_waitcnt vmcnt(0)" ::: "memory");
    __syncthreads();
    if (threadIdx.x == 0) {
        unsigned* bar = b.bar;
        __builtin_amdgcn_s_waitcnt(0);
        unsigned nloc = b.st[0], nx = b.st[1];
        if (nloc == 0u) { xcd_barrier_complete(bar, b.x, nloc, nx); b.st[0] = nloc; b.st[1] = nx; }
        const unsigned old = xb_add(&bar[XB_XSUB(b.x)], 1u);
        const unsigned gen = old / nloc;
        if (old + 1u == (gen + 1u) * nloc) {
            __builtin_amdgcn_fence(__ATOMIC_RELEASE, "agent");
            asm volatile("s_waitcnt vmcnt(0)" ::: "memory");
            const unsigned og = xb_add(&bar[XB_TOP], 1u);
            const unsigned tg = og / nx;
            if (og + 1u == (tg + 1u) * nx) xb_add(&bar[XB_TOPGEN], 1u);
            else XB_SPIN(xb_ld(&bar[XB_TOPGEN]) == tg, bar);
            __builtin_amdgcn_fence(__ATOMIC_ACQUIRE, "agent");
            xb_add(&bar[XB_XGEN(b.x)], 1u);
            asm volatile("s_waitcnt vmcnt(0)" ::: "memory");
        } else {
            XB_SPIN(xb_ld(&bar[XB_XGEN(b.x)]) == gen, bar);
            __builtin_amdgcn_fence(__ATOMIC_ACQUIRE, "agent");
            asm volatile("s_waitcnt vmcnt(0)" ::: "memory");
        }
    }
    __syncthreads();
}

constexpr bool GEMM_SP2 = true, GEMM_ALIGN = true;
using pg8::bf16_t; using pg8::f32x4; using pg8::u32x4; using pg8::bf16x8; using pg8::cvt_pk_bf16; using pg8::Unit; using pg8::HALF; using pg8::BM;
typedef unsigned u32x2 __attribute__((ext_vector_type(2)));
constexpr int T_ = 32768, D_ = 1024, SEQ_ = 8192, NB_ = 4, INC_ = 3080, PJ_ = 3072, FF_ = 2816, PLE_ = 256, NCH_ = 128;
constexpr float EPS_ = 1e-6f;
constexpr int NTHREADS = 512;
constexpr int LDS_BYTES = 144 * 1024;

constexpr size_t WS_WIN = 4096;
constexpr size_t WS_WOUT = WS_WIN + (size_t)PJ_ * D_ * 2;
constexpr size_t WS_WGU = WS_WOUT + (size_t)D_ * D_ * 2;
constexpr size_t WS_WD = WS_WGU + (size_t)2 * FF_ * D_ * 2;
constexpr size_t WS_WPG = WS_WD + (size_t)D_ * FF_ * 2;
constexpr size_t WS_WPP = WS_WPG + (size_t)D_ * D_ * 2;
constexpr size_t WS_LOGITS = WS_WPP + (size_t)D_ * PLE_ * 2;
constexpr size_t WS_PB = WS_LOGITS + (size_t)T_ * 8 * 4;
constexpr size_t WS_SSA = WS_PB + (size_t)T_ * PLE_ * 2;
constexpr size_t WS_SSB = WS_SSA + (size_t)T_ * 16 * 4;
constexpr size_t WS_PTOT = WS_SSB + (size_t)T_ * 16 * 4;
constexpr size_t WS_HEND = WS_PTOT + (size_t)NB_ * NCH_ * 512 * 4;
constexpr size_t WS_CARRY = WS_HEND + (size_t)NB_ * NCH_ * 512 * 4;
constexpr size_t WS_GTOT = WS_CARRY + (size_t)NB_ * NCH_ * 512 * 4;
constexpr size_t WS_XB = WS_GTOT + 8192;
constexpr size_t WS_PROJ = WS_XB + (size_t)T_ * D_ * 2;
constexpr size_t WS_R4 = WS_PROJ + (size_t)T_ * PJ_ * 2;
constexpr size_t WS_Y = WS_XB;
constexpr size_t WS_XB2 = WS_R4;
constexpr size_t WS_PP = WS_R4 + (size_t)T_ * D_ * 2;
constexpr size_t WS_ORAW = WS_R4 + (size_t)2048 * 73728;
constexpr size_t WS_BAR = WS_R4 + (size_t)2048 * 73728 + (size_t)T_ * 512 * 2;
constexpr size_t WS_RGW = WS_BAR + 16384;
constexpr size_t WS_END = WS_RGW + 131072;

struct Params {
    const float* in[25];
    float* out; unsigned char* ws;
    int ph_lo, ph_hi;
};

__device__ __forceinline__ float bf2f(bf16_t b) { return __uint_as_float(((unsigned)b) << 16); }
__device__ __forceinline__ bf16_t f2bf(float f) { return (bf16_t)(cvt_pk_bf16(f, 0.f) & 0xffffu); }
__device__ __forceinline__ float sigmoidf_(float x) { return __builtin_amdgcn_rcpf(1.0f + __expf(-x)); }
__device__ __forceinline__ float siluf_(float x) { return x * __builtin_amdgcn_rcpf(1.0f + __expf(-x)); }
__device__ __forceinline__ float softplusf_(float x) { return fmaxf(x, 0.f) + log1pf(__expf(-fabsf(x))); }
__device__ __forceinline__ float gelu_tanhf_(float x) { const float u = 0.7978845608028654f * (x + 0.044715f * x * x * x); return x * __builtin_amdgcn_rcpf(1.0f + __expf(-2.0f * u)); }
__device__ __forceinline__ float rstd16(const float* ss, int r) {
    const f32x4 a = *(const f32x4*)(ss + (size_t)r * 16), b = *(const f32x4*)(ss + (size_t)r * 16 + 4), c = *(const f32x4*)(ss + (size_t)r * 16 + 8), d = *(const f32x4*)(ss + (size_t)r * 16 + 12);
    const float s = ((a[0] + a[1]) + (a[2] + a[3])) + ((b[0] + b[1]) + (b[2] + b[3])) + ((c[0] + c[1]) + (c[2] + c[3])) + ((d[0] + d[1]) + (d[2] + d[3]));
    return rsqrtf(s * (1.0f / 1024.0f) + EPS_);
}

template <int CTRL> __device__ __forceinline__ float dpp_f(float x) { return __int_as_float(__builtin_amdgcn_update_dpp(0, __float_as_int(x), CTRL, 0xf, 0xf, false)); }
__device__ __forceinline__ float red8(float x) { x += dpp_f<0xB1>(x); x += dpp_f<0x4E>(x); x += dpp_f<0x141>(x); return x; }
struct EpiBf16Plain {
    static constexpr bool PERM = true, AFTER_DRAIN = false;
    bf16_t* O; int ldc;
    __device__ __forceinline__ void operator()(const f32x4 (&acc)[2][2][4][2], const Unit& u, int wr, int wc, int fr, int fq) const {
        int row0 = u.pm * BM + wr * 64 + fr; asm volatile("" : "+v"(row0)); const int col0 = u.pn * BM + wc * 32 + 8 * fq;
#pragma unroll
        for (int ai = 0; ai < 2; ++ai)
#pragma unroll
            for (int m = 0; m < 4; ++m) { bf16_t* rowp = O + (size_t)(row0 + ai * HALF + m * 16) * ldc + col0;
#pragma unroll
                for (int bj = 0; bj < 2; ++bj) { const f32x4 v0 = acc[ai][bj][m][0], v1 = acc[ai][bj][m][1]; u32x4 w; w.x = cvt_pk_bf16(v0[0], v0[1]); w.y = cvt_pk_bf16(v0[2], v0[3]); w.z = cvt_pk_bf16(v1[0], v1[1]); w.w = cvt_pk_bf16(v1[2], v1[3]);
                    *(u32x4*)(rowp + bj * HALF) = w; } }
    }
};
__device__ __forceinline__ void rstd8(const float* ss, int row0, int fq, float (&rs)[8]) {
    f32x4 t[8];
#pragma unroll
    for (int g = 0; g < 8; ++g) t[g] = *(const f32x4*)(ss + (size_t)(row0 + (g >> 2) * HALF + (g & 3) * 16) * 16 + 4 * fq);
#pragma unroll
    for (int g = 0; g < 8; ++g) { float sm = (t[g][0] + t[g][1]) + (t[g][2] + t[g][3]); sm += __shfl_xor(sm, 16); sm += __shfl_xor(sm, 32); rs[g] = rsqrtf(sm * (1.0f / 1024.0f) + EPS_); }
    asm volatile("" ::: "memory");
}
template <bool RES_BF16>
struct EpiResid {
    static constexpr bool PERM = true, AFTER_DRAIN = false;
    const float* res; bf16_t* xb; float* ss;
    __device__ __forceinline__ void operator()(const f32x4 (&acc)[2][2][4][2], const Unit& u, int wr, int wc, int fr, int fq) const {
        int row0 = u.pm * BM + wr * 64 + fr; asm volatile("" : "+v"(row0)); const int col0 = u.pn * BM + wc * 32 + 8 * fq;
        const unsigned e0 = (unsigned)row0 * D_ + col0;
#pragma unroll
        for (int ai = 0; ai < 2; ++ai) {
            constexpr int NB = 4;
#pragma unroll
            for (int mh = 0; mh < 4 / NB; ++mh) {
                f32x4 rv[NB][2][2];
#pragma unroll
                for (int mm = 0; mm < NB; ++mm)
#pragma unroll
                    for (int bj = 0; bj < 2; ++bj) { const unsigned e = e0 + (unsigned)((ai * HALF + (mh * NB + mm) * 16) * D_ + bj * HALF);
                        if (RES_BF16) { const u32x4 w = *(const u32x4*)((const char*)xb + (size_t)(e * 2u));
                            rv[mm][bj][0] = (f32x4){__uint_as_float(w.x << 16), __uint_as_float(w.x & 0xffff0000u), __uint_as_float(w.y << 16), __uint_as_float(w.y & 0xffff0000u)};
                            rv[mm][bj][1] = (f32x4){__uint_as_float(w.z << 16), __uint_as_float(w.z & 0xffff0000u), __uint_as_float(w.w << 16), __uint_as_float(w.w & 0xffff0000u)}; }
                        else { rv[mm][bj][0] = *(const f32x4*)((const char*)res + (size_t)(e * 4u)); rv[mm][bj][1] = *(const f32x4*)((const char*)res + (size_t)(e * 4u) + 16); } }
#pragma unroll
                for (int mm = 0; mm < NB; ++mm) { const int m = mh * NB + mm, r = row0 + ai * HALF + m * 16; float s = 0.f;
#pragma unroll
                    for (int bj = 0; bj < 2; ++bj) { const unsigned e = e0 + (unsigned)((ai * HALF + m * 16) * D_ + bj * HALF);
                        const f32x4 v0 = rv[mm][bj][0] + acc[ai][bj][m][0], v1 = rv[mm][bj][1] + acc[ai][bj][m][1];
                        s += ((v0[0] * v0[0] + v0[1] * v0[1]) + (v0[2] * v0[2] + v0[3] * v0[3])) + ((v1[0] * v1[0] + v1[1] * v1[1]) + (v1[2] * v1[2] + v1[3] * v1[3]));
                        u32x4 w; w.x = cvt_pk_bf16(v0[0], v0[1]); w.y = cvt_pk_bf16(v0[2], v0[3]); w.z = cvt_pk_bf16(v1[0], v1[1]); w.w = cvt_pk_bf16(v1[2], v1[3]); *(u32x4*)((char*)xb + (size_t)(e * 2u)) = w; }
                    s += __shfl_xor(s, 16); s += __shfl_xor(s, 32);
                    if (fq == 0) ss[(size_t)r * 16 + u.pn * 4 + wc] = s; }
                asm volatile("" ::: "memory"); } }
    }
};
struct EpiGateUp {
    static constexpr bool PERM = true, AFTER_DRAIN = false;
    bf16_t* ff; const float* ss;
    __device__ __forceinline__ void operator()(const f32x4 (&acc)[2][2][4][2], const Unit& u, int wr, int wc, int fr, int fq) const {
        int row0 = u.pm * BM + wr * 64 + fr; asm volatile("" : "+v"(row0)); const int col0 = u.pn * HALF + wc * 32 + 8 * fq;
        float rsv[8]; rstd8(ss, row0, fq, rsv);
#pragma unroll
        for (int ai = 0; ai < 2; ++ai)
#pragma unroll
            for (int m = 0; m < 4; ++m) { const int r = row0 + ai * HALF + m * 16; const float rs = rsv[ai * 4 + m];
                float o[8];
#pragma unroll
                for (int n = 0; n < 2; ++n)
#pragma unroll
                    for (int j = 0; j < 4; ++j) { const float g = acc[ai][0][m][n][j] * rs, up = acc[ai][1][m][n][j] * rs; o[n * 4 + j] = siluf_(g) * up; }
                u32x4 w; w.x = cvt_pk_bf16(o[0], o[1]); w.y = cvt_pk_bf16(o[2], o[3]); w.z = cvt_pk_bf16(o[4], o[5]); w.w = cvt_pk_bf16(o[6], o[7]);
                *(u32x4*)(ff + (size_t)r * FF_ + col0) = w; }
    }
};
struct EpiPle {
    static constexpr bool PERM = true, AFTER_DRAIN = false;
    const bf16_t* x2b; bf16_t* x3b; const bf16_t* pp; const float* bias; const float* ss_in; float* ss_out;
    __device__ __forceinline__ void operator()(const f32x4 (&acc)[2][2][4][2], const Unit& u, int wr, int wc, int fr, int fq) const {
        int row0 = u.pm * BM + wr * 64 + fr; asm volatile("" : "+v"(row0)); const int col0 = u.pn * BM + wc * 32 + 8 * fq;
        const unsigned b0 = ((unsigned)row0 * D_ + col0) * 2u;
        const unsigned s0 = (unsigned)row0 * 64u;
        u32x4 X[2][2], P[2][2]; f32x4 S[2];
#define EP_LOAD(set, g) do { const unsigned ro_ = (unsigned)(((g) >> 2) * HALF + ((g) & 3) * 16); \
        _Pragma("unroll") for (int bj = 0; bj < 2; ++bj) { const unsigned bo_ = b0 + (ro_ * D_ + bj * HALF) * 2u; \
            X[set][bj] = *(const u32x4*)((const char*)x2b + (size_t)bo_); P[set][bj] = *(const u32x4*)((const char*)pp + (size_t)bo_); } \
        S[set] = *(const f32x4*)((const char*)ss_in + (size_t)(s0 + ro_ * 64u + (unsigned)fq * 16u)); } while (0)
        f32x4 bv[2][2];
#pragma unroll
        for (int bj = 0; bj < 2; ++bj)
#pragma unroll
            for (int n = 0; n < 2; ++n) bv[bj][n] = *(const f32x4*)(bias + col0 + bj * HALF + 4 * n);
        EP_LOAD(0, 0);
#pragma unroll
        for (int g = 0; g < 8; ++g) { const int ai = g >> 2, m = g & 3, st = g & 1, r = row0 + ai * HALF + m * 16;
            if (g < 7) EP_LOAD((g + 1) & 1, g + 1);
            float sm = (S[st][0] + S[st][1]) + (S[st][2] + S[st][3]); sm += __shfl_xor(sm, 16); sm += __shfl_xor(sm, 32);
            const float rs = rsqrtf(sm * (1.0f / 1024.0f) + EPS_); float s = 0.f;
#pragma unroll
            for (int bj = 0; bj < 2; ++bj) { const unsigned bo = b0 + (unsigned)(((ai * HALF + m * 16) * D_ + bj * HALF) * 2); const u32x4 pw = P[st][bj], xw = X[st][bj];
                const unsigned pwa[4] = {pw.x, pw.y, pw.z, pw.w}, xwa[4] = {xw.x, xw.y, xw.z, xw.w}; unsigned ow[4];
#pragma unroll
                for (int n = 0; n < 2; ++n) { const f32x4 a = acc[ai][bj][m][n]; const f32x4 bb = bv[bj][n];
#pragma unroll
                    for (int hh = 0; hh < 2; ++hh) { const unsigned xq = xwa[2 * n + hh], pq = pwa[2 * n + hh];
                        const float v0 = __uint_as_float(xq << 16) + sigmoidf_(a[2 * hh] * rs + bb[2 * hh]) * __uint_as_float(pq << 16);
                        const float v1 = __uint_as_float(xq & 0xffff0000u) + sigmoidf_(a[2 * hh + 1] * rs + bb[2 * hh + 1]) * __uint_as_float(pq & 0xffff0000u);
                        ow[2 * n + hh] = cvt_pk_bf16(v0, v1); s += v0 * v0 + v1 * v1; } }
                *(u32x4*)((char*)x3b + (size_t)bo) = (u32x4){ow[0], ow[1], ow[2], ow[3]}; }
            s += __shfl_xor(s, 16); s += __shfl_xor(s, 32);
            if (fq == 0) ss_out[(size_t)r * 16 + u.pn * 4 + wc] = s;
            asm volatile("" ::: "memory"); }
#undef EP_LOAD
    }
};

template <class Epi> __device__ __forceinline__ void run_gemm(PG8_LAS unsigned char* lds, const bf16_t* A, const bf16_t* Bt, int M, int N, int K, const Epi& E) {
    pg8::Gemm g; g.A = A; g.Bt = Bt; g.M = M; g.N = N; g.K = K;
    pg8::StaticOrder S; S.init(M, N, (int)gridDim.x, (int)blockIdx.x);
    pg8::gemm_phase<Epi, pg8::StaticOrder, GEMM_ALIGN, GEMM_SP2>(lds, g, S, E);
}

__device__ void prep_transpose(const float* __restrict__ W, int K, int ldw, int c0, int ncols, bf16_t* __restrict__ Wt, const float* __restrict__ ks, int mode, float* tile, int rot, int widx, int nw) {
    const int tid = threadIdx.x, nkt = K / 64, nct = ncols / 64, ntiles = nkt * nct;
    for (int tt = (widx + nw - (rot % nw)) % nw; tt < ntiles; tt += nw) {
        const int kt = tt / nct, ct = tt % nct, k0 = kt * 64, n0 = ct * 64;
        __syncthreads();
#pragma unroll
        for (int i = 0; i < 2; ++i) { const int r = (tid >> 4) + 32 * i, c4 = (tid & 15) * 4; const f32x4 v = *(const f32x4*)(W + (size_t)(k0 + r) * ldw + c0 + n0 + c4);
            const float s = ks ? ks[k0 + r] : 1.0f; tile[r * 65 + c4 + 0] = v[0] * s; tile[r * 65 + c4 + 1] = v[1] * s; tile[r * 65 + c4 + 2] = v[2] * s; tile[r * 65 + c4 + 3] = v[3] * s; }
        __syncthreads();
        const int n = tid >> 3, kseg = (tid & 7) * 8; float v[8];
#pragma unroll
        for (int e = 0; e < 8; ++e) v[e] = tile[(kseg + e) * 65 + n];
        u32x4 w; w.x = cvt_pk_bf16(v[0], v[1]); w.y = cvt_pk_bf16(v[2], v[3]); w.z = cvt_pk_bf16(v[4], v[5]); w.w = cvt_pk_bf16(v[6], v[7]);
        const int f = n0 + n; const int drow = (mode == 0) ? f : (256 * (f >> 7) + 128 * (mode - 1) + (f & 127));
        *(u32x4*)(Wt + (size_t)drow * K + k0 + kseg) = w;
    }
}


__device__ __forceinline__ void prep_weights_late(const Params& p, unsigned char* smem, int widx, int nw) {
    unsigned char* ws = p.ws; float* tile = (float*)smem;
    __syncthreads();
    prep_transpose(p.in[15], D_, D_, 0, D_, (bf16_t*)(ws + WS_WOUT), nullptr, 0, tile, 0, widx, nw);
    prep_transpose(p.in[17], D_, FF_, 0, FF_, (bf16_t*)(ws + WS_WGU), p.in[16], 1, tile, 256, widx, nw);
    prep_transpose(p.in[18], D_, FF_, 0, FF_, (bf16_t*)(ws + WS_WGU), p.in[16], 2, tile, 960, widx, nw);
    prep_transpose(p.in[19], FF_, D_, 0, D_, (bf16_t*)(ws + WS_WD), nullptr, 0, tile, 1664, widx, nw);
    prep_transpose(p.in[21], D_, D_, 0, D_, (bf16_t*)(ws + WS_WPG), p.in[20], 0, tile, 2368, widx, nw);
}

__device__ __forceinline__ void phase_prep(const Params& p, unsigned char* smem) {
    const int tid = threadIdx.x, wid = __builtin_amdgcn_readfirstlane(tid >> 6), lane = tid & 63;
    unsigned char* ws = p.ws;
    float* tile = (float*)smem;
    float* w8s = (float*)(smem + 20480);
    if (blockIdx.x == 0 && tid < 32) ((unsigned*)ws)[tid] = 0u;
    prep_transpose(p.in[3], D_, INC_, 0, PJ_, (bf16_t*)(ws + WS_WIN), nullptr, 0, tile, 0, (int)blockIdx.x, (int)gridDim.x);
    prep_transpose(p.in[23], PLE_, D_, 0, D_, (bf16_t*)(ws + WS_WPP), nullptr, 0, tile, 768, (int)blockIdx.x, (int)gridDim.x);
    if (blockIdx.x < 8) {
        const int hh = blockIdx.x;
        for (int item = tid; item < 1024; item += NTHREADS) { const int gate = item >> 9, fragi = (item >> 6) & 7, ln = item & 63, ntf = fragi >> 1, ksf = fragi & 1, n16f = ln & 15, fqf = ln >> 4;
            const float* wsrc = p.in[gate ? 8 : 6] + (size_t)(hh * 64 + 32 * ksf + 8 * fqf) * 64 + 16 * ntf + n16f;
            const f32x4 lo = {wsrc[0], wsrc[64], wsrc[128], wsrc[192]}, hi = {wsrc[256], wsrc[320], wsrc[384], wsrc[448]};
            u32x4 w; w.x = cvt_pk_bf16(lo[0], lo[1]); w.y = cvt_pk_bf16(lo[2], lo[3]); w.z = cvt_pk_bf16(hi[0], hi[1]); w.w = cvt_pk_bf16(hi[2], hi[3]);
            *(u32x4*)(ws + WS_RGW + ((size_t)((hh * 2 + gate) * 8 + fragi) * 64 + ln) * 16) = w; }
    }
    for (int i = tid; i < 1024 * 8; i += NTHREADS) { const int k = i >> 3, j = i & 7; w8s[i] = p.in[2][k] * p.in[3][(size_t)k * INC_ + PJ_ + j]; }
    __syncthreads();
    {
        const float* x = p.in[0]; const float* nw = p.in[2]; bf16_t* hb = (bf16_t*)(ws + WS_XB); float* logits = (float*)(ws + WS_LOGITS);
        f32x4 nwv[4];
#pragma unroll
        for (int i = 0; i < 4; ++i) nwv[i] = *(const f32x4*)(nw + 4 * (lane + 64 * i));
        f32x4 vn[4]; int row = blockIdx.x * 8 + wid;
        if (row < T_) {
#pragma unroll
            for (int i = 0; i < 4; ++i) vn[i] = *(const f32x4*)(x + (size_t)row * D_ + 4 * (lane + 64 * i)); }
        for (; row < T_; row += gridDim.x * 8) {
            f32x4 v[4]; float s = 0.f;
#pragma unroll
            for (int i = 0; i < 4; ++i) { v[i] = vn[i]; s += (v[i][0] * v[i][0] + v[i][1] * v[i][1]) + (v[i][2] * v[i][2] + v[i][3] * v[i][3]); }
            { const int nrow = row + gridDim.x * 8;
              if (nrow < T_) {
#pragma unroll
                for (int i = 0; i < 4; ++i) vn[i] = *(const f32x4*)(x + (size_t)nrow * D_ + 4 * (lane + 64 * i)); } }
            s = red8(s); s += dpp_f<0x140>(s); s += __shfl_xor(s, 16); s += __shfl_xor(s, 32);
            const float rs = rsqrtf(s * (1.0f / 1024.0f) + EPS_);
            float lg[8];
#pragma unroll
            for (int j = 0; j < 8; ++j) lg[j] = 0.f;
#pragma unroll
            for (int i = 0; i < 4; ++i) {
                const int k0 = 4 * (lane + 64 * i);
#pragma unroll
                for (int e = 0; e < 4; ++e) { const f32x4 wa = *(const f32x4*)(w8s + (k0 + e) * 8), wb = *(const f32x4*)(w8s + (k0 + e) * 8 + 4); const float xv = v[i][e];
                    lg[0] += xv * wa[0]; lg[1] += xv * wa[1]; lg[2] += xv * wa[2]; lg[3] += xv * wa[3]; lg[4] += xv * wb[0]; lg[5] += xv * wb[1]; lg[6] += xv * wb[2]; lg[7] += xv * wb[3]; }
                const f32x4 h = v[i] * rs * nwv[i]; u32x2 w; w.x = cvt_pk_bf16(h[0], h[1]); w.y = cvt_pk_bf16(h[2], h[3]);
                *(u32x2*)(hb + (size_t)row * D_ + k0) = w;
            }
            const bool b5 = (lane & 32) != 0, b4 = (lane & 16) != 0, b3 = (lane & 8) != 0;
            float k4[4], k2[2];
#pragma unroll
            for (int j = 0; j < 4; ++j) { const float send = b5 ? lg[j] : lg[j + 4]; const float keep = b5 ? lg[j + 4] : lg[j]; k4[j] = keep + __shfl_xor(send, 32); }
#pragma unroll
            for (int j = 0; j < 2; ++j) { const float send = b4 ? k4[j] : k4[j + 2]; const float keep = b4 ? k4[j + 2] : k4[j]; k2[j] = keep + __shfl_xor(send, 16); }
            float k1; { const float send = b3 ? k2[0] : k2[1]; const float keep = b3 ? k2[1] : k2[0]; k1 = keep + __shfl_xor(send, 8); }
            k1 = red8(k1);
            if ((lane & 7) == 0) logits[(size_t)row * 8 + ((lane >> 5) & 1) * 4 + ((lane >> 4) & 1) * 2 + ((lane >> 3) & 1)] = k1 * rs;
        }
    }
    {
        const f32x4* src = (const f32x4*)p.in[1]; u32x2* dst = (u32x2*)(ws + WS_PB); const size_t n4 = (size_t)T_ * PLE_ / 4;
        for (size_t i = (size_t)blockIdx.x * NTHREADS + tid; i < n4; i += (size_t)gridDim.x * NTHREADS) { const f32x4 v = src[i]; u32x2 w; w.x = cvt_pk_bf16(v[0], v[1]); w.y = cvt_pk_bf16(v[2], v[3]); dst[i] = w; }
    }
}
__device__ __forceinline__ bf16x8 pack8(const f32x4 a, const f32x4 b) { u32x4 w; w.x = cvt_pk_bf16(a[0], a[1]); w.y = cvt_pk_bf16(a[2], a[3]); w.z = cvt_pk_bf16(b[0], b[1]); w.w = cvt_pk_bf16(b[2], b[3]); return __builtin_bit_cast(bf16x8, w); }
#define MFMA16(a, b, c) __builtin_amdgcn_mfma_f32_16x16x32_bf16((a), (b), (c), 0, 0, 0)
__device__ __forceinline__ float neg_expm1_small(float x, float ehalf) {
    const float ps = -x * (1.0f + x * (0.5f + x * (0.16666667f + x * (0.041666668f + x * (0.008333334f + x * 0.0013888889f)))));
    return (x > -0.25f) ? ps : (1.0f - ehalf * ehalf);
}
template <bool FINAL>
__device__ __forceinline__ void rg_pass_mfma(const Params& p, unsigned char* smem, int widx, int nworkers) {
    const int tid = threadIdx.x, wid = __builtin_amdgcn_readfirstlane(tid >> 6), lane = tid & 63, n16o = lane & 15, fqo = lane >> 4, c = wid * 64 + lane;
    unsigned char* ws = p.ws;
    const bf16_t* proj = (const bf16_t*)(ws + WS_PROJ);
    float* U = (float*)smem + wid * 4352;
    float* ptot = (float*)(ws + WS_PTOT); float* hend = (float*)(ws + WS_HEND); const float* carry = (const float*)(ws + WS_CARRY);
    bf16_t* y = (bf16_t*)(ws + WS_Y);
    bf16x8 Bx[4][2], Ba[4][2];
#pragma unroll
    for (int nt = 0; nt < 4; ++nt)
#pragma unroll
        for (int ks = 0; ks < 2; ++ks) { const unsigned char* fb = ws + WS_RGW + ((size_t)(wid * 16 + nt * 2 + ks) * 64 + lane) * 16;
            Bx[nt][ks] = *(const bf16x8*)fb; Ba[nt][ks] = *(const bf16x8*)(fb + 8 * 64 * 16); }
    const float cw0 = p.in[4][c], cw1 = p.in[4][512 + c], cw2 = p.in[4][1024 + c], cw3 = p.in[4][1536 + c], cb = p.in[5][c];
    float bxv[4], bav[4], spv[4];
#pragma unroll
    for (int nt = 0; nt < 4; ++nt) { const int cgl = wid * 64 + 16 * nt + n16o; bxv[nt] = p.in[7][cgl]; bav[nt] = p.in[9][cgl]; spv[nt] = softplusf_(-p.in[10][cgl]); }
    for (int unit = widx; unit < NB_ * NCH_; unit += nworkers) {
        const int n = unit & (NCH_ - 1); const size_t t0 = (size_t)unit * 64;
        float xm3 = 0.f, xm2 = 0.f, xm1 = 0.f;
        if (n != 0) { xm3 = bf2f(proj[(t0 - 3) * PJ_ + c]); xm2 = bf2f(proj[(t0 - 2) * PJ_ + c]); xm1 = bf2f(proj[(t0 - 1) * PJ_ + c]); }
        __syncthreads();
        { bf16_t xr[16]; const bf16_t* xp0 = proj + t0 * PJ_ + c;
#pragma unroll
          for (int i = 0; i < 16; ++i) xr[i] = xp0[(size_t)i * PJ_];
#pragma unroll
          for (int tb = 0; tb < 4; ++tb) { bf16_t xn[16]; const bf16_t* xp = proj + (t0 + (tb + 1) * 16) * PJ_ + c;
            if (tb < 3) {
#pragma unroll
                for (int i = 0; i < 16; ++i) xn[i] = xp[(size_t)i * PJ_]; }
#pragma unroll
            for (int i = 0; i < 16; ++i) { const float xv = bf2f(xr[i]); U[(16 * ((i >> 2) & 3) + 4 * tb + (i & 3)) * 68 + lane] = cw0 * xm3 + cw1 * xm2 + cw2 * xm1 + cw3 * xv + cb; xm3 = xm2; xm2 = xm1; xm1 = xv; }
            if (tb < 3) {
#pragma unroll
                for (int i = 0; i < 16; ++i) xr[i] = xn[i]; } } }
        __syncthreads();
        const bf16_t* gub = proj + t0 * PJ_ + 512; bf16_t* yub = y + t0 * D_;
#pragma unroll
        for (int nt = 0; nt < 4; ++nt) {
            asm volatile("" ::: "memory");
            int lane_o = lane; asm volatile("" : "+v"(lane_o));
            const int n16 = lane_o & 15, fq = lane_o >> 4;
            const int chl = 16 * nt + n16, cgl = wid * 64 + chl;
            bf16x8 Af[4][2];
#pragma unroll
            for (int mt = 0; mt < 4; ++mt)
#pragma unroll
                for (int ks = 0; ks < 2; ++ks) { const float* up = U + (16 * mt + n16) * 68 + 32 * ks + 8 * fq; Af[mt][ks] = pack8(*(const f32x4*)up, *(const f32x4*)(up + 4)); }

            bf16_t gr[16];
            if (FINAL) {
#pragma unroll
                for (int i = 0; i < 16; ++i) gr[i] = gub[(16 * fq + i) * PJ_ + cgl]; }
            f32x4 ax[4], aa[4];
#pragma unroll
            for (int mt = 0; mt < 4; ++mt) { ax[mt] = (f32x4){bxv[nt], bxv[nt], bxv[nt], bxv[nt]}; aa[mt] = (f32x4){bav[nt], bav[nt], bav[nt], bav[nt]}; }
#pragma unroll
            for (int mt = 0; mt < 4; ++mt)
#pragma unroll
                for (int ks = 0; ks < 2; ++ks) { ax[mt] = MFMA16(Af[mt][ks], Bx[nt][ks], ax[mt]); aa[mt] = MFMA16(Af[mt][ks], Ba[nt][ks], aa[mt]); }
            float av[16], bv[16]; float hl = 0.f, Pl = 1.f;
#pragma unroll
            for (int i = 0; i < 16; ++i) { const int mt = i >> 2, j = i & 3, tok = 16 * fq + i; const float u = U[(16 * mt + 4 * fq + j) * 68 + chl];
                const float gx = sigmoidf_(ax[mt][j]), gg = sigmoidf_(aa[mt][j]); const float la = -8.0f * gg * spv[nt]; const float a = __expf(la);
                float mult = sqrtf(fmaxf(neg_expm1_small(2.0f * la, a), 0.f)); if (n == 0 && tok == 0) mult = 1.0f;
                av[i] = a; bv[i] = u * gx * mult; hl = a * hl + bv[i]; Pl *= a; }
            float Pg[4], Hg[4];
#pragma unroll
            for (int g = 0; g < 4; ++g) { Pg[g] = __shfl(Pl, n16 + 16 * g); Hg[g] = __shfl(hl, n16 + 16 * g); }
            if (FINAL) {
                float h = carry[(size_t)unit * 512 + cgl];
#pragma unroll
                for (int g = 0; g < 3; ++g) if (g < fq) h = Pg[g] * h + Hg[g];
#pragma unroll
                for (int i = 0; i < 16; ++i) { h = av[i] * h + bv[i]; yub[(16 * fq + i) * D_ + cgl] = f2bf(h * gelu_tanhf_(bf2f(gr[i]))); }
            } else {
                float cc = 0.f, Pp = 1.f;
#pragma unroll
                for (int g = 0; g < 4; ++g) { cc = Pg[g] * cc + Hg[g]; Pp *= Pg[g]; }
                if (fq == 0) { ptot[(size_t)unit * 512 + cgl] = Pp; hend[(size_t)unit * 512 + cgl] = cc; }
            }
        }
    }
}

__device__ __forceinline__ void rg_carry(const Params& p, int idx) {
    unsigned char* ws = p.ws; const float* ptot = (const float*)(ws + WS_PTOT); const float* hend = (const float*)(ws + WS_HEND); float* carry = (float*)(ws + WS_CARRY);
    const int b = idx >> 9, c = idx & 511; float hc = 0.f;
    for (int n0 = 0; n0 < NCH_; n0 += 8) { float P[8], H[8];
#pragma unroll
        for (int i = 0; i < 8; ++i) { const size_t o = (size_t)(b * NCH_ + n0 + i) * 512 + c; P[i] = ptot[o]; H[i] = hend[o]; }
#pragma unroll
        for (int i = 0; i < 8; ++i) { const size_t o = (size_t)(b * NCH_ + n0 + i) * 512 + c; carry[o] = hc; hc = P[i] * hc + H[i]; } }
}

constexpr int GU_BYTES = 73728, GU_KDT = 32768, GU_QK = 49152, GU_U = 57344;
typedef float f32x2_ __attribute__((ext_vector_type(2)));
__device__ __forceinline__ int tok_of_pos(int p) { return 16 * (2 * (p >> 5) + ((p >> 2) & 1)) + 4 * ((p >> 3) & 3) + (p & 3); }
__device__ __forceinline__ void unpack8(const u32x4 w, float* f) { f[0] = __uint_as_float(w.x << 16); f[1] = __uint_as_float(w.x & 0xffff0000u); f[2] = __uint_as_float(w.y << 16); f[3] = __uint_as_float(w.y & 0xffff0000u);
    f[4] = __uint_as_float(w.z << 16); f[5] = __uint_as_float(w.z & 0xffff0000u); f[6] = __uint_as_float(w.w << 16); f[7] = __uint_as_float(w.w & 0xffff0000u); }

__device__ __forceinline__ void gdn_pass_a(const Params& p, unsigned char* smem) {
    const int tid = threadIdx.x, wid = __builtin_amdgcn_readfirstlane(tid >> 6);
    unsigned char* ws = p.ws; const bf16_t* proj = (const bf16_t*)(ws + WS_PROJ); const float* logits = (const float*)(ws + WS_LOGITS); float* gtot = (float*)(ws + WS_GTOT);
    bf16_t* Kb = (bf16_t*)smem; bf16_t* Qb = (bf16_t*)(smem + 17408); bf16_t* VBt = (bf16_t*)(smem + 34816); bf16_t* KBGt = (bf16_t*)(smem + 53248);
    float* Lsw = (float*)(smem + 71680); bf16_t* Tb = (bf16_t*)(smem + 89088); float* gcs = (float*)(smem + 98304); float* betas = gcs + 64; float* kdec = gcs + 128;
    const int lane0 = tid & 63, tg0 = tid >> 5, ch0 = (tid & 31) * 4;
    for (int ub = blockIdx.x * 8; ub < 2048; ub += gridDim.x * 8) {
        const int bh = ub >> 7, b = bh >> 2, h = bh & 3;
        const float Aexp = __expf(p.in[12][h]), dtb = p.in[13][h];
        float cw[3][4][4];
#pragma unroll
        for (int a = 0; a < 3; ++a)
#pragma unroll
            for (int j = 0; j < 4; ++j) { const f32x4 w = *(const f32x4*)(p.in[11] + (size_t)j * 1536 + a * 512 + h * 128 + ch0); cw[a][j][0] = w[0]; cw[a][j][1] = w[1]; cw[a][j][2] = w[2]; cw[a][j][3] = w[3]; }
        u32x2 pre[3][7]; float lgb, lga;
#define GA_PREFETCH(unit_) do { const int n_ = (unit_) & 127; const size_t t0_ = (size_t)b * SEQ_ + (size_t)n_ * 64; \
        lgb = logits[(t0_ + lane0) * 8 + h]; lga = logits[(t0_ + lane0) * 8 + 4 + h]; \
        _Pragma("unroll") for (int r = 0; r < 7; ++r) { const int sp_ = n_ * 64 + 4 * tg0 - 3 + r; \
            _Pragma("unroll") for (int a = 0; a < 3; ++a) pre[a][r] = (sp_ >= 0) ? *(const u32x2*)(proj + ((size_t)b * SEQ_ + sp_) * PJ_ + 1024 + a * 512 + h * 128 + ch0) : (u32x2){0u, 0u}; } } while (0)
        GA_PREFETCH(ub);
        for (int k = 0; k < 8; ++k) {
            const int unit = ub + k, n = unit & 127;
            int tid_o = tid; asm volatile("" : "+v"(tid_o));
            const int lane = tid_o & 63, r16 = lane & 15, kq = lane >> 4, cg4 = tid_o & 31, tg = tid_o >> 5, ch = cg4 * 4;
            unsigned char* gbase = ws + WS_R4 + (size_t)unit * GU_BYTES;
            const float betav = sigmoidf_(lgb);
            float gc = -Aexp * softplusf_(lga + dtb);
#pragma unroll
            for (int o = 1; o < 64; o <<= 1) { const float tmp = __shfl_up(gc, o); if (lane >= o) gc += tmp; }
            const float gclast = __shfl(gc, 63);
            if (wid == 0) { gcs[lane] = gc; betas[lane] = betav; kdec[lane] = __expf(gclast - gc); }
            {
                float x[7][4], o[4][4], bt[4], egt[4];
#pragma unroll
                for (int t = 0; t < 4; ++t) { bt[t] = __shfl(betav, 4 * tg + t); egt[t] = __expf(__shfl(gc, 4 * tg + t)); }
#pragma unroll
                for (int a = 0; a < 3; ++a) {
#pragma unroll
                    for (int r = 0; r < 7; ++r) { x[r][0] = __uint_as_float(pre[a][r].x << 16); x[r][1] = __uint_as_float(pre[a][r].x & 0xffff0000u); x[r][2] = __uint_as_float(pre[a][r].y << 16); x[r][3] = __uint_as_float(pre[a][r].y & 0xffff0000u); }
#pragma unroll
                    for (int t = 0; t < 4; ++t)
#pragma unroll
                        for (int e = 0; e < 4; ++e) { float acc = cw[a][0][e] * x[t][e]; acc += cw[a][1][e] * x[t + 1][e]; acc += cw[a][2][e] * x[t + 2][e]; acc += cw[a][3][e] * x[t + 3][e]; o[t][e] = siluf_(acc); }
                    if (a < 2) {
#pragma unroll
                        for (int t = 0; t < 4; ++t) { float ssq = (o[t][0] * o[t][0] + o[t][1] * o[t][1]) + (o[t][2] * o[t][2] + o[t][3] * o[t][3]);
                            ssq += dpp_f<0xB1>(ssq); ssq += dpp_f<0x4E>(ssq); ssq += dpp_f<0x141>(ssq); ssq += dpp_f<0x140>(ssq); ssq += __shfl_xor(ssq, 16);
                            const float rs = rsqrtf(ssq + EPS_) * (a == 0 ? 0.08838834764831845f : 1.0f);
#pragma unroll
                            for (int e = 0; e < 4; ++e) o[t][e] *= rs; }
                    }
                    if (a == 0) {
#pragma unroll
                        for (int t = 0; t < 4; ++t) { const int tok = 4 * tg + t; u32x2 w; w.x = cvt_pk_bf16(o[t][0], o[t][1]); w.y = cvt_pk_bf16(o[t][2], o[t][3]); *(u32x2*)(Qb + tok * 136 + ch) = w;
                            u32x2 wd; wd.x = cvt_pk_bf16(o[t][0] * egt[t], o[t][1] * egt[t]); wd.y = cvt_pk_bf16(o[t][2] * egt[t], o[t][3] * egt[t]);
                            *(u32x2*)((bf16_t*)gbase + (size_t)(64 + tok) * 128 + 32 * (cg4 >> 3) + 8 * (cg4 & 3) + 4 * ((cg4 >> 2) & 1)) = wd; }
                    } else if (a == 1) {
#pragma unroll
                        for (int t = 0; t < 4; ++t) { const int tok = 4 * tg + t; u32x2 w; w.x = cvt_pk_bf16(o[t][0], o[t][1]); w.y = cvt_pk_bf16(o[t][2], o[t][3]); *(u32x2*)(Kb + tok * 136 + ch) = w; }
#pragma unroll
                        for (int e = 0; e < 4; ++e) { u32x2 w; w.x = cvt_pk_bf16(o[0][e] * bt[0] * egt[0], o[1][e] * bt[1] * egt[1]); w.y = cvt_pk_bf16(o[2][e] * bt[2] * egt[2], o[3][e] * bt[3] * egt[3]); *(u32x2*)(KBGt + (ch + e) * 72 + (((tg >> 1) ^ (cg4 & 7)) << 3) + 4 * (tg & 1)) = w; }
                    } else {
#pragma unroll
                        for (int e = 0; e < 4; ++e) { u32x2 w; w.x = cvt_pk_bf16(o[0][e] * bt[0], o[1][e] * bt[1]); w.y = cvt_pk_bf16(o[2][e] * bt[2], o[3][e] * bt[3]); *(u32x2*)(VBt + (ch + e) * 72 + (((tg >> 1) ^ (cg4 & 7)) << 3) + 4 * (tg & 1)) = w; }
                    }
                }
            }
            if (k + 1 < 8) GA_PREFETCH(unit + 1);
            __syncthreads();
#pragma unroll
            for (int rep = 0; rep < 2; ++rep) {
                const int tl = wid + 8 * rep, jt = tl >> 2, it = tl & 3;
                f32x4 accQ = {0.f, 0.f, 0.f, 0.f}, accK = {0.f, 0.f, 0.f, 0.f};
#pragma unroll
                for (int ks = 0; ks < 4; ++ks) { const bf16x8 a = *(const bf16x8*)(Kb + (16 * jt + r16) * 136 + 32 * ks + 8 * kq);
                    const bf16x8 bq = *(const bf16x8*)(Qb + (16 * it + r16) * 136 + 32 * ks + 8 * kq), bk = *(const bf16x8*)(Kb + (16 * it + r16) * 136 + 32 * ks + 8 * kq);
                    accQ = MFMA16(a, bq, accQ); accK = MFMA16(a, bk, accK); }
                const int i = 16 * it + r16; const float gi = gcs[i], bi = betas[i]; float qv[4];
#pragma unroll
                for (int jj = 0; jj < 4; ++jj) { const int j = 16 * jt + 4 * kq + jj; const float d = __expf(fminf(gi - gcs[j], 0.f));
                    qv[jj] = (i >= j) ? accQ[jj] * d : 0.f; Lsw[i * 68 + (j & 7) * 8 + (j >> 3)] = (i > j) ? bi * accK[jj] * d : 0.f; }
                u32x2 w; w.x = cvt_pk_bf16(qv[0], qv[1]); w.y = cvt_pk_bf16(qv[2], qv[3]);
                *(u32x2*)((bf16_t*)(gbase + GU_QK) + i * 64 + 32 * (jt >> 1) + 8 * kq + 4 * (jt & 1)) = w;
            }
            __syncthreads();
            {
                const int s = lane & 7, c = 8 * wid + (lane >> 3); float t[8];
#pragma unroll
                for (int m = 0; m < 8; ++m) t[m] = 0.f;
                f32x4 la[2][2]; la[0][0] = *(const f32x4*)(Lsw + s * 8); la[0][1] = *(const f32x4*)(Lsw + s * 8 + 4);
#pragma unroll
                for (int i = 0; i < 64; ++i) {
                    if (i + 1 < 64) { la[(i + 1) & 1][0] = *(const f32x4*)(Lsw + (i + 1) * 68 + s * 8); la[(i + 1) & 1][1] = *(const f32x4*)(Lsw + (i + 1) * 68 + s * 8 + 4); }
                    asm volatile("" ::: "memory");
                    const f32x4 l0 = la[i & 1][0], l1 = la[i & 1][1];
                    float part = 0.f;
#pragma unroll
                    for (int m = 0; m < 8; ++m) if (8 * m <= i) part += ((m < 4) ? l0[m & 3] : l1[m & 3]) * t[m];
                    part = red8(part);
                    const float val = ((i == c) ? 1.0f : 0.0f) - part;
                    if (s == (i & 7)) t[i >> 3] = val;
                }
#pragma unroll
                for (int m = 0; m < 8; ++m) Tb[(8 * m + s) * 72 + c] = f2bf(t[m]);
            }
            __syncthreads();
            {
#pragma unroll
                for (int mt = 0; mt < 4; ++mt) { f32x4 acc = {0.f, 0.f, 0.f, 0.f};
#pragma unroll
                    for (int ks = 0; ks < 2; ++ks) { const bf16x8 a = *(const bf16x8*)(Tb + (16 * mt + r16) * 72 + 32 * ks + 8 * kq), bb = *(const bf16x8*)(VBt + (16 * wid + r16) * 72 + (((4 * ks + kq) ^ ((4 * wid + (r16 >> 2)) & 7)) << 3)); acc = MFMA16(a, bb, acc); }
                    u32x2 w; w.x = cvt_pk_bf16(acc[0], acc[1]); w.y = cvt_pk_bf16(acc[2], acc[3]);
                    *(u32x2*)((bf16_t*)(gbase + GU_U) + ((wid * 4 + mt) * 64 + lane) * 4) = w; }
#pragma unroll
                for (int it = 0; it < 4; ++it) { f32x4 acc = {0.f, 0.f, 0.f, 0.f};
#pragma unroll
                    for (int ks = 0; ks < 2; ++ks) { const bf16x8 a = *(const bf16x8*)(KBGt + (16 * wid + r16) * 72 + (((4 * ks + kq) ^ ((4 * wid + (r16 >> 2)) & 7)) << 3)), bb = *(const bf16x8*)(Tb + (16 * it + r16) * 72 + 32 * ks + 8 * kq); acc = MFMA16(a, bb, acc); }
                    u32x2 w; w.x = cvt_pk_bf16(acc[0], acc[1]); w.y = cvt_pk_bf16(acc[2], acc[3]);
                    *(u32x2*)((bf16_t*)gbase + (16 * it + r16) * 128 + 32 * (wid >> 1) + 8 * kq + 4 * (wid & 1)) = w; }
                const int dk = tid_o >> 2, pg = tid_o & 3; float v[16];
#pragma unroll
                for (int e = 0; e < 16; ++e) { const int tk = tok_of_pos(16 * pg + e); v[e] = bf2f(Kb[tk * 136 + dk]) * kdec[tk]; }
                u32x4 w0, w1; w0.x = cvt_pk_bf16(v[0], v[1]); w0.y = cvt_pk_bf16(v[2], v[3]); w0.z = cvt_pk_bf16(v[4], v[5]); w0.w = cvt_pk_bf16(v[6], v[7]);
                w1.x = cvt_pk_bf16(v[8], v[9]); w1.y = cvt_pk_bf16(v[10], v[11]); w1.z = cvt_pk_bf16(v[12], v[13]); w1.w = cvt_pk_bf16(v[14], v[15]);
                *(u32x4*)((bf16_t*)(gbase + GU_KDT) + dk * 64 + 16 * pg) = w0; *(u32x4*)((bf16_t*)(gbase + GU_KDT) + dk * 64 + 16 * pg + 8) = w1;
                if (tid == 0) gtot[unit] = __expf(gclast);
            }
            __syncthreads();
        }
    }
#undef GA_PREFETCH
}

constexpr int GB_BUF = 62464, GB_KDT = 34816, GB_QK = 53248, GB_BUF2 = GB_BUF + 4096 + 16;
__device__ __forceinline__ void gdn_pass_b(const Params& p, unsigned char* smem, int wg) {
    const int tid = threadIdx.x, wid = __builtin_amdgcn_readfirstlane(tid >> 6), lane = tid & 63, r16 = lane & 15, kq = lane >> 4;
    const int bh = wg >> 2, cgp = wg & 3, b = bh >> 2, h = bh & 3, nt = cgp * 2 + wid;
    unsigned char* ws = p.ws; const unsigned char* ubase = ws + WS_R4 + (size_t)(bh * 128) * GU_BYTES; const float* gtot = (const float*)(ws + WS_GTOT) + bh * 128;
    bf16_t* oraw = (bf16_t*)(ws + WS_ORAW);
#define GB_BAR() do { asm volatile("s_waitcnt lgkmcnt(0)" ::: "memory"); __builtin_amdgcn_s_barrier(); asm volatile("" ::: "memory"); } while (0)
    if (wid >= 2) {
        const int lt = tid - 128;
        int dsto[10]; size_t srco[10];
#pragma unroll
        for (int it = 0; it < 10; ++it) { const int q = lt + 384 * it;
            dsto[it] = (q < 2048) ? (q >> 4) * 272 + (q & 15) * 16 : (q < 3072) ? GB_KDT + ((q - 2048) >> 3) * 144 + ((q - 2048) & 7) * 16 : (q < 3584) ? GB_QK + ((q - 3072) >> 3) * 144 + ((q - 3072) & 7) * 16 : GB_BUF + (q - 3584) * 16;
            srco[it] = (q < 3584) ? (size_t)q * 16 : (size_t)(GU_U + cgp * 4096 + (q - 3584) * 16); }
        u32x4 sa[10], sb[10], sc[10]; float ga = 0.f, gb = 0.f, gc = 0.f;
#define GB_LD(st, g, n_) do { const unsigned char* rp_ = ubase + (size_t)(n_) * GU_BYTES; _Pragma("unroll") for (int it = 0; it < 10; ++it) st[it] = *(const u32x4*)(rp_ + srco[it]); if (lt == 0) g = gtot[n_]; } while (0)
#define GB_WR(st, g, bufi) do { unsigned char* bp_ = smem + (bufi) * GB_BUF2; _Pragma("unroll") for (int it = 0; it < 10; ++it) *(u32x4*)(bp_ + dsto[it]) = st[it]; if (lt == 0) *(float*)(bp_ + GB_BUF + 4096) = g; } while (0)
        GB_LD(sa, ga, 0); GB_WR(sa, ga, 0); GB_BAR();
        GB_LD(sa, ga, 1); GB_LD(sb, gb, 2); GB_LD(sc, gc, 3);
        for (int n0 = 0; n0 < NCH_; n0 += 3) {
            { const int n = n0;     if (n < NCH_) { if (n + 1 < NCH_) GB_WR(sa, ga, (n + 1) & 1); if (n + 4 < NCH_) GB_LD(sa, ga, n + 4); GB_BAR(); } }
            { const int n = n0 + 1; if (n < NCH_) { if (n + 1 < NCH_) GB_WR(sb, gb, (n + 1) & 1); if (n + 4 < NCH_) GB_LD(sb, gb, n + 4); GB_BAR(); } }
            { const int n = n0 + 2; if (n < NCH_) { if (n + 1 < NCH_) GB_WR(sc, gc, (n + 1) & 1); if (n + 4 < NCH_) GB_LD(sc, gc, n + 4); GB_BAR(); } }
        }
#undef GB_LD
#undef GB_WR
    } else {
        __builtin_amdgcn_s_setprio(3);
        f32x4 S[8]; bf16x8 Sb[4];
#pragma unroll
        for (int d = 0; d < 8; ++d) S[d] = (f32x4){0.f, 0.f, 0.f, 0.f};
#pragma unroll
        for (int k = 0; k < 4; ++k) Sb[k] = (bf16x8){0, 0, 0, 0, 0, 0, 0, 0};
        GB_BAR();
        for (int n = 0; n < NCH_; ++n) {
            const unsigned char* L = smem + (n & 1) * GB_BUF2; const float gt = *(const float*)(L + GB_BUF + 4096); const size_t t0 = (size_t)b * SEQ_ + (size_t)n * 64;
            u32x2 uw[4];
#pragma unroll
            for (int tt = 0; tt < 4; ++tt) uw[tt] = *(const u32x2*)(L + GB_BUF + ((wid * 4 + tt) * 64 + lane) * 8);
            f32x4 P[8];
#pragma unroll
            for (int m = 0; m < 8; ++m) P[m] = (f32x4){0.f, 0.f, 0.f, 0.f};
#pragma unroll
            for (int ks = 0; ks < 4; ++ks)
#pragma unroll
                for (int mt = 0; mt < 8; ++mt) { const bf16x8 a = *(const bf16x8*)(L + (16 * mt + r16) * 272 + (32 * ks + 8 * kq) * 2); P[mt] = MFMA16(a, Sb[ks], P[mt]); }
            f32x4 vn[4];
#pragma unroll
            for (int tt = 0; tt < 4; ++tt) { const f32x4 u = {__uint_as_float(uw[tt].x << 16), __uint_as_float(uw[tt].x & 0xffff0000u), __uint_as_float(uw[tt].y << 16), __uint_as_float(uw[tt].y & 0xffff0000u)}; vn[tt] = u - P[tt]; }
            bf16x8 Vb[2]; Vb[0] = pack8(vn[0], vn[1]); Vb[1] = pack8(vn[2], vn[3]);
#pragma unroll
            for (int tt = 0; tt < 4; ++tt) { f32x4 O = P[4 + tt];
#pragma unroll
                for (int ks = 0; ks < 2; ++ks) { const bf16x8 a = *(const bf16x8*)(L + GB_QK + (16 * tt + r16) * 144 + (32 * ks + 8 * kq) * 2); O = MFMA16(a, Vb[ks], O); }
                bf16_t* op = oraw + (t0 + 16 * tt + 4 * kq) * 512 + h * 128 + 16 * nt + r16;
#pragma unroll
                for (int j = 0; j < 4; ++j) op[(size_t)j * 512] = f2bf(O[j]); }
#pragma unroll
            for (int dt = 0; dt < 8; ++dt) { f32x4 acc = S[dt] * gt;
#pragma unroll
                for (int ks = 0; ks < 2; ++ks) { const bf16x8 a = *(const bf16x8*)(L + GB_KDT + (16 * dt + r16) * 144 + (32 * ks + 8 * kq) * 2); acc = MFMA16(a, Vb[ks], acc); }
                S[dt] = acc; }
#pragma unroll
            for (int ks = 0; ks < 4; ++ks) Sb[ks] = pack8(S[2 * ks], S[2 * ks + 1]);
            GB_BAR();
        }
        __builtin_amdgcn_s_setprio(0);
    }
#undef GB_BAR
}

__device__ __forceinline__ void gdn_norm(const Params& p) {
    unsigned char* ws = p.ws; const bf16_t* oraw = (const bf16_t*)(ws + WS_ORAW); const bf16_t* proj = (const bf16_t*)(ws + WS_PROJ); bf16_t* y = (bf16_t*)(ws + WS_Y);
    int tid_o = threadIdx.x; asm volatile("" : "+v"(tid_o));
    const int gtid = blockIdx.x * NTHREADS + tid_o, sub = gtid & 15;
    const f32x4 nw0 = *(const f32x4*)(p.in[14] + sub * 8), nw1 = *(const f32x4*)(p.in[14] + sub * 8 + 4);
    const int stride = (gridDim.x * NTHREADS) >> 4;
    for (int item0 = gtid >> 4; item0 < T_ * 4; item0 += 4 * stride) {
        u32x4 ow[4], zw[4];
#pragma unroll
        for (int q = 0; q < 4; ++q) { const int item = item0 + q * stride; const int t = item >> 2, h = item & 3;
            if (item < T_ * 4) { ow[q] = *(const u32x4*)(oraw + (size_t)t * 512 + h * 128 + sub * 8); zw[q] = *(const u32x4*)(proj + (size_t)t * PJ_ + 2560 + h * 128 + sub * 8); } else { ow[q] = (u32x4){0u, 0u, 0u, 0u}; zw[q] = (u32x4){0u, 0u, 0u, 0u}; } }
#pragma unroll
        for (int q = 0; q < 4; ++q) { const int item = item0 + q * stride; const int t = item >> 2, h = item & 3;
            float ov[8], zv[8]; unpack8(ow[q], ov); unpack8(zw[q], zv);
            float s = ((ov[0] * ov[0] + ov[1] * ov[1]) + (ov[2] * ov[2] + ov[3] * ov[3])) + ((ov[4] * ov[4] + ov[5] * ov[5]) + (ov[6] * ov[6] + ov[7] * ov[7]));
#pragma unroll
            for (int o = 1; o < 16; o <<= 1) s += __shfl_xor(s, o);
            const float rs = rsqrtf(s * (1.0f / 128.0f) + EPS_);
            u32x4 w; w.x = cvt_pk_bf16(ov[0] * rs * nw0[0] * siluf_(zv[0]), ov[1] * rs * nw0[1] * siluf_(zv[1])); w.y = cvt_pk_bf16(ov[2] * rs * nw0[2] * siluf_(zv[2]), ov[3] * rs * nw0[3] * siluf_(zv[3]));
            w.z = cvt_pk_bf16(ov[4] * rs * nw1[0] * siluf_(zv[4]), ov[5] * rs * nw1[1] * siluf_(zv[5])); w.w = cvt_pk_bf16(ov[6] * rs * nw1[2] * siluf_(zv[6]), ov[7] * rs * nw1[3] * siluf_(zv[7]));
            if (item < T_ * 4) *(u32x4*)(y + (size_t)t * D_ + 512 + h * 128 + sub * 8) = w; }
    }
}

__device__ __forceinline__ void phase_final(const Params& p) {
    const int tid = threadIdx.x, wid = __builtin_amdgcn_readfirstlane(tid >> 6), lane = tid & 63;
    const float* ss = (const float*)(p.ws + WS_SSA); const float* nw = p.in[24]; float* out = p.out; const bf16_t* x3b = (const bf16_t*)(p.ws + WS_XB);
    f32x4 nwv[4];
#pragma unroll
    for (int i = 0; i < 4; ++i) nwv[i] = *(const f32x4*)(nw + 4 * (lane + 64 * i));
    u32x2 wn[4]; int row = blockIdx.x * 8 + wid;
    if (row < T_) {
#pragma unroll
        for (int i = 0; i < 4; ++i) wn[i] = *(const u32x2*)(x3b + (size_t)row * D_ + 4 * (lane + 64 * i)); }
    for (; row < T_; row += gridDim.x * 8) {
        const float rs = rstd16(ss, row);
        u32x2 wc[4];
#pragma unroll
        for (int i = 0; i < 4; ++i) wc[i] = wn[i];
        { const int nrow = row + gridDim.x * 8;
          if (nrow < T_) {
#pragma unroll
            for (int i = 0; i < 4; ++i) wn[i] = *(const u32x2*)(x3b + (size_t)nrow * D_ + 4 * (lane + 64 * i)); } }
#pragma unroll
        for (int i = 0; i < 4; ++i) { const u32x2 w = wc[i]; const f32x4 v = {__uint_as_float(w.x << 16), __uint_as_float(w.x & 0xffff0000u), __uint_as_float(w.y << 16), __uint_as_float(w.y & 0xffff0000u)};
            __builtin_nontemporal_store(v * rs * nwv[i], (f32x4*)(out + (size_t)row * D_ + 4 * (lane + 64 * i))); }
    }
}

constexpr int NPHASES = 11;
__global__ void __launch_bounds__(NTHREADS, 2) mega_fwd(Params p) {
    extern __shared__ __attribute__((aligned(16))) unsigned char smem[];
    PG8_LAS unsigned char* lds = (PG8_LAS unsigned char*)smem;
    cg::grid_group grid = cg::this_grid();
    unsigned char* ws = p.ws;
    bf16_t* hb = (bf16_t*)(ws + WS_XB); bf16_t* xb = (bf16_t*)(ws + WS_XB2); bf16_t* proj = (bf16_t*)(ws + WS_PROJ); bf16_t* ff = proj; bf16_t* y = (bf16_t*)(ws + WS_Y); bf16_t* pp = (bf16_t*)p.out;
    float* ssA = (float*)(ws + WS_SSA); float* ssB = (float*)(ws + WS_SSB);
#ifdef ONLY_PHASE
#define PH_ON(n) ((n) == ONLY_PHASE)
#else
#define PH_ON(n) ((n) >= p.ph_lo && (n) < p.ph_hi)
#endif
    volatile LAS unsigned* xst = (volatile LAS unsigned*)(lds + LDS_BYTES - 16);
    if (threadIdx.x == 0) { xst[0] = 0u; xst[1] = 0u; xst[2] = 0u; xst[3] = 0u; }
    __syncthreads();
    const XcdBarrier xbar = xcd_barrier_post((unsigned*)(ws + WS_BAR), xst);
    if (p.ph_lo == 0x7fffffff) grid.sync();
#define PH_SYNC(n) do { if ((n) > p.ph_lo && (n) < p.ph_hi) { xcd_barrier(xbar); } } while (0)
    if (PH_ON(0)) phase_prep(p, smem);
    PH_SYNC(1);
    if (PH_ON(1)) { EpiBf16Plain E; E.O = proj; E.ldc = PJ_; run_gemm(lds, hb, (const bf16_t*)(ws + WS_WIN), T_, PJ_, D_, E); }
    PH_SYNC(2);
    if (PH_ON(2)) { rg_pass_mfma<false>(p, smem, (int)blockIdx.x, (int)gridDim.x); __syncthreads(); gdn_pass_a(p, smem); }
    PH_SYNC(3);
    if (PH_ON(3)) {
        unsigned* flag = (unsigned*)ws + 16;
        if (blockIdx.x < 64) { const int xq = blockIdx.x & 7, kq8 = blockIdx.x >> 3;
            gdn_pass_b(p, smem, ((xq + 8 * (kq8 >> 2)) << 2) | (kq8 & 3)); }
        else {
            if (blockIdx.x < 68) { rg_carry(p, (blockIdx.x - 64) * NTHREADS + threadIdx.x); __threadfence(); __syncthreads();
                if (threadIdx.x == 0) __hip_atomic_fetch_add(flag, 1u, __ATOMIC_RELEASE, __HIP_MEMORY_SCOPE_AGENT); }
            prep_weights_late(p, smem, (int)blockIdx.x - 64, (int)gridDim.x - 64);
            if (threadIdx.x == 0) { while (__hip_atomic_load(flag, __ATOMIC_ACQUIRE, __HIP_MEMORY_SCOPE_AGENT) < 4u) __builtin_amdgcn_s_sleep(8); }
            __syncthreads(); __threadfence();
            rg_pass_mfma<true>(p, smem, (int)blockIdx.x - 64, (int)gridDim.x - 64);
            __syncthreads();
            { EpiBf16Plain E2; E2.O = pp; E2.ldc = D_; pg8::Gemm g2; g2.A = (const bf16_t*)(ws + WS_PB); g2.Bt = (const bf16_t*)(ws + WS_WPP); g2.M = T_; g2.N = D_; g2.K = PLE_;
              pg8::StaticOrder S2; S2.init(T_, D_, (int)gridDim.x - 64, (int)blockIdx.x - 64); pg8::gemm_phase<EpiBf16Plain, pg8::StaticOrder, GEMM_ALIGN, GEMM_SP2>(lds, g2, S2, E2); }
        }
    }
    PH_SYNC(4);
    if (PH_ON(4)) gdn_norm(p);
    PH_SYNC(5);
    if (PH_ON(5)) { EpiResid<false> E; E.res = p.in[0]; E.xb = xb; E.ss = ssA; run_gemm(lds, y, (const bf16_t*)(ws + WS_WOUT), T_, D_, D_, E); }
    PH_SYNC(6);
    if (PH_ON(6)) { EpiGateUp E; E.ff = ff; E.ss = ssA; run_gemm(lds, xb, (const bf16_t*)(ws + WS_WGU), T_, 2 * FF_, D_, E); }
    PH_SYNC(7);
    if (PH_ON(7)) { EpiResid<true> E; E.res = nullptr; E.xb = xb; E.ss = ssB; run_gemm(lds, ff, (const bf16_t*)(ws + WS_WD), T_, D_, FF_, E); }
    PH_SYNC(8);
    if (PH_ON(8)) { EpiPle E; E.x2b = xb; E.x3b = hb; E.pp = pp; E.bias = p.in[22]; E.ss_in = ssB; E.ss_out = ssA; run_gemm(lds, xb, (const bf16_t*)(ws + WS_WPG), T_, D_, D_, E); }
    PH_SYNC(9);
    if (PH_ON(9)) phase_final(p);
}

extern "C" void kernel_launch(void* const* d_in, const int* in_sizes, int n_in, void* d_out, int out_size, void* d_ws, size_t ws_size, hipStream_t stream) {
    static int grid = 0;
    if (grid == 0) {
        if (n_in != 25 || out_size != T_ * D_ || ws_size < WS_END) { fprintf(stderr, "kernel_launch: unexpected shapes: n_in %d out %d ws %zu (need %zu)\n", n_in, out_size, ws_size, (size_t)WS_END); grid = -1; return; }
        int dev = 0, cus = 0, per_cu = 0;
        hipGetDevice(&dev); hipDeviceGetAttribute(&cus, hipDeviceAttributeMultiprocessorCount, dev);
        if (hipFuncSetAttribute((const void*)mega_fwd, hipFuncAttributeMaxDynamicSharedMemorySize, LDS_BYTES) != hipSuccess) { fprintf(stderr, "kernel_launch: hipFuncSetAttribute failed\n"); grid = -1; return; }
        if (hipOccupancyMaxActiveBlocksPerMultiprocessor(&per_cu, (const void*)mega_fwd, NTHREADS, LDS_BYTES) != hipSuccess || per_cu < 1) { fprintf(stderr, "kernel_launch: occupancy query says %d\n", per_cu); per_cu = 1; }
        (void)hipGetLastError();
        grid = cus * 1;
        if (grid <= 0) grid = 256;
    }
    if (grid < 0) return;
    Params p{};
    for (int i = 0; i < 25; ++i) p.in[i] = (const float*)d_in[i];
    p.out = (float*)d_out; p.ws = (unsigned char*)d_ws; p.ph_lo = 0; p.ph_hi = NPHASES;
    if (hipMemsetAsync((char*)d_ws + WS_BAR, 0, XCD_BAR_WORDS * 4, stream) != hipSuccess) { fprintf(stderr, "kernel_launch: memset of the barrier words failed\n"); return; }
    void* args[] = {&p};
    hipError_t e = hipLaunchCooperativeKernel((const void*)mega_fwd, dim3(grid), dim3(NTHREADS), args, LDS_BYTES, stream);
    if (e != hipSuccess) fprintf(stderr, "cooperative launch failed: %s (grid %d)\n", hipGetErrorString(e), grid);
}
```
